# Optimizing an MI355X kernel written in HIP

```python
import jax, jax.numpy as jnp
from jax import lax
import numpy as np

D_MODEL = 1024
BATCH = 8
SEQ = 2048
DEPTH = 4
DEC_BATCH = 128
DEC_SEQ = 1
PAST_LEN = 16384
PAGE_SIZE = 128

BRANCH_W = D_MODEL // 2
N_BRANCH = 3
CONV_W = 3
CONV_GROUPS = 8
CHUNK = 128
SGU_HEADS = 8
SGU_HEAD_DIM = BRANCH_W // SGU_HEADS
POOL_WINDOWS = (2, 4, 8, 16)
POOL_GROUPS = len(POOL_WINDOWS)
POOL_GROUP_DIM = BRANCH_W // POOL_GROUPS
POOL_BUF = max(POOL_WINDOWS) - 1
EPS = 1e-6
IN_SIZES = (BRANCH_W, BRANCH_W, BRANCH_W, BRANCH_W,
            BRANCH_W, BRANCH_W, BRANCH_W,
            BRANCH_W, BRANCH_W,
            D_MODEL, D_MODEL, D_MODEL)
IN_COLS = sum(IN_SIZES)
IN_SPLITS = [int(s) for s in np.cumsum(IN_SIZES)[:-1]]

kernel_name = 'hybrid_conv_sgu_pool_decoder_step'


def _rmsnorm(x, g):
    xf = x.astype(jnp.float32)
    y = xf * lax.rsqrt(jnp.mean(xf * xf, axis=-1, keepdims=True) + EPS)
    return (y * g.astype(jnp.float32)).astype(x.dtype)


def _layernorm(x, g, b):
    xf = x.astype(jnp.float32)
    mu = jnp.mean(xf, axis=-1, keepdims=True)
    var = jnp.mean(jnp.square(xf - mu), axis=-1, keepdims=True)
    y = (xf - mu) * lax.rsqrt(var + EPS)
    return (y * g.astype(jnp.float32) + b.astype(jnp.float32)).astype(x.dtype)


def _short_conv(z, prev, w, b):
    T = z.shape[1]
    full = jnp.concatenate([prev.astype(z.dtype), z], axis=1)
    out = b + sum(full[:, k:k + T] * w[k] for k in range(CONV_W))
    return out, full[:, -(CONV_W - 1):]


def _spatial_gate(u, v, ws, bs):
    N, T, Wd = v.shape
    L = CHUNK if T >= CHUNK else T
    nc = -(-T // L)
    vp = jnp.pad(v, ((0, 0), (0, nc * L - T), (0, 0)))
    vr = vp.reshape(N, nc, L, SGU_HEADS, SGU_HEAD_DIM)
    mask = jnp.tril(jnp.ones((L, L), dtype=bool))
    ws_m = jnp.where(mask, ws[:, :L, :L], jnp.zeros((), ws.dtype))
    mixed = jnp.einsum('hts,ncshd->ncthd', ws_m, vr) + jnp.transpose(bs[:, :L])[:, :, None]
    mixed = mixed.reshape(N, nc * L, Wd)[:, :T]
    return u * mixed


def _multiscale_pool(xc, prev, start):
    N, T, Wd = xc.shape
    full = jnp.concatenate([prev.astype(xc.dtype), xc], axis=1)
    fullf = full.astype(jnp.float32)
    cs = jnp.concatenate([jnp.zeros((N, 1, Wd), jnp.float32), jnp.cumsum(fullf, axis=1)], axis=1)
    pos = start + jnp.arange(T)
    outs = []
    for g, w in enumerate(POOL_WINDOWS):
        sl = slice(g * POOL_GROUP_DIM, (g + 1) * POOL_GROUP_DIM)
        s = cs[:, POOL_BUF + 1:, sl] - cs[:, POOL_BUF + 1 - w:POOL_BUF + 1 - w + T, sl]
        cnt = jnp.minimum(w, pos + 1).astype(jnp.float32)[None, :, None]
        outs.append(s / cnt)
    pooled = jnp.concatenate(outs, axis=-1)
    mixed = (pooled - xc.astype(jnp.float32)).astype(xc.dtype)
    return mixed, full[:, -POOL_BUF:]


def _layer(x, c, start, conv_prev, pool_prev, w_ada, b_ada, norm_g, w_in, conv_w, conv_b,
           lnv_g, lnv_b, sgu_w, sgu_b, pool_w, pool_b, pool_scale, w_branch, w_out):
    N, T, _ = x.shape
    mod = jax.nn.silu(c) @ w_ada + b_ada
    shift, scale, gate = jnp.split(mod[:, None, :], 3, axis=-1)
    h = _rmsnorm(x, norm_g) * (1 + scale) + shift
    p = h @ w_in
    a_b, a_c, a_h, a_g, b_u, b_v, b_g, c_x, c_g, m_a, m_b, m_c = jnp.split(p, IN_SPLITS, axis=-1)
    conv_out, conv_new = _short_conv(a_c * a_h, conv_prev, conv_w, conv_b)
    y_a = a_b * conv_out * jax.nn.silu(a_g)
    u = jax.nn.gelu(b_u)
    v = _layernorm(jax.nn.gelu(b_v), lnv_g, lnv_b)
    y_b = _spatial_gate(u, v, sgu_w, sgu_b) * jax.nn.silu(b_g)
    v_new = v[:, ((T - 1) // CHUNK) * CHUNK:]
    pm, pool_new = _multiscale_pool(c_x, pool_prev, start)
    y_c = jnp.einsum('ntgi,gio->ntgo', pm.reshape(N, T, POOL_GROUPS, POOL_GROUP_DIM), pool_w)
    y_c = (y_c.reshape(N, T, BRANCH_W) + pool_b) * pool_scale * jax.nn.silu(c_g)
    merged = (jax.nn.sigmoid(m_a) * (y_a @ w_branch[0])
              + jax.nn.sigmoid(m_b) * (y_b @ w_branch[1])
              + jax.nn.sigmoid(m_c) * (y_c @ w_branch[2]))
    x = x + gate * (merged @ w_out)
    return x, conv_new, pool_new, v_new


def setup_inputs(seed: int = 0) -> dict:
    key = jax.random.key(seed)
    ks = jax.random.split(key, 24)
    nrm = lambda k, s, sc: jax.random.normal(k, s, jnp.float32) * sc
    D, W = D_MODEL, BRANCH_W
    return {
        'x_prompt': nrm(ks[0], (BATCH, SEQ, D), 1.0),
        'x_sample': nrm(ks[1], (DEC_BATCH, DEC_SEQ, D), 1.0),
        'c_prompt': nrm(ks[2], (BATCH, D), 1.0),
        'c_sample': nrm(ks[3], (DEC_BATCH, D), 1.0),
        'state_conv': nrm(ks[4], (DEPTH, DEC_BATCH, CONV_W - 1, W), 1.0),
        'state_pool': nrm(ks[5], (DEPTH, DEC_BATCH, POOL_BUF, W), 1.0),
        'w_ada': nrm(ks[6], (DEPTH, D, 3 * D), 0.5 * D ** -0.5),
        'b_ada': nrm(ks[7], (DEPTH, 3 * D), 0.02),
        'norm_g': 1.0 + nrm(ks[8], (DEPTH, D), 0.02),
        'w_in': nrm(ks[9], (DEPTH, D, IN_COLS), D ** -0.5),
        'conv_w': nrm(ks[10], (DEPTH, CONV_W, W), CONV_W ** -0.5),
        'conv_b': nrm(ks[11], (DEPTH, W), 0.02),
        'lnv_g': 1.0 + nrm(ks[12], (DEPTH, W), 0.02),
        'lnv_b': nrm(ks[13], (DEPTH, W), 0.02),
        'sgu_w': nrm(ks[14], (DEPTH, SGU_HEADS, CHUNK, CHUNK), CHUNK ** -0.5),
        'sgu_b': 1.0 + nrm(ks[15], (DEPTH, SGU_HEADS, CHUNK), 0.02),
        'pool_w': nrm(ks[16], (DEPTH, POOL_GROUPS, POOL_GROUP_DIM, POOL_GROUP_DIM), POOL_GROUP_DIM ** -0.5),
        'pool_b': nrm(ks[17], (DEPTH, W), 0.02),
        'pool_scale': 1.0 + nrm(ks[18], (DEPTH, W), 0.1),
        'w_branch': nrm(ks[19], (DEPTH, N_BRANCH, W, D), W ** -0.5),
        'w_out': nrm(ks[20], (DEPTH, D, D), D ** -0.5),
        'final_g': 1.0 + nrm(ks[21], (D,), 0.02),
    }


def reference(x_prompt, x_sample, c_prompt, c_sample, state_conv, state_pool, w_ada, b_ada, norm_g,
              w_in, conv_w, conv_b, lnv_g, lnv_b, sgu_w, sgu_b, pool_w, pool_b, pool_scale,
              w_branch, w_out, final_g):
    xp, xs = x_prompt, x_sample
    conv_p, conv_s, pool_p, pool_s, v_p, v_s = [], [], [], [], [], []
    zero_conv = jnp.zeros((xp.shape[0], CONV_W - 1, BRANCH_W), xp.dtype)
    zero_pool = jnp.zeros((xp.shape[0], POOL_BUF, BRANCH_W), xp.dtype)
    for l in range(DEPTH):
        params = (w_ada[l], b_ada[l], norm_g[l], w_in[l], conv_w[l], conv_b[l], lnv_g[l], lnv_b[l],
                  sgu_w[l], sgu_b[l], pool_w[l], pool_b[l], pool_scale[l], w_branch[l], w_out[l])
        xp, cp, pp, vp = _layer(xp, c_prompt, 0, zero_conv, zero_pool, *params)
        xs, cs_, ps, vs = _layer(xs, c_sample, PAST_LEN, state_conv[l], state_pool[l], *params)
        conv_p.append(cp); conv_s.append(cs_); pool_p.append(pp); pool_s.append(ps)
        v_p.append(vp); v_s.append(vs)
    y_prompt = _rmsnorm(xp, final_g)
    y_sample = _rmsnorm(xs, final_g)
    return (y_prompt, y_sample, jnp.stack(conv_p), jnp.stack(conv_s), jnp.stack(pool_p),
            jnp.stack(pool_s), jnp.stack(v_p), jnp.stack(v_s))
```

```cpp
#include <hip/hip_runtime.h>
#include <cstdio>
#include <cstdint>

#define DEV __device__ __forceinline__
typedef unsigned short bf16_t;
typedef short bf16x8 __attribute__((ext_vector_type(8)));
typedef float f32x4 __attribute__((ext_vector_type(4)));
typedef unsigned u32x4 __attribute__((ext_vector_type(4)));
typedef unsigned u32x2 __attribute__((ext_vector_type(2)));

constexpr int D = 1024, TSEQ = 2048, NBP = 8, MPR = NBP * TSEQ  , NSM = 128, MV = MPR + NSM  , MP = 16640  , NBT = NBP + NSM  ;
constexpr int W = 512, NIN = 7680, PC = 6144, DEPTH = 4;
constexpr int PZ = 0, PABG = 512, PUG = 1024, PGV = 1536, PCX = 2048, PSG = 2560, PGATE = 3072;
constexpr float EPS = 1e-6f;
constexpr size_t O_Y = 0, O_YS = 16777216, O_CONVP = 16908288, O_CONVS = 16941056, O_POOLP = 17465344, O_POOLS = 17711104, O_VP = 21643264, O_VS = 23740416;

constexpr size_t al256(size_t x) { return (x + 255) & ~(size_t)255; }
constexpr size_t WS_WIN = 0;
constexpr size_t WS_WB = al256(WS_WIN + (size_t)DEPTH * NIN * D * 2);
constexpr size_t WS_WO = al256(WS_WB + (size_t)DEPTH * 3 * D * W * 2);
constexpr size_t WS_MOD = al256(WS_WO + (size_t)DEPTH * D * D * 2);
constexpr size_t WS_ATAB = al256(WS_MOD + (size_t)DEPTH * NBT * 3 * D * 4);
constexpr size_t WS_SHB = al256(WS_ATAB + (size_t)DEPTH * NBT * D * 4);
constexpr size_t WS_SW = al256(WS_SHB + (size_t)DEPTH * 256 * D * 2);
constexpr size_t WS_XA = al256(WS_SW + (size_t)DEPTH * NBT * NIN * 4);
constexpr size_t WS_SSQ = al256(WS_XA + (size_t)MP * D * 2);
constexpr size_t WS_PBUF = al256(WS_SSQ + (size_t)MP * 16 * 4);
constexpr size_t WS_Y = al256(WS_PBUF + (size_t)MP * PC * 2);
constexpr size_t WS_MG = al256(WS_Y + (size_t)MP * 1536 * 2);
constexpr size_t WS_END = al256(WS_MG + (size_t)MP * D * 4);

DEV unsigned f2bf(float f) { unsigned u = __builtin_bit_cast(unsigned, f); return (u + 0x7fffu + ((u >> 16) & 1u)) >> 16; }
DEV unsigned pk2(float lo, float hi) { return f2bf(lo) | (f2bf(hi) << 16); }
DEV float bf2f(bf16_t b) { return __builtin_bit_cast(float, (unsigned)b << 16); }
DEV float bflo(unsigned u) { return __builtin_bit_cast(float, u << 16); }
DEV float bfhi(unsigned u) { return __builtin_bit_cast(float, u & 0xffff0000u); }
DEV float sigmoid_f(float x) { return __builtin_amdgcn_rcpf(1.f + __builtin_amdgcn_exp2f(-1.44269504f * x)); }
DEV float silu_f(float x) { return x * sigmoid_f(x); }
DEV float gelu_f(float x) { const float u = 0.7978845608f * (x + 0.044715f * x * x * x); return x * sigmoid_f(2.f * u); }
DEV int perm32(int rho) { const int n = rho >> 4, i = rho & 15; return 8 * (i >> 2) + 4 * n + (i & 3); }
DEV int nidx_of(int row) { return row < MPR ? (row >> 11) : (row < MV ? NBP + (row - MPR) : NBT - 1); }
DEV int src_win(int j) {
    const int pn = j >> 8, c = j & 255, bj = c >> 7, cc = c & 127;
    if (pn < 4) return (bj ? 1024 : 512) + 128 * pn + cc;
    if (pn < 8) return (bj ? 1536 : 0) + 128 * (pn - 4) + cc;
    if (pn < 12) return (bj ? 3072 : 2048) + 128 * (pn - 8) + cc;
    if (pn < 14) return 2560 + 256 * (pn - 12) + c;
    if (pn < 16) return 3584 + 256 * (pn - 14) + c;
    if (pn < 18) return 4096 + 256 * (pn - 16) + c;
    return 4608 + 256 * (pn - 18) + c;
}

struct MapWin { DEV int operator()(int g) const { return src_win((g & ~31) + perm32(g & 31)); } };
struct MapPerm { DEV int operator()(int g) const { return (g & ~31) + perm32(g & 31); } };
template <class Map>
DEV void transpose_item(const float* Wsrc, int ldw, int K, bf16_t* WT, int nblk, int item, float* scr, int lane, Map map) {
    const int kb = item / nblk, nb = item % nblk, k0 = 64 * kb, g0 = 32 * nb;
    const int scol = map(g0 + (lane & 31));
#pragma unroll 8
    for (int i = 0; i < 32; ++i) { const int kk = 2 * i + (lane >> 5); scr[kk * 33 + (lane & 31)] = Wsrc[(size_t)(k0 + kk) * ldw + scol]; }
    __builtin_amdgcn_s_waitcnt(0xc07f); asm volatile("" ::: "memory");
    const int c = lane & 7;
#pragma unroll
    for (int j = 0; j < 4; ++j) { const int n = (lane >> 3) + 8 * j; const float* s = scr + (8 * c) * 33 + n;
        u32x4 o; o.x = pk2(s[0 * 33], s[1 * 33]); o.y = pk2(s[2 * 33], s[3 * 33]); o.z = pk2(s[4 * 33], s[5 * 33]); o.w = pk2(s[6 * 33], s[7 * 33]);
        *(u32x4*)(WT + (size_t)(g0 + n) * K + k0 + 8 * c) = o; }
    __builtin_amdgcn_s_waitcnt(0xc07f); asm volatile("" ::: "memory");
}
constexpr int IT_WIN = (D / 64) * (NIN / 32), IT_WB = (W / 64) * (D / 32), IT_WO = (D / 64) * (D / 32);
constexpr int IT_TOTAL = DEPTH * IT_WIN + DEPTH * 3 * IT_WB + DEPTH * IT_WO;
__global__ __launch_bounds__(256) void k_convert(const float* w_in, const float* w_branch, const float* w_out, bf16_t* WinT, bf16_t* WbT, bf16_t* WoT) {
    __shared__ float scr_all[4][64 * 33];
    const int wave = threadIdx.x >> 6, lane = threadIdx.x & 63;
    float* scr = scr_all[wave];
    for (int it = blockIdx.x * 4 + wave; it < IT_TOTAL; it += gridDim.x * 4) {
        int r = it;
        if (r < DEPTH * IT_WIN) { const int l = r / IT_WIN; r -= l * IT_WIN; transpose_item(w_in + (size_t)l * D * NIN, NIN, D, WinT + (size_t)l * NIN * D, NIN / 32, r, scr, lane, MapWin()); continue; }
        r -= DEPTH * IT_WIN;
        if (r < DEPTH * 3 * IT_WB) { const int li = r / IT_WB; r -= li * IT_WB; transpose_item(w_branch + (size_t)li * W * D, D, W, WbT + (size_t)li * D * W, D / 32, r, scr, lane, MapPerm()); continue; }
        r -= DEPTH * 3 * IT_WB;
        { const int l = r / IT_WO; r -= l * IT_WO; transpose_item(w_out + (size_t)l * D * D, D, D, WoT + (size_t)l * D * D, D / 32, r, scr, lane, MapPerm()); }
    }
}

__global__ __launch_bounds__(256) void k_mod(const float* c_prompt, const float* c_sample, const float* w_ada, const float* b_ada, float* mod) {
    __shared__ float sc[8][1024];
    const int jg = blockIdx.x * 256 + threadIdx.x, l = jg / 3072, j = jg % 3072, n0 = blockIdx.y * 8;
    for (int i = threadIdx.x; i < 8 * 1024; i += 256) { const int n = n0 + (i >> 10), k = i & 1023; const float c = n < NBP ? c_prompt[n * D + k] : c_sample[(n - NBP) * D + k]; sc[i >> 10][k] = silu_f(c); }
    __syncthreads();
    float a0 = 0, a1 = 0, a2 = 0, a3 = 0, a4 = 0, a5 = 0, a6 = 0, a7 = 0;
    const float* w = w_ada + (size_t)l * D * 3072 + j;
    for (int k = 0; k < D; ++k) { const float wv = w[(size_t)k * 3072];
        a0 += sc[0][k] * wv; a1 += sc[1][k] * wv; a2 += sc[2][k] * wv; a3 += sc[3][k] * wv; a4 += sc[4][k] * wv; a5 += sc[5][k] * wv; a6 += sc[6][k] * wv; a7 += sc[7][k] * wv; }
    const float b = b_ada[l * 3072 + j]; float* o = mod + ((size_t)l * NBT + n0) * 3072 + j;
    o[0 * 3072] = a0 + b; o[1 * 3072] = a1 + b; o[2 * 3072] = a2 + b; o[3 * 3072] = a3 + b; o[4 * 3072] = a4 + b; o[5 * 3072] = a5 + b; o[6 * 3072] = a6 + b; o[7 * 3072] = a7 + b;
}
__global__ __launch_bounds__(256) void k_tabs(const float* mod, const float* norm_g, float* atab, bf16_t* shb) {
    const int idx = blockIdx.x * 256 + threadIdx.x;
    const int col = idx & 1023, n = (idx >> 10) & 255, l = idx >> 18;
    if (l >= DEPTH) return;
    if (n < NBT) { const float* m = mod + ((size_t)l * NBT + n) * 3072; atab[((size_t)l * NBT + n) * D + col] = norm_g[l * D + col] * (1.f + m[D + col]); shb[((size_t)l * 256 + n) * D + col] = (bf16_t)f2bf(m[col]); }
    else shb[((size_t)l * 256 + n) * D + col] = 0;
}
__global__ __launch_bounds__(256) void k_xa0(const float* x_prompt, const float* x_sample, const float* atab0, float* xio, bf16_t* xa, float* ssq) {
    const int row = blockIdx.x * 4 + (threadIdx.x >> 6), lane = threadIdx.x & 63;
    if (row >= MP) return;
    u32x2* xo = (u32x2*)(xa + (size_t)row * D) + lane;
    if (row >= MV) { for (int j = 0; j < 4; ++j) xo[64 * j] = (u32x2){0u, 0u}; if (lane < 16) ssq[row * 16 + lane] = 0.f; return; }
    const float* xr = row < MPR ? x_prompt + (size_t)row * D : x_sample + (size_t)(row - MPR) * D;
    const float* ar = atab0 + (size_t)nidx_of(row) * D;
#pragma unroll
    for (int j = 0; j < 4; ++j) {
        const f32x4 v = *((const f32x4*)xr + lane + 64 * j), a = *((const f32x4*)ar + lane + 64 * j);
        *((f32x4*)(xio + (size_t)row * D) + lane + 64 * j) = v;
        xo[64 * j] = (u32x2){pk2(v.x * a.x, v.y * a.y), pk2(v.z * a.z, v.w * a.w)};
        float s = (v.x * v.x + v.y * v.y) + (v.z * v.z + v.w * v.w);
        s += __shfl_xor(s, 1); s += __shfl_xor(s, 2); s += __shfl_xor(s, 4); s += __shfl_xor(s, 32);
        if ((lane & 39) == 0) ssq[row * 16 + 4 * j + (lane >> 3)] = s;
    }
}
DEV float row_rstd(const float* ssq, int row) {
    const f32x4* p = (const f32x4*)(ssq + (size_t)row * 16); const f32x4 a = p[0], b = p[1], c = p[2], d = p[3];
    const float s = ((a.x + a.y) + (a.z + a.w)) + ((b.x + b.y) + (b.z + b.w)) + ((c.x + c.y) + (c.z + c.w)) + ((d.x + d.y) + (d.z + d.w));
    return __builtin_amdgcn_rsqf(s * (1.f / D) + EPS);
}

DEV void wave_gemm(const bf16_t* ap  , const bf16_t* bp  , int ldb, int K, f32x4 (&acc)[2][2]) {
    for (int k = 0; k < K; k += 32) {
        const bf16x8 a = *(const bf16x8*)(ap + k);
#pragma unroll
        for (int bj = 0; bj < 2; ++bj)
#pragma unroll
            for (int n = 0; n < 2; ++n) { const bf16x8 b = *(const bf16x8*)(bp + (size_t)(128 * bj + 16 * n) * ldb + k);
                acc[bj][n] = __builtin_amdgcn_mfma_f32_16x16x32_bf16(b, a, acc[bj][n], 0, 0, 0); }
    }
}
struct GemmS { const bf16_t* A; int lda; const bf16_t* Bt; int ldb; int K; };
template <class Epi> __global__ __launch_bounds__(256) void k_gemm_simple(GemmS g, Epi e) {
    const int wc = threadIdx.x >> 6, lane = threadIdx.x & 63, fr = lane & 15, fq = lane >> 4;
    const int row = blockIdx.x * 16 + fr, pn = blockIdx.y;
    f32x4 acc[2][2];
#pragma unroll
    for (int a = 0; a < 2; ++a)
#pragma unroll
        for (int b = 0; b < 2; ++b) acc[a][b] = (f32x4){0.f, 0.f, 0.f, 0.f};
    wave_gemm(g.A + (size_t)row * g.lda + 8 * fq, g.Bt + (size_t)(256 * pn + 32 * wc + fr) * g.ldb + 8 * fq, g.ldb, g.K, acc);
    e(pn, row, wc, fq, acc);
}

DEV void store8(bf16_t* p, f32x4 a, f32x4 b) { u32x4 w; w.x = pk2(a.x, a.y); w.y = pk2(a.z, a.w); w.z = pk2(b.x, b.y); w.w = pk2(b.z, b.w); *(u32x4*)p = w; }
struct EpiSW { float* SWl;
    DEV void operator()(int pn, int row, int wc, int fq, f32x4 (&v)[2][2]) const {
        if (row >= NBT) return;
        float* o = SWl + (size_t)row * NIN + 256 * pn + 32 * wc + 8 * fq;
        *(f32x4*)(o) = v[0][0]; *(f32x4*)(o + 4) = v[0][1]; *(f32x4*)(o + 128) = v[1][0]; *(f32x4*)(o + 132) = v[1][1];
    } };
struct EpiP1 { bf16_t* pbuf; const float* ssq; const float* SWl;
    DEV void operator()(int pn, int row, int wc, int fq, f32x4 (&v)[2][2]) const {
        const float r = row_rstd(ssq, row);
        const float* sw = SWl + (size_t)nidx_of(row) * NIN + 256 * pn + 32 * wc + 8 * fq;
        const int cb = 32 * wc + 8 * fq;
        f32x4 a0 = v[0][0] * r + *(const f32x4*)(sw), a1 = v[0][1] * r + *(const f32x4*)(sw + 4), b0 = v[1][0] * r + *(const f32x4*)(sw + 128), b1 = v[1][1] * r + *(const f32x4*)(sw + 132);
        bf16_t* pr = pbuf + (size_t)row * PC;
        if (pn < 4) { store8(pr + PZ + 128 * pn + cb, a0 * b0, a1 * b1); }
        else if (pn < 8) {
#pragma unroll
            for (int j = 0; j < 4; ++j) { a0[j] *= silu_f(b0[j]); a1[j] *= silu_f(b1[j]); }
            store8(pr + PABG + 128 * (pn - 4) + cb, a0, a1); }
        else if (pn < 12) {
#pragma unroll
            for (int j = 0; j < 4; ++j) { a0[j] = gelu_f(a0[j]) * silu_f(b0[j]); a1[j] = gelu_f(a1[j]) * silu_f(b1[j]); }
            store8(pr + PUG + 128 * (pn - 8) + cb, a0, a1); }
        else {
            int base;
            if (pn < 14) { base = PGV + 256 * (pn - 12);
#pragma unroll
                for (int j = 0; j < 4; ++j) { a0[j] = gelu_f(a0[j]); a1[j] = gelu_f(a1[j]); b0[j] = gelu_f(b0[j]); b1[j] = gelu_f(b1[j]); } }
            else if (pn < 16) { base = PCX + 256 * (pn - 14); }
            else if (pn < 18) { base = PSG + 256 * (pn - 16);
#pragma unroll
                for (int j = 0; j < 4; ++j) { a0[j] = silu_f(a0[j]); a1[j] = silu_f(a1[j]); b0[j] = silu_f(b0[j]); b1[j] = silu_f(b1[j]); } }
            else { base = PGATE + 256 * (pn - 18);
#pragma unroll
                for (int j = 0; j < 4; ++j) { a0[j] = sigmoid_f(a0[j]); a1[j] = sigmoid_f(a1[j]); b0[j] = sigmoid_f(b0[j]); b1[j] = sigmoid_f(b1[j]); } }
            store8(pr + base + cb, a0, a1); store8(pr + base + 128 + cb, b0, b1);
        }
    } };
__global__ __launch_bounds__(256) void k_p3_simple(const bf16_t* y, const bf16_t* WbTl, const bf16_t* pbuf, bf16_t* mg) {
    const int wc = threadIdx.x >> 6, lane = threadIdx.x & 63, fr = lane & 15, fq = lane >> 4;
    const int row = blockIdx.x * 16 + fr, pn = blockIdx.y, cb = 32 * wc + 8 * fq;
    f32x4 tot[2][2];
#pragma unroll
    for (int a = 0; a < 2; ++a)
#pragma unroll
        for (int b = 0; b < 2; ++b) tot[a][b] = (f32x4){0.f, 0.f, 0.f, 0.f};
    for (int i = 0; i < 3; ++i) {
        f32x4 acc[2][2];
#pragma unroll
        for (int a = 0; a < 2; ++a)
#pragma unroll
            for (int b = 0; b < 2; ++b) acc[a][b] = (f32x4){0.f, 0.f, 0.f, 0.f};
        wave_gemm(y + (size_t)row * 1536 + 512 * i + 8 * fq, WbTl + (size_t)i * D * W + (size_t)(256 * pn + 32 * wc + fr) * W + 8 * fq, W, W, acc);
        const bf16_t* gp = pbuf + (size_t)row * PC + PGATE + 1024 * i + 256 * pn + cb;
#pragma unroll
        for (int bj = 0; bj < 2; ++bj) { const u32x4 g = *(const u32x4*)(gp + 128 * bj);
            tot[bj][0] += acc[bj][0] * (f32x4){bflo(g.x), bfhi(g.x), bflo(g.y), bfhi(g.y)};
            tot[bj][1] += acc[bj][1] * (f32x4){bflo(g.z), bfhi(g.z), bflo(g.w), bfhi(g.w)}; }
    }
    bf16_t* o = mg + (size_t)row * D + 256 * pn + cb;
    store8(o, tot[0][0], tot[0][1]); store8(o + 128, tot[1][0], tot[1][1]);
}
struct EpiP4 { float* xio; const float* gate  ; const float* atab_next  ; bf16_t* xa; float* ssq;
    DEV void operator()(int pn, int row, int wc, int fq, f32x4 (&v)[2][2]) const {
        const int nb = nidx_of(row), col = 256 * pn + 32 * wc + 8 * fq;
        const bool valid = row < MV;
        const float* gp = gate + (size_t)nb * 3072 + col;
        float s = 0.f;
        f32x4 xn[2][2];
#pragma unroll
        for (int bj = 0; bj < 2; ++bj)
#pragma unroll
            for (int n = 0; n < 2; ++n) {
                const f32x4 x0 = valid ? *(const f32x4*)(xio + (size_t)row * D + col + 128 * bj + 4 * n) : (f32x4){0.f, 0.f, 0.f, 0.f};
                const f32x4 g = *(const f32x4*)(gp + 128 * bj + 4 * n);
                const f32x4 t = x0 + g * v[bj][n]; xn[bj][n] = t;
                s += (t.x * t.x + t.y * t.y) + (t.z * t.z + t.w * t.w);
                if (valid) *(f32x4*)(xio + (size_t)row * D + col + 128 * bj + 4 * n) = t;
            }
        s += __shfl_xor(s, 16); s += __shfl_xor(s, 32);
        if (fq == 0 && valid) ssq[row * 16 + 4 * pn + wc] = s;
        if (atab_next && valid) {
            const float* ap = atab_next + (size_t)nb * D + col;
#pragma unroll
            for (int bj = 0; bj < 2; ++bj) { const f32x4 a0 = *(const f32x4*)(ap + 128 * bj), a1 = *(const f32x4*)(ap + 128 * bj + 4);
                store8(xa + (size_t)row * D + col + 128 * bj, xn[bj][0] * a0, xn[bj][1] * a1); }
        }
    } };

__global__ __launch_bounds__(256) void k_p2_A(int l, const bf16_t* pbuf, const float* state_conv, const float* conv_w, const float* conv_b, bf16_t* y, float* out) {
    const int idx = blockIdx.x * 256 + threadIdx.x, row = idx >> 9, ch = idx & 511;
    if (row >= MV) return;
    const bf16_t* pr = pbuf + (size_t)row * PC;
    const float z0 = bf2f(pr[PZ + ch]), abg = bf2f(pr[PABG + ch]);
    float zm1, zm2;
    if (row < MPR) { const int t = row & 2047, n = row >> 11; zm1 = t >= 1 ? bf2f(pr[PZ + ch - PC]) : 0.f; zm2 = t >= 2 ? bf2f(pr[PZ + ch - 2 * PC]) : 0.f;
        if (t >= TSEQ - 2) out[O_CONVP + ((size_t)(l * NBP + n) * 2 + (t - (TSEQ - 2))) * W + ch] = z0; }
    else { const int n = row - MPR; const float* sc = state_conv + ((size_t)(l * NSM + n) * 2) * W; zm2 = sc[ch]; zm1 = sc[W + ch];
        float* o = out + O_CONVS + ((size_t)(l * NSM + n) * 2) * W; o[ch] = zm1; o[W + ch] = z0; }
    const float co = conv_b[l * W + ch] + conv_w[(l * 3 + 0) * W + ch] * zm2 + conv_w[(l * 3 + 1) * W + ch] * zm1 + conv_w[(l * 3 + 2) * W + ch] * z0;
    y[(size_t)row * 1536 + ch] = (bf16_t)f2bf(abg * co);
}
__global__ __launch_bounds__(256) void k_p2_C1(int l, const bf16_t* pbuf, const float* state_pool, bf16_t* pmbuf, float* out) {
    const int idx = blockIdx.x * 256 + threadIdx.x, row = idx >> 9, ch = idx & 511;
    if (row >= MV) return;
    const bf16_t* pr = pbuf + (size_t)row * PC + PCX + ch;
    const float cx0 = bf2f(pr[0]); const int w = 2 << (ch >> 7);
    float s = 0.f, cnt;
    if (row < MPR) { const int t = row & 2047, n = row >> 11;
        for (int j = 0; j < w; ++j) if (t - j >= 0) s += bf2f(*(pr - (size_t)j * PC));
        cnt = (float)(w < t + 1 ? w : t + 1);
        if (t >= TSEQ - 15) out[O_POOLP + ((size_t)(l * NBP + n) * 15 + (t - (TSEQ - 15))) * W + ch] = cx0; }
    else { const int n = row - MPR; const float* sp = state_pool + ((size_t)(l * NSM + n) * 15) * W + ch; s = cx0;
        for (int j = 1; j < w; ++j) s += sp[(size_t)(15 - j) * W];
        cnt = (float)w;
        float* o = out + O_POOLS + ((size_t)(l * NSM + n) * 15) * W + ch;
        for (int i = 0; i < 14; ++i) o[(size_t)i * W] = sp[(size_t)(i + 1) * W];
        o[(size_t)14 * W] = cx0; }
    pmbuf[(size_t)row * W + ch] = (bf16_t)f2bf(s / cnt - cx0);
}
__global__ __launch_bounds__(256) void k_p2_C2(int l, const bf16_t* pbuf, const bf16_t* pmbuf, const float* pool_w, const float* pool_b, const float* pool_scale, bf16_t* y) {
    const int idx = blockIdx.x * 256 + threadIdx.x, row = idx >> 9, o = idx & 511, g = o >> 7, oo = o & 127;
    if (row >= MV) return;
    const bf16_t* pm = pmbuf + (size_t)row * W + 128 * g; const float* pw = pool_w + ((size_t)(l * 4 + g) * 128) * 128 + oo;
    float acc = 0.f;
    for (int i = 0; i < 128; ++i) acc += bf2f(pm[i]) * pw[(size_t)i * 128];
    const float sg = bf2f(pbuf[(size_t)row * PC + PSG + o]);
    y[(size_t)row * 1536 + 1024 + o] = (bf16_t)f2bf((acc + pool_b[l * W + o]) * pool_scale[l * W + o] * sg);
}
__global__ __launch_bounds__(256) void k_p2_B1(int l, const bf16_t* pbuf, const float* lnv_g, const float* lnv_b, float* vbuf, float* out) {
    const int row = blockIdx.x * 4 + (threadIdx.x >> 6), lane = threadIdx.x & 63;
    if (row >= MV) return;
    const u32x4 g = *(const u32x4*)(pbuf + (size_t)row * PC + PGV + 8 * lane);
    float v[8] = {bflo(g.x), bfhi(g.x), bflo(g.y), bfhi(g.y), bflo(g.z), bfhi(g.z), bflo(g.w), bfhi(g.w)};
    float s = 0.f;
#pragma unroll
    for (int j = 0; j < 8; ++j) s += v[j];
#pragma unroll
    for (int o = 1; o < 64; o <<= 1) s += __shfl_xor(s, o);
    const float mu = s * (1.f / W); float q = 0.f;
#pragma unroll
    for (int j = 0; j < 8; ++j) { v[j] -= mu; q += v[j] * v[j]; }
#pragma unroll
    for (int o = 1; o < 64; o <<= 1) q += __shfl_xor(q, o);
    const float rstd = __builtin_amdgcn_rsqf(q * (1.f / W) + EPS);
    float* vo = vbuf + (size_t)row * W + 8 * lane;
    float* oo = nullptr;
    if (row < MPR) { const int t = row & 2047, n = row >> 11; if (t >= TSEQ - 128) oo = out + O_VP + ((size_t)(l * NBP + n) * 128 + (t - (TSEQ - 128))) * W + 8 * lane; }
    else oo = out + O_VS + (size_t)(l * NSM + (row - MPR)) * W + 8 * lane;
#pragma unroll
    for (int j = 0; j < 8; ++j) { const float r = v[j] * rstd * lnv_g[l * W + 8 * lane + j] + lnv_b[l * W + 8 * lane + j]; vo[j] = r; if (oo) oo[j] = r; }
}
__global__ __launch_bounds__(256) void k_p2_B2(int l, const bf16_t* pbuf, const float* vbuf, const float* sgu_w, const float* sgu_b, bf16_t* y) {
    const int idx = blockIdx.x * 256 + threadIdx.x, row = idx >> 9, ch = idx & 511, h = ch >> 6;
    if (row >= MV) return;
    float acc;
    if (row < MPR) { const int t = row & 127, base = row - t; const float* wr = sgu_w + ((size_t)(l * 8 + h) * 128 + t) * 128; acc = sgu_b[(l * 8 + h) * 128 + t];
        for (int s = 0; s <= t; ++s) acc += wr[s] * vbuf[(size_t)(base + s) * W + ch]; }
    else acc = sgu_w[(size_t)(l * 8 + h) * 128 * 128] * vbuf[(size_t)row * W + ch] + sgu_b[(l * 8 + h) * 128];
    y[(size_t)row * 1536 + 512 + ch] = (bf16_t)f2bf(bf2f(pbuf[(size_t)row * PC + PUG + ch]) * acc);
}
__global__ __launch_bounds__(256) void k_final(float* xio, const float* ssq, const float* final_g) {
    const int row = blockIdx.x * 4 + (threadIdx.x >> 6), lane = threadIdx.x & 63;
    if (row >= MV) return;
    const float r = row_rstd(ssq, row);
#pragma unroll
    for (int j = 0; j < 4; ++j) { f32x4* p = (f32x4*)(xio + (size_t)row * D) + lane + 64 * j; *p = *p * r * *((const f32x4*)final_g + lane + 64 * j); }
}

extern "C" void kernel_launch(void* const* d_in, const int* in_sizes, int n_in, void* d_out, int out_size, void* d_ws, size_t ws_size, hipStream_t stream) {
    if (n_in != 22 || ws_size < WS_END) { fprintf(stderr, "kernel_launch: unexpected n_in %d or ws_size %zu < %zu\n", n_in, ws_size, (size_t)WS_END); return; }
    const float* x_prompt = (const float*)d_in[0]; const float* x_sample = (const float*)d_in[1]; const float* c_prompt = (const float*)d_in[2]; const float* c_sample = (const float*)d_in[3];
    const float* state_conv = (const float*)d_in[4]; const float* state_pool = (const float*)d_in[5]; const float* w_ada = (const float*)d_in[6]; const float* b_ada = (const float*)d_in[7];
    const float* norm_g = (const float*)d_in[8]; const float* w_in = (const float*)d_in[9]; const float* conv_w = (const float*)d_in[10]; const float* conv_b = (const float*)d_in[11];
    const float* lnv_g = (const float*)d_in[12]; const float* lnv_b = (const float*)d_in[13]; const float* sgu_w = (const float*)d_in[14]; const float* sgu_b = (const float*)d_in[15];
    const float* pool_w = (const float*)d_in[16]; const float* pool_b = (const float*)d_in[17]; const float* pool_scale = (const float*)d_in[18]; const float* w_branch = (const float*)d_in[19];
    const float* w_out = (const float*)d_in[20]; const float* final_g = (const float*)d_in[21];
    float* out = (float*)d_out; char* ws = (char*)d_ws;
    bf16_t* WinT = (bf16_t*)(ws + WS_WIN); bf16_t* WbT = (bf16_t*)(ws + WS_WB); bf16_t* WoT = (bf16_t*)(ws + WS_WO);
    float* mod = (float*)(ws + WS_MOD); float* atab = (float*)(ws + WS_ATAB); bf16_t* shb = (bf16_t*)(ws + WS_SHB); float* SW = (float*)(ws + WS_SW);
    bf16_t* xa = (bf16_t*)(ws + WS_XA); float* ssq = (float*)(ws + WS_SSQ); bf16_t* pbuf = (bf16_t*)(ws + WS_PBUF); bf16_t* y = (bf16_t*)(ws + WS_Y); bf16_t* mg = (bf16_t*)(ws + WS_MG);
    bf16_t* pmbuf = xa;
    float* vbuf = (float*)mg;

    k_convert<<<1024, 256, 0, stream>>>(w_in, w_branch, w_out, WinT, WbT, WoT);
    k_mod<<<dim3(DEPTH * 3072 / 256, NBT / 8), 256, 0, stream>>>(c_prompt, c_sample, w_ada, b_ada, mod);
    k_tabs<<<DEPTH * 256 * D / 256, 256, 0, stream>>>(mod, norm_g, atab, shb);
    for (int l = 0; l < DEPTH; ++l) {
        GemmS g{shb + (size_t)l * 256 * D, D, WinT + (size_t)l * NIN * D, D, D};
        k_gemm_simple<EpiSW><<<dim3(9, NIN / 256), 256, 0, stream>>>(g, EpiSW{SW + (size_t)l * NBT * NIN});
    }
    k_xa0<<<MP / 4, 256, 0, stream>>>(x_prompt, x_sample, atab, out, xa, ssq);
    for (int l = 0; l < DEPTH; ++l) {
        { GemmS g{xa, D, WinT + (size_t)l * NIN * D, D, D};
          k_gemm_simple<EpiP1><<<dim3(MP / 16, NIN / 256), 256, 0, stream>>>(g, EpiP1{pbuf, ssq, SW + (size_t)l * NBT * NIN}); }
        const int nb = MV * W / 256;
        k_p2_A<<<nb, 256, 0, stream>>>(l, pbuf, state_conv, conv_w, conv_b, y, out);
        k_p2_C1<<<nb, 256, 0, stream>>>(l, pbuf, state_pool, pmbuf, out);
        k_p2_C2<<<nb, 256, 0, stream>>>(l, pbuf, pmbuf, pool_w, pool_b, pool_scale, y);
        k_p2_B1<<<MV / 4, 256, 0, stream>>>(l, pbuf, lnv_g, lnv_b, vbuf, out);
        k_p2_B2<<<nb, 256, 0, stream>>>(l, pbuf, vbuf, sgu_w, sgu_b, y);
        k_p3_simple<<<dim3(MP / 16, 4), 256, 0, stream>>>(y, WbT + (size_t)l * 3 * D * W, pbuf, mg);
        { GemmS g{mg, D, WoT + (size_t)l * D * D, D, D};
          k_gemm_simple<EpiP4><<<dim3(MP / 16, 4), 256, 0, stream>>>(g, EpiP4{out, mod + (size_t)l * NBT * 3072 + 2048, l + 1 < DEPTH ? atab + (size_t)(l + 1) * NBT * D : nullptr, xa, ssq}); }
    }
    k_final<<<MV / 4, 256, 0, stream>>>(out, ssq, final_g);
}
```

```cpp
#include <hip/hip_runtime.h>
#include <cstdio>
#include <cstdint>

#define DEV __device__ __forceinline__
typedef unsigned short bf16_t;
typedef short bf16x8 __attribute__((ext_vector_type(8)));
typedef float f32x4 __attribute__((ext_vector_type(4)));
typedef unsigned u32x4 __attribute__((ext_vector_type(4)));
typedef unsigned u32x2 __attribute__((ext_vector_type(2)));

constexpr int D = 1024, TSEQ = 2048, NBP = 8, MPR = NBP * TSEQ  , NSM = 128, MV = MPR + NSM  , MP = 16640  , NBT = NBP + NSM  ;
constexpr int W = 512, NIN = 7680, PC = 4608  , DEPTH = 4;
constexpr int PZ = 0, PABG = 512, PUG = 1024, PGV = 1536, PCX = 2048, PSG = 2560, PGATE = 3072;
constexpr float EPS = 1e-6f;
constexpr size_t O_Y = 0, O_YS = 16777216, O_CONVP = 16908288, O_CONVS = 16941056, O_POOLP = 17465344, O_POOLS = 17711104, O_VP = 21643264, O_VS = 23740416;

constexpr size_t al256(size_t x) { return (x + 255) & ~(size_t)255; }
constexpr size_t WS_WIN = 0;
constexpr size_t WS_WB = al256(WS_WIN + (size_t)DEPTH * NIN * D * 2);
constexpr size_t WS_WO = al256(WS_WB + (size_t)DEPTH * 3 * D * W * 2);
constexpr size_t WS_MOD = al256(WS_WO + (size_t)DEPTH * D * D * 2);
constexpr size_t WS_ATAB = al256(WS_MOD + (size_t)DEPTH * NBT * 3 * D * 4);
constexpr size_t WS_SHB = al256(WS_ATAB + (size_t)DEPTH * NBT * D * 4);
constexpr size_t WS_SW = al256(WS_SHB + (size_t)DEPTH * 256 * D * 2);
constexpr size_t WS_XA = al256(WS_SW + (size_t)DEPTH * NBT * NIN * 4);
constexpr size_t WS_SSQ = al256(WS_XA + (size_t)MP * D * 2);
constexpr size_t WS_PBUF = al256(WS_SSQ + (size_t)MP * 16 * 4);
constexpr size_t WS_Y = al256(WS_PBUF + (size_t)MP * PC * 2);
constexpr size_t WS_MG = al256(WS_Y + (size_t)MP * 1536 * 2);
constexpr size_t WS_SGUW = al256(WS_MG + (size_t)MP * D * 2);
constexpr size_t WS_POOLW = al256(WS_SGUW + (size_t)DEPTH * 8 * 128 * 128 * 2);
constexpr size_t WS_WADA = al256(WS_POOLW + (size_t)DEPTH * 4 * 128 * 128 * 2);
constexpr size_t WS_SCB = al256(WS_WADA + (size_t)DEPTH * 3072 * D * 2);
constexpr size_t WS_XB = al256(WS_SCB + (size_t)256 * D * 2);
constexpr size_t WS_XA2 = al256(WS_XB + (size_t)MV * D * 2);
constexpr size_t WS_CTL = al256(WS_XA2 + (size_t)MP * D * 2);
constexpr size_t CTL_BYTES = 40960;
constexpr size_t WS_END = al256(WS_CTL + CTL_BYTES);

constexpr int NTHREADS = 512, NWAVES = 8;
constexpr int CW_FIN = 4096;
constexpr int LDS_BYTES = 155648;
constexpr int LDSCTL_OFF = LDS_BYTES - 256;

typedef __bf16 bf16x2_t __attribute__((ext_vector_type(2)));
typedef float f32x2_t __attribute__((ext_vector_type(2)));
DEV unsigned pk2(float lo, float hi) { const f32x2_t v = {lo, hi}; const bf16x2_t b = __builtin_convertvector(v, bf16x2_t); return __builtin_bit_cast(unsigned, b); }
DEV float bflo(unsigned u) { return __builtin_bit_cast(float, u << 16); }
DEV float bfhi(unsigned u) { return __builtin_bit_cast(float, u & 0xffff0000u); }
DEV void unpk8(const u32x4 u, f32x4& a, f32x4& b) { a = (f32x4){bflo(u.x), bfhi(u.x), bflo(u.y), bfhi(u.y)}; b = (f32x4){bflo(u.z), bfhi(u.z), bflo(u.w), bfhi(u.w)}; }
DEV f32x4 gate4(unsigned u) { return (f32x4){(float)(u & 0xffu), (float)((u >> 8) & 0xffu), (float)((u >> 16) & 0xffu), (float)(u >> 24)} * (1.f / 255.f); }
DEV unsigned pku8(f32x4 s) { const unsigned a = (unsigned)(s.x * 255.f + 0.5f), b = (unsigned)(s.y * 255.f + 0.5f), c = (unsigned)(s.z * 255.f + 0.5f), d = (unsigned)(s.w * 255.f + 0.5f); return a | (b << 8) | (c << 16) | (d << 24); }
DEV f32x4 exp2_4(f32x4 t) { return (f32x4){__builtin_amdgcn_exp2f(t.x), __builtin_amdgcn_exp2f(t.y), __builtin_amdgcn_exp2f(t.z), __builtin_amdgcn_exp2f(t.w)}; }
DEV f32x4 rcp4(f32x4 d) { return (f32x4){__builtin_amdgcn_rcpf(d.x), __builtin_amdgcn_rcpf(d.y), __builtin_amdgcn_rcpf(d.z), __builtin_amdgcn_rcpf(d.w)}; }
DEV f32x4 sigmoid4(f32x4 x) { return rcp4(exp2_4(x * -1.44269504f) + 1.f); }
DEV f32x4 silu4(f32x4 x) { return x * sigmoid4(x); }
DEV f32x4 gelu4(f32x4 x) { const f32x4 t = x * (x * x * (-2.f * 0.7978845608f * 0.044715f * 1.44269504f) + (-2.f * 0.7978845608f * 1.44269504f)); return x * rcp4(exp2_4(t) + 1.f); }
DEV int perm32(int rho) { const int n = rho >> 4, i = rho & 15; return 8 * (i >> 2) + 4 * n + (i & 3); }
DEV int nidx_of(int row) { return row < MPR ? (row >> 11) : (row < MV ? NBP + (row - MPR) : NBT - 1); }
DEV int src_win(int j) {
    const int pn = j >> 8, c = j & 255, bj = c >> 7, cc = c & 127;
    if (pn < 4) return (bj ? 1024 : 512) + 128 * pn + cc;
    if (pn < 8) return (bj ? 1536 : 0) + 128 * (pn - 4) + cc;
    if (pn < 12) return (bj ? 3072 : 2048) + 128 * (pn - 8) + cc;
    if (pn < 14) return 2560 + 256 * (pn - 12) + c;
    if (pn < 16) return 3584 + 256 * (pn - 14) + c;
    if (pn < 18) return 4096 + 256 * (pn - 16) + c;
    return 4608 + 256 * (pn - 18) + c;
}

struct Args { const float* in[22]; float* out; unsigned char* ws; };
struct Ctx {
    const float *x_prompt, *x_sample, *c_prompt, *c_sample, *state_conv, *state_pool, *w_ada, *b_ada, *norm_g, *w_in, *conv_w, *conv_b, *lnv_g, *lnv_b, *sgu_w, *sgu_b, *pool_w, *pool_b, *pool_scale, *w_branch, *w_out, *final_g;
    float* out; bf16_t *WinT, *WbT, *WoT; float *mod, *atab; bf16_t* shb; float* SW; bf16_t* xa; float* ssq; bf16_t *pbuf, *y, *mg; bf16_t *SguW, *PoolWT, *WadaT, *scb, *xb, *xa2;
    unsigned char* lds;
    int tid, lane, wave, gw, NGW, gtid, NGT;
};

DEV Ctx make_ctx(const Args& a, size_t z) {
    Ctx c;
    c.x_prompt = a.in[0] + z; c.x_sample = a.in[1] + z; c.c_prompt = a.in[2] + z; c.c_sample = a.in[3] + z; c.state_conv = a.in[4] + z; c.state_pool = a.in[5] + z; c.w_ada = a.in[6] + z; c.b_ada = a.in[7] + z;
    c.norm_g = a.in[8] + z; c.w_in = a.in[9] + z; c.conv_w = a.in[10] + z; c.conv_b = a.in[11] + z; c.lnv_g = a.in[12] + z; c.lnv_b = a.in[13] + z; c.sgu_w = a.in[14] + z; c.sgu_b = a.in[15] + z;
    c.pool_w = a.in[16] + z; c.pool_b = a.in[17] + z; c.pool_scale = a.in[18] + z; c.w_branch = a.in[19] + z; c.w_out = a.in[20] + z; c.final_g = a.in[21] + z;
    c.out = a.out + z; unsigned char* ws = a.ws + z;
    c.WinT = (bf16_t*)(ws + WS_WIN); c.WbT = (bf16_t*)(ws + WS_WB); c.WoT = (bf16_t*)(ws + WS_WO);
    c.mod = (float*)(ws + WS_MOD); c.atab = (float*)(ws + WS_ATAB); c.shb = (bf16_t*)(ws + WS_SHB); c.SW = (float*)(ws + WS_SW);
    c.xa = (bf16_t*)(ws + WS_XA); c.ssq = (float*)(ws + WS_SSQ); c.pbuf = (bf16_t*)(ws + WS_PBUF); c.y = (bf16_t*)(ws + WS_Y); c.mg = (bf16_t*)(ws + WS_MG);
    c.WadaT = (bf16_t*)(ws + WS_WADA); c.scb = (bf16_t*)(ws + WS_SCB); c.xb = (bf16_t*)(ws + WS_XB); c.xa2 = (bf16_t*)(ws + WS_XA2); c.SguW = (bf16_t*)(ws + WS_SGUW); c.PoolWT = (bf16_t*)(ws + WS_POOLW);
    c.lds = nullptr; c.tid = 0; c.lane = 0; c.wave = 0; c.gw = 0; c.NGW = 0; c.gtid = 0; c.NGT = 0;
    return c;
}
#define LAUNDER_CTX(a) size_t z_ = 0; asm volatile("" : "+s"(z_)); Ctx c = make_ctx(a, z_); { int t_ = threadIdx.x; asm volatile("" : "+v"(t_)); c.tid = t_; c.lane = t_ & 63; c.wave = __builtin_amdgcn_readfirstlane(t_ >> 6); \
    c.gw = blockIdx.x * NWAVES + c.wave; c.NGW = gridDim.x * NWAVES; c.gtid = blockIdx.x * NTHREADS + t_; c.NGT = gridDim.x * NTHREADS; }
struct MapWin { DEV int operator()(int g) const { return src_win((g & ~31) + perm32(g & 31)); } };
struct MapPerm { DEV int operator()(int g) const { return (g & ~31) + perm32(g & 31); } };
template <class Map>
DEV void transpose_item(const float* Wsrc, int ldw, int K, bf16_t* WT, int nblk, int item, float* scr, int lane, Map map) {
    const int kb = item / nblk, nb = item % nblk, k0 = 64 * kb, g0 = 32 * nb;
    const int scol = map(g0 + (lane & 31));
#pragma unroll 8
    for (int i = 0; i < 32; ++i) { const int kk = 2 * i + (lane >> 5); scr[kk * 33 + (lane & 31)] = Wsrc[(size_t)(k0 + kk) * ldw + scol]; }
    asm volatile("s_waitcnt lgkmcnt(0)" ::: "memory");
    const int c = lane & 7;
#pragma unroll
    for (int j = 0; j < 4; ++j) { const int n = (lane >> 3) + 8 * j; const float* s = scr + (8 * c) * 33 + n;
        u32x4 o; o.x = pk2(s[0 * 33], s[1 * 33]); o.y = pk2(s[2 * 33], s[3 * 33]); o.z = pk2(s[4 * 33], s[5 * 33]); o.w = pk2(s[6 * 33], s[7 * 33]);
        *(u32x4*)(WT + (size_t)(g0 + n) * K + k0 + 8 * c) = o; }
    asm volatile("s_waitcnt lgkmcnt(0)" ::: "memory");
}
constexpr int IT_WIN = (D / 64) * (NIN / 32), IT_WB = (W / 64) * (D / 32), IT_WO = (D / 64) * (D / 32);
constexpr int IT_PW = (128 / 64) * (128 / 32);
constexpr int IT_WADA = (D / 64) * (3072 / 32);
constexpr int IT_TOTAL = DEPTH * IT_WIN + DEPTH * 3 * IT_WB + DEPTH * IT_WO + DEPTH * 4 * IT_PW + DEPTH * IT_WADA;
DEV void ph_convert(const Args& a, unsigned char* lds, const int stage, const int b0) {
    LAUNDER_CTX(a);
    float* scr = (float*)(lds + c.wave * 16384);
    const int nb = (int)gridDim.x - b0, bw = ((int)blockIdx.x - b0) * NWAVES + c.wave, nw = nb * NWAVES, bt = ((int)blockIdx.x - b0) * NTHREADS + c.tid, nthr = nb * NTHREADS;
    if ((int)blockIdx.x < b0) return;
    if (stage == 0) {
        for (int r = bw; r < DEPTH * IT_WADA; r += nw) { const int l = r / IT_WADA; transpose_item(c.w_ada + (size_t)l * D * 3072, 3072, D, c.WadaT + (size_t)l * 3072 * D, 3072 / 32, r - l * IT_WADA, scr, c.lane, MapPerm()); }
        for (int idx = bt; idx < 256 * D / 4; idx += nthr) { const int n = idx >> 8, k4 = (idx & 255) * 4; f32x4 v = (f32x4){0.f, 0.f, 0.f, 0.f};
            if (n < NBT) { v = *(const f32x4*)((n < NBP ? c.c_prompt + (size_t)n * D : c.c_sample + (size_t)(n - NBP) * D) + k4); v = silu4(v); }
            *((u32x2*)c.scb + idx) = (u32x2){pk2(v.x, v.y), pk2(v.z, v.w)}; }
        return;
    }
    for (int it = bw; it < IT_TOTAL - DEPTH * IT_WADA; it += nw) {
        int r = it;
        if (r < DEPTH * IT_WIN) { const int l = r / IT_WIN; r -= l * IT_WIN; transpose_item(c.w_in + (size_t)l * D * NIN, NIN, D, c.WinT + (size_t)l * NIN * D, NIN / 32, r, scr, c.lane, MapWin()); continue; }
        r -= DEPTH * IT_WIN;
        if (r < DEPTH * 3 * IT_WB) { const int li = r / IT_WB; r -= li * IT_WB; transpose_item(c.w_branch + (size_t)li * W * D, D, W, c.WbT + (size_t)li * D * W, D / 32, r, scr, c.lane, MapPerm()); continue; }
        r -= DEPTH * 3 * IT_WB;
        if (r < DEPTH * IT_WO) { const int l = r / IT_WO; r -= l * IT_WO; transpose_item(c.w_out + (size_t)l * D * D, D, D, c.WoT + (size_t)l * D * D, D / 32, r, scr, c.lane, MapPerm()); continue; }
        r -= DEPTH * IT_WO;
        { const int lg = r / IT_PW; r -= lg * IT_PW; transpose_item(c.pool_w + (size_t)lg * 128 * 128, 128, 128, c.PoolWT + (size_t)lg * 128 * 128, 4, r, scr, c.lane, MapPerm()); }
    }
    for (int idx = bt; idx < DEPTH * 8 * 128 * 128 / 4; idx += nthr) { const int s4 = (idx & 31) * 4, t = (idx >> 5) & 127; const f32x4 v = *((const f32x4*)c.sgu_w + idx);
        *((u32x2*)c.SguW + idx) = (u32x2){pk2(s4 <= t ? v.x : 0.f, s4 + 1 <= t ? v.y : 0.f), pk2(s4 + 2 <= t ? v.z : 0.f, s4 + 3 <= t ? v.w : 0.f)}; }
}
DEV void ph_xa0(const Args& a) {
    LAUNDER_CTX(a);
    const int lane = c.lane, NSW = DEPTH * 30;
    if ((int)gridDim.x <= NSW || (int)blockIdx.x < NSW) { if ((int)gridDim.x > NSW) return; }
    const int w0 = ((int)gridDim.x > NSW) ? ((int)blockIdx.x - NSW) * NWAVES + c.wave : c.gw, nw = ((int)gridDim.x > NSW) ? ((int)gridDim.x - NSW) * NWAVES : c.NGW;
    for (int row = MV + w0; row < MP; row += nw) { u32x2* xo = (u32x2*)(c.xa + (size_t)row * D) + lane;
#pragma unroll
        for (int j = 0; j < 4; ++j) { xo[64 * j] = (u32x2){0u, 0u}; ((u32x2*)(c.xa2 + (size_t)row * D) + lane)[64 * j] = (u32x2){0u, 0u}; }
        if (lane < 16) c.ssq[row * 16 + lane] = 0.f; }
#pragma unroll 2
    for (int row = w0; row < MV; row += nw) {
        u32x2* xo = (u32x2*)(c.xa + (size_t)row * D) + lane;
        const float* xr = row < MPR ? c.x_prompt + (size_t)row * D : c.x_sample + (size_t)(row - MPR) * D;
        const float* ar = c.atab + (size_t)nidx_of(row) * D;
#pragma unroll
        for (int j = 0; j < 4; ++j) {
            const f32x4 v = *((const f32x4*)xr + lane + 64 * j), at = *((const f32x4*)ar + lane + 64 * j);
            xo[64 * j] = (u32x2){pk2(v.x * at.x, v.y * at.y), pk2(v.z * at.z, v.w * at.w)};
            float s = (v.x * v.x + v.y * v.y) + (v.z * v.z + v.w * v.w);
            s += __shfl_xor(s, 1); s += __shfl_xor(s, 2); s += __shfl_xor(s, 4); s += __shfl_xor(s, 32);
            if ((lane & 39) == 0) c.ssq[row * 16 + 4 * j + (lane >> 3)] = s;
        }
    }
}
DEV float row_rstd(const float* ssq, int row) {
    const f32x4* p = (const f32x4*)(ssq + (size_t)row * 16); const f32x4 a = p[0], b = p[1], c = p[2], d = p[3];
    const float s = ((a.x + a.y) + (a.z + a.w)) + ((b.x + b.y) + (b.z + b.w)) + ((c.x + c.y) + (c.z + c.w)) + ((d.x + d.y) + (d.z + d.w));
    return __builtin_amdgcn_rsqf(s * (1.f / D) + EPS);
}

DEV void store8(bf16_t* p, f32x4 a, f32x4 b) { u32x4 w; w.x = pk2(a.x, a.y); w.y = pk2(a.z, a.w); w.z = pk2(b.x, b.y); w.w = pk2(b.z, b.w); *(u32x4*)p = w; }

#define LAS __attribute__((address_space(3)))
constexpr int BK = 64, HALF = 128, HTB = HALF * BK * 2, STAGE_BYTES = 8 * HTB;
DEV int lds_byte(int r, int c) { const int st = (r >> 4) * 2 + (c >> 5), rr = r & 15, cc = c & 31, ob = rr * 64 + cc * 2; return st * 1024 + (ob ^ (((ob >> 9) & 1) << 5)); }
DEV void stage_rc(int b, int& R, int& C) { const int st = b / 1024, sb = b % 1024, swz = sb ^ (((sb >> 9) & 1) << 5); R = (st >> 1) * 16 + swz / 64; C = (st & 1) * 32 + (swz % 64) / 2; }
struct UnitD { const char* A; const char* B; int pm, pn, aux; };
constexpr int NXCD = 8;
constexpr int WGM_P1 = 5, WGM_P3 = 4, WGM_P4 = 8;
struct TileOrder {
    int nM, nN, nwg, G, c;
    DEV void init(int nM_, int nN_, int G_, int c_) { nM = nM_; nN = nN_; nwg = nM * nN; G = G_; c = c_; }
    template <int WGM> DEV bool tile(int i, int& pm, int& pn) const {
        const long L = (long)i * G + c; if (L >= nwg) return false;
        int wgid = (int)L; { const int q = nwg / NXCD, r = nwg % NXCD, xcd = wgid % NXCD, off = wgid / NXCD; wgid = (xcd < r ? xcd * (q + 1) : r * (q + 1) + (xcd - r) * q) + off; }
        const int nig = WGM * nN, gid = wgid / nig, fm = gid * WGM, gsz = (nM - fm) < WGM ? (nM - fm) : WGM;
        pm = fm + ((wgid % nig) % gsz); pn = (wgid % nig) / gsz; return true;
    }
};
template <class Epi, class Sched, int NBH = 2>
DEV void gemm_phase(LAS unsigned char* lds, const int lda  , const int ldb  , const int nt  , const Sched& S, const Epi& E) {
    int tid = threadIdx.x; asm volatile("" : "+v"(tid));
    const int wid = __builtin_amdgcn_readfirstlane(tid >> 6), lane = tid & 63, wr = wid >> 2, wc = wid & 3, fr = lane & 15, fq = lane >> 4;
    unsigned voffA[2], voffB[2];
#pragma unroll
    for (int i = 0; i < 2; ++i) { int R, C; stage_rc(tid * 16 + i * 8192, R, C); voffA[i] = (unsigned)(R * lda + C * 2); voffB[i] = (unsigned)(R * ldb + C * 2); }
    const size_t kstep = (size_t)(BK * 2);
    const size_t hstepA = (size_t)HALF * lda, hstepB = (size_t)HALF * ldb;
    const unsigned ldsw = (unsigned)wid * 1024u;
    const int aoff = lds_byte(wr * 64 + fr, fq * 8), boff = lds_byte(wc * 32 + fr, fq * 8);
#define PG8_SA(b, h) (((b) * 2 + (h)) * HTB)
#define PG8_SB(b, h) ((4 + (b) * 2 + (h)) * HTB)
#define PG8_STAGE(bufoff, gbase, voff) do { _Pragma("unroll") for (int _i = 0; _i < 2; ++_i) \
        __builtin_amdgcn_global_load_lds((const unsigned*)((const char*)(gbase) + (voff)[_i]), (LAS unsigned*)(lds + (bufoff) + ldsw + _i * 8192), 16, 0, 0); } while (0)
#define PG8_LDA(dst, b, h) do { _Pragma("unroll") for (int m = 0; m < 4; ++m) _Pragma("unroll") for (int k = 0; k < 2; ++k) dst[m][k] = *(const LAS bf16x8*)(lds + PG8_SA(b, h) + aoff + m * 2048 + k * 1024); } while (0)
#define PG8_LDB(dst, b, h) do { _Pragma("unroll") for (int n = 0; n < 2; ++n) _Pragma("unroll") for (int k = 0; k < 2; ++k) dst[n][k] = *(const LAS bf16x8*)(lds + PG8_SB(b, h) + boff + n * 2048 + k * 1024); } while (0)
#define PG8_MMA(ai, bj, At, Bt) do { __builtin_amdgcn_s_setprio(1); _Pragma("unroll") for (int m = 0; m < 4; ++m) _Pragma("unroll") for (int n = 0; n < 2; ++n) _Pragma("unroll") for (int k = 0; k < 2; ++k) \
        acc[ai][bj][m][n] = __builtin_amdgcn_mfma_f32_16x16x32_bf16(Bt[n][k], At[m][k], acc[ai][bj][m][n], 0, 0, 0); __builtin_amdgcn_s_setprio(0); } while (0)
#define PG8_WAIT_V(n) asm volatile("s_waitcnt vmcnt(" #n ")" ::: "memory")
#define PG8_WAIT_VN() do { if constexpr (NBH == 2) PG8_WAIT_V(8); else PG8_WAIT_V(6); } while (0)
#define PG8_WAIT_L(n) asm volatile("s_waitcnt lgkmcnt(" #n ")" ::: "memory")
#define PG8_BAR __builtin_amdgcn_s_barrier()
#define PG8_SCHED __builtin_amdgcn_sched_barrier(0)
    UnitD cur, nxt; int ui = 0;
    if (!S.next(0, cur)) return;
    f32x4 acc[2][NBH][4][2];
#pragma unroll
    for (int a = 0; a < 2; ++a)
#pragma unroll
        for (int b = 0; b < NBH; ++b)
#pragma unroll
            for (int m = 0; m < 4; ++m)
#pragma unroll
                for (int n = 0; n < 2; ++n) acc[a][b][m][n] = (f32x4){0.f, 0.f, 0.f, 0.f};
    bf16x8 At[4][2], B0[2][2], B1[2][2];
    const char* cA = cur.A; const char* cB = cur.B;
    PG8_STAGE(PG8_SB(0, 0), cB, voffB); if constexpr (NBH == 2) PG8_STAGE(PG8_SB(0, 1), cB + hstepB, voffB); PG8_STAGE(PG8_SA(0, 0), cA, voffA); PG8_STAGE(PG8_SA(0, 1), cA + hstepA, voffA);
    if (wr == 1) PG8_BAR;
    PG8_WAIT_V(2); PG8_BAR;
    PG8_STAGE(PG8_SB(1, 0), cB + kstep, voffB); PG8_STAGE(PG8_SA(1, 0), cA + kstep, voffA); if constexpr (NBH == 2) PG8_STAGE(PG8_SB(1, 1), cB + hstepB + kstep, voffB);
    if constexpr (NBH == 2) PG8_WAIT_V(6); else PG8_WAIT_V(4);
    PG8_BAR;
    for (;;) {
        const bool has_next = S.next(ui + 1, nxt);
        const char* nA = has_next ? nxt.A : cA; const char* nB = has_next ? nxt.B : cB;
        for (int t = 0; t < nt; t += 2) {
            const bool last = (t == nt - 2);
            const char* a1 = cA + (size_t)(t + 1) * kstep;
            const char* a2 = last ? nA : cA + (size_t)(t + 2) * kstep; const char* b2 = last ? nB : cB + (size_t)(t + 2) * kstep;
            const char* a3 = a2 + kstep; const char* b3 = b2 + kstep;
            PG8_LDB(B0, 0, 0); if constexpr (NBH == 2) PG8_LDB(B1, 0, 1); PG8_SCHED; PG8_LDA(At, 0, 0); PG8_STAGE(PG8_SA(1, 1), a1 + hstepA, voffA);
            PG8_WAIT_VN(); PG8_WAIT_L(0); PG8_BAR; PG8_MMA(0, 0, At, B0); if constexpr (NBH == 2) PG8_MMA(0, 1, At, B1); PG8_BAR; PG8_SCHED;
            PG8_LDA(At, 0, 1); PG8_STAGE(PG8_SB(0, 0), b2, voffB); if constexpr (NBH == 2) PG8_STAGE(PG8_SB(0, 1), b2 + hstepB, voffB); PG8_STAGE(PG8_SA(0, 0), a2, voffA);
            PG8_WAIT_VN(); PG8_WAIT_L(0); PG8_BAR; PG8_MMA(1, 0, At, B0); if constexpr (NBH == 2) PG8_MMA(1, 1, At, B1); PG8_BAR; PG8_SCHED;
            PG8_LDB(B0, 1, 0); if constexpr (NBH == 2) PG8_LDB(B1, 1, 1); PG8_SCHED; PG8_LDA(At, 1, 0); PG8_STAGE(PG8_SA(0, 1), a2 + hstepA, voffA);
            PG8_WAIT_VN(); PG8_WAIT_L(0); PG8_BAR; PG8_MMA(0, 0, At, B0); if constexpr (NBH == 2) PG8_MMA(0, 1, At, B1); PG8_BAR; PG8_SCHED;
            PG8_LDA(At, 1, 1); PG8_STAGE(PG8_SB(1, 0), b3, voffB); if constexpr (NBH == 2) PG8_STAGE(PG8_SB(1, 1), b3 + hstepB, voffB); PG8_STAGE(PG8_SA(1, 0), a3, voffA);
            PG8_WAIT_VN(); PG8_WAIT_L(0); PG8_BAR; PG8_MMA(1, 0, At, B0); if constexpr (NBH == 2) PG8_MMA(1, 1, At, B1); PG8_BAR; PG8_SCHED;
        }
        if (wr == 0) PG8_BAR;
        E(acc, cur, nxt, has_next, wr, wc, fr, fq);
        if (!has_next) break;
#pragma unroll
        for (int a = 0; a < 2; ++a)
#pragma unroll
            for (int b = 0; b < NBH; ++b)
#pragma unroll
                for (int m = 0; m < 4; ++m)
#pragma unroll
                    for (int n = 0; n < 2; ++n) acc[a][b][m][n] = (f32x4){0.f, 0.f, 0.f, 0.f};
        cur = nxt; cA = nA; cB = nB; ++ui;
        if (wr == 1) PG8_BAR;
    }
    PG8_WAIT_V(0);
    PG8_BAR;
#undef PG8_SA
#undef PG8_SB
#undef PG8_STAGE
#undef PG8_LDA
#undef PG8_LDB
#undef PG8_MMA
#undef PG8_WAIT_V
#undef PG8_WAIT_L
#undef PG8_WAIT_VN
#undef PG8_BAR
#undef PG8_SCHED
}


struct SchedMod { int G, c; const char* A; const char* B;
    DEV bool next(int i, UnitD& u) const { const int idx = i * G + c; if (idx >= 48) return false; u.pm = 0; u.pn = idx; u.aux = 0; u.A = A; u.B = B + (size_t)idx * 256 * (D * 2); return true; } };
struct EpiMod { float* mod; float* atab; bf16_t* shb; const float* b_ada; const float* norm_g;
    DEV void operator()(int pn, int row, int wc, int fq, f32x4 (&v)[2][2]) const {
#pragma unroll
        for (int bj = 0; bj < 2; ++bj) { const int gc = 256 * pn + 128 * bj + 32 * wc + 8 * fq, l = gc / 3072, j3 = gc - l * 3072;
            const f32x4 v0 = v[bj][0] + *(const f32x4*)(b_ada + gc), v1 = v[bj][1] + *(const f32x4*)(b_ada + gc + 4);
            if (row < NBT) { float* o = mod + ((size_t)l * NBT + row) * 3072 + j3; *(f32x4*)o = v0; *(f32x4*)(o + 4) = v1; }
            if (j3 < D) { const f32x4 z = (f32x4){0.f, 0.f, 0.f, 0.f}; store8(shb + ((size_t)l * 256 + row) * D + j3, row < NBT ? v0 : z, row < NBT ? v1 : z); }
            else if (j3 < 2 * D && row < NBT) { const float* ng = norm_g + l * D + (j3 - D); float* o = atab + ((size_t)l * NBT + row) * D + (j3 - D);
                f32x4 a0 = *(const f32x4*)ng * (v0 + 1.f), a1 = *(const f32x4*)(ng + 4) * (v1 + 1.f);
#pragma unroll
                for (int j = 0; j < 4; ++j) { a0[j] = __builtin_fabsf(a0[j]) < 1e-20f ? 1e-20f : a0[j]; a1[j] = __builtin_fabsf(a1[j]) < 1e-20f ? 1e-20f : a1[j]; }
                *(f32x4*)o = a0; *(f32x4*)(o + 4) = a1; }
        }
    } };
template <int NSEG, int KS  , class RowEpi>
DEV void mini_gemm(const Args& a, LAS unsigned char* lds, int u, const bf16_t* A, int lda, int a_seg, const bf16_t* Bt, int ldb, size_t b_seg, const RowEpi& e) {
    LAUNDER_CTX(a);
    const int lane = c.lane, w = c.wave, fr = lane & 15, fq = lane >> 4, rb = u & 7, pn = (u >> 3) & 3, wc = u >> 5, row = MPR + 16 * rb + fr, kw = 32 * KS;
    bf16x8 af[NSEG][KS], bf[NSEG][KS][4];
#pragma unroll
    for (int s = 0; s < NSEG; ++s) { const bf16_t* ap = A + (size_t)row * lda + s * a_seg + w * kw + 8 * fq; const bf16_t* bp = Bt + s * b_seg + (size_t)(256 * pn + 32 * wc + fr) * ldb + w * kw + 8 * fq;
#pragma unroll
        for (int k = 0; k < KS; ++k) { af[s][k] = *(const bf16x8*)(ap + 32 * k);
#pragma unroll
            for (int q = 0; q < 4; ++q) bf[s][k][q] = *(const bf16x8*)(bp + (size_t)(128 * (q >> 1) + 16 * (q & 1)) * ldb + 32 * k); } }
    f32x4 acc[NSEG][4];
#pragma unroll
    for (int s = 0; s < NSEG; ++s) {
#pragma unroll
        for (int q = 0; q < 4; ++q) acc[s][q] = (f32x4){0.f, 0.f, 0.f, 0.f};
#pragma unroll
        for (int k = 0; k < KS; ++k)
#pragma unroll
            for (int q = 0; q < 4; ++q) acc[s][q] = __builtin_amdgcn_mfma_f32_16x16x32_bf16(bf[s][k][q], af[s][k], acc[s][q], 0, 0, 0);
    }
#pragma unroll
    for (int s = 0; s < NSEG; ++s)
#pragma unroll
        for (int q = 0; q < 4; ++q) *(LAS f32x4*)(lds + (((w * NSEG + s) * 4 + q) * 64 + lane) * 16) = acc[s][q];
    __syncthreads();
    if (w == 0) {
        f32x4 v[NSEG][2][2];
#pragma unroll
        for (int s = 0; s < NSEG; ++s)
#pragma unroll
            for (int q = 0; q < 4; ++q) { f32x4 t = *(const LAS f32x4*)(lds + (((0 * NSEG + s) * 4 + q) * 64 + lane) * 16);
#pragma unroll
                for (int ww = 1; ww < 8; ++ww) t += *(const LAS f32x4*)(lds + (((ww * NSEG + s) * 4 + q) * 64 + lane) * 16);
                v[s][q >> 1][q & 1] = t; }
        e(pn, row, wc, fq, v);
    }
    __syncthreads();
}

constexpr int RTAB_OFF = STAGE_BYTES;
constexpr int SWT_OFF = RTAB_OFF + 8192;
template <int TY, bool SMP> DEV void p1_rows(const f32x4 (&acc)[2][2][4][2], bf16_t* pb  , const LAS float* rt, const float* swb, const int row0, f32x4 s00, f32x4 s01, f32x4 s10, f32x4 s11) {
    f32x4 n00 = s00, n01 = s01, n10 = s10, n11 = s11;
    if (SMP) { const float* sw = swb + (size_t)nidx_of(row0) * NIN; n00 = *(const f32x4*)(sw); n01 = *(const f32x4*)(sw + 4); n10 = *(const f32x4*)(sw + 128); n11 = *(const f32x4*)(sw + 132); }
#pragma unroll
    for (int ai = 0; ai < 2; ++ai) {
#pragma unroll
        for (int m = 0; m < 4; ++m) { const int rl = ai * HALF + m * 16; const float r = rt[rl];
            if (SMP) { s00 = n00; s01 = n01; s10 = n10; s11 = n11;
                if (ai * 4 + m < 7) { const int rn = ((ai * 4 + m + 1) >> 2) * HALF + ((ai * 4 + m + 1) & 3) * 16; const float* sw = swb + (size_t)nidx_of(row0 + rn) * NIN; n00 = *(const f32x4*)(sw); n01 = *(const f32x4*)(sw + 4); n10 = *(const f32x4*)(sw + 128); n11 = *(const f32x4*)(sw + 132); } }
            f32x4 a0 = acc[ai][0][m][0] * r + s00, a1 = acc[ai][0][m][1] * r + s01, b0 = acc[ai][1][m][0] * r + s10, b1 = acc[ai][1][m][1] * r + s11;
            bf16_t* pr = pb + (size_t)rl * PC;
            if (TY == 0) { store8(pr, a0 * b0, a1 * b1); }
            else if (TY == 1) { store8(pr, a0 * silu4(b0), a1 * silu4(b1)); }
            else if (TY == 2) { store8(pr, gelu4(a0) * silu4(b0), gelu4(a1) * silu4(b1)); }
            else {
                if (TY == 3) { a0 = gelu4(a0); a1 = gelu4(a1); b0 = gelu4(b0); b1 = gelu4(b1); }
                if (TY == 5) { a0 = silu4(a0); a1 = silu4(a1); b0 = silu4(b0); b1 = silu4(b1); }
                if (TY == 6) { a0 = sigmoid4(a0); a1 = sigmoid4(a1); b0 = sigmoid4(b0); b1 = sigmoid4(b1); }
                if (TY == 6) { unsigned char* gq = (unsigned char*)pr; *(u32x2*)gq = (u32x2){pku8(a0), pku8(a1)}; *(u32x2*)(gq + 128) = (u32x2){pku8(b0), pku8(b1)}; }
                else { store8(pr, a0, a1); store8(pr + 128, b0, b1); } }
        }
        if (!SMP) asm volatile("" ::: "memory");
    }
}
struct EpiP1T { bf16_t* pbuf; const float* SWl; const LAS float* rtab; const LAS float* swt;
    DEV void operator()(f32x4 (&acc)[2][2][4][2], const UnitD& u, const UnitD& un, const bool has_next, int wr, int wc, int fr, int fq) const {
        const int pn = u.pn, cb = 32 * wc + 8 * fq, row0 = u.pm * 256 + wr * 64 + fr; const bool smp = u.pm >= MPR / 256;
        const float* swb = SWl + 256 * pn + cb; const LAS float* sw = swt + u.aux * 256 + cb;
        const f32x4 s00 = *(const LAS f32x4*)(sw), s01 = *(const LAS f32x4*)(sw + 4), s10 = *(const LAS f32x4*)(sw + 128), s11 = *(const LAS f32x4*)(sw + 132);
        const LAS float* rt = rtab + u.aux * 256 + wr * 64 + fr;
        bf16_t* pb = pbuf + (size_t)row0 * PC + cb;
#define P1_DISPATCH(SM) \
        if (pn < 4) p1_rows<0, SM>(acc, pb + PZ + 128 * pn, rt, swb, row0, s00, s01, s10, s11); \
        else if (pn < 8) p1_rows<1, SM>(acc, pb + PABG + 128 * (pn - 4), rt, swb, row0, s00, s01, s10, s11); \
        else if (pn < 12) p1_rows<2, SM>(acc, pb + PUG + 128 * (pn - 8), rt, swb, row0, s00, s01, s10, s11); \
        else if (pn < 14) p1_rows<3, SM>(acc, pb + PGV + 256 * (pn - 12), rt, swb, row0, s00, s01, s10, s11); \
        else if (pn < 16) p1_rows<4, SM>(acc, pb + PCX + 256 * (pn - 14), rt, swb, row0, s00, s01, s10, s11); \
        else if (pn < 18) p1_rows<5, SM>(acc, pb + PSG + 256 * (pn - 16), rt, swb, row0, s00, s01, s10, s11); \
        else p1_rows<6, SM>(acc, (bf16_t*)((unsigned char*)(pb - cb + PGATE) + 256 * (pn - 18) + cb), rt, swb, row0, s00, s01, s10, s11);
        if (smp) { P1_DISPATCH(true) } else { P1_DISPATCH(false) }
#undef P1_DISPATCH
    } };
template <class Sched> DEV void p1_rtab(const Sched& S, const float* ssq, const float* SWl, LAS float* rtab, LAS float* swt) {
    int t = threadIdx.x; asm volatile("" : "+v"(t));
#pragma unroll
    for (int k = 0; k < 4; ++k) { const int q = t + 512 * k, i = q >> 8, rl = q & 255; UnitD u;
        if (S.next(i, u)) { rtab[q] = row_rstd(ssq, u.pm * 256 + rl); swt[q] = SWl[(size_t)(u.pm < MPR / 256 ? (u.pm >> 3) : NBP) * NIN + 256 * u.pn + rl]; } }
    __syncthreads();
}
template <bool IN16, bool LAST> struct EpiP4T { const float* gate; const float* atab_cur; const float* atab_next; const bf16_t* xa; bf16_t* xao; float* ssq; const float* xin; bf16_t* xb;
    DEV void operator()(f32x4 (&acc)[2][2][4][2], const UnitD& u, const UnitD& un, const bool has_next, int wr, int wc, int fr, int fq) const {
        const int pn = u.pn, nb = u.pm >> 3, col = 256 * pn + 32 * wc + 8 * fq, row0 = u.pm * 256 + wr * 64 + fr;
        const float* gp = gate + (size_t)nb * 3072 + col;
        f32x4 g[2][2], at[2][2], iv[2][2];
#pragma unroll
        for (int bj = 0; bj < 2; ++bj)
#pragma unroll
            for (int n = 0; n < 2; ++n) { g[bj][n] = *(const f32x4*)(gp + 128 * bj + 4 * n);
                at[bj][n] = LAST ? (f32x4){0.f, 0.f, 0.f, 0.f} : *(const f32x4*)(atab_next + (size_t)nb * D + col + 128 * bj + 4 * n);
                iv[bj][n] = IN16 ? rcp4(*(const f32x4*)(atab_cur + (size_t)nb * D + col + 128 * bj + 4 * n)) : (f32x4){0.f, 0.f, 0.f, 0.f}; }
        const size_t off0 = (size_t)row0 * D + col;
        f32x4 x[2][2], xn[2][2]; u32x4 xh[2], xhn[2];
#pragma unroll
        for (int bj = 0; bj < 2; ++bj) { if (IN16) xh[bj] = *(const u32x4*)(xa + off0 + 128 * bj); else { x[bj][0] = *(const f32x4*)(xin + off0 + 128 * bj); x[bj][1] = *(const f32x4*)(xin + off0 + 128 * bj + 4); } }
#pragma unroll
        for (int r = 0; r < 8; ++r) { const int ai = r >> 2, m = r & 3, rl = ai * HALF + m * 16, row = row0 + rl; float s = 0.f;
            if (r < 7) { const size_t offn = off0 + (size_t)(((r + 1) >> 2) * HALF + ((r + 1) & 3) * 16) * D;
#pragma unroll
                for (int bj = 0; bj < 2; ++bj) { if (IN16) xhn[bj] = *(const u32x4*)(xa + offn + 128 * bj); else { xn[bj][0] = *(const f32x4*)(xin + offn + 128 * bj); xn[bj][1] = *(const f32x4*)(xin + offn + 128 * bj + 4); } } }
            const size_t off = off0 + (size_t)rl * D;
#pragma unroll
            for (int bj = 0; bj < 2; ++bj) {
                if (IN16) { unpk8(xh[bj], x[bj][0], x[bj][1]); x[bj][0] *= iv[bj][0]; x[bj][1] *= iv[bj][1]; }
#pragma unroll
                for (int n = 0; n < 2; ++n) { const f32x4 t = x[bj][n] + g[bj][n] * acc[ai][bj][m][n]; x[bj][n] = t; s += (t.x * t.x + t.y * t.y) + (t.z * t.z + t.w * t.w); }
                if (LAST) store8(xb + off + 128 * bj, x[bj][0], x[bj][1]);
                else store8(xao + off + 128 * bj, x[bj][0] * at[bj][0], x[bj][1] * at[bj][1]); }
            s += __shfl_xor(s, 16); s += __shfl_xor(s, 32);
            if (fq == 0) ssq[row * 16 + 4 * pn + wc] = s;
#pragma unroll
            for (int bj = 0; bj < 2; ++bj) { xh[bj] = xhn[bj]; x[bj][0] = xn[bj][0]; x[bj][1] = xn[bj][1]; }
        }
    } };

struct SchedP3R { TileOrder T; const char* A; const char* B;
    DEV bool next(int i, UnitD& u) const { int pm, pc; const int seg = i % 3; if (!T.tile<WGM_P3>(i / 3, pm, pc)) return false; u.pm = pm; u.pn = pc; u.aux = seg;
        u.A = A + (size_t)pm * 256 * (1536 * 2) + (size_t)seg * (W * 2); u.B = B + (size_t)seg * D * (W * 2) + (size_t)pc * 128 * (W * 2); return true; } };
struct EpiP3R { f32x4 (&tot)[2][4][2]; u32x2 (&gpre)[8]; const bf16_t* pbuf; bf16_t* mg;
    DEV void prefetch(const UnitD& u, int wr, int wc, int fr, int fq) const {
        const unsigned char* gp = (const unsigned char*)(pbuf + (size_t)(u.pm * 256 + wr * 64 + fr) * PC + PGATE) + 1024 * u.aux + 128 * u.pn + 32 * wc + 8 * fq;
#pragma unroll
        for (int r = 0; r < 8; ++r) gpre[r] = *(const u32x2*)(gp + (size_t)((r >> 2) * HALF + (r & 3) * 16) * (PC * 2));
    }
    DEV void operator()(f32x4 (&acc)[2][1][4][2], const UnitD& u, const UnitD& un, const bool has_next, int wr, int wc, int fr, int fq) const {
        const int seg = u.aux, cb = 128 * u.pn + 32 * wc + 8 * fq, row0 = u.pm * 256 + wr * 64 + fr;
        bf16_t* o = mg + (size_t)row0 * D + cb;
        u32x2 g[8];
#pragma unroll
        for (int r = 0; r < 8; ++r) g[r] = gpre[r];
        if (has_next) prefetch(un, wr, wc, fr, fq);
        const float keep = seg ? 1.f : 0.f;
#pragma unroll
        for (int r = 0; r < 8; ++r) { const int ai = r >> 2, m = r & 3; const f32x4 g0 = gate4(g[r].x), g1 = gate4(g[r].y);
            const f32x4 t0 = acc[ai][0][m][0] * g0 + tot[ai][m][0] * keep, t1 = acc[ai][0][m][1] * g1 + tot[ai][m][1] * keep;
            tot[ai][m][0] = t0; tot[ai][m][1] = t1;
            if (seg == 2) store8(o + (size_t)(ai * HALF + m * 16) * D, t0, t1); }
    } };

DEV bool fin_wait(unsigned* cnt, unsigned want) {
    unsigned sp = 0; bool ok = true;
    while (__hip_atomic_load(cnt, __ATOMIC_RELAXED, __HIP_MEMORY_SCOPE_AGENT) < want) { __builtin_amdgcn_s_sleep(2); if (++sp > (1u << 20)) { ok = false; break; } }
    __builtin_amdgcn_fence(__ATOMIC_ACQUIRE, "agent");
    asm volatile("s_waitcnt vmcnt(0)" ::: "memory");
    return ok;
}
struct EpiP4TL { const float* gate; const float* atab_cur; const bf16_t* xa; float* xch  ; unsigned* cnt  ; const float* final_g; float* out; LAS float* ptab  ;
    DEV void operator()(f32x4 (&acc)[2][2][4][2], const UnitD& u, const UnitD& un, const bool has_next, int wr, int wc, int fr, int fq) const {
        const int pn = u.pn, nb = u.pm >> 3, col = 256 * pn + 32 * wc + 8 * fq, rl0 = wr * 64 + fr, row0 = u.pm * 256 + rl0;
        int tid = threadIdx.x; asm volatile("" : "+v"(tid));
        const float* gp = gate + (size_t)nb * 3072 + col;
        f32x4 g[2][2], iv[2][2];
#pragma unroll
        for (int bj = 0; bj < 2; ++bj)
#pragma unroll
            for (int n = 0; n < 2; ++n) { g[bj][n] = *(const f32x4*)(gp + 128 * bj + 4 * n); iv[bj][n] = rcp4(*(const f32x4*)(atab_cur + (size_t)nb * D + col + 128 * bj + 4 * n)); }
        const size_t off0 = (size_t)row0 * D + col;
        u32x4 xh[2], xhn[2];
#pragma unroll
        for (int bj = 0; bj < 2; ++bj) xh[bj] = *(const u32x4*)(xa + off0 + 128 * bj);
#pragma unroll
        for (int r = 0; r < 8; ++r) { const int ai = r >> 2, m = r & 3, rl = ai * HALF + m * 16; float s = 0.f;
            if (r < 7) { const size_t offn = off0 + (size_t)(((r + 1) >> 2) * HALF + ((r + 1) & 3) * 16) * D;
#pragma unroll
                for (int bj = 0; bj < 2; ++bj) xhn[bj] = *(const u32x4*)(xa + offn + 128 * bj); }
#pragma unroll
            for (int bj = 0; bj < 2; ++bj) { f32x4 x0, x1; unpk8(xh[bj], x0, x1);
                const f32x4 t0 = x0 * iv[bj][0] + g[bj][0] * acc[ai][bj][m][0], t1 = x1 * iv[bj][1] + g[bj][1] * acc[ai][bj][m][1];
                acc[ai][bj][m][0] = t0; acc[ai][bj][m][1] = t1;
                s += ((t0.x * t0.x + t0.y * t0.y) + (t0.z * t0.z + t0.w * t0.w)) + ((t1.x * t1.x + t1.y * t1.y) + (t1.z * t1.z + t1.w * t1.w)); }
            s += __shfl_xor(s, 16); s += __shfl_xor(s, 32);
            if (fq == 0) ptab[(rl0 + rl) * 4 + wc] = s;
            xh[0] = xhn[0]; xh[1] = xhn[1];
        }
        asm volatile("s_waitcnt lgkmcnt(0)" ::: "memory"); __builtin_amdgcn_s_barrier(); asm volatile("" ::: "memory");
        if (tid < 256) { const f32x4 p = *(const LAS f32x4*)(ptab + tid * 4);
            __hip_atomic_store(xch + (size_t)(u.pm * 256 + tid) * 16 + pn, (p.x + p.y) + (p.z + p.w), __ATOMIC_RELAXED, __HIP_MEMORY_SCOPE_AGENT); }
        asm volatile("s_waitcnt vmcnt(0)" ::: "memory");
        if (tid < 256 && (tid & 63) == 0) __hip_atomic_fetch_add(cnt + 64 * u.pm, 1u, __ATOMIC_RELAXED, __HIP_MEMORY_SCOPE_AGENT);
        if (tid < 64) (void)fin_wait(cnt + 64 * u.pm, 16u);
        asm volatile("s_waitcnt vmcnt(0) lgkmcnt(0)" ::: "memory"); __builtin_amdgcn_s_barrier(); asm volatile("" ::: "memory");
        if (tid < 256) { const float* sl = xch + (size_t)(u.pm * 256 + tid) * 16;
            const float t = (__hip_atomic_load(sl, __ATOMIC_RELAXED, __HIP_MEMORY_SCOPE_AGENT) + __hip_atomic_load(sl + 1, __ATOMIC_RELAXED, __HIP_MEMORY_SCOPE_AGENT)) + (__hip_atomic_load(sl + 2, __ATOMIC_RELAXED, __HIP_MEMORY_SCOPE_AGENT) + __hip_atomic_load(sl + 3, __ATOMIC_RELAXED, __HIP_MEMORY_SCOPE_AGENT));
            ptab[1024 + tid] = __builtin_amdgcn_rsqf(t * (1.f / D) + EPS); }
        asm volatile("s_waitcnt lgkmcnt(0)" ::: "memory"); __builtin_amdgcn_s_barrier(); asm volatile("" ::: "memory");
        f32x4 fg[2][2];
#pragma unroll
        for (int bj = 0; bj < 2; ++bj)
#pragma unroll
            for (int n = 0; n < 2; ++n) fg[bj][n] = *(const f32x4*)(final_g + col + 128 * bj + 4 * n);
#pragma unroll
        for (int r = 0; r < 8; ++r) { const int ai = r >> 2, m = r & 3, rl = ai * HALF + m * 16; const float rs = ptab[1024 + rl0 + rl];
#pragma unroll
            for (int bj = 0; bj < 2; ++bj)
#pragma unroll
                for (int n = 0; n < 2; ++n) *(f32x4*)(out + off0 + (size_t)rl * D + 128 * bj + 4 * n) = acc[ai][bj][m][n] * rs * fg[bj][n]; }
    } };
struct EpiP4L { const float* gate; const float* atab_cur; const bf16_t* xa; float* xch; unsigned* cnt; const float* final_g; float* out;
    DEV void operator()(int pn, int row, int wc, int fq, f32x4 (&vv)[1][2][2]) const {
        f32x4 (&v)[2][2] = vv[0];
        const int nb = nidx_of(row), col = 256 * pn + 32 * wc + 8 * fq, rb = (row - MPR) >> 4;
        const float* gp = gate + (size_t)nb * 3072 + col;
        f32x4 t[2][2]; float s = 0.f;
#pragma unroll
        for (int bj = 0; bj < 2; ++bj) { f32x4 x0, x1; unpk8(*(const u32x4*)(xa + (size_t)row * D + col + 128 * bj), x0, x1); const float* ac = atab_cur + (size_t)nb * D + col + 128 * bj;
            t[bj][0] = x0 * rcp4(*(const f32x4*)ac) + *(const f32x4*)(gp + 128 * bj) * v[bj][0]; t[bj][1] = x1 * rcp4(*(const f32x4*)(ac + 4)) + *(const f32x4*)(gp + 128 * bj + 4) * v[bj][1];
            s += ((t[bj][0].x * t[bj][0].x + t[bj][0].y * t[bj][0].y) + (t[bj][0].z * t[bj][0].z + t[bj][0].w * t[bj][0].w)) + ((t[bj][1].x * t[bj][1].x + t[bj][1].y * t[bj][1].y) + (t[bj][1].z * t[bj][1].z + t[bj][1].w * t[bj][1].w)); }
        s += __shfl_xor(s, 16); s += __shfl_xor(s, 32);
        if (fq == 0) __hip_atomic_store(xch + (size_t)row * 16 + 4 * pn + wc, s, __ATOMIC_RELAXED, __HIP_MEMORY_SCOPE_AGENT);
        asm volatile("s_waitcnt vmcnt(0)" ::: "memory");
        if ((threadIdx.x & 63) == 0) __hip_atomic_fetch_add(cnt + 64 * (64 + rb), 1u, __ATOMIC_RELAXED, __HIP_MEMORY_SCOPE_AGENT);
        (void)fin_wait(cnt + 64 * (64 + rb), 16u);
        const float* sl = xch + (size_t)row * 16; float tot = 0.f;
#pragma unroll
        for (int k = 0; k < 16; ++k) tot += __hip_atomic_load(sl + k, __ATOMIC_RELAXED, __HIP_MEMORY_SCOPE_AGENT);
        const float rs = __builtin_amdgcn_rsqf(tot * (1.f / D) + EPS);
#pragma unroll
        for (int bj = 0; bj < 2; ++bj)
#pragma unroll
            for (int n = 0; n < 2; ++n) *(f32x4*)(out + (size_t)row * D + col + 128 * bj + 4 * n) = t[bj][n] * rs * *(const f32x4*)(final_g + col + 128 * bj + 4 * n);
    } };
#define XB_TMO      128
#define XB_XCNT(j)  (256  + 64 * (j))
#define XB_XSUB(j)  (1280 + 64 * (j))
#define XB_XGEN(j)  (2304 + 64 * (j))
#define XB_TOP      3328
#define XB_TOPGEN   3392
#define XCD_BAR_WORDS 3456
#define XB_SPIN_CAP (1u << 18)
DEV unsigned xb_ld(unsigned* p)              { return __hip_atomic_load(p, __ATOMIC_RELAXED, __HIP_MEMORY_SCOPE_AGENT); }
DEV unsigned xb_add(unsigned* p, unsigned v) { return __hip_atomic_fetch_add(p, v, __ATOMIC_RELAXED, __HIP_MEMORY_SCOPE_AGENT); }
DEV unsigned xb_xcc_id() { return (unsigned)__builtin_amdgcn_s_getreg((3 << 11) | 20) & 0xFu; }
#define XB_SPIN(cond, bar) do { unsigned _sp = 0; while (cond) { __builtin_amdgcn_s_sleep(1); \
    if ((++_sp & 255u) == 0u) { if (xb_ld(&(bar)[XB_TMO])) break; if (_sp > XB_SPIN_CAP) { atomicAdd(&(bar)[XB_TMO], 1u); break; } } } } while (0)
struct XcdBarrier { unsigned* bar; unsigned x; volatile LAS unsigned* st; };
DEV XcdBarrier xcd_barrier_post(unsigned* bar, volatile LAS unsigned* st) {
    XcdBarrier b; b.bar = bar; b.x = xb_xcc_id(); b.st = st;
    if (threadIdx.x == 0) (void)xb_add(&bar[XB_XCNT(b.x)], 1u);
    return b;
}
DEV void xcd_barrier_complete(unsigned* bar, unsigned x, unsigned& nloc, unsigned& nx) {
    const unsigned G = gridDim.x * gridDim.y * gridDim.z;
    unsigned sum, cnt, mine, sp = 0u;
    for (;;) {
        sum = 0u; cnt = 0u; mine = 0u;
#pragma unroll
        for (unsigned j = 0; j < 16; ++j) { const unsigned c = xb_ld(&bar[XB_XCNT(j)]); sum += c; cnt += (c > 0u) ? 1u : 0u; mine = (j == x) ? c : mine; }
        if (sum == G) break;
        __builtin_amdgcn_s_sleep(1);
        if ((++sp & 255u) == 0u) { if (xb_ld(&bar[XB_TMO])) break; if (sp > XB_SPIN_CAP) { atomicAdd(&bar[XB_TMO], 1u); break; } }
    }
    nloc = mine > 0u ? mine : 1u; nx = cnt > 0u ? cnt : 1u;
}
DEV void xcd_barrier(const XcdBarrier& b) {
    asm volatile("s_waitcnt vmcnt(0)" ::: "memory");
    __syncthreads();
    if (threadIdx.x == 0) {
        unsigned* bar = b.bar; unsigned bx = b.x; asm volatile("" : "+s"(bar), "+s"(bx));
        __builtin_amdgcn_s_waitcnt(0);
        unsigned nloc = b.st[0], nx = b.st[1];
        if (nloc == 0u) { xcd_barrier_complete(bar, bx, nloc, nx); b.st[0] = nloc; b.st[1] = nx; }
        const unsigned old = xb_add(&bar[XB_XSUB(bx)], 1u);
        const unsigned gen = old / nloc;
        if (old + 1u == (gen + 1u) * nloc) {
            __builtin_amdgcn_fence(__ATOMIC_RELEASE, "agent");
            asm volatile("s_waitcnt vmcnt(0)" ::: "memory");
            const unsigned og = xb_add(&bar[XB_TOP], 1u);
            const unsigned tg = og / nx;
            if (og + 1u == (tg + 1u) * nx) xb_add(&bar[XB_TOPGEN], 1u);
            else XB_SPIN(xb_ld(&bar[XB_TOPGEN]) == tg, bar);
            __builtin_amdgcn_fence(__ATOMIC_ACQUIRE, "agent");
            xb_add(&bar[XB_XGEN(bx)], 1u);
            asm volatile("s_waitcnt vmcnt(0)" ::: "memory");
        } else {
            XB_SPIN(xb_ld(&bar[XB_XGEN(bx)]) == gen, bar);
            __builtin_amdgcn_fence(__ATOMIC_ACQUIRE, "agent");
            asm volatile("s_waitcnt vmcnt(0)" ::: "memory");
        }
    }
    __syncthreads();
}
template <class RowEpi> struct EpiRows { RowEpi e;
    DEV void operator()(f32x4 (&acc)[2][2][4][2], const UnitD& u, const UnitD& un, const bool has_next, int wr, int wc, int fr, int fq) const {
#pragma unroll
        for (int ai = 0; ai < 2; ++ai)
#pragma unroll
            for (int m = 0; m < 4; ++m) { f32x4 v[2][2] = {{acc[ai][0][m][0], acc[ai][0][m][1]}, {acc[ai][1][m][0], acc[ai][1][m][1]}};
                e(u.pn, u.pm * 256 + ai * HALF + wr * 64 + m * 16 + fr, wc, fq, v); asm volatile("" ::: "memory"); }
    } };
struct SchedP1 { TileOrder T; const char* A; const char* B;
    DEV bool next(int i, UnitD& u) const { int pm, pn; if (!T.tile<WGM_P1>(i, pm, pn)) return false; u.pm = pm; u.pn = pn; u.aux = i; u.A = A + (size_t)pm * 256 * (D * 2); u.B = B + (size_t)pn * 256 * (D * 2); return true; } };

struct SchedP4 { TileOrder T; const char* A; const char* B;
    DEV bool next(int i, UnitD& u) const { int pm, pn; if (!T.tile<WGM_P4>(i, pm, pn)) return false; u.pm = pm; u.pn = pn; u.aux = 0; u.A = A + (size_t)pm * 256 * (D * 2); u.B = B + (size_t)pn * 256 * (D * 2); return true; } };
struct EpiP3 { const bf16_t* pbuf; bf16_t* mg;
    DEV void operator()(int pn, int row, int wc, int fq, f32x4 (&v)[3][2][2]) const {
        const int cb = 256 * pn + 32 * wc + 8 * fq;
        const unsigned char* gp = (const unsigned char*)(pbuf + (size_t)row * PC + PGATE) + cb; bf16_t* o = mg + (size_t)row * D + cb;
        u32x2 g[3][2];
#pragma unroll
        for (int s = 0; s < 3; ++s) { g[s][0] = *(const u32x2*)(gp + 1024 * s); g[s][1] = *(const u32x2*)(gp + 1024 * s + 128); }
#pragma unroll
        for (int bj = 0; bj < 2; ++bj) { f32x4 t0 = v[0][bj][0] * gate4(g[0][bj].x), t1 = v[0][bj][1] * gate4(g[0][bj].y);
#pragma unroll
            for (int s = 1; s < 3; ++s) { t0 += v[s][bj][0] * gate4(g[s][bj].x); t1 += v[s][bj][1] * gate4(g[s][bj].y); }
            store8(o + 128 * bj, t0, t1); }
    } };
struct SchedSW { int G, c; const char* A; const char* B;
    DEV bool next(int i, UnitD& u) const { const int idx = i * G + c; if (idx >= DEPTH * 30) return false; const int l = idx / 30, pn = idx % 30; u.pm = 0; u.pn = pn + 32 * l; u.aux = l;
        u.A = A + (size_t)l * 256 * (D * 2); u.B = B + (size_t)l * NIN * (D * 2) + (size_t)pn * 256 * (D * 2); return true; } };
struct EpiSWx { float* SW;
    DEV void operator()(int pnx, int row, int wc, int fq, f32x4 (&v)[2][2]) const {
        if (row >= NBT) return;
        const int l = pnx >> 5, pn = pnx & 31;
        float* o = SW + (size_t)l * NBT * NIN + (size_t)row * NIN + 256 * pn + 32 * wc + 8 * fq;
        *(f32x4*)(o) = v[0][0]; *(f32x4*)(o + 4) = v[0][1]; *(f32x4*)(o + 128) = v[1][0]; *(f32x4*)(o + 132) = v[1][1];
    } };
struct EpiP4 { const float* gate  ; const float* atab_cur; const float* atab_next  ; const bf16_t* xa; bf16_t* xao; float* ssq; const float* xin  ; bf16_t* xb; int in16;
    DEV void operator()(int pn, int row, int wc, int fq, f32x4 (&vv)[1][2][2]) const {
        f32x4 (&v)[2][2] = vv[0];
        const int nb = nidx_of(row), col = 256 * pn + 32 * wc + 8 * fq;
        const float* gp = gate + (size_t)nb * 3072 + col;
        float s = 0.f;
#pragma unroll
        for (int bj = 0; bj < 2; ++bj) {
            f32x4 x0, x1;
            if (in16) { unpk8(*(const u32x4*)(xa + (size_t)row * D + col + 128 * bj), x0, x1); const float* ac = atab_cur + (size_t)nb * D + col + 128 * bj; x0 *= rcp4(*(const f32x4*)ac); x1 *= rcp4(*(const f32x4*)(ac + 4)); }
            else { x0 = *(const f32x4*)(xin + (size_t)row * D + col + 128 * bj); x1 = *(const f32x4*)(xin + (size_t)row * D + col + 128 * bj + 4); }
            const f32x4 t0 = x0 + *(const f32x4*)(gp + 128 * bj) * v[bj][0], t1 = x1 + *(const f32x4*)(gp + 128 * bj + 4) * v[bj][1];
            s += ((t0.x * t0.x + t0.y * t0.y) + (t0.z * t0.z + t0.w * t0.w)) + ((t1.x * t1.x + t1.y * t1.y) + (t1.z * t1.z + t1.w * t1.w));
            if (atab_next) { const float* ap = atab_next + (size_t)nb * D + col + 128 * bj; store8(xao + (size_t)row * D + col + 128 * bj, t0 * *(const f32x4*)ap, t1 * *(const f32x4*)(ap + 4)); }
            else store8(xb + (size_t)row * D + col + 128 * bj, t0, t1);
        }
        s += __shfl_xor(s, 16); s += __shfl_xor(s, 32);
        if (fq == 0) ssq[row * 16 + 4 * pn + wc] = s;
    } };


typedef short v4i16 __attribute__((ext_vector_type(4)));
constexpr int TP = 528, VT_OFF = 0, PM_OFF = 128 * TP;
DEV f32x4 unpk4(u32x2 r) { return (f32x4){bflo(r.x), bfhi(r.x), bflo(r.y), bfhi(r.y)}; }
DEV void p2_ln(const Ctx& c, int l, int ck, int hh, const bf16_t* pb, LAS unsigned char* lds) {
    int lane_ = c.lane; asm volatile("" : "+v"(lane_));
    const int lane = lane_, w = c.wave; const bool own = (lane >> 5) == hh, lastck = (ck & 15) == 15;
    const f32x4 g0 = *(const f32x4*)(c.lnv_g + l * W + 8 * lane), g1 = *(const f32x4*)(c.lnv_g + l * W + 8 * lane + 4), b0 = *(const f32x4*)(c.lnv_b + l * W + 8 * lane), b1 = *(const f32x4*)(c.lnv_b + l * W + 8 * lane + 4);
    u32x4 gv[16];
#pragma unroll
    for (int i = 0; i < 16; ++i) gv[i] = *(const u32x4*)(pb + (size_t)(16 * w + i) * PC + PGV + 8 * lane);
    float* vout = c.out + O_VP + ((size_t)(l * NBP + (ck >> 4)) * 128) * W + 8 * lane;
#pragma unroll
    for (int i = 0; i < 16; ++i) { const int t = 16 * w + i;
        f32x4 x0 = (f32x4){bflo(gv[i].x), bfhi(gv[i].x), bflo(gv[i].y), bfhi(gv[i].y)}, x1 = (f32x4){bflo(gv[i].z), bfhi(gv[i].z), bflo(gv[i].w), bfhi(gv[i].w)};
        float s = ((x0.x + x0.y) + (x0.z + x0.w)) + ((x1.x + x1.y) + (x1.z + x1.w));
        float q = ((x0.x * x0.x + x0.y * x0.y) + (x0.z * x0.z + x0.w * x0.w)) + ((x1.x * x1.x + x1.y * x1.y) + (x1.z * x1.z + x1.w * x1.w));
#pragma unroll
        for (int o = 1; o < 64; o <<= 1) { s += __shfl_xor(s, o); q += __shfl_xor(q, o); }
        const float mu = s * (1.f / W), var = fmaxf(q * (1.f / W) - mu * mu, 0.f), rstd = __builtin_amdgcn_rsqf(var + EPS);
        if (own) {
            x0 = (x0 - mu) * rstd * g0 + b0; x1 = (x1 - mu) * rstd * g1 + b1;
            u32x4 o; o.x = pk2(x0.x, x0.y); o.y = pk2(x0.z, x0.w); o.z = pk2(x1.x, x1.y); o.w = pk2(x1.z, x1.w);
            *(LAS u32x4*)(lds + VT_OFF + t * TP + (lane & 31) * 16) = o;
            if (lastck) { *(f32x4*)(vout + (size_t)t * W) = x0; *(f32x4*)(vout + (size_t)t * W + 4) = x1; }
        }
    }
}
template <int HH> DEV void p2_pool(const Ctx& c, int l, int ck, const bf16_t* pb, LAS unsigned char* lds) {
    constexpr int W0 = 2 << (2 * HH), W1 = 2 * W0, H = W1 - 1, NX = H + 16;
    int lane_ = c.lane; asm volatile("" : "+v"(lane_));
    const int lane = lane_, w = c.wave, gi = lane >> 5, cpos = (ck & 15) * 128, ch = 256 * HH + 4 * lane; const bool lastck = (ck & 15) == 15;
    f32x4 x[NX];
#pragma unroll
    for (int k = 0; k < NX; ++k) { const int tt = 16 * w - H + k; const bool valid = cpos + tt >= 0; const int tc = valid ? tt : 0;
        const u32x2 r = *(const u32x2*)(pb + (ptrdiff_t)tc * PC + PCX + ch); const f32x4 v = unpk4(r); x[k] = valid ? v : (f32x4){0.f, 0.f, 0.f, 0.f}; }
    f32x4 slo = x[H];
#pragma unroll
    for (int j = 1; j < W0; ++j) slo += x[H - j];
    f32x4 shi = slo;
#pragma unroll
    for (int j = W0; j < W1; ++j) shi += x[H - j];
    float* pout = c.out + O_POOLP + ((size_t)(l * NBP + (ck >> 4)) * 15) * W + ch;
#pragma unroll
    for (int i = 0; i < 16; ++i) { const int t = 16 * w + i, pos = cpos + t, wd = gi ? W1 : W0;
        const f32x4 s = gi ? shi : slo; const float inv = __builtin_amdgcn_rcpf((float)(wd < pos + 1 ? wd : pos + 1));
        const f32x4 pm = s * inv - x[H + i];
        *(LAS u32x2*)(lds + PM_OFF + t * TP + 8 * lane) = (u32x2){pk2(pm.x, pm.y), pk2(pm.z, pm.w)};
        if (lastck && t >= 113) *(f32x4*)(pout + (size_t)(t - 113) * W) = x[H + i];
        if (i < 15) { slo += x[H + i + 1] - x[H + i + 1 - W0]; shi += x[H + i + 1] - x[H + i + 1 - W1]; }
    }
}
DEV void p2_conv(const Ctx& c, int l, int ck, int hh, const bf16_t* pb) {
    int lane_ = c.lane; asm volatile("" : "+v"(lane_));
    const int lane = lane_, w = c.wave, cpos = (ck & 15) * 128, ch = 256 * hh + 4 * lane, row0 = ck * 128; const bool lastck = (ck & 15) == 15;
    const f32x4 cb = *(const f32x4*)(c.conv_b + l * W + ch), w0 = *(const f32x4*)(c.conv_w + (l * 3 + 0) * W + ch), w1 = *(const f32x4*)(c.conv_w + (l * 3 + 1) * W + ch), w2 = *(const f32x4*)(c.conv_w + (l * 3 + 2) * W + ch);
    f32x4 z[18];
#pragma unroll
    for (int k = 0; k < 18; ++k) { const int tt = 16 * w - 2 + k; const bool valid = cpos + tt >= 0; const int tc = valid ? tt : 0;
        const f32x4 v = unpk4(*(const u32x2*)(pb + (ptrdiff_t)tc * PC + PZ + ch)); z[k] = valid ? v : (f32x4){0.f, 0.f, 0.f, 0.f}; }
    float* cout = c.out + O_CONVP + ((size_t)(l * NBP + (ck >> 4)) * 2) * W + ch;
#pragma unroll
    for (int i = 0; i < 16; ++i) { const int t = 16 * w + i;
        const f32x4 abg = unpk4(*(const u32x2*)(pb + (size_t)t * PC + PABG + ch));
        const f32x4 o = abg * (cb + w0 * z[i] + w1 * z[i + 1] + w2 * z[i + 2]);
        *(u32x2*)(c.y + (size_t)(row0 + t) * 1536 + ch) = (u32x2){pk2(o.x, o.y), pk2(o.z, o.w)};
        if (lastck && t >= 126) *(f32x4*)(cout + (size_t)(t - 126) * W) = z[i + 2];
    }
}
constexpr int TPS = 1040;
DEV void p2_sample_block(const Ctx& c, int l, int sb, LAS unsigned char* ldsw) {
    const int lane = c.lane, fr = lane & 15, fq = lane >> 4, ch = 8 * lane, h = lane >> 3, g = lane >> 4;
    {
        const int i = c.wave, n = 8 * sb + i, row = MPR + n; const bf16_t* pr = c.pbuf + (size_t)row * PC; bf16_t* yr = c.y + (size_t)row * 1536;
        const float* sc = c.state_conv + ((size_t)(l * NSM + n) * 2) * W + ch; const float* sp = c.state_pool + ((size_t)(l * NSM + n) * 15) * W + ch;
        const u32x4 qz = *(const u32x4*)(pr + PZ + ch), qa = *(const u32x4*)(pr + PABG + ch), qg = *(const u32x4*)(pr + PGV + ch), qu = *(const u32x4*)(pr + PUG + ch), qc = *(const u32x4*)(pr + PCX + ch);
        const f32x4 s00 = *(const f32x4*)(sc), s01 = *(const f32x4*)(sc + 4), s10 = *(const f32x4*)(sc + W), s11 = *(const f32x4*)(sc + W + 4);
        f32x4 st0[15], st1[15];
#pragma unroll
        for (int k = 7; k < 15; ++k) { st0[k] = *(const f32x4*)(sp + (size_t)k * W); st1[k] = *(const f32x4*)(sp + (size_t)k * W + 4); }
        const f32x4 cb0 = *(const f32x4*)(c.conv_b + l * W + ch), cb1 = *(const f32x4*)(c.conv_b + l * W + ch + 4);
        const f32x4 w0a = *(const f32x4*)(c.conv_w + (l * 3 + 0) * W + ch), w0b = *(const f32x4*)(c.conv_w + (l * 3 + 0) * W + ch + 4);
        const f32x4 w1a = *(const f32x4*)(c.conv_w + (l * 3 + 1) * W + ch), w1b = *(const f32x4*)(c.conv_w + (l * 3 + 1) * W + ch + 4);
        const f32x4 w2a = *(const f32x4*)(c.conv_w + (l * 3 + 2) * W + ch), w2b = *(const f32x4*)(c.conv_w + (l * 3 + 2) * W + ch + 4);
        const f32x4 lg0 = *(const f32x4*)(c.lnv_g + l * W + ch), lg1 = *(const f32x4*)(c.lnv_g + l * W + ch + 4), lb0 = *(const f32x4*)(c.lnv_b + l * W + ch), lb1 = *(const f32x4*)(c.lnv_b + l * W + ch + 4);
        const float w00 = c.sgu_w[(size_t)(l * 8 + h) * 128 * 128], b00 = c.sgu_b[(l * 8 + h) * 128], invw = 1.f / (float)(2 << g);
        asm volatile("" ::: "memory");
        {
            f32x4 z0, z1, a0, a1; unpk8(qz, z0, z1); unpk8(qa, a0, a1);
            const f32x4 ya = a0 * (cb0 + w0a * s00 + w1a * s10 + w2a * z0), yb = a1 * (cb1 + w0b * s01 + w1b * s11 + w2b * z1);
#pragma unroll
            for (int k = 0; k < 7; ++k) { st0[k] = *(const f32x4*)(sp + (size_t)k * W); st1[k] = *(const f32x4*)(sp + (size_t)k * W + 4); }
            store8(yr + ch, ya, yb);
            float* o = c.out + O_CONVS + ((size_t)(l * NSM + n) * 2) * W + ch;
            *(f32x4*)(o) = s10; *(f32x4*)(o + 4) = s11; *(f32x4*)(o + W) = z0; *(f32x4*)(o + W + 4) = z1;
        }
        {
            f32x4 x0, x1, u0, u1; unpk8(qg, x0, x1); unpk8(qu, u0, u1);
            float s = ((x0.x + x0.y) + (x0.z + x0.w)) + ((x1.x + x1.y) + (x1.z + x1.w));
            float q = ((x0.x * x0.x + x0.y * x0.y) + (x0.z * x0.z + x0.w * x0.w)) + ((x1.x * x1.x + x1.y * x1.y) + (x1.z * x1.z + x1.w * x1.w));
#pragma unroll
            for (int o = 1; o < 64; o <<= 1) { s += __shfl_xor(s, o); q += __shfl_xor(q, o); }
            const float mu = s * (1.f / W), var = fmaxf(q * (1.f / W) - mu * mu, 0.f), rstd = __builtin_amdgcn_rsqf(var + EPS);
            x0 = (x0 - mu) * rstd * lg0 + lb0; x1 = (x1 - mu) * rstd * lg1 + lb1;
            float* vo = c.out + O_VS + (size_t)(l * NSM + n) * W + ch; *(f32x4*)(vo) = x0; *(f32x4*)(vo + 4) = x1;
            store8(yr + 512 + ch, u0 * (x0 * w00 + b00), u1 * (x1 * w00 + b00));
        }
        {
            f32x4 c0, c1; unpk8(qc, c0, c1);
            float* po = c.out + O_POOLS + ((size_t)(l * NSM + n) * 15) * W + ch;
            f32x4 r0 = c0, r1 = c1, s2a, s2b, s4a, s4b, s8a, s8b;
#pragma unroll
            for (int k = 14; k >= 0; --k) {
                if (k >= 1) { *(f32x4*)(po + (size_t)(k - 1) * W) = st0[k]; *(f32x4*)(po + (size_t)(k - 1) * W + 4) = st1[k]; }
                r0 += st0[k]; r1 += st1[k];
                if (k == 14) { s2a = r0; s2b = r1; } if (k == 12) { s4a = r0; s4b = r1; } if (k == 8) { s8a = r0; s8b = r1; } }
            *(f32x4*)(po + (size_t)14 * W) = c0; *(f32x4*)(po + (size_t)14 * W + 4) = c1;
            const f32x4 sa = g == 0 ? s2a : g == 1 ? s4a : g == 2 ? s8a : r0, sb2 = g == 0 ? s2b : g == 1 ? s4b : g == 2 ? s8b : r1;
            const f32x4 p0 = sa * invw - c0, p1 = sb2 * invw - c1;
            u32x4 o; o.x = pk2(p0.x, p0.y); o.y = pk2(p0.z, p0.w); o.z = pk2(p1.x, p1.y); o.w = pk2(p1.z, p1.w);
            *(LAS u32x4*)(ldsw + i * TPS + 16 * lane) = o;
        }
    }
    __syncthreads();
    const int row = MPR + 8 * sb + (fr & 7); const bf16_t* pr = c.pbuf + (size_t)row * PC; bf16_t* yr = c.y + (size_t)row * 1536;
    bf16x8 bw[2][4][2]; u32x4 sgv[2]; f32x4 pbv[2][2], psv[2][2];
#pragma unroll
    for (int gi2 = 0; gi2 < 2; ++gi2) { const int gq = 2 * c.wave + gi2, g2 = gq >> 2, nq = gq & 3, cc = 128 * g2 + 32 * nq + 8 * fq;
        const bf16_t* pw = c.PoolWT + ((size_t)(l * 4 + g2) * 128 + 32 * nq + fr) * 128 + 8 * fq;
#pragma unroll
        for (int ks = 0; ks < 4; ++ks) { bw[gi2][ks][0] = *(const bf16x8*)(pw + 32 * ks); bw[gi2][ks][1] = *(const bf16x8*)(pw + 16 * 128 + 32 * ks); }
        sgv[gi2] = *(const u32x4*)(pr + PSG + cc);
        pbv[gi2][0] = *(const f32x4*)(c.pool_b + l * W + cc); pbv[gi2][1] = *(const f32x4*)(c.pool_b + l * W + cc + 4); psv[gi2][0] = *(const f32x4*)(c.pool_scale + l * W + cc); psv[gi2][1] = *(const f32x4*)(c.pool_scale + l * W + cc + 4); }
#pragma unroll
    for (int gi2 = 0; gi2 < 2; ++gi2) { const int gq = 2 * c.wave + gi2, g2 = gq >> 2, nq = gq & 3, cc = 128 * g2 + 32 * nq + 8 * fq;
        f32x4 a0 = (f32x4){0.f, 0.f, 0.f, 0.f}, a1 = (f32x4){0.f, 0.f, 0.f, 0.f};
#pragma unroll
        for (int ks = 0; ks < 4; ++ks) { const bf16x8 af = *(const LAS bf16x8*)(ldsw + fr * TPS + 2 * (128 * g2 + 32 * ks + 8 * fq));
            a0 = __builtin_amdgcn_mfma_f32_16x16x32_bf16(bw[gi2][ks][0], af, a0, 0, 0, 0); a1 = __builtin_amdgcn_mfma_f32_16x16x32_bf16(bw[gi2][ks][1], af, a1, 0, 0, 0); }
        f32x4 g0v, g1v; unpk8(sgv[gi2], g0v, g1v);
        if (fr < 8) store8(yr + 1024 + cc, (a0 + pbv[gi2][0]) * psv[gi2][0] * g0v, (a1 + pbv[gi2][1]) * psv[gi2][1] * g1v);
    }
}

DEV void p2_mm(const Ctx& c, const int l, const int ck, const int hh, const bf16_t* pb, LAS unsigned char* lds) {
    int lane_ = c.lane; asm volatile("" : "+v"(lane_));
    const int lane = lane_, w = c.wave, fr = lane & 15, fq = lane >> 4, row0 = ck * 128;
    const int hq = w >> 1, a = w & 1, h = 4 * hh + hq;
    bf16x8 wf[4][4]; u32x4 ug[4][2]; float bias[4];
    { const bf16_t* wm = c.SguW + ((size_t)(l * 8 + h) * 128) * 128;
#pragma unroll
      for (int i = 0; i < 4; ++i) { const int tb = a ? (i == 0 ? 1 : i == 1 ? 2 : i == 2 ? 5 : 6) : (i == 0 ? 0 : i == 1 ? 3 : i == 2 ? 4 : 7), t = 16 * tb + fr;
#pragma unroll
          for (int ks = 0; ks < 4; ++ks) wf[i][ks] = *(const bf16x8*)(wm + (size_t)t * 128 + 32 * ks + 8 * fq);
      } }
    __syncthreads();
#pragma unroll
    for (int i = 0; i < 4; ++i) { const int tb = a ? (i == 0 ? 1 : i == 1 ? 2 : i == 2 ? 5 : 6) : (i == 0 ? 0 : i == 1 ? 3 : i == 2 ? 4 : 7), t = 16 * tb + fr;
        bias[i] = c.sgu_b[(l * 8 + h) * 128 + t];
#pragma unroll
        for (int c2 = 0; c2 < 2; ++c2) ug[i][c2] = *(const u32x4*)(pb + (size_t)t * PC + PUG + 256 * hh + 64 * hq + 32 * c2 + 8 * fq); }
    f32x4 acc[4][4];
#pragma unroll
    for (int i = 0; i < 4; ++i)
#pragma unroll
        for (int cc = 0; cc < 4; ++cc) acc[i][cc] = (f32x4){0.f, 0.f, 0.f, 0.f};
    { const int q = fr >> 2, p = fr & 3;
#pragma unroll
      for (int ks = 0; ks < 4; ++ks) {
        bf16x8 vb[4];
#pragma unroll
        for (int cc = 0; cc < 4; ++cc) { const int col = 64 * hq + 32 * (cc >> 1) + 8 * p + 4 * (cc & 1);
            const v4i16 lo = __builtin_amdgcn_ds_read_tr16_b64_v4i16((LAS v4i16*)(lds + VT_OFF + (32 * ks + 8 * fq + q) * TP + 2 * col));
            const v4i16 hi = __builtin_amdgcn_ds_read_tr16_b64_v4i16((LAS v4i16*)(lds + VT_OFF + (32 * ks + 8 * fq + 4 + q) * TP + 2 * col));
            vb[cc] = (bf16x8){lo[0], lo[1], lo[2], lo[3], hi[0], hi[1], hi[2], hi[3]}; }
#pragma unroll
        for (int i = 0; i < 4; ++i) { const int tb = a ? (i == 0 ? 1 : i == 1 ? 2 : i == 2 ? 5 : 6) : (i == 0 ? 0 : i == 1 ? 3 : i == 2 ? 4 : 7);
            if (ks <= (tb >> 1)) {
#pragma unroll
                for (int cc = 0; cc < 4; ++cc) acc[i][cc] = __builtin_amdgcn_mfma_f32_16x16x32_bf16(vb[cc], wf[i][ks], acc[i][cc], 0, 0, 0); } }
      } }
    asm volatile("" ::: "memory");
    const int gi2 = w >> 2, nq = w & 3, chc = 256 * hh + 128 * gi2 + 32 * nq + 8 * fq;
    bf16x8 pw0[4], pw1[4]; u32x4 sgv[8];
    { const bf16_t* pw = c.PoolWT + ((size_t)(l * 4 + 2 * hh + gi2) * 128 + 32 * nq + fr) * 128 + 8 * fq;
#pragma unroll
      for (int ks = 0; ks < 4; ++ks) { pw0[ks] = *(const bf16x8*)(pw + 32 * ks); pw1[ks] = *(const bf16x8*)(pw + 16 * 128 + 32 * ks); }
#pragma unroll
      for (int m = 0; m < 8; ++m) sgv[m] = *(const u32x4*)(pb + (size_t)(16 * m + fr) * PC + PSG + chc); }
    const f32x4 pb0 = *(const f32x4*)(c.pool_b + l * W + chc), pb1 = *(const f32x4*)(c.pool_b + l * W + chc + 4), ps0 = *(const f32x4*)(c.pool_scale + l * W + chc), ps1 = *(const f32x4*)(c.pool_scale + l * W + chc + 4);
#pragma unroll
    for (int i = 0; i < 4; ++i) { const int tb = a ? (i == 0 ? 1 : i == 1 ? 2 : i == 2 ? 5 : 6) : (i == 0 ? 0 : i == 1 ? 3 : i == 2 ? 4 : 7), t = 16 * tb + fr;
#pragma unroll
        for (int c2 = 0; c2 < 2; ++c2) { f32x4 u0, u1; unpk8(ug[i][c2], u0, u1);
            store8(c.y + (size_t)(row0 + t) * 1536 + 512 + 256 * hh + 64 * hq + 32 * c2 + 8 * fq, (acc[i][2 * c2] + bias[i]) * u0, (acc[i][2 * c2 + 1] + bias[i]) * u1); } }
    f32x4 ac2[8][2];
#pragma unroll
    for (int m = 0; m < 8; ++m) { ac2[m][0] = (f32x4){0.f, 0.f, 0.f, 0.f}; ac2[m][1] = (f32x4){0.f, 0.f, 0.f, 0.f}; }
#pragma unroll
    for (int ks = 0; ks < 4; ++ks)
#pragma unroll
        for (int m = 0; m < 8; ++m) { const bf16x8 af = *(const LAS bf16x8*)(lds + PM_OFF + (16 * m + fr) * TP + 2 * (128 * gi2 + 32 * ks + 8 * fq));
            ac2[m][0] = __builtin_amdgcn_mfma_f32_16x16x32_bf16(pw0[ks], af, ac2[m][0], 0, 0, 0); ac2[m][1] = __builtin_amdgcn_mfma_f32_16x16x32_bf16(pw1[ks], af, ac2[m][1], 0, 0, 0); }
#pragma unroll
    for (int m = 0; m < 8; ++m) { f32x4 s0, s1; unpk8(sgv[m], s0, s1);
        store8(c.y + (size_t)(row0 + 16 * m + fr) * 1536 + 1024 + chc, (ac2[m][0] + pb0) * ps0 * s0, (ac2[m][1] + pb1) * ps1 * s1); }
    __syncthreads();
}
DEV void ph_p2_prompt(const Args& a, int l, LAS unsigned char* lds) {
    LAUNDER_CTX(a);
    if (blockIdx.x + 16 >= gridDim.x) { p2_sample_block(c, l, (int)(gridDim.x - 1 - blockIdx.x), lds); __syncthreads(); }
    for (int item = blockIdx.x; item < 256; item += gridDim.x) {
        const int ck = item >> 1, hh = item & 1; const bf16_t* pb = c.pbuf + (size_t)ck * 128 * PC;
        p2_ln(c, l, ck, hh, pb, lds);
        { if (hh) p2_pool<1>(c, l, ck, pb, lds); else p2_pool<0>(c, l, ck, pb, lds); }
        p2_conv(c, l, ck, hh, pb);
        p2_mm(c, l, ck, hh, pb, lds);
    }
}
DEV void ph_final(const Args& a) {
    LAUNDER_CTX(a);
    const int lane = c.lane;
#pragma unroll 2
    for (int row = c.gw; row < MV; row += c.NGW) {
        const float r = row_rstd(c.ssq, row);
#pragma unroll
        for (int j = 0; j < 2; ++j) { f32x4 x0, x1; unpk8(*((const u32x4*)(c.xb + (size_t)row * D) + lane + 64 * j), x0, x1);
            const f32x4* gp = (const f32x4*)c.final_g + 2 * lane + 128 * j; f32x4* o = (f32x4*)(c.out + (size_t)row * D) + 2 * lane + 128 * j;
            o[0] = x0 * r * gp[0]; o[1] = x1 * r * gp[1]; }
    }
}

__global__ __launch_bounds__(NTHREADS, 2) void mega_fwd(Args a) {
    extern __shared__ __attribute__((aligned(16))) unsigned char lds[];
    LAS unsigned char* ldsp = (LAS unsigned char*)lds;
    if (threadIdx.x < 16) ((LAS unsigned*)(ldsp + LDSCTL_OFF))[threadIdx.x] = 0u;
    __syncthreads();
    const XcdBarrier bar = xcd_barrier_post((unsigned*)(a.ws + WS_CTL), (volatile LAS unsigned*)(ldsp + LDSCTL_OFF));
    ph_convert(a, lds, 0, 0);
    xcd_barrier(bar);
    { LAUNDER_CTX(a); int bx_ = blockIdx.x, gx_ = gridDim.x; asm volatile("" : "+s"(bx_), "+s"(gx_)); SchedMod S{gx_, bx_, (const char*)c.scb, (const char*)c.WadaT}; EpiRows<EpiMod> E{EpiMod{c.mod, c.atab, c.shb, c.b_ada, c.norm_g}}; gemm_phase(ldsp, D * 2, D * 2, D / BK, S, E); }
    ph_convert(a, lds, 1, (int)gridDim.x > 96 ? 48 : 0);
    xcd_barrier(bar);
    { LAUNDER_CTX(a); int bx_ = blockIdx.x, gx_ = gridDim.x; asm volatile("" : "+s"(bx_), "+s"(gx_)); SchedSW S{gx_, bx_, (const char*)c.shb, (const char*)c.WinT}; EpiRows<EpiSWx> E{EpiSWx{c.SW}}; gemm_phase(ldsp, D * 2, D * 2, D / BK, S, E); }
    ph_xa0(a);
    xcd_barrier(bar);
#pragma unroll 1
    for (int l = 0; l < DEPTH; ++l) {
        { LAUNDER_CTX(a); int bx_ = blockIdx.x, gx_ = gridDim.x; asm volatile("" : "+s"(bx_), "+s"(gx_)); SchedP1 S; S.T.init(MP / 256, NIN / 256, gx_, bx_); S.A = (const char*)((l & 1) ? c.xa2 : c.xa); S.B = (const char*)(c.WinT + (size_t)l * NIN * D);
          p1_rtab(S, c.ssq, c.SW + (size_t)l * NBT * NIN, (LAS float*)(ldsp + RTAB_OFF), (LAS float*)(ldsp + SWT_OFF));
          EpiP1T E{c.pbuf, c.SW + (size_t)l * NBT * NIN, (const LAS float*)(ldsp + RTAB_OFF), (const LAS float*)(ldsp + SWT_OFF)};
          gemm_phase(ldsp, D * 2, D * 2, D / BK, S, E); }
        xcd_barrier(bar);
        ph_p2_prompt(a, l, ldsp);
        xcd_barrier(bar);
        { LAUNDER_CTX(a); int bx_ = blockIdx.x, gx_ = gridDim.x; asm volatile("" : "+s"(bx_), "+s"(gx_)); const EpiP3 e3{c.pbuf, c.mg};
          if (bx_ < 128) mini_gemm<3, 2>(a, ldsp, bx_, c.y, 1536, W, c.WbT + (size_t)l * 3 * D * W, W, (size_t)D * W, e3);
          SchedP3R S; S.T.init(MPR / 256, 8, gx_, bx_); S.A = (const char*)c.y; S.B = (const char*)(c.WbT + (size_t)l * 3 * D * W);
          f32x4 tot[2][4][2];
#pragma unroll
          for (int i0 = 0; i0 < 2; ++i0)
#pragma unroll
              for (int i1 = 0; i1 < 4; ++i1) { tot[i0][i1][0] = (f32x4){0.f, 0.f, 0.f, 0.f}; tot[i0][i1][1] = (f32x4){0.f, 0.f, 0.f, 0.f}; }
          u32x2 gpre[8]; EpiP3R E{tot, gpre, c.pbuf, c.mg};
          { UnitD u0; int t_ = threadIdx.x; asm volatile("" : "+v"(t_)); const int wv = __builtin_amdgcn_readfirstlane(t_ >> 6); if (S.next(0, u0)) E.prefetch(u0, wv >> 2, wv & 3, t_ & 15, (t_ & 63) >> 4); }
          gemm_phase<EpiP3R, SchedP3R, 1>(ldsp, 1536 * 2, W * 2, W / BK, S, E); }
        xcd_barrier(bar);
        { LAUNDER_CTX(a); int bx_ = blockIdx.x, gx_ = gridDim.x; asm volatile("" : "+s"(bx_), "+s"(gx_)); const float* gate = c.mod + (size_t)l * NBT * 3072 + 2048;
          const float* atc = c.atab + (size_t)l * NBT * D; const float* atn = l + 1 < DEPTH ? c.atab + (size_t)(l + 1) * NBT * D : nullptr;
          const bf16_t* xai = (l & 1) ? c.xa2 : c.xa; bf16_t* xao = (l & 1) ? c.xa : c.xa2;
          unsigned* fcnt = (unsigned*)(a.ws + WS_CTL) + CW_FIN;
          if (l + 1 < DEPTH) { const EpiP4 e4{gate, atc, atn, xai, xao, c.ssq, c.x_sample - (size_t)MPR * D, c.xb, l > 0};
              if (bx_ < 128) mini_gemm<1, 4>(a, ldsp, bx_, c.mg, D, 0, c.WoT + (size_t)l * D * D, D, (size_t)0, e4); }
          else { const EpiP4L e4{gate, atc, xai, c.ssq, fcnt, c.final_g, c.out};
              if (bx_ < 128) mini_gemm<1, 4>(a, ldsp, bx_, c.mg, D, 0, c.WoT + (size_t)l * D * D, D, (size_t)0, e4); }
          SchedP4 S; S.T.init(MPR / 256, 4, gx_, bx_); S.A = (const char*)c.mg; S.B = (const char*)(c.WoT + (size_t)l * D * D);
          if (l == 0) { EpiP4T<false, false> E{gate, atc, atn, xai, xao, c.ssq, c.x_prompt, c.xb}; gemm_phase(ldsp, D * 2, D * 2, D / BK, S, E); }
          else if (l + 1 < DEPTH) { EpiP4T<true, false> E{gate, atc, atn, xai, xao, c.ssq, c.x_prompt, c.xb}; gemm_phase(ldsp, D * 2, D * 2, D / BK, S, E); }
          else { EpiP4TL E{gate, atc, xai, c.ssq, fcnt, c.final_g, c.out, (LAS float*)(ldsp + RTAB_OFF)}; gemm_phase(ldsp, D * 2, D * 2, D / BK, S, E); } }
        if (l + 1 < DEPTH) xcd_barrier(bar);
    }
}

extern "C" void kernel_launch(void* const* d_in, const int* in_sizes, int n_in, void* d_out, int out_size, void* d_ws, size_t ws_size, hipStream_t stream) {
    static int grid_blocks = 0;
    if (grid_blocks == 0) {
        if (n_in != 22 || ws_size < WS_END) { fprintf(stderr, "kernel_launch: unexpected n_in %d or ws_size %zu < %zu\n", n_in, ws_size, (size_t)WS_END); grid_blocks = -1; return; }
        int dev = 0, cus = 0, per_cu = 0;
        (void)hipGetDevice(&dev); (void)hipDeviceGetAttribute(&cus, hipDeviceAttributeMultiprocessorCount, dev);
        if (hipFuncSetAttribute((const void*)mega_fwd, hipFuncAttributeMaxDynamicSharedMemorySize, LDS_BYTES) != hipSuccess) { fprintf(stderr, "kernel_launch: hipFuncSetAttribute failed\n"); grid_blocks = -1; return; }
        if (hipOccupancyMaxActiveBlocksPerMultiprocessor(&per_cu, (const void*)mega_fwd, NTHREADS, LDS_BYTES) != hipSuccess || per_cu < 1) { fprintf(stderr, "kernel_launch: occupancy query gave %d\n", per_cu); grid_blocks = -1; return; }
        if (cus < 256) { fprintf(stderr, "kernel_launch: this kernel is laid out for >= 256 CUs (found %d)\n", cus); grid_blocks = -1; return; }
        grid_blocks = 256;
        fprintf(stderr, "kernel_launch: cus %d per_cu %d grid %d\n", cus, per_cu, grid_blocks);
    }
    if (grid_blocks < 0) return;
    Args a{};
    for (int i = 0; i < 22; ++i) a.in[i] = (const float*)d_in[i];
    a.out = (float*)d_out; a.ws = (unsigned char*)d_ws;
    if (hipMemsetAsync((char*)d_ws + WS_CTL, 0, CTL_BYTES, stream) != hipSuccess) { fprintf(stderr, "kernel_launch: memset failed\n"); return; }
    void* args[] = {&a};
    hipError_t e = hipLaunchCooperativeKernel((const void*)mega_fwd, dim3(grid_blocks), dim3(NTHREADS), args, LDS_BYTES, stream);
    if (e != hipSuccess) fprintf(stderr, "kernel_launch: cooperative launch failed: %s (grid %d)\n", hipGetErrorString(e), grid_blocks);
}
```

```cpp
#include <hip/hip_runtime.h>
#include <cstdio>
#include <cstdint>

#define DEV __device__ __forceinline__
typedef unsigned short bf16_t;
typedef short bf16x8 __attribute__((ext_vector_type(8)));
typedef float f32x4 __attribute__((ext_vector_type(4)));
typedef unsigned u32x4 __attribute__((ext_vector_type(4)));
typedef unsigned u32x2 __attribute__((ext_vector_type(2)));

constexpr int D = 1024, TSEQ = 2048, NBP = 8, MPR = NBP * TSEQ  , NSM = 128, MV = MPR + NSM  , MP = 16640  , NBT = NBP + NSM  ;
constexpr int W = 512, NIN = 7680, PC = 4608  , DEPTH = 4;
constexpr int PZ = 0, PABG = 512, PUG = 1024, PGV = 1536, PCX = 2048, PSG = 2560, PGATE = 3072;
constexpr float EPS = 1e-6f;
constexpr size_t O_Y = 0, O_YS = 16777216, O_CONVP = 16908288, O_CONVS = 16941056, O_POOLP = 17465344, O_POOLS = 17711104, O_VP = 21643264, O_VS = 23740416;

constexpr size_t al256(size_t x) { return (x + 255) & ~(size_t)255; }
constexpr size_t WS_WIN = 0;
constexpr size_t WS_WB = al256(WS_WIN + (size_t)DEPTH * NIN * D * 2);
constexpr size_t WS_WO = al256(WS_WB + (size_t)DEPTH * 3 * D * W * 2);
constexpr size_t WS_MOD = al256(WS_WO + (size_t)DEPTH * D * D * 2);
constexpr size_t WS_ATAB = al256(WS_MOD + (size_t)DEPTH * NBT * 3 * D * 4);
constexpr size_t WS_SHB = al256(WS_ATAB + (size_t)DEPTH * NBT * D * 4);
constexpr size_t WS_SW = al256(WS_SHB + (size_t)DEPTH * 256 * D * 2);
constexpr size_t WS_XA = al256(WS_SW + (size_t)DEPTH * NBT * NIN * 4);
constexpr size_t WS_SSQ = al256(WS_XA + (size_t)MP * D * 2);
constexpr size_t WS_PBUF = al256(WS_SSQ + (size_t)MP * 16 * 4);
constexpr size_t WS_Y = al256(WS_PBUF + (size_t)MP * PC * 2);
constexpr size_t WS_MG = al256(WS_Y + (size_t)MP * 1536 * 2);
constexpr size_t WS_SGUW = al256(WS_MG + (size_t)MP * D * 2);
constexpr size_t WS_POOLW = al256(WS_SGUW + (size_t)DEPTH * 8 * 128 * 128 * 2);
constexpr size_t WS_WADA = al256(WS_POOLW + (size_t)DEPTH * 4 * 128 * 128 * 2);
constexpr size_t WS_SCB = al256(WS_WADA + (size_t)DEPTH * 3072 * D * 2);
constexpr size_t WS_XB = al256(WS_SCB + (size_t)256 * D * 2);
constexpr size_t WS_XA2 = al256(WS_XB + (size_t)MV * D * 2);
constexpr size_t WS_LNST = al256(WS_XA2 + (size_t)MP * D * 2);
constexpr size_t WS_CTL = al256(WS_LNST + (size_t)MP * 16 * 4);
constexpr size_t CTL_BYTES = 16384;
constexpr size_t WS_END = al256(WS_CTL + CTL_BYTES);

constexpr int NTHREADS = 512, NWAVES = 8;
constexpr int LDS_BYTES = 155648;
constexpr int LDSCTL_OFF = LDS_BYTES - 256;

typedef __bf16 bf16x2_t __attribute__((ext_vector_type(2)));
typedef float f32x2_t __attribute__((ext_vector_type(2)));
DEV unsigned pk2(float lo, float hi) { const f32x2_t v = {lo, hi}; const bf16x2_t b = __builtin_convertvector(v, bf16x2_t); return __builtin_bit_cast(unsigned, b); }
DEV float bflo(unsigned u) { return __builtin_bit_cast(float, u << 16); }
DEV float bfhi(unsigned u) { return __builtin_bit_cast(float, u & 0xffff0000u); }
DEV void unpk8(const u32x4 u, f32x4& a, f32x4& b) { a = (f32x4){bflo(u.x), bfhi(u.x), bflo(u.y), bfhi(u.y)}; b = (f32x4){bflo(u.z), bfhi(u.z), bflo(u.w), bfhi(u.w)}; }
DEV f32x4 gate4(unsigned u) { return (f32x4){(float)(u & 0xffu), (float)((u >> 8) & 0xffu), (float)((u >> 16) & 0xffu), (float)(u >> 24)} * (1.f / 255.f); }
DEV unsigned pku8(f32x4 s) { const unsigned a = (unsigned)(s.x * 255.f + 0.5f), b = (unsigned)(s.y * 255.f + 0.5f), c = (unsigned)(s.z * 255.f + 0.5f), d = (unsigned)(s.w * 255.f + 0.5f); return a | (b << 8) | (c << 16) | (d << 24); }
DEV f32x4 exp2_4(f32x4 t) { return (f32x4){__builtin_amdgcn_exp2f(t.x), __builtin_amdgcn_exp2f(t.y), __builtin_amdgcn_exp2f(t.z), __builtin_amdgcn_exp2f(t.w)}; }
DEV f32x4 rcp4(f32x4 d) { return (f32x4){__builtin_amdgcn_rcpf(d.x), __builtin_amdgcn_rcpf(d.y), __builtin_amdgcn_rcpf(d.z), __builtin_amdgcn_rcpf(d.w)}; }
DEV f32x4 sigmoid4(f32x4 x) { return rcp4(exp2_4(x * -1.44269504f) + 1.f); }
DEV f32x4 silu4(f32x4 x) { return x * sigmoid4(x); }
DEV f32x4 gelu4(f32x4 x) { const f32x4 t = x * (x * x * (-2.f * 0.7978845608f * 0.044715f * 1.44269504f) + (-2.f * 0.7978845608f * 1.44269504f)); return x * rcp4(exp2_4(t) + 1.f); }
DEV int perm32(int rho) { const int n = rho >> 4, i = rho & 15; return 8 * (i >> 2) + 4 * n + (i & 3); }
DEV int nidx_of(int row) { return row < MPR ? (row >> 11) : (row < MV ? NBP + (row - MPR) : NBT - 1); }
DEV int src_win(int j) {
    const int pn = j >> 8, c = j & 255, bj = c >> 7, cc = c & 127;
    if (pn < 4) return (bj ? 1024 : 512) + 128 * pn + cc;
    if (pn < 8) return (bj ? 1536 : 0) + 128 * (pn - 4) + cc;
    if (pn < 12) return (bj ? 3072 : 2048) + 128 * (pn - 8) + cc;
    if (pn < 14) return 2560 + 256 * (pn - 12) + c;
    if (pn < 16) return 3584 + 256 * (pn - 14) + c;
    if (pn < 18) return 4096 + 256 * (pn - 16) + c;
    return 4608 + 256 * (pn - 18) + c;
}

struct Args { const float* in[22]; float* out; unsigned char* ws; };
struct Ctx {
    const float *x_prompt, *x_sample, *c_prompt, *c_sample, *state_conv, *state_pool, *w_ada, *b_ada, *norm_g, *w_in, *conv_w, *conv_b, *lnv_g, *lnv_b, *sgu_w, *sgu_b, *pool_w, *pool_b, *pool_scale, *w_branch, *w_out, *final_g;
    float* out; bf16_t *WinT, *WbT, *WoT; float *mod, *atab; bf16_t* shb; float* SW; bf16_t* xa; float* ssq; bf16_t *pbuf, *y, *mg; bf16_t *SguW, *PoolWT, *WadaT, *scb, *xb, *xa2; float* lnst;
    unsigned char* lds;
    int tid, lane, wave, gw, NGW, gtid, NGT;
};

DEV Ctx make_ctx(const Args& a, size_t z) {
    Ctx c;
    c.x_prompt = a.in[0] + z; c.x_sample = a.in[1] + z; c.c_prompt = a.in[2] + z; c.c_sample = a.in[3] + z; c.state_conv = a.in[4] + z; c.state_pool = a.in[5] + z; c.w_ada = a.in[6] + z; c.b_ada = a.in[7] + z;
    c.norm_g = a.in[8] + z; c.w_in = a.in[9] + z; c.conv_w = a.in[10] + z; c.conv_b = a.in[11] + z; c.lnv_g = a.in[12] + z; c.lnv_b = a.in[13] + z; c.sgu_w = a.in[14] + z; c.sgu_b = a.in[15] + z;
    c.pool_w = a.in[16] + z; c.pool_b = a.in[17] + z; c.pool_scale = a.in[18] + z; c.w_branch = a.in[19] + z; c.w_out = a.in[20] + z; c.final_g = a.in[21] + z;
    c.out = a.out + z; unsigned char* ws = a.ws + z;
    c.WinT = (bf16_t*)(ws + WS_WIN); c.WbT = (bf16_t*)(ws + WS_WB); c.WoT = (bf16_t*)(ws + WS_WO);
    c.mod = (float*)(ws + WS_MOD); c.atab = (float*)(ws + WS_ATAB); c.shb = (bf16_t*)(ws + WS_SHB); c.SW = (float*)(ws + WS_SW);
    c.xa = (bf16_t*)(ws + WS_XA); c.ssq = (float*)(ws + WS_SSQ); c.pbuf = (bf16_t*)(ws + WS_PBUF); c.y = (bf16_t*)(ws + WS_Y); c.mg = (bf16_t*)(ws + WS_MG);
    c.WadaT = (bf16_t*)(ws + WS_WADA); c.scb = (bf16_t*)(ws + WS_SCB); c.xb = (bf16_t*)(ws + WS_XB); c.xa2 = (bf16_t*)(ws + WS_XA2); c.lnst = (float*)(ws + WS_LNST); c.SguW = (bf16_t*)(ws + WS_SGUW); c.PoolWT = (bf16_t*)(ws + WS_POOLW);
    c.lds = nullptr; c.tid = 0; c.lane = 0; c.wave = 0; c.gw = 0; c.NGW = 0; c.gtid = 0; c.NGT = 0;
    return c;
}
#define LAUNDER_CTX(a) size_t z_ = 0; asm volatile("" : "+s"(z_)); Ctx c = make_ctx(a, z_); { int t_ = threadIdx.x; asm volatile("" : "+v"(t_)); c.tid = t_; c.lane = t_ & 63; c.wave = __builtin_amdgcn_readfirstlane(t_ >> 6); \
    c.gw = blockIdx.x * NWAVES + c.wave; c.NGW = gridDim.x * NWAVES; c.gtid = blockIdx.x * NTHREADS + t_; c.NGT = gridDim.x * NTHREADS; }
struct MapWin { DEV int operator()(int g) const { return src_win((g & ~31) + perm32(g & 31)); } };
struct MapPerm { DEV int operator()(int g) const { return (g & ~31) + perm32(g & 31); } };
template <class Map>
DEV void transpose_item(const float* Wsrc, int ldw, int K, bf16_t* WT, int nblk, int item, float* scr, int lane, Map map) {
    const int kb = item / nblk, nb = item % nblk, k0 = 64 * kb, g0 = 32 * nb;
    const int scol = map(g0 + (lane & 31));
#pragma unroll 8
    for (int i = 0; i < 32; ++i) { const int kk = 2 * i + (lane >> 5); scr[kk * 33 + (lane & 31)] = Wsrc[(size_t)(k0 + kk) * ldw + scol]; }
    asm volatile("s_waitcnt lgkmcnt(0)" ::: "memory");
    const int c = lane & 7;
#pragma unroll
    for (int j = 0; j < 4; ++j) { const int n = (lane >> 3) + 8 * j; const float* s = scr + (8 * c) * 33 + n;
        u32x4 o; o.x = pk2(s[0 * 33], s[1 * 33]); o.y = pk2(s[2 * 33], s[3 * 33]); o.z = pk2(s[4 * 33], s[5 * 33]); o.w = pk2(s[6 * 33], s[7 * 33]);
        *(u32x4*)(WT + (size_t)(g0 + n) * K + k0 + 8 * c) = o; }
    asm volatile("s_waitcnt lgkmcnt(0)" ::: "memory");
}
constexpr int IT_WIN = (D / 64) * (NIN / 32), IT_WB = (W / 64) * (D / 32), IT_WO = (D / 64) * (D / 32);
constexpr int IT_PW = (128 / 64) * (128 / 32);
constexpr int IT_WADA = (D / 64) * (3072 / 32);
constexpr int IT_TOTAL = DEPTH * IT_WIN + DEPTH * 3 * IT_WB + DEPTH * IT_WO + DEPTH * 4 * IT_PW + DEPTH * IT_WADA;
DEV void ph_convert(const Args& a, unsigned char* lds, const int stage, const int b0) {
    LAUNDER_CTX(a);
    float* scr = (float*)(lds + c.wave * 16384);
    const int nb = (int)gridDim.x - b0, bw = ((int)blockIdx.x - b0) * NWAVES + c.wave, nw = nb * NWAVES, bt = ((int)blockIdx.x - b0) * NTHREADS + c.tid, nthr = nb * NTHREADS;
    if ((int)blockIdx.x < b0) return;
    if (stage == 0) {
        for (int r = bw; r < DEPTH * IT_WADA; r += nw) { const int l = r / IT_WADA; transpose_item(c.w_ada + (size_t)l * D * 3072, 3072, D, c.WadaT + (size_t)l * 3072 * D, 3072 / 32, r - l * IT_WADA, scr, c.lane, MapPerm()); }
        for (int idx = bt; idx < 256 * D / 4; idx += nthr) { const int n = idx >> 8, k4 = (idx & 255) * 4; f32x4 v = (f32x4){0.f, 0.f, 0.f, 0.f};
            if (n < NBT) { v = *(const f32x4*)((n < NBP ? c.c_prompt + (size_t)n * D : c.c_sample + (size_t)(n - NBP) * D) + k4); v = silu4(v); }
            *((u32x2*)c.scb + idx) = (u32x2){pk2(v.x, v.y), pk2(v.z, v.w)}; }
        return;
    }
    for (int it = bw; it < IT_TOTAL - DEPTH * IT_WADA; it += nw) {
        int r = it;
        if (r < DEPTH * IT_WIN) { const int l = r / IT_WIN; r -= l * IT_WIN; transpose_item(c.w_in + (size_t)l * D * NIN, NIN, D, c.WinT + (size_t)l * NIN * D, NIN / 32, r, scr, c.lane, MapWin()); continue; }
        r -= DEPTH * IT_WIN;
        if (r < DEPTH * 3 * IT_WB) { const int li = r / IT_WB; r -= li * IT_WB; transpose_item(c.w_branch + (size_t)li * W * D, D, W, c.WbT + (size_t)li * D * W, D / 32, r, scr, c.lane, MapPerm()); continue; }
        r -= DEPTH * 3 * IT_WB;
        if (r < DEPTH * IT_WO) { const int l = r / IT_WO; r -= l * IT_WO; transpose_item(c.w_out + (size_t)l * D * D, D, D, c.WoT + (size_t)l * D * D, D / 32, r, scr, c.lane, MapPerm()); continue; }
        r -= DEPTH * IT_WO;
        { const int lg = r / IT_PW; r -= lg * IT_PW; transpose_item(c.pool_w + (size_t)lg * 128 * 128, 128, 128, c.PoolWT + (size_t)lg * 128 * 128, 4, r, scr, c.lane, MapPerm()); }
    }
    for (int idx = bt; idx < DEPTH * 8 * 128 * 128 / 4; idx += nthr) { const int s4 = (idx & 31) * 4, t = (idx >> 5) & 127; const f32x4 v = *((const f32x4*)c.sgu_w + idx);
        *((u32x2*)c.SguW + idx) = (u32x2){pk2(s4 <= t ? v.x : 0.f, s4 + 1 <= t ? v.y : 0.f), pk2(s4 + 2 <= t ? v.z : 0.f, s4 + 3 <= t ? v.w : 0.f)}; }
}
DEV void ph_xa0(const Args& a) {
    LAUNDER_CTX(a);
    const int lane = c.lane, NSW = DEPTH * 30;
    if ((int)gridDim.x <= NSW || (int)blockIdx.x < NSW) { if ((int)gridDim.x > NSW) return; }
    const int w0 = ((int)gridDim.x > NSW) ? ((int)blockIdx.x - NSW) * NWAVES + c.wave : c.gw, nw = ((int)gridDim.x > NSW) ? ((int)gridDim.x - NSW) * NWAVES : c.NGW;
    for (int row = MV + w0; row < MP; row += nw) { u32x2* xo = (u32x2*)(c.xa + (size_t)row * D) + lane;
#pragma unroll
        for (int j = 0; j < 4; ++j) { xo[64 * j] = (u32x2){0u, 0u}; ((u32x2*)(c.xa2 + (size_t)row * D) + lane)[64 * j] = (u32x2){0u, 0u}; }
        if (lane < 16) c.ssq[row * 16 + lane] = 0.f; }
#pragma unroll 2
    for (int row = w0; row < MV; row += nw) {
        u32x2* xo = (u32x2*)(c.xa + (size_t)row * D) + lane;
        const float* xr = row < MPR ? c.x_prompt + (size_t)row * D : c.x_sample + (size_t)(row - MPR) * D;
        const float* ar = c.atab + (size_t)nidx_of(row) * D;
#pragma unroll
        for (int j = 0; j < 4; ++j) {
            const f32x4 v = *((const f32x4*)xr + lane + 64 * j), at = *((const f32x4*)ar + lane + 64 * j);
            xo[64 * j] = (u32x2){pk2(v.x * at.x, v.y * at.y), pk2(v.z * at.z, v.w * at.w)};
            float s = (v.x * v.x + v.y * v.y) + (v.z * v.z + v.w * v.w);
            s += __shfl_xor(s, 1); s += __shfl_xor(s, 2); s += __shfl_xor(s, 4); s += __shfl_xor(s, 32);
            if ((lane & 39) == 0) c.ssq[row * 16 + 4 * j + (lane >> 3)] = s;
        }
    }
}
DEV float row_rstd(const float* ssq, int row) {
    const f32x4* p = (const f32x4*)(ssq + (size_t)row * 16); const f32x4 a = p[0], b = p[1], c = p[2], d = p[3];
    const float s = ((a.x + a.y) + (a.z + a.w)) + ((b.x + b.y) + (b.z + b.w)) + ((c.x + c.y) + (c.z + c.w)) + ((d.x + d.y) + (d.z + d.w));
    return __builtin_amdgcn_rsqf(s * (1.f / D) + EPS);
}

DEV void store8(bf16_t* p, f32x4 a, f32x4 b) { u32x4 w; w.x = pk2(a.x, a.y); w.y = pk2(a.z, a.w); w.z = pk2(b.x, b.y); w.w = pk2(b.z, b.w); *(u32x4*)p = w; }

#define LAS __attribute__((address_space(3)))
constexpr int BK = 64, HALF = 128, HTB = HALF * BK * 2, STAGE_BYTES = 8 * HTB;
DEV int lds_byte(int r, int c) { const int st = (r >> 4) * 2 + (c >> 5), rr = r & 15, cc = c & 31, ob = rr * 64 + cc * 2; return st * 1024 + (ob ^ (((ob >> 9) & 1) << 5)); }
DEV void stage_rc(int b, int& R, int& C) { const int st = b / 1024, sb = b % 1024, swz = sb ^ (((sb >> 9) & 1) << 5); R = (st >> 1) * 16 + swz / 64; C = (st & 1) * 32 + (swz % 64) / 2; }
struct UnitD { const char* A; const char* B; int pm, pn, aux; };
constexpr int NXCD = 8;
constexpr int WGM_P1 = 5, WGM_P3 = 4, WGM_P4 = 8;
struct TileOrder {
    int nM, nN, nwg, G, c;
    DEV void init(int nM_, int nN_, int G_, int c_) { nM = nM_; nN = nN_; nwg = nM * nN; G = G_; c = c_; }
    template <int WGM> DEV bool tile(int i, int& pm, int& pn) const {
        const long L = (long)i * G + c; if (L >= nwg) return false;
        int wgid = (int)L; { const int q = nwg / NXCD, r = nwg % NXCD, xcd = wgid % NXCD, off = wgid / NXCD; wgid = (xcd < r ? xcd * (q + 1) : r * (q + 1) + (xcd - r) * q) + off; }
        const int nig = WGM * nN, gid = wgid / nig, fm = gid * WGM, gsz = (nM - fm) < WGM ? (nM - fm) : WGM;
        pm = fm + ((wgid % nig) % gsz); pn = (wgid % nig) / gsz; return true;
    }
};
template <class Epi, class Sched, int NBH = 2>
DEV void gemm_phase(LAS unsigned char* lds, const int lda  , const int ldb  , const int nt  , const Sched& S, const Epi& E) {
    int tid = threadIdx.x; asm volatile("" : "+v"(tid));
    const int wid = __builtin_amdgcn_readfirstlane(tid >> 6), lane = tid & 63, wr = wid >> 2, wc = wid & 3, fr = lane & 15, fq = lane >> 4;
    unsigned voffA[2], voffB[2];
#pragma unroll
    for (int i = 0; i < 2; ++i) { int R, C; stage_rc(tid * 16 + i * 8192, R, C); voffA[i] = (unsigned)(R * lda + C * 2); voffB[i] = (unsigned)(R * ldb + C * 2); }
    const size_t kstep = (size_t)(BK * 2);
    const size_t hstepA = (size_t)HALF * lda, hstepB = (size_t)HALF * ldb;
    const unsigned ldsw = (unsigned)wid * 1024u;
    const int aoff = lds_byte(wr * 64 + fr, fq * 8), boff = lds_byte(wc * 32 + fr, fq * 8);
#define PG8_SA(b, h) (((b) * 2 + (h)) * HTB)
#define PG8_SB(b, h) ((4 + (b) * 2 + (h)) * HTB)
#define PG8_STAGE(bufoff, gbase, voff) do { _Pragma("unroll") for (int _i = 0; _i < 2; ++_i) \
        __builtin_amdgcn_global_load_lds((const unsigned*)((const char*)(gbase) + (voff)[_i]), (LAS unsigned*)(lds + (bufoff) + ldsw + _i * 8192), 16, 0, 0); } while (0)
#define PG8_LDA(dst, b, h) do { _Pragma("unroll") for (int m = 0; m < 4; ++m) _Pragma("unroll") for (int k = 0; k < 2; ++k) dst[m][k] = *(const LAS bf16x8*)(lds + PG8_SA(b, h) + aoff + m * 2048 + k * 1024); } while (0)
#define PG8_LDB(dst, b, h) do { _Pragma("unroll") for (int n = 0; n < 2; ++n) _Pragma("unroll") for (int k = 0; k < 2; ++k) dst[n][k] = *(const LAS bf16x8*)(lds + PG8_SB(b, h) + boff + n * 2048 + k * 1024); } while (0)
#define PG8_MMA(ai, bj, At, Bt) do { __builtin_amdgcn_s_setprio(1); _Pragma("unroll") for (int m = 0; m < 4; ++m) _Pragma("unroll") for (int n = 0; n < 2; ++n) _Pragma("unroll") for (int k = 0; k < 2; ++k) \
        acc[ai][bj][m][n] = __builtin_amdgcn_mfma_f32_16x16x32_bf16(Bt[n][k], At[m][k], acc[ai][bj][m][n], 0, 0, 0); __builtin_amdgcn_s_setprio(0); } while (0)
#define PG8_WAIT_V(n) asm volatile("s_waitcnt vmcnt(" #n ")" ::: "memory")
#define PG8_WAIT_VN() do { if constexpr (NBH == 2) PG8_WAIT_V(8); else PG8_WAIT_V(6); } while (0)
#define PG8_WAIT_L(n) asm volatile("s_waitcnt lgkmcnt(" #n ")" ::: "memory")
#define PG8_BAR __builtin_amdgcn_s_barrier()
#define PG8_SCHED __builtin_amdgcn_sched_barrier(0)
    UnitD cur, nxt; int ui = 0;
    if (!S.next(0, cur)) return;
    f32x4 acc[2][NBH][4][2];
#pragma unroll
    for (int a = 0; a < 2; ++a)
#pragma unroll
        for (int b = 0; b < NBH; ++b)
#pragma unroll
            for (int m = 0; m < 4; ++m)
#pragma unroll
                for (int n = 0; n < 2; ++n) acc[a][b][m][n] = (f32x4){0.f, 0.f, 0.f, 0.f};
    bf16x8 At[4][2], B0[2][2], B1[2][2];
    const char* cA = cur.A; const char* cB = cur.B;
    PG8_STAGE(PG8_SB(0, 0), cB, voffB); if constexpr (NBH == 2) PG8_STAGE(PG8_SB(0, 1), cB + hstepB, voffB); PG8_STAGE(PG8_SA(0, 0), cA, voffA); PG8_STAGE(PG8_SA(0, 1), cA + hstepA, voffA);
    if (wr == 1) PG8_BAR;
    PG8_WAIT_V(2); PG8_BAR;
    PG8_STAGE(PG8_SB(1, 0), cB + kstep, voffB); PG8_STAGE(PG8_SA(1, 0), cA + kstep, voffA); if constexpr (NBH == 2) PG8_STAGE(PG8_SB(1, 1), cB + hstepB + kstep, voffB);
    if constexpr (NBH == 2) PG8_WAIT_V(6); else PG8_WAIT_V(4);
    PG8_BAR;
    for (;;) {
        const bool has_next = S.next(ui + 1, nxt);
        const char* nA = has_next ? nxt.A : cA; const char* nB = has_next ? nxt.B : cB;
        for (int t = 0; t < nt; t += 2) {
            const bool last = (t == nt - 2);
            const char* a1 = cA + (size_t)(t + 1) * kstep;
            const char* a2 = last ? nA : cA + (size_t)(t + 2) * kstep; const char* b2 = last ? nB : cB + (size_t)(t + 2) * kstep;
            const char* a3 = a2 + kstep; const char* b3 = b2 + kstep;
            PG8_LDB(B0, 0, 0); if constexpr (NBH == 2) PG8_LDB(B1, 0, 1); PG8_SCHED; PG8_LDA(At, 0, 0); PG8_STAGE(PG8_SA(1, 1), a1 + hstepA, voffA);
            PG8_WAIT_VN(); PG8_WAIT_L(0); PG8_BAR; PG8_MMA(0, 0, At, B0); if constexpr (NBH == 2) PG8_MMA(0, 1, At, B1); PG8_BAR; PG8_SCHED;
            PG8_LDA(At, 0, 1); PG8_STAGE(PG8_SB(0, 0), b2, voffB); if constexpr (NBH == 2) PG8_STAGE(PG8_SB(0, 1), b2 + hstepB, voffB); PG8_STAGE(PG8_SA(0, 0), a2, voffA);
            PG8_WAIT_VN(); PG8_WAIT_L(0); PG8_BAR; PG8_MMA(1, 0, At, B0); if constexpr (NBH == 2) PG8_MMA(1, 1, At, B1); PG8_BAR; PG8_SCHED;
            PG8_LDB(B0, 1, 0); if constexpr (NBH == 2) PG8_LDB(B1, 1, 1); PG8_SCHED; PG8_LDA(At, 1, 0); PG8_STAGE(PG8_SA(0, 1), a2 + hstepA, voffA);
            PG8_WAIT_VN(); PG8_WAIT_L(0); PG8_BAR; PG8_MMA(0, 0, At, B0); if constexpr (NBH == 2) PG8_MMA(0, 1, At, B1); PG8_BAR; PG8_SCHED;
            PG8_LDA(At, 1, 1); PG8_STAGE(PG8_SB(1, 0), b3, voffB); if constexpr (NBH == 2) PG8_STAGE(PG8_SB(1, 1), b3 + hstepB, voffB); PG8_STAGE(PG8_SA(1, 0), a3, voffA);
            PG8_WAIT_VN(); PG8_WAIT_L(0); PG8_BAR; PG8_MMA(1, 0, At, B0); if constexpr (NBH == 2) PG8_MMA(1, 1, At, B1); PG8_BAR; PG8_SCHED;
        }
        if (wr == 0) PG8_BAR;
        E(acc, cur, nxt, has_next, wr, wc, fr, fq);
        if (!has_next) break;
#pragma unroll
        for (int a = 0; a < 2; ++a)
#pragma unroll
            for (int b = 0; b < NBH; ++b)
#pragma unroll
                for (int m = 0; m < 4; ++m)
#pragma unroll
                    for (int n = 0; n < 2; ++n) acc[a][b][m][n] = (f32x4){0.f, 0.f, 0.f, 0.f};
        cur = nxt; cA = nA; cB = nB; ++ui;
        if (wr == 1) PG8_BAR;
    }
    PG8_WAIT_V(0);
    PG8_BAR;
#undef PG8_SA
#undef PG8_SB
#undef PG8_STAGE
#undef PG8_LDA
#undef PG8_LDB
#undef PG8_MMA
#undef PG8_WAIT_V
#undef PG8_WAIT_L
#undef PG8_WAIT_VN
#undef PG8_BAR
#undef PG8_SCHED
}


struct SchedMod { int G, c; const char* A; const char* B;
    DEV bool next(int i, UnitD& u) const { const int idx = i * G + c; if (idx >= 48) return false; u.pm = 0; u.pn = idx; u.aux = 0; u.A = A; u.B = B + (size_t)idx * 256 * (D * 2); return true; } };
struct EpiMod { float* mod; float* atab; bf16_t* shb; const float* b_ada; const float* norm_g;
    DEV void operator()(int pn, int row, int wc, int fq, f32x4 (&v)[2][2]) const {
#pragma unroll
        for (int bj = 0; bj < 2; ++bj) { const int gc = 256 * pn + 128 * bj + 32 * wc + 8 * fq, l = gc / 3072, j3 = gc - l * 3072;
            const f32x4 v0 = v[bj][0] + *(const f32x4*)(b_ada + gc), v1 = v[bj][1] + *(const f32x4*)(b_ada + gc + 4);
            if (row < NBT) { float* o = mod + ((size_t)l * NBT + row) * 3072 + j3; *(f32x4*)o = v0; *(f32x4*)(o + 4) = v1; }
            if (j3 < D) { const f32x4 z = (f32x4){0.f, 0.f, 0.f, 0.f}; store8(shb + ((size_t)l * 256 + row) * D + j3, row < NBT ? v0 : z, row < NBT ? v1 : z); }
            else if (j3 < 2 * D && row < NBT) { const float* ng = norm_g + l * D + (j3 - D); float* o = atab + ((size_t)l * NBT + row) * D + (j3 - D);
                f32x4 a0 = *(const f32x4*)ng * (v0 + 1.f), a1 = *(const f32x4*)(ng + 4) * (v1 + 1.f);
#pragma unroll
                for (int j = 0; j < 4; ++j) { a0[j] = __builtin_fabsf(a0[j]) < 1e-20f ? 1e-20f : a0[j]; a1[j] = __builtin_fabsf(a1[j]) < 1e-20f ? 1e-20f : a1[j]; }
                *(f32x4*)o = a0; *(f32x4*)(o + 4) = a1; }
        }
    } };
template <int NSEG, int KS  , class RowEpi>
DEV void mini_gemm(const Args& a, LAS unsigned char* lds, int u, const bf16_t* A, int lda, int a_seg, const bf16_t* Bt, int ldb, size_t b_seg, const RowEpi& e) {
    LAUNDER_CTX(a);
    const int lane = c.lane, w = c.wave, fr = lane & 15, fq = lane >> 4, rb = u & 7, pn = (u >> 3) & 3, wc = u >> 5, row = MPR + 16 * rb + fr, kw = 32 * KS;
    bf16x8 af[NSEG][KS], bf[NSEG][KS][4];
#pragma unroll
    for (int s = 0; s < NSEG; ++s) { const bf16_t* ap = A + (size_t)row * lda + s * a_seg + w * kw + 8 * fq; const bf16_t* bp = Bt + s * b_seg + (size_t)(256 * pn + 32 * wc + fr) * ldb + w * kw + 8 * fq;
#pragma unroll
        for (int k = 0; k < KS; ++k) { af[s][k] = *(const bf16x8*)(ap + 32 * k);
#pragma unroll
            for (int q = 0; q < 4; ++q) bf[s][k][q] = *(const bf16x8*)(bp + (size_t)(128 * (q >> 1) + 16 * (q & 1)) * ldb + 32 * k); } }
    f32x4 acc[NSEG][4];
#pragma unroll
    for (int s = 0; s < NSEG; ++s) {
#pragma unroll
        for (int q = 0; q < 4; ++q) acc[s][q] = (f32x4){0.f, 0.f, 0.f, 0.f};
#pragma unroll
        for (int k = 0; k < KS; ++k)
#pragma unroll
            for (int q = 0; q < 4; ++q) acc[s][q] = __builtin_amdgcn_mfma_f32_16x16x32_bf16(bf[s][k][q], af[s][k], acc[s][q], 0, 0, 0);
    }
#pragma unroll
    for (int s = 0; s < NSEG; ++s)
#pragma unroll
        for (int q = 0; q < 4; ++q) *(LAS f32x4*)(lds + (((w * NSEG + s) * 4 + q) * 64 + lane) * 16) = acc[s][q];
    __syncthreads();
    if (w == 0) {
        f32x4 v[NSEG][2][2];
#pragma unroll
        for (int s = 0; s < NSEG; ++s)
#pragma unroll
            for (int q = 0; q < 4; ++q) { f32x4 t = *(const LAS f32x4*)(lds + (((0 * NSEG + s) * 4 + q) * 64 + lane) * 16);
#pragma unroll
                for (int ww = 1; ww < 8; ++ww) t += *(const LAS f32x4*)(lds + (((ww * NSEG + s) * 4 + q) * 64 + lane) * 16);
                v[s][q >> 1][q & 1] = t; }
        e(pn, row, wc, fq, v);
    }
    __syncthreads();
}

constexpr int RTAB_OFF = STAGE_BYTES;
constexpr int SWT_OFF = RTAB_OFF + 8192;
template <int TY, bool SMP> DEV void p1_rows(const f32x4 (&acc)[2][2][4][2], bf16_t* pb  , const LAS float* rt, const float* swb, const int row0, f32x4 s00, f32x4 s01, f32x4 s10, f32x4 s11, float* st = nullptr  ) {
    f32x4 n00 = s00, n01 = s01, n10 = s10, n11 = s11;
    if (SMP) { const float* sw = swb + (size_t)nidx_of(row0) * NIN; n00 = *(const f32x4*)(sw); n01 = *(const f32x4*)(sw + 4); n10 = *(const f32x4*)(sw + 128); n11 = *(const f32x4*)(sw + 132); }
#pragma unroll
    for (int ai = 0; ai < 2; ++ai) {
#pragma unroll
        for (int m = 0; m < 4; ++m) { const int rl = ai * HALF + m * 16; const float r = rt[rl];
            if (SMP) { s00 = n00; s01 = n01; s10 = n10; s11 = n11;
                if (ai * 4 + m < 7) { const int rn = ((ai * 4 + m + 1) >> 2) * HALF + ((ai * 4 + m + 1) & 3) * 16; const float* sw = swb + (size_t)nidx_of(row0 + rn) * NIN; n00 = *(const f32x4*)(sw); n01 = *(const f32x4*)(sw + 4); n10 = *(const f32x4*)(sw + 128); n11 = *(const f32x4*)(sw + 132); } }
            f32x4 a0 = acc[ai][0][m][0] * r + s00, a1 = acc[ai][0][m][1] * r + s01, b0 = acc[ai][1][m][0] * r + s10, b1 = acc[ai][1][m][1] * r + s11;
            bf16_t* pr = pb + (size_t)rl * PC;
            if (TY == 0) { store8(pr, a0 * b0, a1 * b1); }
            else if (TY == 1) { store8(pr, a0 * silu4(b0), a1 * silu4(b1)); }
            else if (TY == 2) { store8(pr, gelu4(a0) * silu4(b0), gelu4(a1) * silu4(b1)); }
            else {
                if (TY == 3) { a0 = gelu4(a0); a1 = gelu4(a1); b0 = gelu4(b0); b1 = gelu4(b1); }
                if (TY == 3) {
                    const f32x4 sv = (a0 + a1) + (b0 + b1), qv = (a0 * a0 + a1 * a1) + (b0 * b0 + b1 * b1);
                    float s = (sv.x + sv.y) + (sv.z + sv.w), q = (qv.x + qv.y) + (qv.z + qv.w);
                    s += __shfl_xor(s, 16); q += __shfl_xor(q, 16); s += __shfl_xor(s, 32); q += __shfl_xor(q, 32);
                    if (st) *(f32x2_t*)(st + (size_t)rl * 16) = (f32x2_t){s, q}; }
                if (TY == 5) { a0 = silu4(a0); a1 = silu4(a1); b0 = silu4(b0); b1 = silu4(b1); }
                if (TY == 6) { a0 = sigmoid4(a0); a1 = sigmoid4(a1); b0 = sigmoid4(b0); b1 = sigmoid4(b1); }
                if (TY == 6) { unsigned char* gq = (unsigned char*)pr; *(u32x2*)gq = (u32x2){pku8(a0), pku8(a1)}; *(u32x2*)(gq + 128) = (u32x2){pku8(b0), pku8(b1)}; }
                else { store8(pr, a0, a1); store8(pr + 128, b0, b1); } }
        }
        if (!SMP) asm volatile("" ::: "memory");
    }
}
struct EpiP1T { bf16_t* pbuf; const float* SWl; const LAS float* rtab; const LAS float* swt; float* lnst;
    DEV void operator()(f32x4 (&acc)[2][2][4][2], const UnitD& u, const UnitD& un, const bool has_next, int wr, int wc, int fr, int fq) const {
        const int pn = u.pn, cb = 32 * wc + 8 * fq, row0 = u.pm * 256 + wr * 64 + fr; const bool smp = u.pm >= MPR / 256;
        const float* swb = SWl + 256 * pn + cb; const LAS float* sw = swt + u.aux * 256 + cb;
        const f32x4 s00 = *(const LAS f32x4*)(sw), s01 = *(const LAS f32x4*)(sw + 4), s10 = *(const LAS f32x4*)(sw + 128), s11 = *(const LAS f32x4*)(sw + 132);
        const LAS float* rt = rtab + u.aux * 256 + wr * 64 + fr;
        bf16_t* pb = pbuf + (size_t)row0 * PC + cb;
#define P1_DISPATCH(SM) \
        if (pn < 4) p1_rows<0, SM>(acc, pb + PZ + 128 * pn, rt, swb, row0, s00, s01, s10, s11); \
        else if (pn < 8) p1_rows<1, SM>(acc, pb + PABG + 128 * (pn - 4), rt, swb, row0, s00, s01, s10, s11); \
        else if (pn < 12) p1_rows<2, SM>(acc, pb + PUG + 128 * (pn - 8), rt, swb, row0, s00, s01, s10, s11); \
        else if (pn < 14) p1_rows<3, SM>(acc, pb + PGV + 256 * (pn - 12), rt, swb, row0, s00, s01, s10, s11, fq == 0 ? lnst + (size_t)row0 * 16 + 2 * (4 * (pn - 12) + wc) : nullptr); \
        else if (pn < 16) p1_rows<4, SM>(acc, pb + PCX + 256 * (pn - 14), rt, swb, row0, s00, s01, s10, s11); \
        else if (pn < 18) p1_rows<5, SM>(acc, pb + PSG + 256 * (pn - 16), rt, swb, row0, s00, s01, s10, s11); \
        else p1_rows<6, SM>(acc, (bf16_t*)((unsigned char*)(pb - cb + PGATE) + 256 * (pn - 18) + cb), rt, swb, row0, s00, s01, s10, s11);
        if (smp) { P1_DISPATCH(true) } else { P1_DISPATCH(false) }
#undef P1_DISPATCH
    } };
template <class Sched> DEV void p1_rtab(const Sched& S, const float* ssq, const float* SWl, LAS float* rtab, LAS float* swt) {
    int t = threadIdx.x; asm volatile("" : "+v"(t));
#pragma unroll
    for (int k = 0; k < 4; ++k) { const int q = t + 512 * k, i = q >> 8, rl = q & 255; UnitD u;
        if (S.next(i, u)) { rtab[q] = row_rstd(ssq, u.pm * 256 + rl); swt[q] = SWl[(size_t)(u.pm < MPR / 256 ? (u.pm >> 3) : NBP) * NIN + 256 * u.pn + rl]; } }
    __syncthreads();
}
template <bool IN16, bool LAST> struct EpiP4T { const float* gate; const float* atab_cur; const float* atab_next; const bf16_t* xa; bf16_t* xao; float* ssq; const float* xin; bf16_t* xb;
    DEV void operator()(f32x4 (&acc)[2][2][4][2], const UnitD& u, const UnitD& un, const bool has_next, int wr, int wc, int fr, int fq) const {
        const int pn = u.pn, nb = u.pm >> 3, col = 256 * pn + 32 * wc + 8 * fq, row0 = u.pm * 256 + wr * 64 + fr;
        const float* gp = gate + (size_t)nb * 3072 + col;
        f32x4 g[2][2], at[2][2], iv[2][2];
#pragma unroll
        for (int bj = 0; bj < 2; ++bj)
#pragma unroll
            for (int n = 0; n < 2; ++n) { g[bj][n] = *(const f32x4*)(gp + 128 * bj + 4 * n);
                at[bj][n] = LAST ? (f32x4){0.f, 0.f, 0.f, 0.f} : *(const f32x4*)(atab_next + (size_t)nb * D + col + 128 * bj + 4 * n);
                iv[bj][n] = IN16 ? rcp4(*(const f32x4*)(atab_cur + (size_t)nb * D + col + 128 * bj + 4 * n)) : (f32x4){0.f, 0.f, 0.f, 0.f}; }
        const size_t off0 = (size_t)row0 * D + col;
        f32x4 x[2][2], xn[2][2]; u32x4 xh[2], xhn[2];
#pragma unroll
        for (int bj = 0; bj < 2; ++bj) { if (IN16) xh[bj] = *(const u32x4*)(xa + off0 + 128 * bj); else { x[bj][0] = *(const f32x4*)(xin + off0 + 128 * bj); x[bj][1] = *(const f32x4*)(xin + off0 + 128 * bj + 4); } }
#pragma unroll
        for (int r = 0; r < 8; ++r) { const int ai = r >> 2, m = r & 3, rl = ai * HALF + m * 16, row = row0 + rl; float s = 0.f;
            if (r < 7) { const size_t offn = off0 + (size_t)(((r + 1) >> 2) * HALF + ((r + 1) & 3) * 16) * D;
#pragma unroll
                for (int bj = 0; bj < 2; ++bj) { if (IN16) xhn[bj] = *(const u32x4*)(xa + offn + 128 * bj); else { xn[bj][0] = *(const f32x4*)(xin + offn + 128 * bj); xn[bj][1] = *(const f32x4*)(xin + offn + 128 * bj + 4); } } }
            const size_t off = off0 + (size_t)rl * D;
#pragma unroll
            for (int bj = 0; bj < 2; ++bj) {
                if (IN16) { unpk8(xh[bj], x[bj][0], x[bj][1]); x[bj][0] *= iv[bj][0]; x[bj][1] *= iv[bj][1]; }
#pragma unroll
                for (int n = 0; n < 2; ++n) { const f32x4 t = x[bj][n] + g[bj][n] * acc[ai][bj][m][n]; x[bj][n] = t; s += (t.x * t.x + t.y * t.y) + (t.z * t.z + t.w * t.w); }
                if (LAST) store8(xb + off + 128 * bj, x[bj][0], x[bj][1]);
                else store8(xao + off + 128 * bj, x[bj][0] * at[bj][0], x[bj][1] * at[bj][1]); }
            s += __shfl_xor(s, 16); s += __shfl_xor(s, 32);
            if (fq == 0) ssq[row * 16 + 4 * pn + wc] = s;
#pragma unroll
            for (int bj = 0; bj < 2; ++bj) { xh[bj] = xhn[bj]; x[bj][0] = xn[bj][0]; x[bj][1] = xn[bj][1]; }
        }
    } };

struct SchedP3R { TileOrder T; const char* A; const char* B;
    DEV bool next(int i, UnitD& u) const { int pm, pc; const int seg = i % 3; if (!T.tile<WGM_P3>(i / 3, pm, pc)) return false; u.pm = pm; u.pn = pc; u.aux = seg;
        u.A = A + (size_t)pm * 256 * (1536 * 2) + (size_t)seg * (W * 2); u.B = B + (size_t)seg * D * (W * 2) + (size_t)pc * 128 * (W * 2); return true; } };
struct EpiP3R { f32x4 (&tot)[2][4][2]; u32x2 (&gpre)[8]; const bf16_t* pbuf; bf16_t* mg;
    DEV void prefetch(const UnitD& u, int wr, int wc, int fr, int fq) const {
        const unsigned char* gp = (const unsigned char*)(pbuf + (size_t)(u.pm * 256 + wr * 64 + fr) * PC + PGATE) + 1024 * u.aux + 128 * u.pn + 32 * wc + 8 * fq;
#pragma unroll
        for (int r = 0; r < 8; ++r) gpre[r] = *(const u32x2*)(gp + (size_t)((r >> 2) * HALF + (r & 3) * 16) * (PC * 2));
    }
    DEV void operator()(f32x4 (&acc)[2][1][4][2], const UnitD& u, const UnitD& un, const bool has_next, int wr, int wc, int fr, int fq) const {
        const int seg = u.aux, cb = 128 * u.pn + 32 * wc + 8 * fq, row0 = u.pm * 256 + wr * 64 + fr;
        bf16_t* o = mg + (size_t)row0 * D + cb;
        u32x2 g[8];
#pragma unroll
        for (int r = 0; r < 8; ++r) g[r] = gpre[r];
        if (has_next) prefetch(un, wr, wc, fr, fq);
        const float keep = seg ? 1.f : 0.f;
#pragma unroll
        for (int r = 0; r < 8; ++r) { const int ai = r >> 2, m = r & 3; const f32x4 g0 = gate4(g[r].x), g1 = gate4(g[r].y);
            const f32x4 t0 = acc[ai][0][m][0] * g0 + tot[ai][m][0] * keep, t1 = acc[ai][0][m][1] * g1 + tot[ai][m][1] * keep;
            tot[ai][m][0] = t0; tot[ai][m][1] = t1;
            if (seg == 2) store8(o + (size_t)(ai * HALF + m * 16) * D, t0, t1); }
    } };
#define XB_TMO      128
#define XB_XCNT(j)  (256  + 64 * (j))
#define XB_XSUB(j)  (1280 + 64 * (j))
#define XB_XGEN(j)  (2304 + 64 * (j))
#define XB_TOP      3328
#define XB_TOPGEN   3392
#define XCD_BAR_WORDS 3456
#define XB_SPIN_CAP (1u << 18)
DEV unsigned xb_ld(unsigned* p)              { return __hip_atomic_load(p, __ATOMIC_RELAXED, __HIP_MEMORY_SCOPE_AGENT); }
DEV unsigned xb_add(unsigned* p, unsigned v) { return __hip_atomic_fetch_add(p, v, __ATOMIC_RELAXED, __HIP_MEMORY_SCOPE_AGENT); }
DEV unsigned xb_xcc_id() { return (unsigned)__builtin_amdgcn_s_getreg((3 << 11) | 20) & 0xFu; }
#define XB_SPIN(cond, bar) do { unsigned _sp = 0; while (cond) { __builtin_amdgcn_s_sleep(1); \
    if ((++_sp & 255u) == 0u) { if (xb_ld(&(bar)[XB_TMO])) break; if (_sp > XB_SPIN_CAP) { atomicAdd(&(bar)[XB_TMO], 1u); break; } } } } while (0)
struct XcdBarrier { unsigned* bar; unsigned x; volatile LAS unsigned* st; };
DEV XcdBarrier xcd_barrier_post(unsigned* bar, volatile LAS unsigned* st) {
    XcdBarrier b; b.bar = bar; b.x = xb_xcc_id(); b.st = st;
    if (threadIdx.x == 0) (void)xb_add(&bar[XB_XCNT(b.x)], 1u);
    return b;
}
DEV void xcd_barrier_complete(unsigned* bar, unsigned x, unsigned& nloc, unsigned& nx) {
    const unsigned G = gridDim.x * gridDim.y * gridDim.z;
    unsigned sum, cnt, mine, sp = 0u;
    for (;;) {
        sum = 0u; cnt = 0u; mine = 0u;
#pragma unroll
        for (unsigned j = 0; j < 16; ++j) { const unsigned c = xb_ld(&bar[XB_XCNT(j)]); sum += c; cnt += (c > 0u) ? 1u : 0u; mine = (j == x) ? c : mine; }
        if (sum == G) break;
        __builtin_amdgcn_s_sleep(1);
        if ((++sp & 255u) == 0u) { if (xb_ld(&bar[XB_TMO])) break; if (sp > XB_SPIN_CAP) { atomicAdd(&bar[XB_TMO], 1u); break; } }
    }
    nloc = mine > 0u ? mine : 1u; nx = cnt > 0u ? cnt : 1u;
}
DEV void xcd_barrier(const XcdBarrier& b) {
    asm volatile("s_waitcnt vmcnt(0)" ::: "memory");
    __syncthreads();
    if (threadIdx.x == 0) {
        unsigned* bar = b.bar; unsigned bx = b.x; asm volatile("" : "+s"(bar), "+s"(bx));
        __builtin_amdgcn_s_waitcnt(0);
        unsigned nloc = b.st[0], nx = b.st[1];
        if (nloc == 0u) { xcd_barrier_complete(bar, bx, nloc, nx); b.st[0] = nloc; b.st[1] = nx; }
        const unsigned old = xb_add(&bar[XB_XSUB(bx)], 1u);
        const unsigned gen = old / nloc;
        if (old + 1u == (gen + 1u) * nloc) {
            __builtin_amdgcn_fence(__ATOMIC_RELEASE, "agent");
            asm volatile("s_waitcnt vmcnt(0)" ::: "memory");
            const unsigned og = xb_add(&bar[XB_TOP], 1u);
            const unsigned tg = og / nx;
            if (og + 1u == (tg + 1u) * nx) xb_add(&bar[XB_TOPGEN], 1u);
            else XB_SPIN(xb_ld(&bar[XB_TOPGEN]) == tg, bar);
            __builtin_amdgcn_fence(__ATOMIC_ACQUIRE, "agent");
            xb_add(&bar[XB_XGEN(bx)], 1u);
            asm volatile("s_waitcnt vmcnt(0)" ::: "memory");
        } else {
            XB_SPIN(xb_ld(&bar[XB_XGEN(bx)]) == gen, bar);
            __builtin_amdgcn_fence(__ATOMIC_ACQUIRE, "agent");
            asm volatile("s_waitcnt vmcnt(0)" ::: "memory");
        }
    }
    __syncthreads();
}
template <class RowEpi> struct EpiRows { RowEpi e;
    DEV void operator()(f32x4 (&acc)[2][2][4][2], const UnitD& u, const UnitD& un, const bool has_next, int wr, int wc, int fr, int fq) const {
#pragma unroll
        for (int ai = 0; ai < 2; ++ai)
#pragma unroll
            for (int m = 0; m < 4; ++m) { f32x4 v[2][2] = {{acc[ai][0][m][0], acc[ai][0][m][1]}, {acc[ai][1][m][0], acc[ai][1][m][1]}};
                e(u.pn, u.pm * 256 + ai * HALF + wr * 64 + m * 16 + fr, wc, fq, v); asm volatile("" ::: "memory"); }
    } };
struct SchedP1 { TileOrder T; const char* A; const char* B;
    DEV bool next(int i, UnitD& u) const { int pm, pn; if (!T.tile<WGM_P1>(i, pm, pn)) return false; u.pm = pm; u.pn = pn; u.aux = i; u.A = A + (size_t)pm * 256 * (D * 2); u.B = B + (size_t)pn * 256 * (D * 2); return true; } };

struct SchedP4 { TileOrder T; const char* A; const char* B;
    DEV bool next(int i, UnitD& u) const { int pm, pn; if (!T.tile<WGM_P4>(i, pm, pn)) return false; u.pm = pm; u.pn = pn; u.aux = 0; u.A = A + (size_t)pm * 256 * (D * 2); u.B = B + (size_t)pn * 256 * (D * 2); return true; } };
struct EpiP3 { const bf16_t* pbuf; bf16_t* mg;
    DEV void operator()(int pn, int row, int wc, int fq, f32x4 (&v)[3][2][2]) const {
        const int cb = 256 * pn + 32 * wc + 8 * fq;
        const unsigned char* gp = (const unsigned char*)(pbuf + (size_t)row * PC + PGATE) + cb; bf16_t* o = mg + (size_t)row * D + cb;
        u32x2 g[3][2];
#pragma unroll
        for (int s = 0; s < 3; ++s) { g[s][0] = *(const u32x2*)(gp + 1024 * s); g[s][1] = *(const u32x2*)(gp + 1024 * s + 128); }
#pragma unroll
        for (int bj = 0; bj < 2; ++bj) { f32x4 t0 = v[0][bj][0] * gate4(g[0][bj].x), t1 = v[0][bj][1] * gate4(g[0][bj].y);
#pragma unroll
            for (int s = 1; s < 3; ++s) { t0 += v[s][bj][0] * gate4(g[s][bj].x); t1 += v[s][bj][1] * gate4(g[s][bj].y); }
            store8(o + 128 * bj, t0, t1); }
    } };
struct SchedSW { int G, c; const char* A; const char* B;
    DEV bool next(int i, UnitD& u) const { const int idx = i * G + c; if (idx >= DEPTH * 30) return false; const int l = idx / 30, pn = idx % 30; u.pm = 0; u.pn = pn + 32 * l; u.aux = l;
        u.A = A + (size_t)l * 256 * (D * 2); u.B = B + (size_t)l * NIN * (D * 2) + (size_t)pn * 256 * (D * 2); return true; } };
struct EpiSWx { float* SW;
    DEV void operator()(int pnx, int row, int wc, int fq, f32x4 (&v)[2][2]) const {
        if (row >= NBT) return;
        const int l = pnx >> 5, pn = pnx & 31;
        float* o = SW + (size_t)l * NBT * NIN + (size_t)row * NIN + 256 * pn + 32 * wc + 8 * fq;
        *(f32x4*)(o) = v[0][0]; *(f32x4*)(o + 4) = v[0][1]; *(f32x4*)(o + 128) = v[1][0]; *(f32x4*)(o + 132) = v[1][1];
    } };
struct EpiP4 { const float* gate  ; const float* atab_cur; const float* atab_next  ; const bf16_t* xa; bf16_t* xao; float* ssq; const float* xin  ; bf16_t* xb; int in16;
    DEV void operator()(int pn, int row, int wc, int fq, f32x4 (&vv)[1][2][2]) const {
        f32x4 (&v)[2][2] = vv[0];
        const int nb = nidx_of(row), col = 256 * pn + 32 * wc + 8 * fq;
        const float* gp = gate + (size_t)nb * 3072 + col;
        float s = 0.f;
#pragma unroll
        for (int bj = 0; bj < 2; ++bj) {
            f32x4 x0, x1;
            if (in16) { unpk8(*(const u32x4*)(xa + (size_t)row * D + col + 128 * bj), x0, x1); const float* ac = atab_cur + (size_t)nb * D + col + 128 * bj; x0 *= rcp4(*(const f32x4*)ac); x1 *= rcp4(*(const f32x4*)(ac + 4)); }
            else { x0 = *(const f32x4*)(xin + (size_t)row * D + col + 128 * bj); x1 = *(const f32x4*)(xin + (size_t)row * D + col + 128 * bj + 4); }
            const f32x4 t0 = x0 + *(const f32x4*)(gp + 128 * bj) * v[bj][0], t1 = x1 + *(const f32x4*)(gp + 128 * bj + 4) * v[bj][1];
            s += ((t0.x * t0.x + t0.y * t0.y) + (t0.z * t0.z + t0.w * t0.w)) + ((t1.x * t1.x + t1.y * t1.y) + (t1.z * t1.z + t1.w * t1.w));
            if (atab_next) { const float* ap = atab_next + (size_t)nb * D + col + 128 * bj; store8(xao + (size_t)row * D + col + 128 * bj, t0 * *(const f32x4*)ap, t1 * *(const f32x4*)(ap + 4)); }
            else store8(xb + (size_t)row * D + col + 128 * bj, t0, t1);
        }
        s += __shfl_xor(s, 16); s += __shfl_xor(s, 32);
        if (fq == 0) ssq[row * 16 + 4 * pn + wc] = s;
    } };


typedef short v4i16 __attribute__((ext_vector_type(4)));
constexpr int TP = 528, VT_OFF = 0, PM_OFF = 128 * TP;
DEV f32x4 unpk4(u32x2 r) { return (f32x4){bflo(r.x), bfhi(r.x), bflo(r.y), bfhi(r.y)}; }
DEV void p2_ln(const Ctx& c, int l, int ck, int hh, const bf16_t* pb, LAS unsigned char* lds) {
    int lane_ = c.lane; asm volatile("" : "+v"(lane_));
    const int lane = lane_, w = c.wave, p = lane >> 5, ch = 256 * hh + 8 * (lane & 31); const bool lastck = (ck & 15) == 15;
    const float* st = c.lnst + ((size_t)ck * 128 + 16 * w + (lane & 15)) * 16;
    const f32x4 t0 = *(const f32x4*)st, t1 = *(const f32x4*)(st + 4), t2 = *(const f32x4*)(st + 8), t3 = *(const f32x4*)(st + 12);
    u32x4 gv[8];
#pragma unroll
    for (int k = 0; k < 8; ++k) gv[k] = *(const u32x4*)(pb + (size_t)(16 * w + 2 * k + p) * PC + PGV + ch);
    const f32x4 g0 = *(const f32x4*)(c.lnv_g + l * W + ch), g1 = *(const f32x4*)(c.lnv_g + l * W + ch + 4), b0 = *(const f32x4*)(c.lnv_b + l * W + ch), b1 = *(const f32x4*)(c.lnv_b + l * W + ch + 4);
    const float s = ((t0.x + t0.z) + (t1.x + t1.z)) + ((t2.x + t2.z) + (t3.x + t3.z)), q = ((t0.y + t0.w) + (t1.y + t1.w)) + ((t2.y + t2.w) + (t3.y + t3.w));
    const float mu_l = s * (1.f / W), rstd_l = __builtin_amdgcn_rsqf(fmaxf(q * (1.f / W) - mu_l * mu_l, 0.f) + EPS);
    float* vout = c.out + O_VP + ((size_t)(l * NBP + (ck >> 4)) * 128) * W + ch;
#pragma unroll
    for (int k = 0; k < 8; ++k) { const int t = 16 * w + 2 * k + p;
        const float mu = __shfl(mu_l, 2 * k + p), rstd = __shfl(rstd_l, 2 * k + p);
        f32x4 x0 = (f32x4){bflo(gv[k].x), bfhi(gv[k].x), bflo(gv[k].y), bfhi(gv[k].y)}, x1 = (f32x4){bflo(gv[k].z), bfhi(gv[k].z), bflo(gv[k].w), bfhi(gv[k].w)};
        x0 = (x0 - mu) * rstd * g0 + b0; x1 = (x1 - mu) * rstd * g1 + b1;
        u32x4 o; o.x = pk2(x0.x, x0.y); o.y = pk2(x0.z, x0.w); o.z = pk2(x1.x, x1.y); o.w = pk2(x1.z, x1.w);
        *(LAS u32x4*)(lds + VT_OFF + t * TP + (lane & 31) * 16) = o;
        if (lastck) { *(f32x4*)(vout + (size_t)t * W) = x0; *(f32x4*)(vout + (size_t)t * W + 4) = x1; }
    }
}
template <int HH> DEV void p2_pool(const Ctx& c, int l, int ck, const bf16_t* pb, LAS unsigned char* lds) {
    constexpr int W0 = 2 << (2 * HH), W1 = 2 * W0, H = W1 - 1, NX = H + 16;
    int lane_ = c.lane; asm volatile("" : "+v"(lane_));
    const int lane = lane_, w = c.wave, gi = lane >> 5, cpos = (ck & 15) * 128, ch = 256 * HH + 4 * lane; const bool lastck = (ck & 15) == 15;
    f32x4 x[NX];
#pragma unroll
    for (int k = 0; k < NX; ++k) { const int tt = 16 * w - H + k; const bool valid = cpos + tt >= 0; const int tc = valid ? tt : 0;
        const u32x2 r = *(const u32x2*)(pb + (ptrdiff_t)tc * PC + PCX + ch); const f32x4 v = unpk4(r); x[k] = valid ? v : (f32x4){0.f, 0.f, 0.f, 0.f}; }
    f32x4 slo = x[H];
#pragma unroll
    for (int j = 1; j < W0; ++j) slo += x[H - j];
    f32x4 shi = slo;
#pragma unroll
    for (int j = W0; j < W1; ++j) shi += x[H - j];
    float* pout = c.out + O_POOLP + ((size_t)(l * NBP + (ck >> 4)) * 15) * W + ch;
#pragma unroll
    for (int i = 0; i < 16; ++i) { const int t = 16 * w + i, pos = cpos + t, wd = gi ? W1 : W0;
        const f32x4 s = gi ? shi : slo; const float inv = __builtin_amdgcn_rcpf((float)(wd < pos + 1 ? wd : pos + 1));
        const f32x4 pm = s * inv - x[H + i];
        *(LAS u32x2*)(lds + PM_OFF + t * TP + 8 * lane) = (u32x2){pk2(pm.x, pm.y), pk2(pm.z, pm.w)};
        if (lastck && t >= 113) *(f32x4*)(pout + (size_t)(t - 113) * W) = x[H + i];
        if (i < 15) { slo += x[H + i + 1] - x[H + i + 1 - W0]; shi += x[H + i + 1] - x[H + i + 1 - W1]; }
    }
}
DEV void p2_conv(const Ctx& c, int l, int ck, int hh, const bf16_t* pb) {
    int lane_ = c.lane; asm volatile("" : "+v"(lane_));
    const int lane = lane_, w = c.wave, cpos = (ck & 15) * 128, ch = 256 * hh + 4 * lane, row0 = ck * 128; const bool lastck = (ck & 15) == 15;
    const f32x4 cb = *(const f32x4*)(c.conv_b + l * W + ch), w0 = *(const f32x4*)(c.conv_w + (l * 3 + 0) * W + ch), w1 = *(const f32x4*)(c.conv_w + (l * 3 + 1) * W + ch), w2 = *(const f32x4*)(c.conv_w + (l * 3 + 2) * W + ch);
    f32x4 z[18];
#pragma unroll
    for (int k = 0; k < 18; ++k) { const int tt = 16 * w - 2 + k; const bool valid = cpos + tt >= 0; const int tc = valid ? tt : 0;
        const f32x4 v = unpk4(*(const u32x2*)(pb + (ptrdiff_t)tc * PC + PZ + ch)); z[k] = valid ? v : (f32x4){0.f, 0.f, 0.f, 0.f}; }
    float* cout = c.out + O_CONVP + ((size_t)(l * NBP + (ck >> 4)) * 2) * W + ch;
#pragma unroll
    for (int i = 0; i < 16; ++i) { const int t = 16 * w + i;
        const f32x4 abg = unpk4(*(const u32x2*)(pb + (size_t)t * PC + PABG + ch));
        const f32x4 o = abg * (cb + w0 * z[i] + w1 * z[i + 1] + w2 * z[i + 2]);
        *(u32x2*)(c.y + (size_t)(row0 + t) * 1536 + ch) = (u32x2){pk2(o.x, o.y), pk2(o.z, o.w)};
        if (lastck && t >= 126) *(f32x4*)(cout + (size_t)(t - 126) * W) = z[i + 2];
    }
}
constexpr int TPS = 1040;
DEV void p2_sample_block(const Ctx& c, int l, int sb, LAS unsigned char* ldsw) {
    const int lane = c.lane, fr = lane & 15, fq = lane >> 4, ch = 8 * lane, h = lane >> 3, g = lane >> 4;
    {
        const int i = c.wave, n = 8 * sb + i, row = MPR + n; const bf16_t* pr = c.pbuf + (size_t)row * PC; bf16_t* yr = c.y + (size_t)row * 1536;
        const float* sc = c.state_conv + ((size_t)(l * NSM + n) * 2) * W + ch; const float* sp = c.state_pool + ((size_t)(l * NSM + n) * 15) * W + ch;
        const u32x4 qz = *(const u32x4*)(pr + PZ + ch), qa = *(const u32x4*)(pr + PABG + ch), qg = *(const u32x4*)(pr + PGV + ch), qu = *(const u32x4*)(pr + PUG + ch), qc = *(const u32x4*)(pr + PCX + ch);
        const f32x4 s00 = *(const f32x4*)(sc), s01 = *(const f32x4*)(sc + 4), s10 = *(const f32x4*)(sc + W), s11 = *(const f32x4*)(sc + W + 4);
        f32x4 st0[15], st1[15];
#pragma unroll
        for (int k = 7; k < 15; ++k) { st0[k] = *(const f32x4*)(sp + (size_t)k * W); st1[k] = *(const f32x4*)(sp + (size_t)k * W + 4); }
        const f32x4 cb0 = *(const f32x4*)(c.conv_b + l * W + ch), cb1 = *(const f32x4*)(c.conv_b + l * W + ch + 4);
        const f32x4 w0a = *(const f32x4*)(c.conv_w + (l * 3 + 0) * W + ch), w0b = *(const f32x4*)(c.conv_w + (l * 3 + 0) * W + ch + 4);
        const f32x4 w1a = *(const f32x4*)(c.conv_w + (l * 3 + 1) * W + ch), w1b = *(const f32x4*)(c.conv_w + (l * 3 + 1) * W + ch + 4);
        const f32x4 w2a = *(const f32x4*)(c.conv_w + (l * 3 + 2) * W + ch), w2b = *(const f32x4*)(c.conv_w + (l * 3 + 2) * W + ch + 4);
        const f32x4 lg0 = *(const f32x4*)(c.lnv_g + l * W + ch), lg1 = *(const f32x4*)(c.lnv_g + l * W + ch + 4), lb0 = *(const f32x4*)(c.lnv_b + l * W + ch), lb1 = *(const f32x4*)(c.lnv_b + l * W + ch + 4);
        const float w00 = c.sgu_w[(size_t)(l * 8 + h) * 128 * 128], b00 = c.sgu_b[(l * 8 + h) * 128], invw = 1.f / (float)(2 << g);
        asm volatile("" ::: "memory");
        {
            f32x4 z0, z1, a0, a1; unpk8(qz, z0, z1); unpk8(qa, a0, a1);
            const f32x4 ya = a0 * (cb0 + w0a * s00 + w1a * s10 + w2a * z0), yb = a1 * (cb1 + w0b * s01 + w1b * s11 + w2b * z1);
#pragma unroll
            for (int k = 0; k < 7; ++k) { st0[k] = *(const f32x4*)(sp + (size_t)k * W); st1[k] = *(const f32x4*)(sp + (size_t)k * W + 4); }
            store8(yr + ch, ya, yb);
            float* o = c.out + O_CONVS + ((size_t)(l * NSM + n) * 2) * W + ch;
            *(f32x4*)(o) = s10; *(f32x4*)(o + 4) = s11; *(f32x4*)(o + W) = z0; *(f32x4*)(o + W + 4) = z1;
        }
        {
            f32x4 x0, x1, u0, u1; unpk8(qg, x0, x1); unpk8(qu, u0, u1);
            float s = ((x0.x + x0.y) + (x0.z + x0.w)) + ((x1.x + x1.y) + (x1.z + x1.w));
            float q = ((x0.x * x0.x + x0.y * x0.y) + (x0.z * x0.z + x0.w * x0.w)) + ((x1.x * x1.x + x1.y * x1.y) + (x1.z * x1.z + x1.w * x1.w));
#pragma unroll
            for (int o = 1; o < 64; o <<= 1) { s += __shfl_xor(s, o); q += __shfl_xor(q, o); }
            const float mu = s * (1.f / W), var = fmaxf(q * (1.f / W) - mu * mu, 0.f), rstd = __builtin_amdgcn_rsqf(var + EPS);
            x0 = (x0 - mu) * rstd * lg0 + lb0; x1 = (x1 - mu) * rstd * lg1 + lb1;
            float* vo = c.out + O_VS + (size_t)(l * NSM + n) * W + ch; *(f32x4*)(vo) = x0; *(f32x4*)(vo + 4) = x1;
            store8(yr + 512 + ch, u0 * (x0 * w00 + b00), u1 * (x1 * w00 + b00));
        }
        {
            f32x4 c0, c1; unpk8(qc, c0, c1);
            float* po = c.out + O_POOLS + ((size_t)(l * NSM + n) * 15) * W + ch;
            f32x4 r0 = c0, r1 = c1, s2a, s2b, s4a, s4b, s8a, s8b;
#pragma unroll
            for (int k = 14; k >= 0; --k) {
                if (k >= 1) { *(f32x4*)(po + (size_t)(k - 1) * W) = st0[k]; *(f32x4*)(po + (size_t)(k - 1) * W + 4) = st1[k]; }
                r0 += st0[k]; r1 += st1[k];
                if (k == 14) { s2a = r0; s2b = r1; } if (k == 12) { s4a = r0; s4b = r1; } if (k == 8) { s8a = r0; s8b = r1; } }
            *(f32x4*)(po + (size_t)14 * W) = c0; *(f32x4*)(po + (size_t)14 * W + 4) = c1;
            const f32x4 sa = g == 0 ? s2a : g == 1 ? s4a : g == 2 ? s8a : r0, sb2 = g == 0 ? s2b : g == 1 ? s4b : g == 2 ? s8b : r1;
            const f32x4 p0 = sa * invw - c0, p1 = sb2 * invw - c1;
            u32x4 o; o.x = pk2(p0.x, p0.y); o.y = pk2(p0.z, p0.w); o.z = pk2(p1.x, p1.y); o.w = pk2(p1.z, p1.w);
            *(LAS u32x4*)(ldsw + i * TPS + 16 * lane) = o;
        }
    }
    __syncthreads();
    const int row = MPR + 8 * sb + (fr & 7); const bf16_t* pr = c.pbuf + (size_t)row * PC; bf16_t* yr = c.y + (size_t)row * 1536;
    bf16x8 bw[2][4][2]; u32x4 sgv[2]; f32x4 pbv[2][2], psv[2][2];
#pragma unroll
    for (int gi2 = 0; gi2 < 2; ++gi2) { const int gq = 2 * c.wave + gi2, g2 = gq >> 2, nq = gq & 3, cc = 128 * g2 + 32 * nq + 8 * fq;
        const bf16_t* pw = c.PoolWT + ((size_t)(l * 4 + g2) * 128 + 32 * nq + fr) * 128 + 8 * fq;
#pragma unroll
        for (int ks = 0; ks < 4; ++ks) { bw[gi2][ks][0] = *(const bf16x8*)(pw + 32 * ks); bw[gi2][ks][1] = *(const bf16x8*)(pw + 16 * 128 + 32 * ks); }
        sgv[gi2] = *(const u32x4*)(pr + PSG + cc);
        pbv[gi2][0] = *(const f32x4*)(c.pool_b + l * W + cc); pbv[gi2][1] = *(const f32x4*)(c.pool_b + l * W + cc + 4); psv[gi2][0] = *(const f32x4*)(c.pool_scale + l * W + cc); psv[gi2][1] = *(const f32x4*)(c.pool_scale + l * W + cc + 4); }
#pragma unroll
    for (int gi2 = 0; gi2 < 2; ++gi2) { const int gq = 2 * c.wave + gi2, g2 = gq >> 2, nq = gq & 3, cc = 128 * g2 + 32 * nq + 8 * fq;
        f32x4 a0 = (f32x4){0.f, 0.f, 0.f, 0.f}, a1 = (f32x4){0.f, 0.f, 0.f, 0.f};
#pragma unroll
        for (int ks = 0; ks < 4; ++ks) { const bf16x8 af = *(const LAS bf16x8*)(ldsw + fr * TPS + 2 * (128 * g2 + 32 * ks + 8 * fq));
            a0 = __builtin_amdgcn_mfma_f32_16x16x32_bf16(bw[gi2][ks][0], af, a0, 0, 0, 0); a1 = __builtin_amdgcn_mfma_f32_16x16x32_bf16(bw[gi2][ks][1], af, a1, 0, 0, 0); }
        f32x4 g0v, g1v; unpk8(sgv[gi2], g0v, g1v);
        if (fr < 8) store8(yr + 1024 + cc, (a0 + pbv[gi2][0]) * psv[gi2][0] * g0v, (a1 + pbv[gi2][1]) * psv[gi2][1] * g1v);
    }
}

DEV void p2_mm(const Ctx& c, const int l, const int ck, const int hh, const bf16_t* pb, LAS unsigned char* lds) {
    int lane_ = c.lane; asm volatile("" : "+v"(lane_));
    const int lane = lane_, w = c.wave, fr = lane & 15, fq = lane >> 4, row0 = ck * 128;
    const int hq = w >> 1, a = w & 1, h = 4 * hh + hq;
    bf16x8 wf[4][4]; u32x4 ug[4][2]; float bias[4];
    { const bf16_t* wm = c.SguW + ((size_t)(l * 8 + h) * 128) * 128;
#pragma unroll
      for (int i = 0; i < 4; ++i) { const int tb = a ? (i == 0 ? 1 : i == 1 ? 2 : i == 2 ? 5 : 6) : (i == 0 ? 0 : i == 1 ? 3 : i == 2 ? 4 : 7), t = 16 * tb + fr;
#pragma unroll
          for (int ks = 0; ks < 4; ++ks) wf[i][ks] = *(const bf16x8*)(wm + (size_t)t * 128 + 32 * ks + 8 * fq);
      } }
    __syncthreads();
#pragma unroll
    for (int i = 0; i < 4; ++i) { const int tb = a ? (i == 0 ? 1 : i == 1 ? 2 : i == 2 ? 5 : 6) : (i == 0 ? 0 : i == 1 ? 3 : i == 2 ? 4 : 7), t = 16 * tb + fr;
        bias[i] = c.sgu_b[(l * 8 + h) * 128 + t];
#pragma unroll
        for (int c2 = 0; c2 < 2; ++c2) ug[i][c2] = *(const u32x4*)(pb + (size_t)t * PC + PUG + 256 * hh + 64 * hq + 32 * c2 + 8 * fq); }
    f32x4 acc[4][4];
#pragma unroll
    for (int i = 0; i < 4; ++i)
#pragma unroll
        for (int cc = 0; cc < 4; ++cc) acc[i][cc] = (f32x4){0.f, 0.f, 0.f, 0.f};
    { const int q = fr >> 2, p = fr & 3;
#pragma unroll
      for (int ks = 0; ks < 4; ++ks) {
        bf16x8 vb[4];
#pragma unroll
        for (int cc = 0; cc < 4; ++cc) { const int col = 64 * hq + 32 * (cc >> 1) + 8 * p + 4 * (cc & 1);
            const v4i16 lo = __builtin_amdgcn_ds_read_tr16_b64_v4i16((LAS v4i16*)(lds + VT_OFF + (32 * ks + 8 * fq + q) * TP + 2 * col));
            const v4i16 hi = __builtin_amdgcn_ds_read_tr16_b64_v4i16((LAS v4i16*)(lds + VT_OFF + (32 * ks + 8 * fq + 4 + q) * TP + 2 * col));
            vb[cc] = (bf16x8){lo[0], lo[1], lo[2], lo[3], hi[0], hi[1], hi[2], hi[3]}; }
#pragma unroll
        for (int i = 0; i < 4; ++i) { const int tb = a ? (i == 0 ? 1 : i == 1 ? 2 : i == 2 ? 5 : 6) : (i == 0 ? 0 : i == 1 ? 3 : i == 2 ? 4 : 7);
            if (ks <= (tb >> 1)) {
#pragma unroll
                for (int cc = 0; cc < 4; ++cc) acc[i][cc] = __builtin_amdgcn_mfma_f32_16x16x32_bf16(vb[cc], wf[i][ks], acc[i][cc], 0, 0, 0); } }
      } }
    asm volatile("" ::: "memory");
    const int gi2 = w >> 2, nq = w & 3, chc = 256 * hh + 128 * gi2 + 32 * nq + 8 * fq;
    bf16x8 pw0[4], pw1[4]; u32x4 sgv[8];
    { const bf16_t* pw = c.PoolWT + ((size_t)(l * 4 + 2 * hh + gi2) * 128 + 32 * nq + fr) * 128 + 8 * fq;
#pragma unroll
      for (int ks = 0; ks < 4; ++ks) { pw0[ks] = *(const bf16x8*)(pw + 32 * ks); pw1[ks] = *(const bf16x8*)(pw + 16 * 128 + 32 * ks); }
#pragma unroll
      for (int m = 0; m < 8; ++m) sgv[m] = *(const u32x4*)(pb + (size_t)(16 * m + fr) * PC + PSG + chc); }
    const f32x4 pb0 = *(const f32x4*)(c.pool_b + l * W + chc), pb1 = *(const f32x4*)(c.pool_b + l * W + chc + 4), ps0 = *(const f32x4*)(c.pool_scale + l * W + chc), ps1 = *(const f32x4*)(c.pool_scale + l * W + chc + 4);
#pragma unroll
    for (int i = 0; i < 4; ++i) { const int tb = a ? (i == 0 ? 1 : i == 1 ? 2 : i == 2 ? 5 : 6) : (i == 0 ? 0 : i == 1 ? 3 : i == 2 ? 4 : 7), t = 16 * tb + fr;
#pragma unroll
        for (int c2 = 0; c2 < 2; ++c2) { f32x4 u0, u1; unpk8(ug[i][c2], u0, u1);
            store8(c.y + (size_t)(row0 + t) * 1536 + 512 + 256 * hh + 64 * hq + 32 * c2 + 8 * fq, (acc[i][2 * c2] + bias[i]) * u0, (acc[i][2 * c2 + 1] + bias[i]) * u1); } }
    f32x4 ac2[8][2];
#pragma unroll
    for (int m = 0; m < 8; ++m) { ac2[m][0] = (f32x4){0.f, 0.f, 0.f, 0.f}; ac2[m][1] = (f32x4){0.f, 0.f, 0.f, 0.f}; }
#pragma unroll
    for (int ks = 0; ks < 4; ++ks)
#pragma unroll
        for (int m = 0; m < 8; ++m) { const bf16x8 af = *(const LAS bf16x8*)(lds + PM_OFF + (16 * m + fr) * TP + 2 * (128 * gi2 + 32 * ks + 8 * fq));
            ac2[m][0] = __builtin_amdgcn_mfma_f32_16x16x32_bf16(pw0[ks], af, ac2[m][0], 0, 0, 0); ac2[m][1] = __builtin_amdgcn_mfma_f32_16x16x32_bf16(pw1[ks], af, ac2[m][1], 0, 0, 0); }
#pragma unroll
    for (int m = 0; m < 8; ++m) { f32x4 s0, s1; unpk8(sgv[m], s0, s1);
        store8(c.y + (size_t)(row0 + 16 * m + fr) * 1536 + 1024 + chc, (ac2[m][0] + pb0) * ps0 * s0, (ac2[m][1] + pb1) * ps1 * s1); }
    __syncthreads();
}
DEV void ph_p2_prompt(const Args& a, int l, LAS unsigned char* lds) {
    LAUNDER_CTX(a);
    if (blockIdx.x + 16 >= gridDim.x) { p2_sample_block(c, l, (int)(gridDim.x - 1 - blockIdx.x), lds); __syncthreads(); }
    for (int item = blockIdx.x; item < 256; item += gridDim.x) {
        const int ck = item >> 1, hh = item & 1; const bf16_t* pb = c.pbuf + (size_t)ck * 128 * PC;
        p2_ln(c, l, ck, hh, pb, lds);
        { if (hh) p2_pool<1>(c, l, ck, pb, lds); else p2_pool<0>(c, l, ck, pb, lds); }
        p2_conv(c, l, ck, hh, pb);
        p2_mm(c, l, ck, hh, pb, lds);
    }
}
DEV void ph_final(const Args& a) {
    LAUNDER_CTX(a);
    const int lane = c.lane;
#pragma unroll 2
    for (int row = c.gw; row < MV; row += c.NGW) {
        const float r = row_rstd(c.ssq, row);
#pragma unroll
        for (int j = 0; j < 2; ++j) { f32x4 x0, x1; unpk8(*((const u32x4*)(c.xb + (size_t)row * D) + lane + 64 * j), x0, x1);
            const f32x4* gp = (const f32x4*)c.final_g + 2 * lane + 128 * j; f32x4* o = (f32x4*)(c.out + (size_t)row * D) + 2 * lane + 128 * j;
            o[0] = x0 * r * gp[0]; o[1] = x1 * r * gp[1]; }
    }
}

__global__ __launch_bounds__(NTHREADS, 2) void mega_fwd(Args a) {
    extern __shared__ __attribute__((aligned(16))) unsigned char lds[];
    LAS unsigned char* ldsp = (LAS unsigned char*)lds;
    if (threadIdx.x < 16) ((LAS unsigned*)(ldsp + LDSCTL_OFF))[threadIdx.x] = 0u;
    __syncthreads();
    const XcdBarrier bar = xcd_barrier_post((unsigned*)(a.ws + WS_CTL), (volatile LAS unsigned*)(ldsp + LDSCTL_OFF));
    ph_convert(a, lds, 0, 0);
    xcd_barrier(bar);
    { LAUNDER_CTX(a); int bx_ = blockIdx.x, gx_ = gridDim.x; asm volatile("" : "+s"(bx_), "+s"(gx_)); SchedMod S{gx_, bx_, (const char*)c.scb, (const char*)c.WadaT}; EpiRows<EpiMod> E{EpiMod{c.mod, c.atab, c.shb, c.b_ada, c.norm_g}}; gemm_phase(ldsp, D * 2, D * 2, D / BK, S, E); }
    ph_convert(a, lds, 1, (int)gridDim.x > 96 ? 48 : 0);
    xcd_barrier(bar);
    { LAUNDER_CTX(a); int bx_ = blockIdx.x, gx_ = gridDim.x; asm volatile("" : "+s"(bx_), "+s"(gx_)); SchedSW S{gx_, bx_, (const char*)c.shb, (const char*)c.WinT}; EpiRows<EpiSWx> E{EpiSWx{c.SW}}; gemm_phase(ldsp, D * 2, D * 2, D / BK, S, E); }
    ph_xa0(a);
    xcd_barrier(bar);
#pragma unroll 1
    for (int l = 0; l < DEPTH; ++l) {
        { LAUNDER_CTX(a); int bx_ = blockIdx.x, gx_ = gridDim.x; asm volatile("" : "+s"(bx_), "+s"(gx_)); SchedP1 S; S.T.init(MP / 256, NIN / 256, gx_, bx_); S.A = (const char*)((l & 1) ? c.xa2 : c.xa); S.B = (const char*)(c.WinT + (size_t)l * NIN * D);
          p1_rtab(S, c.ssq, c.SW + (size_t)l * NBT * NIN, (LAS float*)(ldsp + RTAB_OFF), (LAS float*)(ldsp + SWT_OFF));
          EpiP1T E{c.pbuf, c.SW + (size_t)l * NBT * NIN, (const LAS float*)(ldsp + RTAB_OFF), (const LAS float*)(ldsp + SWT_OFF), c.lnst};
          gemm_phase(ldsp, D * 2, D * 2, D / BK, S, E); }
        xcd_barrier(bar);
        ph_p2_prompt(a, l, ldsp);
        xcd_barrier(bar);
        { LAUNDER_CTX(a); int bx_ = blockIdx.x, gx_ = gridDim.x; asm volatile("" : "+s"(bx_), "+s"(gx_)); const EpiP3 e3{c.pbuf, c.mg};
          if (bx_ < 128) mini_gemm<3, 2>(a, ldsp, bx_, c.y, 1536, W, c.WbT + (size_t)l * 3 * D * W, W, (size_t)D * W, e3);
          SchedP3R S; S.T.init(MPR / 256, 8, gx_, bx_); S.A = (const char*)c.y; S.B = (const char*)(c.WbT + (size_t)l * 3 * D * W);
          f32x4 tot[2][4][2];
#pragma unroll
          for (int i0 = 0; i0 < 2; ++i0)
#pragma unroll
              for (int i1 = 0; i1 < 4; ++i1) { tot[i0][i1][0] = (f32x4){0.f, 0.f, 0.f, 0.f}; tot[i0][i1][1] = (f32x4){0.f, 0.f, 0.f, 0.f}; }
          u32x2 gpre[8]; EpiP3R E{tot, gpre, c.pbuf, c.mg};
          { UnitD u0; int t_ = threadIdx.x; asm volatile("" : "+v"(t_)); const int wv = __builtin_amdgcn_readfirstlane(t_ >> 6); if (S.next(0, u0)) E.prefetch(u0, wv >> 2, wv & 3, t_ & 15, (t_ & 63) >> 4); }
          gemm_phase<EpiP3R, SchedP3R, 1>(ldsp, 1536 * 2, W * 2, W / BK, S, E); }
        xcd_barrier(bar);
        { LAUNDER_CTX(a); int bx_ = blockIdx.x, gx_ = gridDim.x; asm volatile("" : "+s"(bx_), "+s"(gx_)); const float* gate = c.mod + (size_t)l * NBT * 3072 + 2048;
          const float* atc = c.atab + (size_t)l * NBT * D; const float* atn = l + 1 < DEPTH ? c.atab + (size_t)(l + 1) * NBT * D : nullptr;
          const bf16_t* xai = (l & 1) ? c.xa2 : c.xa; bf16_t* xao = (l & 1) ? c.xa : c.xa2;
          const EpiP4 e4{gate, atc, atn, xai, xao, c.ssq, c.x_sample - (size_t)MPR * D, c.xb, l > 0};
          if (bx_ < 128) mini_gemm<1, 4>(a, ldsp, bx_, c.mg, D, 0, c.WoT + (size_t)l * D * D, D, (size_t)0, e4);
          SchedP4 S; S.T.init(MPR / 256, 4, gx_, bx_); S.A = (const char*)c.mg; S.B = (const char*)(c.WoT + (size_t)l * D * D);
          if (l == 0) { EpiP4T<false, false> E{gate, atc, atn, xai, xao, c.ssq, c.x_prompt, c.xb}; gemm_phase(ldsp, D * 2, D * 2, D / BK, S, E); }
          else if (l + 1 < DEPTH) { EpiP4T<true, false> E{gate, atc, atn, xai, xao, c.ssq, c.x_prompt, c.xb}; gemm_phase(ldsp, D * 2, D * 2, D / BK, S, E); }
          else { EpiP4T<true, true> E{gate, atc, atn, xai, xao, c.ssq, c.x_prompt, c.xb}; gemm_phase(ldsp, D * 2, D * 2, D / BK, S, E); } }
        xcd_barrier(bar);
    }
    ph_final(a);
}

extern "C" void kernel_launch(void* const* d_in, const int* in_sizes, int n_in, void* d_out, int out_size, void* d_ws, size_t ws_size, hipStream_t stream) {
    static int grid_blocks = 0;
    if (grid_blocks == 0) {
        if (n_in != 22 || ws_size < WS_END) { fprintf(stderr, "kernel_launch: unexpected n_in %d or ws_size %zu < %zu\n", n_in, ws_size, (size_t)WS_END); grid_blocks = -1; return; }
        int dev = 0, cus = 0, per_cu = 0;
        (void)hipGetDevice(&dev); (void)hipDeviceGetAttribute(&cus, hipDeviceAttributeMultiprocessorCount, dev);
        if (hipFuncSetAttribute((const void*)mega_fwd, hipFuncAttributeMaxDynamicSharedMemorySize, LDS_BYTES) != hipSuccess) { fprintf(stderr, "kernel_launch: hipFuncSetAttribute failed\n"); grid_blocks = -1; return; }
        if (hipOccupancyMaxActiveBlocksPerMultiprocessor(&per_cu, (const void*)mega_fwd, NTHREADS, LDS_BYTES) != hipSuccess || per_cu < 1) { fprintf(stderr, "kernel_launch: occupancy query gave %d\n", per_cu); grid_blocks = -1; return; }
        if (cus < 256) { fprintf(stderr, "kernel_launch: this kernel is laid out for >= 256 CUs (found %d)\n", cus); grid_blocks = -1; return; }
        grid_blocks = 256;
        fprintf(stderr, "kernel_launch: cus %d per_cu %d grid %d\n", cus, per_cu, grid_blocks);
    }
    if (grid_blocks < 0) return;
    Args a{};
    for (int i = 0; i < 22; ++i) a.in[i] = (const float*)d_in[i];
    a.out = (float*)d_out; a.ws = (unsigned char*)d_ws;
    if (hipMemsetAsync((char*)d_ws + WS_CTL, 0, CTL_BYTES, stream) != hipSuccess) { fprintf(stderr, "kernel_launch: memset failed\n"); return; }
    void* args[] = {&a};
    hipError_t e = hipLaunchCooperativeKernel((const void*)mega_fwd, dim3(grid_blocks), dim3(NTHREADS), args, LDS_BYTES, stream);
    if (e != hipSuccess) fprintf(stderr, "kernel_launch: cooperative launch failed: %s (grid %d)\n", hipGetErrorString(e), grid_blocks);
}
```

```cpp
#include <hip/hip_runtime.h>
#include <cstdio>
#include <cstdint>

#define DEV __device__ __forceinline__
typedef unsigned short bf16_t;
typedef short bf16x8 __attribute__((ext_vector_type(8)));
typedef float f32x4 __attribute__((ext_vector_type(4)));
typedef unsigned u32x4 __attribute__((ext_vector_type(4)));
typedef unsigned u32x2 __attribute__((ext_vector_type(2)));

constexpr int D = 1024, TSEQ = 2048, NBP = 8, MPR = NBP * TSEQ  , NSM = 128, MV = MPR + NSM  , MP = 16640  , NBT = NBP + NSM  ;
constexpr int W = 512, NIN = 7680, PC = 4608  , DEPTH = 4;
constexpr int PZ = 0, PABG = 512, PUG = 1024, PGV = 1536, PCX = 2048, PSG = 2560, PGATE = 3072;
constexpr float EPS = 1e-6f;
constexpr size_t O_Y = 0, O_YS = 16777216, O_CONVP = 16908288, O_CONVS = 16941056, O_POOLP = 17465344, O_POOLS = 17711104, O_VP = 21643264, O_VS = 23740416;

constexpr size_t al256(size_t x) { return (x + 255) & ~(size_t)255; }
constexpr size_t WS_WIN = 0;
constexpr size_t WS_WB = al256(WS_WIN + (size_t)DEPTH * NIN * D * 2);
constexpr size_t WS_WO = al256(WS_WB + (size_t)DEPTH * 3 * D * W * 2);
constexpr size_t WS_MOD = al256(WS_WO + (size_t)DEPTH * D * D * 2);
constexpr size_t WS_ATAB = al256(WS_MOD + (size_t)DEPTH * NBT * 3 * D * 4);
constexpr size_t WS_SHB = al256(WS_ATAB + (size_t)DEPTH * NBT * D * 4);
constexpr size_t WS_SW = al256(WS_SHB + (size_t)DEPTH * 256 * D * 2);
constexpr size_t WS_XA = al256(WS_SW + (size_t)DEPTH * NBT * NIN * 4);
constexpr size_t WS_SSQ = al256(WS_XA + (size_t)MP * D * 2);
constexpr size_t WS_PBUF = al256(WS_SSQ + (size_t)MP * 16 * 4);
constexpr size_t WS_Y = al256(WS_PBUF + (size_t)MP * PC * 2);
constexpr size_t WS_MG = al256(WS_Y + (size_t)MP * 1536 * 2);
constexpr size_t WS_SGUW = al256(WS_MG + (size_t)MP * D * 2);
constexpr size_t WS_POOLW = al256(WS_SGUW + (size_t)DEPTH * 8 * 128 * 128 * 2);
constexpr size_t WS_WADA = al256(WS_POOLW + (size_t)DEPTH * 4 * 128 * 128 * 2);
constexpr size_t WS_SCB = al256(WS_WADA + (size_t)DEPTH * 3072 * D * 2);
constexpr size_t WS_XB = al256(WS_SCB + (size_t)256 * D * 2);
constexpr size_t WS_XA2 = al256(WS_XB + (size_t)MV * D * 2);
constexpr size_t WS_LNST = al256(WS_XA2 + (size_t)MP * D * 2);
constexpr size_t WS_CTL = al256(WS_LNST + (size_t)MP * 16 * 4);
constexpr size_t CTL_BYTES = 32768;
constexpr size_t WS_END = al256(WS_CTL + CTL_BYTES);

constexpr int NTHREADS = 512, NWAVES = 8;
constexpr int LDS_BYTES = 155648;
constexpr int LDSCTL_OFF = LDS_BYTES - 256;

typedef __bf16 bf16x2_t __attribute__((ext_vector_type(2)));
typedef float f32x2_t __attribute__((ext_vector_type(2)));
DEV unsigned pk2(float lo, float hi) { const f32x2_t v = {lo, hi}; const bf16x2_t b = __builtin_convertvector(v, bf16x2_t); return __builtin_bit_cast(unsigned, b); }
DEV float bflo(unsigned u) { return __builtin_bit_cast(float, u << 16); }
DEV float bfhi(unsigned u) { return __builtin_bit_cast(float, u & 0xffff0000u); }
DEV void unpk8(const u32x4 u, f32x4& a, f32x4& b) { a = (f32x4){bflo(u.x), bfhi(u.x), bflo(u.y), bfhi(u.y)}; b = (f32x4){bflo(u.z), bfhi(u.z), bflo(u.w), bfhi(u.w)}; }
DEV f32x4 gate4(unsigned u) { return (f32x4){(float)(u & 0xffu), (float)((u >> 8) & 0xffu), (float)((u >> 16) & 0xffu), (float)(u >> 24)} * (1.f / 255.f); }
DEV unsigned pku8(f32x4 s) { const unsigned a = (unsigned)(s.x * 255.f + 0.5f), b = (unsigned)(s.y * 255.f + 0.5f), c = (unsigned)(s.z * 255.f + 0.5f), d = (unsigned)(s.w * 255.f + 0.5f); return a | (b << 8) | (c << 16) | (d << 24); }
DEV f32x4 exp2_4(f32x4 t) { return (f32x4){__builtin_amdgcn_exp2f(t.x), __builtin_amdgcn_exp2f(t.y), __builtin_amdgcn_exp2f(t.z), __builtin_amdgcn_exp2f(t.w)}; }
DEV f32x4 rcp4(f32x4 d) { return (f32x4){__builtin_amdgcn_rcpf(d.x), __builtin_amdgcn_rcpf(d.y), __builtin_amdgcn_rcpf(d.z), __builtin_amdgcn_rcpf(d.w)}; }
DEV f32x4 sigmoid4(f32x4 x) { return rcp4(exp2_4(x * -1.44269504f) + 1.f); }
DEV f32x4 silu4(f32x4 x) { return x * sigmoid4(x); }
DEV f32x4 gelu4(f32x4 x) { const f32x4 t = x * (x * x * (-2.f * 0.7978845608f * 0.044715f * 1.44269504f) + (-2.f * 0.7978845608f * 1.44269504f)); return x * rcp4(exp2_4(t) + 1.f); }
DEV int perm32(int rho) { const int n = rho >> 4, i = rho & 15; return 8 * (i >> 2) + 4 * n + (i & 3); }
DEV int nidx_of(int row) { return row < MPR ? (row >> 11) : (row < MV ? NBP + (row - MPR) : NBT - 1); }
DEV int src_win(int j) {
    const int pn = j >> 8, c = j & 255, bj = c >> 7, cc = c & 127;
    if (pn < 4) return (bj ? 1024 : 512) + 128 * pn + cc;
    if (pn < 8) return (bj ? 1536 : 0) + 128 * (pn - 4) + cc;
    if (pn < 12) return (bj ? 3072 : 2048) + 128 * (pn - 8) + cc;
    if (pn < 14) return 2560 + 256 * (pn - 12) + c;
    if (pn < 16) return 3584 + 256 * (pn - 14) + c;
    if (pn < 18) return 4096 + 256 * (pn - 16) + c;
    return 4608 + 256 * (pn - 18) + c;
}

struct Args { const float* in[22]; float* out; unsigned char* ws; };
struct Ctx {
    const float *x_prompt, *x_sample, *c_prompt, *c_sample, *state_conv, *state_pool, *w_ada, *b_ada, *norm_g, *w_in, *conv_w, *conv_b, *lnv_g, *lnv_b, *sgu_w, *sgu_b, *pool_w, *pool_b, *pool_scale, *w_branch, *w_out, *final_g;
    float* out; bf16_t *WinT, *WbT, *WoT; float *mod, *atab; bf16_t* shb; float* SW; bf16_t* xa; float* ssq; bf16_t *pbuf, *y, *mg; bf16_t *SguW, *PoolWT, *WadaT, *scb, *xb, *xa2; float* lnst;
    unsigned char* lds;
    int tid, lane, wave, gw, NGW, gtid, NGT;
};

DEV Ctx make_ctx(const Args& a, size_t z) {
    Ctx c;
    c.x_prompt = a.in[0] + z; c.x_sample = a.in[1] + z; c.c_prompt = a.in[2] + z; c.c_sample = a.in[3] + z; c.state_conv = a.in[4] + z; c.state_pool = a.in[5] + z; c.w_ada = a.in[6] + z; c.b_ada = a.in[7] + z;
    c.norm_g = a.in[8] + z; c.w_in = a.in[9] + z; c.conv_w = a.in[10] + z; c.conv_b = a.in[11] + z; c.lnv_g = a.in[12] + z; c.lnv_b = a.in[13] + z; c.sgu_w = a.in[14] + z; c.sgu_b = a.in[15] + z;
    c.pool_w = a.in[16] + z; c.pool_b = a.in[17] + z; c.pool_scale = a.in[18] + z; c.w_branch = a.in[19] + z; c.w_out = a.in[20] + z; c.final_g = a.in[21] + z;
    c.out = a.out + z; unsigned char* ws = a.ws + z;
    c.WinT = (bf16_t*)(ws + WS_WIN); c.WbT = (bf16_t*)(ws + WS_WB); c.WoT = (bf16_t*)(ws + WS_WO);
    c.mod = (float*)(ws + WS_MOD); c.atab = (float*)(ws + WS_ATAB); c.shb = (bf16_t*)(ws + WS_SHB); c.SW = (float*)(ws + WS_SW);
    c.xa = (bf16_t*)(ws + WS_XA); c.ssq = (float*)(ws + WS_SSQ); c.pbuf = (bf16_t*)(ws + WS_PBUF); c.y = (bf16_t*)(ws + WS_Y); c.mg = (bf16_t*)(ws + WS_MG);
    c.WadaT = (bf16_t*)(ws + WS_WADA); c.scb = (bf16_t*)(ws + WS_SCB); c.xb = (bf16_t*)(ws + WS_XB); c.xa2 = (bf16_t*)(ws + WS_XA2); c.lnst = (float*)(ws + WS_LNST); c.SguW = (bf16_t*)(ws + WS_SGUW); c.PoolWT = (bf16_t*)(ws + WS_POOLW);
    c.lds = nullptr; c.tid = 0; c.lane = 0; c.wave = 0; c.gw = 0; c.NGW = 0; c.gtid = 0; c.NGT = 0;
    return c;
}
#define LAUNDER_CTX(a) size_t z_ = 0; asm volatile("" : "+s"(z_)); Ctx c = make_ctx(a, z_); { int t_ = threadIdx.x; asm volatile("" : "+v"(t_)); c.tid = t_; c.lane = t_ & 63; c.wave = __builtin_amdgcn_readfirstlane(t_ >> 6); \
    c.gw = blockIdx.x * NWAVES + c.wave; c.NGW = gridDim.x * NWAVES; c.gtid = blockIdx.x * NTHREADS + t_; c.NGT = gridDim.x * NTHREADS; }
#define VB_LOAD(ldsp) const int vb_ = __builtin_amdgcn_readfirstlane((int)((volatile LAS unsigned*)((ldsp) + LDSCTL_OFF))[2]); const int vx_ = vb_ >> 5, vr_ = vb_ & 31;
struct MapWin { DEV int operator()(int g) const { return src_win((g & ~31) + perm32(g & 31)); } };
struct MapPerm { DEV int operator()(int g) const { return (g & ~31) + perm32(g & 31); } };
template <class Map>
DEV void transpose_item(const float* Wsrc, int ldw, int K, bf16_t* WT, int nblk, int item, float* scr, int lane, Map map) {
    const int kb = item / nblk, nb = item % nblk, k0 = 64 * kb, g0 = 32 * nb;
    const int scol = map(g0 + (lane & 31));
#pragma unroll 8
    for (int i = 0; i < 32; ++i) { const int kk = 2 * i + (lane >> 5); scr[kk * 33 + (lane & 31)] = Wsrc[(size_t)(k0 + kk) * ldw + scol]; }
    asm volatile("s_waitcnt lgkmcnt(0)" ::: "memory");
    const int c = lane & 7;
#pragma unroll
    for (int j = 0; j < 4; ++j) { const int n = (lane >> 3) + 8 * j; const float* s = scr + (8 * c) * 33 + n;
        u32x4 o; o.x = pk2(s[0 * 33], s[1 * 33]); o.y = pk2(s[2 * 33], s[3 * 33]); o.z = pk2(s[4 * 33], s[5 * 33]); o.w = pk2(s[6 * 33], s[7 * 33]);
        *(u32x4*)(WT + (size_t)(g0 + n) * K + k0 + 8 * c) = o; }
    asm volatile("s_waitcnt lgkmcnt(0)" ::: "memory");
}
constexpr int IT_WIN = (D / 64) * (NIN / 32), IT_WB = (W / 64) * (D / 32), IT_WO = (D / 64) * (D / 32);
constexpr int IT_PW = (128 / 64) * (128 / 32);
constexpr int IT_WADA = (D / 64) * (3072 / 32);
constexpr int IT_TOTAL = DEPTH * IT_WIN + DEPTH * 3 * IT_WB + DEPTH * IT_WO + DEPTH * 4 * IT_PW + DEPTH * IT_WADA;
DEV void ph_convert(const Args& a, unsigned char* lds, const int stage, const int b0) {
    LAUNDER_CTX(a);
    float* scr = (float*)(lds + c.wave * 16384);
    const int nb = (int)gridDim.x - b0, bw = ((int)blockIdx.x - b0) * NWAVES + c.wave, nw = nb * NWAVES, bt = ((int)blockIdx.x - b0) * NTHREADS + c.tid, nthr = nb * NTHREADS;
    if ((int)blockIdx.x < b0) return;
    if (stage == 0) {
        for (int r = bw; r < DEPTH * IT_WADA; r += nw) { const int l = r / IT_WADA; transpose_item(c.w_ada + (size_t)l * D * 3072, 3072, D, c.WadaT + (size_t)l * 3072 * D, 3072 / 32, r - l * IT_WADA, scr, c.lane, MapPerm()); }
        for (int idx = bt; idx < 256 * D / 4; idx += nthr) { const int n = idx >> 8, k4 = (idx & 255) * 4; f32x4 v = (f32x4){0.f, 0.f, 0.f, 0.f};
            if (n < NBT) { v = *(const f32x4*)((n < NBP ? c.c_prompt + (size_t)n * D : c.c_sample + (size_t)(n - NBP) * D) + k4); v = silu4(v); }
            *((u32x2*)c.scb + idx) = (u32x2){pk2(v.x, v.y), pk2(v.z, v.w)}; }
        return;
    }
    for (int it = bw; it < IT_TOTAL - DEPTH * IT_WADA; it += nw) {
        int r = it;
        if (r < DEPTH * IT_WIN) { const int l = r / IT_WIN; r -= l * IT_WIN; transpose_item(c.w_in + (size_t)l * D * NIN, NIN, D, c.WinT + (size_t)l * NIN * D, NIN / 32, r, scr, c.lane, MapWin()); continue; }
        r -= DEPTH * IT_WIN;
        if (r < DEPTH * 3 * IT_WB) { const int li = r / IT_WB; r -= li * IT_WB; transpose_item(c.w_branch + (size_t)li * W * D, D, W, c.WbT + (size_t)li * D * W, D / 32, r, scr, c.lane, MapPerm()); continue; }
        r -= DEPTH * 3 * IT_WB;
        if (r < DEPTH * IT_WO) { const int l = r / IT_WO; r -= l * IT_WO; transpose_item(c.w_out + (size_t)l * D * D, D, D, c.WoT + (size_t)l * D * D, D / 32, r, scr, c.lane, MapPerm()); continue; }
        r -= DEPTH * IT_WO;
        { const int lg = r / IT_PW; r -= lg * IT_PW; transpose_item(c.pool_w + (size_t)lg * 128 * 128, 128, 128, c.PoolWT + (size_t)lg * 128 * 128, 4, r, scr, c.lane, MapPerm()); }
    }
    for (int idx = bt; idx < DEPTH * 8 * 128 * 128 / 4; idx += nthr) { const int s4 = (idx & 31) * 4, t = (idx >> 5) & 127; const f32x4 v = *((const f32x4*)c.sgu_w + idx);
        *((u32x2*)c.SguW + idx) = (u32x2){pk2(s4 <= t ? v.x : 0.f, s4 + 1 <= t ? v.y : 0.f), pk2(s4 + 2 <= t ? v.z : 0.f, s4 + 3 <= t ? v.w : 0.f)}; }
}
DEV void ph_xa0(const Args& a) {
    LAUNDER_CTX(a);
    const int lane = c.lane, NSW = DEPTH * 30;
    if ((int)gridDim.x <= NSW || (int)blockIdx.x < NSW) { if ((int)gridDim.x > NSW) return; }
    const int w0 = ((int)gridDim.x > NSW) ? ((int)blockIdx.x - NSW) * NWAVES + c.wave : c.gw, nw = ((int)gridDim.x > NSW) ? ((int)gridDim.x - NSW) * NWAVES : c.NGW;
    for (int row = MV + w0; row < MP; row += nw) { u32x2* xo = (u32x2*)(c.xa + (size_t)row * D) + lane;
#pragma unroll
        for (int j = 0; j < 4; ++j) { xo[64 * j] = (u32x2){0u, 0u}; ((u32x2*)(c.xa2 + (size_t)row * D) + lane)[64 * j] = (u32x2){0u, 0u}; }
        if (lane < 16) c.ssq[row * 16 + lane] = 0.f; }
#pragma unroll 2
    for (int row = w0; row < MV; row += nw) {
        u32x2* xo = (u32x2*)(c.xa + (size_t)row * D) + lane;
        const float* xr = row < MPR ? c.x_prompt + (size_t)row * D : c.x_sample + (size_t)(row - MPR) * D;
        const float* ar = c.atab + (size_t)nidx_of(row) * D;
#pragma unroll
        for (int j = 0; j < 4; ++j) {
            const f32x4 v = *((const f32x4*)xr + lane + 64 * j), at = *((const f32x4*)ar + lane + 64 * j);
            xo[64 * j] = (u32x2){pk2(v.x * at.x, v.y * at.y), pk2(v.z * at.z, v.w * at.w)};
            float s = (v.x * v.x + v.y * v.y) + (v.z * v.z + v.w * v.w);
            s += __shfl_xor(s, 1); s += __shfl_xor(s, 2); s += __shfl_xor(s, 4); s += __shfl_xor(s, 32);
            if ((lane & 39) == 0) c.ssq[row * 16 + 4 * j + (lane >> 3)] = s;
        }
    }
}
DEV float row_rstd(const float* ssq, int row) {
    const f32x4* p = (const f32x4*)(ssq + (size_t)row * 16); const f32x4 a = p[0], b = p[1], c = p[2], d = p[3];
    const float s = ((a.x + a.y) + (a.z + a.w)) + ((b.x + b.y) + (b.z + b.w)) + ((c.x + c.y) + (c.z + c.w)) + ((d.x + d.y) + (d.z + d.w));
    return __builtin_amdgcn_rsqf(s * (1.f / D) + EPS);
}

DEV void store8(bf16_t* p, f32x4 a, f32x4 b) { u32x4 w; w.x = pk2(a.x, a.y); w.y = pk2(a.z, a.w); w.z = pk2(b.x, b.y); w.w = pk2(b.z, b.w); *(u32x4*)p = w; }

#define LAS __attribute__((address_space(3)))
constexpr int BK = 64, HALF = 128, HTB = HALF * BK * 2, STAGE_BYTES = 8 * HTB;
DEV int lds_byte(int r, int c) { const int st = (r >> 4) * 2 + (c >> 5), rr = r & 15, cc = c & 31, ob = rr * 64 + cc * 2; return st * 1024 + (ob ^ (((ob >> 9) & 1) << 5)); }
DEV void stage_rc(int b, int& R, int& C) { const int st = b / 1024, sb = b % 1024, swz = sb ^ (((sb >> 9) & 1) << 5); R = (st >> 1) * 16 + swz / 64; C = (st & 1) * 32 + (swz % 64) / 2; }
struct UnitD { const char* A; const char* B; int pm, pn, aux; };
constexpr int NXCD = 8;
constexpr int WGM_P1 = 4, WGM_P3 = 4, WGM_P4 = 8;
struct TileOrder {
    int nM, nN, nwg, G, c, pm0;
    DEV void init(int nM_, int nN_, int G_, int c_, int pm0_) { nM = nM_; nN = nN_; nwg = nM * nN; G = G_; c = c_; pm0 = pm0_; }
    template <int WGM> DEV bool tile(int i, int& pm, int& pn) const {
        const int wgid = i * G + c; if (wgid >= nwg) return false;
        const int nig = WGM * nN, gid = wgid / nig, fm = gid * WGM, gsz = (nM - fm) < WGM ? (nM - fm) : WGM;
        pm = pm0 + fm + ((wgid % nig) % gsz); pn = (wgid % nig) / gsz; return true;
    }
};
template <class Epi, class Sched, int NBH = 2>
DEV void gemm_phase(LAS unsigned char* lds, const int lda  , const int ldb  , const int nt  , const Sched& S, const Epi& E) {
    int tid = threadIdx.x; asm volatile("" : "+v"(tid));
    const int wid = __builtin_amdgcn_readfirstlane(tid >> 6), lane = tid & 63, wr = wid >> 2, wc = wid & 3, fr = lane & 15, fq = lane >> 4;
    unsigned voffA[2], voffB[2];
#pragma unroll
    for (int i = 0; i < 2; ++i) { int R, C; stage_rc(tid * 16 + i * 8192, R, C); voffA[i] = (unsigned)(R * lda + C * 2); voffB[i] = (unsigned)(R * ldb + C * 2); }
    const size_t kstep = (size_t)(BK * 2);
    const size_t hstepA = (size_t)HALF * lda, hstepB = (size_t)HALF * ldb;
    const unsigned ldsw = (unsigned)wid * 1024u;
    const int aoff = lds_byte(wr * 64 + fr, fq * 8), boff = lds_byte(wc * 32 + fr, fq * 8);
#define PG8_SA(b, h) (((b) * 2 + (h)) * HTB)
#define PG8_SB(b, h) ((4 + (b) * 2 + (h)) * HTB)
#define PG8_STAGE(bufoff, gbase, voff) do { _Pragma("unroll") for (int _i = 0; _i < 2; ++_i) \
        __builtin_amdgcn_global_load_lds((const unsigned*)((const char*)(gbase) + (voff)[_i]), (LAS unsigned*)(lds + (bufoff) + ldsw + _i * 8192), 16, 0, 0); } while (0)
#define PG8_LDA(dst, b, h) do { _Pragma("unroll") for (int m = 0; m < 4; ++m) _Pragma("unroll") for (int k = 0; k < 2; ++k) dst[m][k] = *(const LAS bf16x8*)(lds + PG8_SA(b, h) + aoff + m * 2048 + k * 1024); } while (0)
#define PG8_LDB(dst, b, h) do { _Pragma("unroll") for (int n = 0; n < 2; ++n) _Pragma("unroll") for (int k = 0; k < 2; ++k) dst[n][k] = *(const LAS bf16x8*)(lds + PG8_SB(b, h) + boff + n * 2048 + k * 1024); } while (0)
#define PG8_MMA(ai, bj, At, Bt) do { __builtin_amdgcn_s_setprio(1); _Pragma("unroll") for (int m = 0; m < 4; ++m) _Pragma("unroll") for (int n = 0; n < 2; ++n) _Pragma("unroll") for (int k = 0; k < 2; ++k) \
        acc[ai][bj][m][n] = __builtin_amdgcn_mfma_f32_16x16x32_bf16(Bt[n][k], At[m][k], acc[ai][bj][m][n], 0, 0, 0); __builtin_amdgcn_s_setprio(0); } while (0)
#define PG8_WAIT_V(n) asm volatile("s_waitcnt vmcnt(" #n ")" ::: "memory")
#define PG8_WAIT_VN() do { if constexpr (NBH == 2) PG8_WAIT_V(8); else PG8_WAIT_V(6); } while (0)
#define PG8_WAIT_L(n) asm volatile("s_waitcnt lgkmcnt(" #n ")" ::: "memory")
#define PG8_BAR __builtin_amdgcn_s_barrier()
#define PG8_SCHED __builtin_amdgcn_sched_barrier(0)
    UnitD cur, nxt; int ui = 0;
    if (!S.next(0, cur)) return;
    f32x4 acc[2][NBH][4][2];
#pragma unroll
    for (int a = 0; a < 2; ++a)
#pragma unroll
        for (int b = 0; b < NBH; ++b)
#pragma unroll
            for (int m = 0; m < 4; ++m)
#pragma unroll
                for (int n = 0; n < 2; ++n) acc[a][b][m][n] = (f32x4){0.f, 0.f, 0.f, 0.f};
    bf16x8 At[4][2], B0[2][2], B1[2][2];
    const char* cA = cur.A; const char* cB = cur.B;
    PG8_STAGE(PG8_SB(0, 0), cB, voffB); if constexpr (NBH == 2) PG8_STAGE(PG8_SB(0, 1), cB + hstepB, voffB); PG8_STAGE(PG8_SA(0, 0), cA, voffA); PG8_STAGE(PG8_SA(0, 1), cA + hstepA, voffA);
    if (wr == 1) PG8_BAR;
    PG8_WAIT_V(2); PG8_BAR;
    PG8_STAGE(PG8_SB(1, 0), cB + kstep, voffB); PG8_STAGE(PG8_SA(1, 0), cA + kstep, voffA); if constexpr (NBH == 2) PG8_STAGE(PG8_SB(1, 1), cB + hstepB + kstep, voffB);
    if constexpr (NBH == 2) PG8_WAIT_V(6); else PG8_WAIT_V(4);
    PG8_BAR;
    for (;;) {
        const bool has_next = S.next(ui + 1, nxt);
        const char* nA = has_next ? nxt.A : cA; const char* nB = has_next ? nxt.B : cB;
        for (int t = 0; t < nt; t += 2) {
            const bool last = (t == nt - 2);
            const char* a1 = cA + (size_t)(t + 1) * kstep;
            const char* a2 = last ? nA : cA + (size_t)(t + 2) * kstep; const char* b2 = last ? nB : cB + (size_t)(t + 2) * kstep;
            const char* a3 = a2 + kstep; const char* b3 = b2 + kstep;
            PG8_LDB(B0, 0, 0); if constexpr (NBH == 2) PG8_LDB(B1, 0, 1); PG8_SCHED; PG8_LDA(At, 0, 0); PG8_STAGE(PG8_SA(1, 1), a1 + hstepA, voffA);
            PG8_WAIT_VN(); PG8_WAIT_L(0); PG8_BAR; PG8_MMA(0, 0, At, B0); if constexpr (NBH == 2) PG8_MMA(0, 1, At, B1); PG8_BAR; PG8_SCHED;
            PG8_LDA(At, 0, 1); PG8_STAGE(PG8_SB(0, 0), b2, voffB); if constexpr (NBH == 2) PG8_STAGE(PG8_SB(0, 1), b2 + hstepB, voffB); PG8_STAGE(PG8_SA(0, 0), a2, voffA);
            PG8_WAIT_VN(); PG8_WAIT_L(0); PG8_BAR; PG8_MMA(1, 0, At, B0); if constexpr (NBH == 2) PG8_MMA(1, 1, At, B1); PG8_BAR; PG8_SCHED;
            PG8_LDB(B0, 1, 0); if constexpr (NBH == 2) PG8_LDB(B1, 1, 1); PG8_SCHED; PG8_LDA(At, 1, 0); PG8_STAGE(PG8_SA(0, 1), a2 + hstepA, voffA);
            PG8_WAIT_VN(); PG8_WAIT_L(0); PG8_BAR; PG8_MMA(0, 0, At, B0); if constexpr (NBH == 2) PG8_MMA(0, 1, At, B1); PG8_BAR; PG8_SCHED;
            PG8_LDA(At, 1, 1); PG8_STAGE(PG8_SB(1, 0), b3, voffB); if constexpr (NBH == 2) PG8_STAGE(PG8_SB(1, 1), b3 + hstepB, voffB); PG8_STAGE(PG8_SA(1, 0), a3, voffA);
            PG8_WAIT_VN(); PG8_WAIT_L(0); PG8_BAR; PG8_MMA(1, 0, At, B0); if constexpr (NBH == 2) PG8_MMA(1, 1, At, B1); PG8_BAR; PG8_SCHED;
        }
        if (wr == 0) PG8_BAR;
        E(acc, cur, nxt, has_next, wr, wc, fr, fq);
        if (!has_next) break;
#pragma unroll
        for (int a = 0; a < 2; ++a)
#pragma unroll
            for (int b = 0; b < NBH; ++b)
#pragma unroll
                for (int m = 0; m < 4; ++m)
#pragma unroll
                    for (int n = 0; n < 2; ++n) acc[a][b][m][n] = (f32x4){0.f, 0.f, 0.f, 0.f};
        cur = nxt; cA = nA; cB = nB; ++ui;
        if (wr == 1) PG8_BAR;
    }
    PG8_WAIT_V(0);
    PG8_BAR;
#undef PG8_SA
#undef PG8_SB
#undef PG8_STAGE
#undef PG8_LDA
#undef PG8_LDB
#undef PG8_MMA
#undef PG8_WAIT_V
#undef PG8_WAIT_L
#undef PG8_WAIT_VN
#undef PG8_BAR
#undef PG8_SCHED
}


struct SchedMod { int G, c; const char* A; const char* B;
    DEV bool next(int i, UnitD& u) const { const int idx = i * G + c; if (idx >= 48) return false; u.pm = 0; u.pn = idx; u.aux = 0; u.A = A; u.B = B + (size_t)idx * 256 * (D * 2); return true; } };
struct EpiMod { float* mod; float* atab; bf16_t* shb; const float* b_ada; const float* norm_g;
    DEV void operator()(int pn, int row, int wc, int fq, f32x4 (&v)[2][2]) const {
#pragma unroll
        for (int bj = 0; bj < 2; ++bj) { const int gc = 256 * pn + 128 * bj + 32 * wc + 8 * fq, l = gc / 3072, j3 = gc - l * 3072;
            const f32x4 v0 = v[bj][0] + *(const f32x4*)(b_ada + gc), v1 = v[bj][1] + *(const f32x4*)(b_ada + gc + 4);
            if (row < NBT) { float* o = mod + ((size_t)l * NBT + row) * 3072 + j3; *(f32x4*)o = v0; *(f32x4*)(o + 4) = v1; }
            if (j3 < D) { const f32x4 z = (f32x4){0.f, 0.f, 0.f, 0.f}; store8(shb + ((size_t)l * 256 + row) * D + j3, row < NBT ? v0 : z, row < NBT ? v1 : z); }
            else if (j3 < 2 * D && row < NBT) { const float* ng = norm_g + l * D + (j3 - D); float* o = atab + ((size_t)l * NBT + row) * D + (j3 - D);
                f32x4 a0 = *(const f32x4*)ng * (v0 + 1.f), a1 = *(const f32x4*)(ng + 4) * (v1 + 1.f);
#pragma unroll
                for (int j = 0; j < 4; ++j) { a0[j] = __builtin_fabsf(a0[j]) < 1e-20f ? 1e-20f : a0[j]; a1[j] = __builtin_fabsf(a1[j]) < 1e-20f ? 1e-20f : a1[j]; }
                *(f32x4*)o = a0; *(f32x4*)(o + 4) = a1; }
        }
    } };
template <int NSEG, int KS  , class RowEpi>
DEV void mini_gemm(const Args& a, LAS unsigned char* lds, int u, const bf16_t* A, int lda, int a_seg, const bf16_t* Bt, int ldb, size_t b_seg, const RowEpi& e) {
    LAUNDER_CTX(a);
    const int lane = c.lane, w = c.wave, fr = lane & 15, fq = lane >> 4, rb = u & 7, pn = u >> 5, wc = (u >> 3) & 3, row = MPR + 16 * rb + fr, kw = 32 * KS;
    bf16x8 af[NSEG][KS], bf[NSEG][KS][4];
#pragma unroll
    for (int s = 0; s < NSEG; ++s) { const bf16_t* ap = A + (size_t)row * lda + s * a_seg + w * kw + 8 * fq; const bf16_t* bp = Bt + s * b_seg + (size_t)(256 * pn + 32 * wc + fr) * ldb + w * kw + 8 * fq;
#pragma unroll
        for (int k = 0; k < KS; ++k) { af[s][k] = *(const bf16x8*)(ap + 32 * k);
#pragma unroll
            for (int q = 0; q < 4; ++q) bf[s][k][q] = *(const bf16x8*)(bp + (size_t)(128 * (q >> 1) + 16 * (q & 1)) * ldb + 32 * k); } }
    f32x4 acc[NSEG][4];
#pragma unroll
    for (int s = 0; s < NSEG; ++s) {
#pragma unroll
        for (int q = 0; q < 4; ++q) acc[s][q] = (f32x4){0.f, 0.f, 0.f, 0.f};
#pragma unroll
        for (int k = 0; k < KS; ++k)
#pragma unroll
            for (int q = 0; q < 4; ++q) acc[s][q] = __builtin_amdgcn_mfma_f32_16x16x32_bf16(bf[s][k][q], af[s][k], acc[s][q], 0, 0, 0);
    }
#pragma unroll
    for (int s = 0; s < NSEG; ++s)
#pragma unroll
        for (int q = 0; q < 4; ++q) *(LAS f32x4*)(lds + (((w * NSEG + s) * 4 + q) * 64 + lane) * 16) = acc[s][q];
    __syncthreads();
    if (w == 0) {
        f32x4 v[NSEG][2][2];
#pragma unroll
        for (int s = 0; s < NSEG; ++s)
#pragma unroll
            for (int q = 0; q < 4; ++q) { f32x4 t = *(const LAS f32x4*)(lds + (((0 * NSEG + s) * 4 + q) * 64 + lane) * 16);
#pragma unroll
                for (int ww = 1; ww < 8; ++ww) t += *(const LAS f32x4*)(lds + (((ww * NSEG + s) * 4 + q) * 64 + lane) * 16);
                v[s][q >> 1][q & 1] = t; }
        e(pn, row, wc, fq, v);
    }
    __syncthreads();
}

constexpr int RTAB_OFF = STAGE_BYTES;
constexpr int SWT_OFF = RTAB_OFF + 8192;
template <int TY, bool SMP> DEV void p1_rows(const f32x4 (&acc)[2][2][4][2], bf16_t* pb  , const LAS float* rt, const float* swb, const int row0, f32x4 s00, f32x4 s01, f32x4 s10, f32x4 s11, float* st = nullptr  ) {
    f32x4 n00 = s00, n01 = s01, n10 = s10, n11 = s11;
    if (SMP) { const float* sw = swb + (size_t)nidx_of(row0) * NIN; n00 = *(const f32x4*)(sw); n01 = *(const f32x4*)(sw + 4); n10 = *(const f32x4*)(sw + 128); n11 = *(const f32x4*)(sw + 132); }
#pragma unroll
    for (int ai = 0; ai < 2; ++ai) {
#pragma unroll
        for (int m = 0; m < 4; ++m) { const int rl = ai * HALF + m * 16; const float r = rt[rl];
            if (SMP) { s00 = n00; s01 = n01; s10 = n10; s11 = n11;
                if (ai * 4 + m < 7) { const int rn = ((ai * 4 + m + 1) >> 2) * HALF + ((ai * 4 + m + 1) & 3) * 16; const float* sw = swb + (size_t)nidx_of(row0 + rn) * NIN; n00 = *(const f32x4*)(sw); n01 = *(const f32x4*)(sw + 4); n10 = *(const f32x4*)(sw + 128); n11 = *(const f32x4*)(sw + 132); } }
            f32x4 a0 = acc[ai][0][m][0] * r + s00, a1 = acc[ai][0][m][1] * r + s01, b0 = acc[ai][1][m][0] * r + s10, b1 = acc[ai][1][m][1] * r + s11;
            bf16_t* pr = pb + (size_t)rl * PC;
            if (TY == 0) { store8(pr, a0 * b0, a1 * b1); }
            else if (TY == 1) { store8(pr, a0 * silu4(b0), a1 * silu4(b1)); }
            else if (TY == 2) { store8(pr, gelu4(a0) * silu4(b0), gelu4(a1) * silu4(b1)); }
            else {
                if (TY == 3) { a0 = gelu4(a0); a1 = gelu4(a1); b0 = gelu4(b0); b1 = gelu4(b1); }
                if (TY == 3) {
                    const f32x4 sv = (a0 + a1) + (b0 + b1), qv = (a0 * a0 + a1 * a1) + (b0 * b0 + b1 * b1);
                    float s = (sv.x + sv.y) + (sv.z + sv.w), q = (qv.x + qv.y) + (qv.z + qv.w);
                    s += __shfl_xor(s, 16); q += __shfl_xor(q, 16); s += __shfl_xor(s, 32); q += __shfl_xor(q, 32);
                    if (st) *(f32x2_t*)(st + (size_t)rl * 16) = (f32x2_t){s, q}; }
                if (TY == 5) { a0 = silu4(a0); a1 = silu4(a1); b0 = silu4(b0); b1 = silu4(b1); }
                if (TY == 6) { a0 = sigmoid4(a0); a1 = sigmoid4(a1); b0 = sigmoid4(b0); b1 = sigmoid4(b1); }
                if (TY == 6) { unsigned char* gq = (unsigned char*)pr; *(u32x2*)gq = (u32x2){pku8(a0), pku8(a1)}; *(u32x2*)(gq + 128) = (u32x2){pku8(b0), pku8(b1)}; }
                else { store8(pr, a0, a1); store8(pr + 128, b0, b1); } }
        }
        if (!SMP) asm volatile("" ::: "memory");
    }
}
struct EpiP1T { bf16_t* pbuf; const float* SWl; const LAS float* rtab; const LAS float* swt; float* lnst;
    DEV void operator()(f32x4 (&acc)[2][2][4][2], const UnitD& u, const UnitD& un, const bool has_next, int wr, int wc, int fr, int fq) const {
        const int pn = u.pn, cb = 32 * wc + 8 * fq, row0 = u.pm * 256 + wr * 64 + fr; const bool smp = u.pm >= MPR / 256;
        const float* swb = SWl + 256 * pn + cb; const LAS float* sw = swt + u.aux * 256 + cb;
        const f32x4 s00 = *(const LAS f32x4*)(sw), s01 = *(const LAS f32x4*)(sw + 4), s10 = *(const LAS f32x4*)(sw + 128), s11 = *(const LAS f32x4*)(sw + 132);
        const LAS float* rt = rtab + u.aux * 256 + wr * 64 + fr;
        bf16_t* pb = pbuf + (size_t)row0 * PC + cb;
#define P1_DISPATCH(SM) \
        if (pn < 4) p1_rows<0, SM>(acc, pb + PZ + 128 * pn, rt, swb, row0, s00, s01, s10, s11); \
        else if (pn < 8) p1_rows<1, SM>(acc, pb + PABG + 128 * (pn - 4), rt, swb, row0, s00, s01, s10, s11); \
        else if (pn < 12) p1_rows<2, SM>(acc, pb + PUG + 128 * (pn - 8), rt, swb, row0, s00, s01, s10, s11); \
        else if (pn < 14) p1_rows<3, SM>(acc, pb + PGV + 256 * (pn - 12), rt, swb, row0, s00, s01, s10, s11, fq == 0 ? lnst + (size_t)row0 * 16 + 2 * (4 * (pn - 12) + wc) : nullptr); \
        else if (pn < 16) p1_rows<4, SM>(acc, pb + PCX + 256 * (pn - 14), rt, swb, row0, s00, s01, s10, s11); \
        else if (pn < 18) p1_rows<5, SM>(acc, pb + PSG + 256 * (pn - 16), rt, swb, row0, s00, s01, s10, s11); \
        else p1_rows<6, SM>(acc, (bf16_t*)((unsigned char*)(pb - cb + PGATE) + 256 * (pn - 18) + cb), rt, swb, row0, s00, s01, s10, s11);
        if (smp) { P1_DISPATCH(true) } else { P1_DISPATCH(false) }
#undef P1_DISPATCH
    } };
struct EpiP1S { bf16_t* pbuf; const float* SWl; const float* ssq;
    DEV void operator()(int pn, int row, int wc, int fq, f32x4 (&v)[1][2][2]) const {
        const int cb = 32 * wc + 8 * fq; const float r = row_rstd(ssq, row);
        const float* sw = SWl + (size_t)nidx_of(row) * NIN + 256 * pn + cb;
        const f32x4 a0 = v[0][0][0] * r + *(const f32x4*)(sw), a1 = v[0][0][1] * r + *(const f32x4*)(sw + 4), b0 = v[0][1][0] * r + *(const f32x4*)(sw + 128), b1 = v[0][1][1] * r + *(const f32x4*)(sw + 132);
        bf16_t* pr = pbuf + (size_t)row * PC + cb;
        if (pn < 4) store8(pr + PZ + 128 * pn, a0 * b0, a1 * b1);
        else if (pn < 8) store8(pr + PABG + 128 * (pn - 4), a0 * silu4(b0), a1 * silu4(b1));
        else if (pn < 12) store8(pr + PUG + 128 * (pn - 8), gelu4(a0) * silu4(b0), gelu4(a1) * silu4(b1));
        else if (pn < 14) { bf16_t* o = pr + PGV + 256 * (pn - 12); store8(o, gelu4(a0), gelu4(a1)); store8(o + 128, gelu4(b0), gelu4(b1)); }
        else if (pn < 16) { bf16_t* o = pr + PCX + 256 * (pn - 14); store8(o, a0, a1); store8(o + 128, b0, b1); }
        else if (pn < 18) { bf16_t* o = pr + PSG + 256 * (pn - 16); store8(o, silu4(a0), silu4(a1)); store8(o + 128, silu4(b0), silu4(b1)); }
        else { unsigned char* gq = (unsigned char*)(pbuf + (size_t)row * PC + PGATE) + 256 * (pn - 18) + cb;
            *(u32x2*)gq = (u32x2){pku8(sigmoid4(a0)), pku8(sigmoid4(a1))}; *(u32x2*)(gq + 128) = (u32x2){pku8(sigmoid4(b0)), pku8(sigmoid4(b1))}; }
    } };
DEV void p1_sample_slice(const int tid, const int vx, const int slice  , const bf16_t* xa, const bf16_t* Wl, const EpiP1S& e) {
    const int lane = tid & 63, fr = lane & 15, fq = lane >> 4, pn = slice >> 2, wc = slice & 3, row = MPR + 16 * vx + fr;
    const bf16_t* ap = xa + (size_t)row * D + 8 * fq; const bf16_t* bp = Wl + (size_t)(256 * pn + 32 * wc + fr) * D + 8 * fq;
    f32x4 v[1][2][2];
#pragma unroll
    for (int q = 0; q < 4; ++q) v[0][q >> 1][q & 1] = (f32x4){0.f, 0.f, 0.f, 0.f};
    bf16x8 af[2][4], bf[2][4][4];
#pragma unroll
    for (int k = 0; k < 4; ++k) { af[0][k] = *(const bf16x8*)(ap + 32 * k);
#pragma unroll
        for (int q = 0; q < 4; ++q) bf[0][k][q] = *(const bf16x8*)(bp + (size_t)(128 * (q >> 1) + 16 * (q & 1)) * D + 32 * k); }
#pragma unroll
    for (int kb = 0; kb < 8; ++kb) {
        if (kb + 1 < 8) {
#pragma unroll
            for (int k = 0; k < 4; ++k) { af[(kb + 1) & 1][k] = *(const bf16x8*)(ap + 128 * (kb + 1) + 32 * k);
#pragma unroll
                for (int q = 0; q < 4; ++q) bf[(kb + 1) & 1][k][q] = *(const bf16x8*)(bp + (size_t)(128 * (q >> 1) + 16 * (q & 1)) * D + 128 * (kb + 1) + 32 * k); } }
#pragma unroll
        for (int k = 0; k < 4; ++k)
#pragma unroll
            for (int q = 0; q < 4; ++q) v[0][q >> 1][q & 1] = __builtin_amdgcn_mfma_f32_16x16x32_bf16(bf[kb & 1][k][q], af[kb & 1][k], v[0][q >> 1][q & 1], 0, 0, 0);
    }
    e(pn, row, wc, fq, v);
}
template <class Sched> DEV void p1_rtab(const Sched& S, const float* ssq, const float* SWl, LAS float* rtab, LAS float* swt) {
    int t = threadIdx.x; asm volatile("" : "+v"(t));
#pragma unroll
    for (int k = 0; k < 4; ++k) { const int q = t + 512 * k, i = q >> 8, rl = q & 255; UnitD u;
        if (S.next(i, u)) { rtab[q] = row_rstd(ssq, u.pm * 256 + rl); swt[q] = SWl[(size_t)(u.pm < MPR / 256 ? (u.pm >> 3) : NBP) * NIN + 256 * u.pn + rl]; } }
    __syncthreads();
}
template <bool IN16, bool LAST> struct EpiP4T { const float* gate; const float* atab_cur; const float* atab_next; const bf16_t* xa; bf16_t* xao; float* ssq; const float* xin; bf16_t* xb;
    DEV void operator()(f32x4 (&acc)[2][2][4][2], const UnitD& u, const UnitD& un, const bool has_next, int wr, int wc, int fr, int fq) const {
        const int pn = u.pn, nb = u.pm >> 3, col = 256 * pn + 32 * wc + 8 * fq, row0 = u.pm * 256 + wr * 64 + fr;
        const float* gp = gate + (size_t)nb * 3072 + col;
        f32x4 g[2][2], at[2][2], iv[2][2];
#pragma unroll
        for (int bj = 0; bj < 2; ++bj)
#pragma unroll
            for (int n = 0; n < 2; ++n) { g[bj][n] = *(const f32x4*)(gp + 128 * bj + 4 * n);
                at[bj][n] = LAST ? (f32x4){0.f, 0.f, 0.f, 0.f} : *(const f32x4*)(atab_next + (size_t)nb * D + col + 128 * bj + 4 * n);
                iv[bj][n] = IN16 ? rcp4(*(const f32x4*)(atab_cur + (size_t)nb * D + col + 128 * bj + 4 * n)) : (f32x4){0.f, 0.f, 0.f, 0.f}; }
        const size_t off0 = (size_t)row0 * D + col;
        f32x4 x[2][2], xn[2][2]; u32x4 xh[2], xhn[2];
#pragma unroll
        for (int bj = 0; bj < 2; ++bj) { if (IN16) xh[bj] = *(const u32x4*)(xa + off0 + 128 * bj); else { x[bj][0] = *(const f32x4*)(xin + off0 + 128 * bj); x[bj][1] = *(const f32x4*)(xin + off0 + 128 * bj + 4); } }
#pragma unroll
        for (int r = 0; r < 8; ++r) { const int ai = r >> 2, m = r & 3, rl = ai * HALF + m * 16, row = row0 + rl; float s = 0.f;
            if (r < 7) { const size_t offn = off0 + (size_t)(((r + 1) >> 2) * HALF + ((r + 1) & 3) * 16) * D;
#pragma unroll
                for (int bj = 0; bj < 2; ++bj) { if (IN16) xhn[bj] = *(const u32x4*)(xa + offn + 128 * bj); else { xn[bj][0] = *(const f32x4*)(xin + offn + 128 * bj); xn[bj][1] = *(const f32x4*)(xin + offn + 128 * bj + 4); } } }
            const size_t off = off0 + (size_t)rl * D;
#pragma unroll
            for (int bj = 0; bj < 2; ++bj) {
                if (IN16) { unpk8(xh[bj], x[bj][0], x[bj][1]); x[bj][0] *= iv[bj][0]; x[bj][1] *= iv[bj][1]; }
#pragma unroll
                for (int n = 0; n < 2; ++n) { const f32x4 t = x[bj][n] + g[bj][n] * acc[ai][bj][m][n]; x[bj][n] = t; s += (t.x * t.x + t.y * t.y) + (t.z * t.z + t.w * t.w); }
                if (LAST) store8(xb + off + 128 * bj, x[bj][0], x[bj][1]);
                else store8(xao + off + 128 * bj, x[bj][0] * at[bj][0], x[bj][1] * at[bj][1]); }
            s += __shfl_xor(s, 16); s += __shfl_xor(s, 32);
            if (fq == 0) ssq[row * 16 + 4 * pn + wc] = s;
#pragma unroll
            for (int bj = 0; bj < 2; ++bj) { xh[bj] = xhn[bj]; x[bj][0] = xn[bj][0]; x[bj][1] = xn[bj][1]; }
        }
    } };

struct SchedP3R { TileOrder T; const char* A; const char* B;
    DEV bool next(int i, UnitD& u) const { int pm, pc; const int seg = i % 3; if (!T.tile<WGM_P3>(i / 3, pm, pc)) return false; u.pm = pm; u.pn = pc; u.aux = seg;
        u.A = A + (size_t)pm * 256 * (1536 * 2) + (size_t)seg * (W * 2); u.B = B + (size_t)seg * D * (W * 2) + (size_t)pc * 128 * (W * 2); return true; } };
struct EpiP3R { f32x4 (&tot)[2][4][2]; u32x2 (&gpre)[8]; const bf16_t* pbuf; bf16_t* mg;
    DEV void prefetch(const UnitD& u, int wr, int wc, int fr, int fq) const {
        const unsigned char* gp = (const unsigned char*)(pbuf + (size_t)(u.pm * 256 + wr * 64 + fr) * PC + PGATE) + 1024 * u.aux + 128 * u.pn + 32 * wc + 8 * fq;
#pragma unroll
        for (int r = 0; r < 8; ++r) gpre[r] = *(const u32x2*)(gp + (size_t)((r >> 2) * HALF + (r & 3) * 16) * (PC * 2));
    }
    DEV void operator()(f32x4 (&acc)[2][1][4][2], const UnitD& u, const UnitD& un, const bool has_next, int wr, int wc, int fr, int fq) const {
        const int seg = u.aux, cb = 128 * u.pn + 32 * wc + 8 * fq, row0 = u.pm * 256 + wr * 64 + fr;
        bf16_t* o = mg + (size_t)row0 * D + cb;
        u32x2 g[8];
#pragma unroll
        for (int r = 0; r < 8; ++r) g[r] = gpre[r];
        if (has_next) prefetch(un, wr, wc, fr, fq);
        const float keep = seg ? 1.f : 0.f;
#pragma unroll
        for (int r = 0; r < 8; ++r) { const int ai = r >> 2, m = r & 3; const f32x4 g0 = gate4(g[r].x), g1 = gate4(g[r].y);
            const f32x4 t0 = acc[ai][0][m][0] * g0 + tot[ai][m][0] * keep, t1 = acc[ai][0][m][1] * g1 + tot[ai][m][1] * keep;
            tot[ai][m][0] = t0; tot[ai][m][1] = t1;
            if (seg == 2) store8(o + (size_t)(ai * HALF + m * 16) * D, t0, t1); }
    } };
#define XB_TMO      128
#define XB_XCNT(j)  (256  + 64 * (j))
#define XB_XSUB(j)  (1280 + 64 * (j))
#define XB_XGEN(j)  (2304 + 64 * (j))
#define XB_TOP      3328
#define XB_TOPGEN   3392
#define XCD_BAR_WORDS 3456
#define XB_LSUB(j)  (3456 + 64 * (j))
#define XB_LGEN(j)  (3968 + 64 * (j))
#define XB_SPIN_CAP (1u << 18)
DEV unsigned xb_ld(unsigned* p)              { return __hip_atomic_load(p, __ATOMIC_RELAXED, __HIP_MEMORY_SCOPE_AGENT); }
DEV unsigned xb_add(unsigned* p, unsigned v) { return __hip_atomic_fetch_add(p, v, __ATOMIC_RELAXED, __HIP_MEMORY_SCOPE_AGENT); }
DEV unsigned xb_xcc_id() { return (unsigned)__builtin_amdgcn_s_getreg((3 << 11) | 20) & 0xFu; }
#define XB_SPIN(cond, bar) do { unsigned _sp = 0; while (cond) { __builtin_amdgcn_s_sleep(1); \
    if ((++_sp & 255u) == 0u) { if (xb_ld(&(bar)[XB_TMO])) break; if (_sp > XB_SPIN_CAP) { atomicAdd(&(bar)[XB_TMO], 1u); break; } } } } while (0)
struct XcdBarrier { unsigned* bar; unsigned x; volatile LAS unsigned* st; };
DEV XcdBarrier xcd_barrier_post(unsigned* bar, volatile LAS unsigned* st) {
    XcdBarrier b; b.bar = bar; b.x = xb_xcc_id(); b.st = st;
    if (threadIdx.x == 0) st[4] = xb_add(&bar[XB_XCNT(b.x)], 1u);
    return b;
}
DEV void xcd_barrier_complete(unsigned* bar, unsigned x, unsigned& nloc, unsigned& nx, unsigned& even) {
    const unsigned G = gridDim.x * gridDim.y * gridDim.z;
    unsigned sum, cnt, mine, n32, sp = 0u;
    for (;;) {
        sum = 0u; cnt = 0u; mine = 0u; n32 = 0u;
#pragma unroll
        for (unsigned j = 0; j < 16; ++j) { const unsigned c = xb_ld(&bar[XB_XCNT(j)]); sum += c; cnt += (c > 0u) ? 1u : 0u; n32 += (j < 8u && c == 32u) ? 1u : 0u; mine = (j == x) ? c : mine; }
        if (sum == G) break;
        __builtin_amdgcn_s_sleep(1);
        if ((++sp & 255u) == 0u) { if (xb_ld(&bar[XB_TMO])) break; if (sp > XB_SPIN_CAP) { atomicAdd(&bar[XB_TMO], 1u); break; } }
    }
    nloc = mine > 0u ? mine : 1u; nx = cnt > 0u ? cnt : 1u;
    even = (sum == G && G == 256u && n32 == 8u) ? 1u : 0u;
}
DEV void xcd_barrier(const XcdBarrier& b) {
    asm volatile("s_waitcnt vmcnt(0)" ::: "memory");
    __syncthreads();
    if (threadIdx.x == 0) {
        unsigned* bar = b.bar; unsigned bx = b.x; asm volatile("" : "+s"(bar), "+s"(bx));
        __builtin_amdgcn_s_waitcnt(0);
        unsigned nloc = b.st[0], nx = b.st[1];
        if (nloc == 0u) { unsigned even; xcd_barrier_complete(bar, bx, nloc, nx, even); b.st[0] = nloc; b.st[1] = nx;
            b.st[2] = even ? bx * 32u + b.st[4] : (unsigned)blockIdx.x;
            b.st[3] = even; }
        const unsigned old = xb_add(&bar[XB_XSUB(bx)], 1u);
        const unsigned gen = old / nloc;
        if (old + 1u == (gen + 1u) * nloc) {
            __builtin_amdgcn_fence(__ATOMIC_RELEASE, "agent");
            asm volatile("s_waitcnt vmcnt(0)" ::: "memory");
            const unsigned og = xb_add(&bar[XB_TOP], 1u);
            const unsigned tg = og / nx;
            if (og + 1u == (tg + 1u) * nx) xb_add(&bar[XB_TOPGEN], 1u);
            else XB_SPIN(xb_ld(&bar[XB_TOPGEN]) == tg, bar);
            __builtin_amdgcn_fence(__ATOMIC_ACQUIRE, "agent");
            xb_add(&bar[XB_XGEN(bx)], 1u);
            asm volatile("s_waitcnt vmcnt(0)" ::: "memory");
        } else {
            XB_SPIN(xb_ld(&bar[XB_XGEN(bx)]) == gen, bar);
            __builtin_amdgcn_fence(__ATOMIC_ACQUIRE, "agent");
            asm volatile("s_waitcnt vmcnt(0)" ::: "memory");
        }
    }
    __syncthreads();
}
DEV void xcd_local_barrier(const XcdBarrier& b) {
    asm volatile("s_waitcnt vmcnt(0)" ::: "memory");
    __syncthreads();
    if (threadIdx.x == 0) {
        unsigned* bar = b.bar; unsigned bx = b.x; asm volatile("" : "+s"(bar), "+s"(bx));
        __builtin_amdgcn_s_waitcnt(0);
        const unsigned old = xb_add(&bar[XB_LSUB(bx)], 1u);
        const unsigned gen = old >> 5;
        if ((old & 31u) == 31u) xb_add(&bar[XB_LGEN(bx)], 1u);
        else XB_SPIN(xb_ld(&bar[XB_LGEN(bx)]) == gen, bar);
        __builtin_amdgcn_fence(__ATOMIC_ACQUIRE, "agent");
        asm volatile("s_waitcnt vmcnt(0)" ::: "memory");
    }
    __syncthreads();
}
constexpr bool LOCAL_BAR = true;
DEV void layer_barrier(const XcdBarrier& b) { if (LOCAL_BAR && b.st[3]) xcd_local_barrier(b); else xcd_barrier(b); }
template <class RowEpi> struct EpiRows { RowEpi e;
    DEV void operator()(f32x4 (&acc)[2][2][4][2], const UnitD& u, const UnitD& un, const bool has_next, int wr, int wc, int fr, int fq) const {
#pragma unroll
        for (int ai = 0; ai < 2; ++ai)
#pragma unroll
            for (int m = 0; m < 4; ++m) { f32x4 v[2][2] = {{acc[ai][0][m][0], acc[ai][0][m][1]}, {acc[ai][1][m][0], acc[ai][1][m][1]}};
                e(u.pn, u.pm * 256 + ai * HALF + wr * 64 + m * 16 + fr, wc, fq, v); asm volatile("" ::: "memory"); }
    } };
struct SchedP1 { TileOrder T; const char* A; const char* B;
    DEV bool next(int i, UnitD& u) const { int pm, pn; if (!T.tile<WGM_P1>(i, pm, pn)) return false; pn += (T.pm0 >> 3) * 4; pn -= pn >= 30 ? 30 : 0;   u.pm = pm; u.pn = pn; u.aux = i; u.A = A + (size_t)pm * 256 * (D * 2); u.B = B + (size_t)pn * 256 * (D * 2); return true; } };

struct SchedP4 { TileOrder T; const char* A; const char* B;
    DEV bool next(int i, UnitD& u) const { int pm, pn; if (!T.tile<WGM_P4>(i, pm, pn)) return false; u.pm = pm; u.pn = pn; u.aux = 0; u.A = A + (size_t)pm * 256 * (D * 2); u.B = B + (size_t)pn * 256 * (D * 2); return true; } };
struct EpiP3 { const bf16_t* pbuf; bf16_t* mg;
    DEV void operator()(int pn, int row, int wc, int fq, f32x4 (&v)[3][2][2]) const {
        const int cb = 256 * pn + 32 * wc + 8 * fq;
        const unsigned char* gp = (const unsigned char*)(pbuf + (size_t)row * PC + PGATE) + cb; bf16_t* o = mg + (size_t)row * D + cb;
        u32x2 g[3][2];
#pragma unroll
        for (int s = 0; s < 3; ++s) { g[s][0] = *(const u32x2*)(gp + 1024 * s); g[s][1] = *(const u32x2*)(gp + 1024 * s + 128); }
#pragma unroll
        for (int bj = 0; bj < 2; ++bj) { f32x4 t0 = v[0][bj][0] * gate4(g[0][bj].x), t1 = v[0][bj][1] * gate4(g[0][bj].y);
#pragma unroll
            for (int s = 1; s < 3; ++s) { t0 += v[s][bj][0] * gate4(g[s][bj].x); t1 += v[s][bj][1] * gate4(g[s][bj].y); }
            store8(o + 128 * bj, t0, t1); }
    } };
struct SchedSW { int G, c; const char* A; const char* B;
    DEV bool next(int i, UnitD& u) const { const int idx = i * G + c; if (idx >= DEPTH * 30) return false; const int l = idx / 30, pn = idx % 30; u.pm = 0; u.pn = pn + 32 * l; u.aux = l;
        u.A = A + (size_t)l * 256 * (D * 2); u.B = B + (size_t)l * NIN * (D * 2) + (size_t)pn * 256 * (D * 2); return true; } };
struct EpiSWx { float* SW;
    DEV void operator()(int pnx, int row, int wc, int fq, f32x4 (&v)[2][2]) const {
        if (row >= NBT) return;
        const int l = pnx >> 5, pn = pnx & 31;
        float* o = SW + (size_t)l * NBT * NIN + (size_t)row * NIN + 256 * pn + 32 * wc + 8 * fq;
        *(f32x4*)(o) = v[0][0]; *(f32x4*)(o + 4) = v[0][1]; *(f32x4*)(o + 128) = v[1][0]; *(f32x4*)(o + 132) = v[1][1];
    } };
struct EpiP4 { const float* gate  ; const float* atab_cur; const float* atab_next  ; const bf16_t* xa; bf16_t* xao; float* ssq; const float* xin  ; bf16_t* xb; int in16;
    DEV void operator()(int pn, int row, int wc, int fq, f32x4 (&vv)[1][2][2]) const {
        f32x4 (&v)[2][2] = vv[0];
        const int nb = nidx_of(row), col = 256 * pn + 32 * wc + 8 * fq;
        const float* gp = gate + (size_t)nb * 3072 + col;
        float s = 0.f;
#pragma unroll
        for (int bj = 0; bj < 2; ++bj) {
            f32x4 x0, x1;
            if (in16) { unpk8(*(const u32x4*)(xa + (size_t)row * D + col + 128 * bj), x0, x1); const float* ac = atab_cur + (size_t)nb * D + col + 128 * bj; x0 *= rcp4(*(const f32x4*)ac); x1 *= rcp4(*(const f32x4*)(ac + 4)); }
            else { x0 = *(const f32x4*)(xin + (size_t)row * D + col + 128 * bj); x1 = *(const f32x4*)(xin + (size_t)row * D + col + 128 * bj + 4); }
            const f32x4 t0 = x0 + *(const f32x4*)(gp + 128 * bj) * v[bj][0], t1 = x1 + *(const f32x4*)(gp + 128 * bj + 4) * v[bj][1];
            s += ((t0.x * t0.x + t0.y * t0.y) + (t0.z * t0.z + t0.w * t0.w)) + ((t1.x * t1.x + t1.y * t1.y) + (t1.z * t1.z + t1.w * t1.w));
            if (atab_next) { const float* ap = atab_next + (size_t)nb * D + col + 128 * bj; store8(xao + (size_t)row * D + col + 128 * bj, t0 * *(const f32x4*)ap, t1 * *(const f32x4*)(ap + 4)); }
            else store8(xb + (size_t)row * D + col + 128 * bj, t0, t1);
        }
        s += __shfl_xor(s, 16); s += __shfl_xor(s, 32);
        if (fq == 0) ssq[row * 16 + 4 * pn + wc] = s;
    } };


typedef short v4i16 __attribute__((ext_vector_type(4)));
constexpr int TP = 528, VT_OFF = 0, PM_OFF = 128 * TP;
DEV f32x4 unpk4(u32x2 r) { return (f32x4){bflo(r.x), bfhi(r.x), bflo(r.y), bfhi(r.y)}; }
DEV void p2_ln(const Ctx& c, int l, int ck, int hh, const bf16_t* pb, LAS unsigned char* lds) {
    int lane_ = c.lane; asm volatile("" : "+v"(lane_));
    const int lane = lane_, w = c.wave, p = lane >> 5, ch = 256 * hh + 8 * (lane & 31); const bool lastck = (ck & 15) == 15;
    const float* st = c.lnst + ((size_t)ck * 128 + 16 * w + (lane & 15)) * 16;
    const f32x4 t0 = *(const f32x4*)st, t1 = *(const f32x4*)(st + 4), t2 = *(const f32x4*)(st + 8), t3 = *(const f32x4*)(st + 12);
    u32x4 gv[8];
#pragma unroll
    for (int k = 0; k < 8; ++k) gv[k] = *(const u32x4*)(pb + (size_t)(16 * w + 2 * k + p) * PC + PGV + ch);
    const f32x4 g0 = *(const f32x4*)(c.lnv_g + l * W + ch), g1 = *(const f32x4*)(c.lnv_g + l * W + ch + 4), b0 = *(const f32x4*)(c.lnv_b + l * W + ch), b1 = *(const f32x4*)(c.lnv_b + l * W + ch + 4);
    const float s = ((t0.x + t0.z) + (t1.x + t1.z)) + ((t2.x + t2.z) + (t3.x + t3.z)), q = ((t0.y + t0.w) + (t1.y + t1.w)) + ((t2.y + t2.w) + (t3.y + t3.w));
    const float mu_l = s * (1.f / W), rstd_l = __builtin_amdgcn_rsqf(fmaxf(q * (1.f / W) - mu_l * mu_l, 0.f) + EPS);
    float* vout = c.out + O_VP + ((size_t)(l * NBP + (ck >> 4)) * 128) * W + ch;
#pragma unroll
    for (int k = 0; k < 8; ++k) { const int t = 16 * w + 2 * k + p;
        const float mu = __shfl(mu_l, 2 * k + p), rstd = __shfl(rstd_l, 2 * k + p);
        f32x4 x0 = (f32x4){bflo(gv[k].x), bfhi(gv[k].x), bflo(gv[k].y), bfhi(gv[k].y)}, x1 = (f32x4){bflo(gv[k].z), bfhi(gv[k].z), bflo(gv[k].w), bfhi(gv[k].w)};
        x0 = (x0 - mu) * rstd * g0 + b0; x1 = (x1 - mu) * rstd * g1 + b1;
        u32x4 o; o.x = pk2(x0.x, x0.y); o.y = pk2(x0.z, x0.w); o.z = pk2(x1.x, x1.y); o.w = pk2(x1.z, x1.w);
        *(LAS u32x4*)(lds + VT_OFF + t * TP + (lane & 31) * 16) = o;
        if (lastck) { *(f32x4*)(vout + (size_t)t * W) = x0; *(f32x4*)(vout + (size_t)t * W + 4) = x1; }
    }
}
template <int HH> DEV void p2_pool(const Ctx& c, int l, int ck, const bf16_t* pb, LAS unsigned char* lds) {
    constexpr int W0 = 2 << (2 * HH), W1 = 2 * W0, H = W1 - 1, NX = H + 16;
    int lane_ = c.lane; asm volatile("" : "+v"(lane_));
    const int lane = lane_, w = c.wave, gi = lane >> 5, cpos = (ck & 15) * 128, ch = 256 * HH + 4 * lane; const bool lastck = (ck & 15) == 15;
    f32x4 x[NX];
#pragma unroll
    for (int k = 0; k < NX; ++k) { const int tt = 16 * w - H + k; const bool valid = cpos + tt >= 0; const int tc = valid ? tt : 0;
        const u32x2 r = *(const u32x2*)(pb + (ptrdiff_t)tc * PC + PCX + ch); const f32x4 v = unpk4(r); x[k] = valid ? v : (f32x4){0.f, 0.f, 0.f, 0.f}; }
    f32x4 slo = x[H];
#pragma unroll
    for (int j = 1; j < W0; ++j) slo += x[H - j];
    f32x4 shi = slo;
#pragma unroll
    for (int j = W0; j < W1; ++j) shi += x[H - j];
    float* pout = c.out + O_POOLP + ((size_t)(l * NBP + (ck >> 4)) * 15) * W + ch;
#pragma unroll
    for (int i = 0; i < 16; ++i) { const int t = 16 * w + i, pos = cpos + t, wd = gi ? W1 : W0;
        const f32x4 s = gi ? shi : slo; const float inv = __builtin_amdgcn_rcpf((float)(wd < pos + 1 ? wd : pos + 1));
        const f32x4 pm = s * inv - x[H + i];
        *(LAS u32x2*)(lds + PM_OFF + t * TP + 8 * lane) = (u32x2){pk2(pm.x, pm.y), pk2(pm.z, pm.w)};
        if (lastck && t >= 113) *(f32x4*)(pout + (size_t)(t - 113) * W) = x[H + i];
        if (i < 15) { slo += x[H + i + 1] - x[H + i + 1 - W0]; shi += x[H + i + 1] - x[H + i + 1 - W1]; }
    }
}
DEV void p2_conv(const Ctx& c, int l, int ck, int hh, const bf16_t* pb) {
    int lane_ = c.lane; asm volatile("" : "+v"(lane_));
    const int lane = lane_, w = c.wave, cpos = (ck & 15) * 128, ch = 256 * hh + 4 * lane, row0 = ck * 128; const bool lastck = (ck & 15) == 15;
    const f32x4 cb = *(const f32x4*)(c.conv_b + l * W + ch), w0 = *(const f32x4*)(c.conv_w + (l * 3 + 0) * W + ch), w1 = *(const f32x4*)(c.conv_w + (l * 3 + 1) * W + ch), w2 = *(const f32x4*)(c.conv_w + (l * 3 + 2) * W + ch);
    f32x4 z[18];
#pragma unroll
    for (int k = 0; k < 18; ++k) { const int tt = 16 * w - 2 + k; const bool valid = cpos + tt >= 0; const int tc = valid ? tt : 0;
        const f32x4 v = unpk4(*(const u32x2*)(pb + (ptrdiff_t)tc * PC + PZ + ch)); z[k] = valid ? v : (f32x4){0.f, 0.f, 0.f, 0.f}; }
    float* cout = c.out + O_CONVP + ((size_t)(l * NBP + (ck >> 4)) * 2) * W + ch;
#pragma unroll
    for (int i = 0; i < 16; ++i) { const int t = 16 * w + i;
        const f32x4 abg = unpk4(*(const u32x2*)(pb + (size_t)t * PC + PABG + ch));
        const f32x4 o = abg * (cb + w0 * z[i] + w1 * z[i + 1] + w2 * z[i + 2]);
        *(u32x2*)(c.y + (size_t)(row0 + t) * 1536 + ch) = (u32x2){pk2(o.x, o.y), pk2(o.z, o.w)};
        if (lastck && t >= 126) *(f32x4*)(cout + (size_t)(t - 126) * W) = z[i + 2];
    }
}
constexpr int TPS = 1040;
DEV void p2_sample_block(const Ctx& c, int l, int sb, LAS unsigned char* ldsw) {
    const int lane = c.lane, fr = lane & 15, fq = lane >> 4, ch = 8 * lane, h = lane >> 3, g = lane >> 4;
    {
        const int i = c.wave, n = 8 * sb + i, row = MPR + n; const bf16_t* pr = c.pbuf + (size_t)row * PC; bf16_t* yr = c.y + (size_t)row * 1536;
        const float* sc = c.state_conv + ((size_t)(l * NSM + n) * 2) * W + ch; const float* sp = c.state_pool + ((size_t)(l * NSM + n) * 15) * W + ch;
        const u32x4 qz = *(const u32x4*)(pr + PZ + ch), qa = *(const u32x4*)(pr + PABG + ch), qg = *(const u32x4*)(pr + PGV + ch), qu = *(const u32x4*)(pr + PUG + ch), qc = *(const u32x4*)(pr + PCX + ch);
        const f32x4 s00 = *(const f32x4*)(sc), s01 = *(const f32x4*)(sc + 4), s10 = *(const f32x4*)(sc + W), s11 = *(const f32x4*)(sc + W + 4);
        f32x4 st0[15], st1[15];
#pragma unroll
        for (int k = 7; k < 15; ++k) { st0[k] = *(const f32x4*)(sp + (size_t)k * W); st1[k] = *(const f32x4*)(sp + (size_t)k * W + 4); }
        const f32x4 cb0 = *(const f32x4*)(c.conv_b + l * W + ch), cb1 = *(const f32x4*)(c.conv_b + l * W + ch + 4);
        const f32x4 w0a = *(const f32x4*)(c.conv_w + (l * 3 + 0) * W + ch), w0b = *(const f32x4*)(c.conv_w + (l * 3 + 0) * W + ch + 4);
        const f32x4 w1a = *(const f32x4*)(c.conv_w + (l * 3 + 1) * W + ch), w1b = *(const f32x4*)(c.conv_w + (l * 3 + 1) * W + ch + 4);
        const f32x4 w2a = *(const f32x4*)(c.conv_w + (l * 3 + 2) * W + ch), w2b = *(const f32x4*)(c.conv_w + (l * 3 + 2) * W + ch + 4);
        const f32x4 lg0 = *(const f32x4*)(c.lnv_g + l * W + ch), lg1 = *(const f32x4*)(c.lnv_g + l * W + ch + 4), lb0 = *(const f32x4*)(c.lnv_b + l * W + ch), lb1 = *(const f32x4*)(c.lnv_b + l * W + ch + 4);
        const float w00 = c.sgu_w[(size_t)(l * 8 + h) * 128 * 128], b00 = c.sgu_b[(l * 8 + h) * 128], invw = 1.f / (float)(2 << g);
        asm volatile("" ::: "memory");
        {
            f32x4 z0, z1, a0, a1; unpk8(qz, z0, z1); unpk8(qa, a0, a1);
            const f32x4 ya = a0 * (cb0 + w0a * s00 + w1a * s10 + w2a * z0), yb = a1 * (cb1 + w0b * s01 + w1b * s11 + w2b * z1);
#pragma unroll
            for (int k = 0; k < 7; ++k) { st0[k] = *(const f32x4*)(sp + (size_t)k * W); st1[k] = *(const f32x4*)(sp + (size_t)k * W + 4); }
            store8(yr + ch, ya, yb);
            float* o = c.out + O_CONVS + ((size_t)(l * NSM + n) * 2) * W + ch;
            *(f32x4*)(o) = s10; *(f32x4*)(o + 4) = s11; *(f32x4*)(o + W) = z0; *(f32x4*)(o + W + 4) = z1;
        }
        {
            f32x4 x0, x1, u0, u1; unpk8(qg, x0, x1); unpk8(qu, u0, u1);
            float s = ((x0.x + x0.y) + (x0.z + x0.w)) + ((x1.x + x1.y) + (x1.z + x1.w));
            float q = ((x0.x * x0.x + x0.y * x0.y) + (x0.z * x0.z + x0.w * x0.w)) + ((x1.x * x1.x + x1.y * x1.y) + (x1.z * x1.z + x1.w * x1.w));
#pragma unroll
            for (int o = 1; o < 64; o <<= 1) { s += __shfl_xor(s, o); q += __shfl_xor(q, o); }
            const float mu = s * (1.f / W), var = fmaxf(q * (1.f / W) - mu * mu, 0.f), rstd = __builtin_amdgcn_rsqf(var + EPS);
            x0 = (x0 - mu) * rstd * lg0 + lb0; x1 = (x1 - mu) * rstd * lg1 + lb1;
            float* vo = c.out + O_VS + (size_t)(l * NSM + n) * W + ch; *(f32x4*)(vo) = x0; *(f32x4*)(vo + 4) = x1;
            store8(yr + 512 + ch, u0 * (x0 * w00 + b00), u1 * (x1 * w00 + b00));
        }
        {
            f32x4 c0, c1; unpk8(qc, c0, c1);
            float* po = c.out + O_POOLS + ((size_t)(l * NSM + n) * 15) * W + ch;
            f32x4 r0 = c0, r1 = c1, s2a, s2b, s4a, s4b, s8a, s8b;
#pragma unroll
            for (int k = 14; k >= 0; --k) {
                if (k >= 1) { *(f32x4*)(po + (size_t)(k - 1) * W) = st0[k]; *(f32x4*)(po + (size_t)(k - 1) * W + 4) = st1[k]; }
                r0 += st0[k]; r1 += st1[k];
                if (k == 14) { s2a = r0; s2b = r1; } if (k == 12) { s4a = r0; s4b = r1; } if (k == 8) { s8a = r0; s8b = r1; } }
            *(f32x4*)(po + (size_t)14 * W) = c0; *(f32x4*)(po + (size_t)14 * W + 4) = c1;
            const f32x4 sa = g == 0 ? s2a : g == 1 ? s4a : g == 2 ? s8a : r0, sb2 = g == 0 ? s2b : g == 1 ? s4b : g == 2 ? s8b : r1;
            const f32x4 p0 = sa * invw - c0, p1 = sb2 * invw - c1;
            u32x4 o; o.x = pk2(p0.x, p0.y); o.y = pk2(p0.z, p0.w); o.z = pk2(p1.x, p1.y); o.w = pk2(p1.z, p1.w);
            *(LAS u32x4*)(ldsw + i * TPS + 16 * lane) = o;
        }
    }
    __syncthreads();
    const int row = MPR + 8 * sb + (fr & 7); const bf16_t* pr = c.pbuf + (size_t)row * PC; bf16_t* yr = c.y + (size_t)row * 1536;
    bf16x8 bw[2][4][2]; u32x4 sgv[2]; f32x4 pbv[2][2], psv[2][2];
#pragma unroll
    for (int gi2 = 0; gi2 < 2; ++gi2) { const int gq = 2 * c.wave + gi2, g2 = gq >> 2, nq = gq & 3, cc = 128 * g2 + 32 * nq + 8 * fq;
        const bf16_t* pw = c.PoolWT + ((size_t)(l * 4 + g2) * 128 + 32 * nq + fr) * 128 + 8 * fq;
#pragma unroll
        for (int ks = 0; ks < 4; ++ks) { bw[gi2][ks][0] = *(const bf16x8*)(pw + 32 * ks); bw[gi2][ks][1] = *(const bf16x8*)(pw + 16 * 128 + 32 * ks); }
        sgv[gi2] = *(const u32x4*)(pr + PSG + cc);
        pbv[gi2][0] = *(const f32x4*)(c.pool_b + l * W + cc); pbv[gi2][1] = *(const f32x4*)(c.pool_b + l * W + cc + 4); psv[gi2][0] = *(const f32x4*)(c.pool_scale + l * W + cc); psv[gi2][1] = *(const f32x4*)(c.pool_scale + l * W + cc + 4); }
#pragma unroll
    for (int gi2 = 0; gi2 < 2; ++gi2) { const int gq = 2 * c.wave + gi2, g2 = gq >> 2, nq = gq & 3, cc = 128 * g2 + 32 * nq + 8 * fq;
        f32x4 a0 = (f32x4){0.f, 0.f, 0.f, 0.f}, a1 = (f32x4){0.f, 0.f, 0.f, 0.f};
#pragma unroll
        for (int ks = 0; ks < 4; ++ks) { const bf16x8 af = *(const LAS bf16x8*)(ldsw + fr * TPS + 2 * (128 * g2 + 32 * ks + 8 * fq));
            a0 = __builtin_amdgcn_mfma_f32_16x16x32_bf16(bw[gi2][ks][0], af, a0, 0, 0, 0); a1 = __builtin_amdgcn_mfma_f32_16x16x32_bf16(bw[gi2][ks][1], af, a1, 0, 0, 0); }
        f32x4 g0v, g1v; unpk8(sgv[gi2], g0v, g1v);
        if (fr < 8) store8(yr + 1024 + cc, (a0 + pbv[gi2][0]) * psv[gi2][0] * g0v, (a1 + pbv[gi2][1]) * psv[gi2][1] * g1v);
    }
}

DEV void p2_mm(const Ctx& c, const int l, const int ck, const int hh, const bf16_t* pb, LAS unsigned char* lds) {
    int lane_ = c.lane; asm volatile("" : "+v"(lane_));
    const int lane = lane_, w = c.wave, fr = lane & 15, fq = lane >> 4, row0 = ck * 128;
    const int hq = w >> 1, a = w & 1, h = 4 * hh + hq;
    bf16x8 wf[4][4]; u32x4 ug[4][2]; float bias[4];
    { const bf16_t* wm = c.SguW + ((size_t)(l * 8 + h) * 128) * 128;
#pragma unroll
      for (int i = 0; i < 4; ++i) { const int tb = a ? (i == 0 ? 1 : i == 1 ? 2 : i == 2 ? 5 : 6) : (i == 0 ? 0 : i == 1 ? 3 : i == 2 ? 4 : 7), t = 16 * tb + fr;
#pragma unroll
          for (int ks = 0; ks < 4; ++ks) wf[i][ks] = *(const bf16x8*)(wm + (size_t)t * 128 + 32 * ks + 8 * fq);
      } }
    __syncthreads();
#pragma unroll
    for (int i = 0; i < 4; ++i) { const int tb = a ? (i == 0 ? 1 : i == 1 ? 2 : i == 2 ? 5 : 6) : (i == 0 ? 0 : i == 1 ? 3 : i == 2 ? 4 : 7), t = 16 * tb + fr;
        bias[i] = c.sgu_b[(l * 8 + h) * 128 + t];
#pragma unroll
        for (int c2 = 0; c2 < 2; ++c2) ug[i][c2] = *(const u32x4*)(pb + (size_t)t * PC + PUG + 256 * hh + 64 * hq + 32 * c2 + 8 * fq); }
    f32x4 acc[4][4];
#pragma unroll
    for (int i = 0; i < 4; ++i)
#pragma unroll
        for (int cc = 0; cc < 4; ++cc) acc[i][cc] = (f32x4){0.f, 0.f, 0.f, 0.f};
    { const int q = fr >> 2, p = fr & 3;
#pragma unroll
      for (int ks = 0; ks < 4; ++ks) {
        bf16x8 vb[4];
#pragma unroll
        for (int cc = 0; cc < 4; ++cc) { const int col = 64 * hq + 32 * (cc >> 1) + 8 * p + 4 * (cc & 1);
            const v4i16 lo = __builtin_amdgcn_ds_read_tr16_b64_v4i16((LAS v4i16*)(lds + VT_OFF + (32 * ks + 8 * fq + q) * TP + 2 * col));
            const v4i16 hi = __builtin_amdgcn_ds_read_tr16_b64_v4i16((LAS v4i16*)(lds + VT_OFF + (32 * ks + 8 * fq + 4 + q) * TP + 2 * col));
            vb[cc] = (bf16x8){lo[0], lo[1], lo[2], lo[3], hi[0], hi[1], hi[2], hi[3]}; }
#pragma unroll
        for (int i = 0; i < 4; ++i) { const int tb = a ? (i == 0 ? 1 : i == 1 ? 2 : i == 2 ? 5 : 6) : (i == 0 ? 0 : i == 1 ? 3 : i == 2 ? 4 : 7);
            if (ks <= (tb >> 1)) {
#pragma unroll
                for (int cc = 0; cc < 4; ++cc) acc[i][cc] = __builtin_amdgcn_mfma_f32_16x16x32_bf16(vb[cc], wf[i][ks], acc[i][cc], 0, 0, 0); } }
      } }
    asm volatile("" ::: "memory");
    const int gi2 = w >> 2, nq = w & 3, chc = 256 * hh + 128 * gi2 + 32 * nq + 8 * fq;
    bf16x8 pw0[4], pw1[4]; u32x4 sgv[8];
    { const bf16_t* pw = c.PoolWT + ((size_t)(l * 4 + 2 * hh + gi2) * 128 + 32 * nq + fr) * 128 + 8 * fq;
#pragma unroll
      for (int ks = 0; ks < 4; ++ks) { pw0[ks] = *(const bf16x8*)(pw + 32 * ks); pw1[ks] = *(const bf16x8*)(pw + 16 * 128 + 32 * ks); }
#pragma unroll
      for (int m = 0; m < 8; ++m) sgv[m] = *(const u32x4*)(pb + (size_t)(16 * m + fr) * PC + PSG + chc); }
    const f32x4 pb0 = *(const f32x4*)(c.pool_b + l * W + chc), pb1 = *(const f32x4*)(c.pool_b + l * W + chc + 4), ps0 = *(const f32x4*)(c.pool_scale + l * W + chc), ps1 = *(const f32x4*)(c.pool_scale + l * W + chc + 4);
#pragma unroll
    for (int i = 0; i < 4; ++i) { const int tb = a ? (i == 0 ? 1 : i == 1 ? 2 : i == 2 ? 5 : 6) : (i == 0 ? 0 : i == 1 ? 3 : i == 2 ? 4 : 7), t = 16 * tb + fr;
#pragma unroll
        for (int c2 = 0; c2 < 2; ++c2) { f32x4 u0, u1; unpk8(ug[i][c2], u0, u1);
            store8(c.y + (size_t)(row0 + t) * 1536 + 512 + 256 * hh + 64 * hq + 32 * c2 + 8 * fq, (acc[i][2 * c2] + bias[i]) * u0, (acc[i][2 * c2 + 1] + bias[i]) * u1); } }
    f32x4 ac2[8][2];
#pragma unroll
    for (int m = 0; m < 8; ++m) { ac2[m][0] = (f32x4){0.f, 0.f, 0.f, 0.f}; ac2[m][1] = (f32x4){0.f, 0.f, 0.f, 0.f}; }
#pragma unroll
    for (int ks = 0; ks < 4; ++ks)
#pragma unroll
        for (int m = 0; m < 8; ++m) { const bf16x8 af = *(const LAS bf16x8*)(lds + PM_OFF + (16 * m + fr) * TP + 2 * (128 * gi2 + 32 * ks + 8 * fq));
            ac2[m][0] = __builtin_amdgcn_mfma_f32_16x16x32_bf16(pw0[ks], af, ac2[m][0], 0, 0, 0); ac2[m][1] = __builtin_amdgcn_mfma_f32_16x16x32_bf16(pw1[ks], af, ac2[m][1], 0, 0, 0); }
#pragma unroll
    for (int m = 0; m < 8; ++m) { f32x4 s0, s1; unpk8(sgv[m], s0, s1);
        store8(c.y + (size_t)(row0 + 16 * m + fr) * 1536 + 1024 + chc, (ac2[m][0] + pb0) * ps0 * s0, (ac2[m][1] + pb1) * ps1 * s1); }
    __syncthreads();
}
DEV void ph_p2_prompt(const Args& a, int l, LAS unsigned char* lds) {
    LAUNDER_CTX(a);
    VB_LOAD(lds);
    if (vr_ >= 30) { p2_sample_block(c, l, 2 * vx_ + (vr_ - 30), lds); __syncthreads(); }
    {
        const int ck = 16 * vx_ + (vr_ >> 1), hh = vr_ & 1; const bf16_t* pb = c.pbuf + (size_t)ck * 128 * PC;
        p2_ln(c, l, ck, hh, pb, lds);
        { if (hh) p2_pool<1>(c, l, ck, pb, lds); else p2_pool<0>(c, l, ck, pb, lds); }
        p2_conv(c, l, ck, hh, pb);
        p2_mm(c, l, ck, hh, pb, lds);
    }
}
DEV void ph_final(const Args& a, LAS unsigned char* lds) {
    LAUNDER_CTX(a); VB_LOAD(lds);
    const int lane = c.lane;
#pragma unroll 2
    for (int i = 8 * vr_ + c.wave; i < 2048 + 16; i += 256) { const int row = i < 2048 ? 2048 * vx_ + i : MPR + 16 * vx_ + (i - 2048);
        const float r = row_rstd(c.ssq, row);
#pragma unroll
        for (int j = 0; j < 2; ++j) { f32x4 x0, x1; unpk8(*((const u32x4*)(c.xb + (size_t)row * D) + lane + 64 * j), x0, x1);
            const f32x4* gp = (const f32x4*)c.final_g + 2 * lane + 128 * j; f32x4* o = (f32x4*)(c.out + (size_t)row * D) + 2 * lane + 128 * j;
            o[0] = x0 * r * gp[0]; o[1] = x1 * r * gp[1]; }
    }
}

__global__ __launch_bounds__(NTHREADS, 2) void mega_fwd(Args a) {
    extern __shared__ __attribute__((aligned(16))) unsigned char lds[];
    LAS unsigned char* ldsp = (LAS unsigned char*)lds;
    if (threadIdx.x < 16) ((LAS unsigned*)(ldsp + LDSCTL_OFF))[threadIdx.x] = 0u;
    __syncthreads();
    const XcdBarrier bar = xcd_barrier_post((unsigned*)(a.ws + WS_CTL), (volatile LAS unsigned*)(ldsp + LDSCTL_OFF));
    ph_convert(a, lds, 0, 0);
    xcd_barrier(bar);
    { LAUNDER_CTX(a); int bx_ = blockIdx.x, gx_ = gridDim.x; asm volatile("" : "+s"(bx_), "+s"(gx_)); SchedMod S{gx_, bx_, (const char*)c.scb, (const char*)c.WadaT}; EpiRows<EpiMod> E{EpiMod{c.mod, c.atab, c.shb, c.b_ada, c.norm_g}}; gemm_phase(ldsp, D * 2, D * 2, D / BK, S, E); }
    ph_convert(a, lds, 1, (int)gridDim.x > 96 ? 48 : 0);
    xcd_barrier(bar);
    { LAUNDER_CTX(a); int bx_ = blockIdx.x, gx_ = gridDim.x; asm volatile("" : "+s"(bx_), "+s"(gx_)); SchedSW S{gx_, bx_, (const char*)c.shb, (const char*)c.WinT}; EpiRows<EpiSWx> E{EpiSWx{c.SW}}; gemm_phase(ldsp, D * 2, D * 2, D / BK, S, E); }
    ph_xa0(a);
    xcd_barrier(bar);
#pragma unroll 1
    for (int l = 0; l < DEPTH; ++l) {
        { LAUNDER_CTX(a); VB_LOAD(ldsp); SchedP1 S; S.T.init(8, NIN / 256, 32, vr_, 8 * vx_); S.A = (const char*)((l & 1) ? c.xa2 : c.xa); S.B = (const char*)(c.WinT + (size_t)l * NIN * D);
          p1_rtab(S, c.ssq, c.SW + (size_t)l * NBT * NIN, (LAS float*)(ldsp + RTAB_OFF), (LAS float*)(ldsp + SWT_OFF));
          EpiP1T E{c.pbuf, c.SW + (size_t)l * NBT * NIN, (const LAS float*)(ldsp + RTAB_OFF), (const LAS float*)(ldsp + SWT_OFF), c.lnst};
          gemm_phase(ldsp, D * 2, D * 2, D / BK, S, E);
          if (vr_ >= 16) {
              const EpiP1S es{c.pbuf, c.SW + (size_t)l * NBT * NIN, c.ssq};
              const int sl = 8 * (vr_ - 16) + c.wave;
              if (sl < 120) p1_sample_slice(c.tid, vx_, sl, (l & 1) ? c.xa2 : c.xa, c.WinT + (size_t)l * NIN * D, es); } }
        layer_barrier(bar);
        ph_p2_prompt(a, l, ldsp);
        layer_barrier(bar);
        { LAUNDER_CTX(a); VB_LOAD(ldsp); const EpiP3 e3{c.pbuf, c.mg};
          if (vr_ < 16) mini_gemm<3, 2>(a, ldsp, vx_ | (vr_ << 3), c.y, 1536, W, c.WbT + (size_t)l * 3 * D * W, W, (size_t)D * W, e3);
          SchedP3R S; S.T.init(8, 8, 32, vr_, 8 * vx_); S.A = (const char*)c.y; S.B = (const char*)(c.WbT + (size_t)l * 3 * D * W);
          f32x4 tot[2][4][2];
#pragma unroll
          for (int i0 = 0; i0 < 2; ++i0)
#pragma unroll
              for (int i1 = 0; i1 < 4; ++i1) { tot[i0][i1][0] = (f32x4){0.f, 0.f, 0.f, 0.f}; tot[i0][i1][1] = (f32x4){0.f, 0.f, 0.f, 0.f}; }
          u32x2 gpre[8]; EpiP3R E{tot, gpre, c.pbuf, c.mg};
          { UnitD u0; int t_ = threadIdx.x; asm volatile("" : "+v"(t_)); const int wv = __builtin_amdgcn_readfirstlane(t_ >> 6); if (S.next(0, u0)) E.prefetch(u0, wv >> 2, wv & 3, t_ & 15, (t_ & 63) >> 4); }
          gemm_phase<EpiP3R, SchedP3R, 1>(ldsp, 1536 * 2, W * 2, W / BK, S, E); }
        layer_barrier(bar);
        { LAUNDER_CTX(a); VB_LOAD(ldsp); const float* gate = c.mod + (size_t)l * NBT * 3072 + 2048;
          const float* atc = c.atab + (size_t)l * NBT * D; const float* atn = l + 1 < DEPTH ? c.atab + (size_t)(l + 1) * NBT * D : nullptr;
          const bf16_t* xai = (l & 1) ? c.xa2 : c.xa; bf16_t* xao = (l & 1) ? c.xa : c.xa2;
          const EpiP4 e4{gate, atc, atn, xai, xao, c.ssq, c.x_sample - (size_t)MPR * D, c.xb, l > 0};
          if (vr_ < 16) mini_gemm<1, 4>(a, ldsp, vx_ | (vr_ << 3), c.mg, D, 0, c.WoT + (size_t)l * D * D, D, (size_t)0, e4);
          SchedP4 S; S.T.init(8, 4, 32, vr_, 8 * vx_); S.A = (const char*)c.mg; S.B = (const char*)(c.WoT + (size_t)l * D * D);
          if (l == 0) { EpiP4T<false, false> E{gate, atc, atn, xai, xao, c.ssq, c.x_prompt, c.xb}; gemm_phase(ldsp, D * 2, D * 2, D / BK, S, E); }
          else if (l + 1 < DEPTH) { EpiP4T<true, false> E{gate, atc, atn, xai, xao, c.ssq, c.x_prompt, c.xb}; gemm_phase(ldsp, D * 2, D * 2, D / BK, S, E); }
          else { EpiP4T<true, true> E{gate, atc, atn, xai, xao, c.ssq, c.x_prompt, c.xb}; gemm_phase(ldsp, D * 2, D * 2, D / BK, S, E); } }
        layer_barrier(bar);
    }
    ph_final(a, ldsp);
}

extern "C" void kernel_launch(void* const* d_in, const int* in_sizes, int n_in, void* d_out, int out_size, void* d_ws, size_t ws_size, hipStream_t stream) {
    static int grid_blocks = 0;
    if (grid_blocks == 0) {
        if (n_in != 22 || ws_size < WS_END) { fprintf(stderr, "kernel_launch: unexpected n_in %d or ws_size %zu < %zu\n", n_in, ws_size, (size_t)WS_END); grid_blocks = -1; return; }
        int dev = 0, cus = 0, per_cu = 0;
        (void)hipGetDevice(&dev); (void)hipDeviceGetAttribute(&cus, hipDeviceAttributeMultiprocessorCount, dev);
        if (hipFuncSetAttribute((const void*)mega_fwd, hipFuncAttributeMaxDynamicSharedMemorySize, LDS_BYTES) != hipSuccess) { fprintf(stderr, "kernel_launch: hipFuncSetAttribute failed\n"); grid_blocks = -1; return; }
        if (hipOccupancyMaxActiveBlocksPerMultiprocessor(&per_cu, (const void*)mega_fwd, NTHREADS, LDS_BYTES) != hipSuccess || per_cu < 1) { fprintf(stderr, "kernel_launch: occupancy query gave %d\n", per_cu); grid_blocks = -1; return; }
        if (cus < 256) { fprintf(stderr, "kernel_launch: this kernel is laid out for >= 256 CUs (found %d)\n", cus); grid_blocks = -1; return; }
        grid_blocks = 256;
        fprintf(stderr, "kernel_launch: cus %d per_cu %d grid %d\n", cus, per_cu, grid_blocks);
    }
    if (grid_blocks < 0) return;
    Args a{};
    for (int i = 0; i < 22; ++i) a.in[i] = (const float*)d_in[i];
    a.out = (float*)d_out; a.ws = (unsigned char*)d_ws;
    if (hipMemsetAsync((char*)d_ws + WS_CTL, 0, CTL_BYTES, stream) != hipSuccess) { fprintf(stderr, "kernel_launch: memset failed\n"); return; }
    void* args[] = {&a};
    hipError_t e = hipLaunchCooperativeKernel((const void*)mega_fwd, dim3(grid_blocks), dim3(NTHREADS), args, LDS_BYTES, stream);
    if (e != hipSuccess) fprintf(stderr, "kernel_launch: cooperative launch failed: %s (grid %d)\n", hipGetErrorString(e), grid_blocks);
}
```

```cpp
#include <hip/hip_runtime.h>
#include <cstdio>
#include <cstdint>

#define DEV __device__ __forceinline__
typedef unsigned short bf16_t;
typedef short bf16x8 __attribute__((ext_vector_type(8)));
typedef float f32x4 __attribute__((ext_vector_type(4)));
typedef unsigned u32x4 __attribute__((ext_vector_type(4)));
typedef unsigned u32x2 __attribute__((ext_vector_type(2)));

constexpr int D = 1024, TSEQ = 2048, NBP = 8, MPR = NBP * TSEQ  , NSM = 128, MV = MPR + NSM  , MP = 16640  , NBT = NBP + NSM  ;
constexpr int W = 512, NIN = 7680, PC = 4608  , DEPTH = 4;
constexpr int PZ = 0, PABG = 512, PUG = 1024, PGV = 1536, PCX = 2048, PSG = 2560, PGATE = 3072;
constexpr float EPS = 1e-6f;
constexpr size_t O_Y = 0, O_YS = 16777216, O_CONVP = 16908288, O_CONVS = 16941056, O_POOLP = 17465344, O_POOLS = 17711104, O_VP = 21643264, O_VS = 23740416;

constexpr size_t al256(size_t x) { return (x + 255) & ~(size_t)255; }
constexpr size_t WS_WIN = 0;
constexpr size_t WS_WB = al256(WS_WIN + (size_t)DEPTH * NIN * D * 2);
constexpr size_t WS_WO = al256(WS_WB + (size_t)DEPTH * 3 * D * W * 2);
constexpr size_t WS_MOD = al256(WS_WO + (size_t)DEPTH * D * D * 2);
constexpr size_t WS_ATAB = al256(WS_MOD + (size_t)DEPTH * NBT * 3 * D * 4);
constexpr size_t WS_SHB = al256(WS_ATAB + (size_t)DEPTH * NBT * D * 4);
constexpr size_t WS_SW = al256(WS_SHB + (size_t)DEPTH * 256 * D * 2);
constexpr size_t WS_XA = al256(WS_SW + (size_t)DEPTH * NBT * NIN * 4);
constexpr size_t WS_SSQ = al256(WS_XA + (size_t)MP * D * 2);
constexpr size_t WS_PBUF = al256(WS_SSQ + (size_t)MP * 16 * 4);
constexpr size_t WS_Y = al256(WS_PBUF + (size_t)MP * PC * 2);
constexpr size_t WS_MG = al256(WS_Y + (size_t)MP * 1536 * 2);
constexpr size_t WS_SGUW = al256(WS_MG + (size_t)MP * D * 2);
constexpr size_t WS_POOLW = al256(WS_SGUW + (size_t)DEPTH * 8 * 128 * 128 * 2);
constexpr size_t WS_WADA = al256(WS_POOLW + (size_t)DEPTH * 4 * 128 * 128 * 2);
constexpr size_t WS_SCB = al256(WS_WADA + (size_t)DEPTH * 3072 * D * 2);
constexpr size_t WS_XB = al256(WS_SCB + (size_t)256 * D * 2);
constexpr size_t WS_XA2 = al256(WS_XB + (size_t)MV * D * 2);
constexpr size_t WS_LNST = al256(WS_XA2 + (size_t)MP * D * 2);
constexpr size_t WS_CTL = al256(WS_LNST + (size_t)MP * 16 * 4);
constexpr size_t CTL_BYTES = 32768;
constexpr size_t WS_END = al256(WS_CTL + CTL_BYTES);

constexpr int NTHREADS = 512, NWAVES = 8;
constexpr int LDS_BYTES = 155648;
constexpr int LDSCTL_OFF = LDS_BYTES - 256;

typedef __bf16 bf16x2_t __attribute__((ext_vector_type(2)));
typedef float f32x2_t __attribute__((ext_vector_type(2)));
DEV unsigned pk2(float lo, float hi) { const f32x2_t v = {lo, hi}; const bf16x2_t b = __builtin_convertvector(v, bf16x2_t); return __builtin_bit_cast(unsigned, b); }
typedef unsigned long long u64_t;
DEV u32x2 ld_sc8(const void* p) { const u64_t v = __hip_atomic_load((const u64_t*)p, __ATOMIC_RELAXED, __HIP_MEMORY_SCOPE_AGENT); return (u32x2){(unsigned)v, (unsigned)(v >> 32)}; }
DEV u32x4 ld_sc16(const void* p) { const u32x2 a = ld_sc8(p), b = ld_sc8((const char*)p + 8); return (u32x4){a.x, a.y, b.x, b.y}; }
DEV void st_sc8(void* p, u32x2 v) { __hip_atomic_store((u64_t*)p, (u64_t)v.x | ((u64_t)v.y << 32), __ATOMIC_RELAXED, __HIP_MEMORY_SCOPE_AGENT); }
DEV void st_sc16(void* p, u32x4 v) { st_sc8(p, (u32x2){v.x, v.y}); st_sc8((char*)p + 8, (u32x2){v.z, v.w}); }
DEV void store8_sc(bf16_t* p, f32x4 a, f32x4 b) { u32x4 w; w.x = pk2(a.x, a.y); w.y = pk2(a.z, a.w); w.z = pk2(b.x, b.y); w.w = pk2(b.z, b.w); st_sc16(p, w); }
DEV float row_rstd_sc(const float* ssq, int row) {
    float s = 0.f;
#pragma unroll
    for (int i = 0; i < 8; ++i) { const u32x2 v = ld_sc8(ssq + (size_t)row * 16 + 2 * i); const unsigned lo = v.x, hi = v.y; s += __builtin_bit_cast(float, lo) + __builtin_bit_cast(float, hi); }
    return __builtin_amdgcn_rsqf(s * (1.f / D) + EPS);
}
DEV float bflo(unsigned u) { return __builtin_bit_cast(float, u << 16); }
DEV float bfhi(unsigned u) { return __builtin_bit_cast(float, u & 0xffff0000u); }
DEV void unpk8(const u32x4 u, f32x4& a, f32x4& b) { a = (f32x4){bflo(u.x), bfhi(u.x), bflo(u.y), bfhi(u.y)}; b = (f32x4){bflo(u.z), bfhi(u.z), bflo(u.w), bfhi(u.w)}; }
DEV f32x4 gate4(unsigned u) { return (f32x4){(float)(u & 0xffu), (float)((u >> 8) & 0xffu), (float)((u >> 16) & 0xffu), (float)(u >> 24)} * (1.f / 255.f); }
DEV unsigned pku8(f32x4 s) { const unsigned a = (unsigned)(s.x * 255.f + 0.5f), b = (unsigned)(s.y * 255.f + 0.5f), c = (unsigned)(s.z * 255.f + 0.5f), d = (unsigned)(s.w * 255.f + 0.5f); return a | (b << 8) | (c << 16) | (d << 24); }
DEV f32x4 exp2_4(f32x4 t) { return (f32x4){__builtin_amdgcn_exp2f(t.x), __builtin_amdgcn_exp2f(t.y), __builtin_amdgcn_exp2f(t.z), __builtin_amdgcn_exp2f(t.w)}; }
DEV f32x4 rcp4(f32x4 d) { return (f32x4){__builtin_amdgcn_rcpf(d.x), __builtin_amdgcn_rcpf(d.y), __builtin_amdgcn_rcpf(d.z), __builtin_amdgcn_rcpf(d.w)}; }
DEV f32x4 sigmoid4(f32x4 x) { return rcp4(exp2_4(x * -1.44269504f) + 1.f); }
DEV f32x4 silu4(f32x4 x) { return x * sigmoid4(x); }
DEV f32x4 gelu4(f32x4 x) { const f32x4 t = x * (x * x * (-2.f * 0.7978845608f * 0.044715f * 1.44269504f) + (-2.f * 0.7978845608f * 1.44269504f)); return x * rcp4(exp2_4(t) + 1.f); }
DEV int perm32(int rho) { const int n = rho >> 4, i = rho & 15; return 8 * (i >> 2) + 4 * n + (i & 3); }
DEV int nidx_of(int row) { return row < MPR ? (row >> 11) : (row < MV ? NBP + (row - MPR) : NBT - 1); }
DEV int src_win(int j) {
    const int pn = j >> 8, c = j & 255, bj = c >> 7, cc = c & 127;
    if (pn < 4) return (bj ? 1024 : 512) + 128 * pn + cc;
    if (pn < 8) return (bj ? 1536 : 0) + 128 * (pn - 4) + cc;
    if (pn < 12) return (bj ? 3072 : 2048) + 128 * (pn - 8) + cc;
    if (pn < 14) return 2560 + 256 * (pn - 12) + c;
    if (pn < 16) return 3584 + 256 * (pn - 14) + c;
    if (pn < 18) return 4096 + 256 * (pn - 16) + c;
    return 4608 + 256 * (pn - 18) + c;
}

struct Args { const float* in[22]; float* out; unsigned char* ws; };
struct Ctx {
    const float *x_prompt, *x_sample, *c_prompt, *c_sample, *state_conv, *state_pool, *w_ada, *b_ada, *norm_g, *w_in, *conv_w, *conv_b, *lnv_g, *lnv_b, *sgu_w, *sgu_b, *pool_w, *pool_b, *pool_scale, *w_branch, *w_out, *final_g;
    float* out; bf16_t *WinT, *WbT, *WoT; float *mod, *atab; bf16_t* shb; float* SW; bf16_t* xa; float* ssq; bf16_t *pbuf, *y, *mg; bf16_t *SguW, *PoolWT, *WadaT, *scb, *xb, *xa2; float* lnst;
    unsigned char* lds;
    int tid, lane, wave, gw, NGW, gtid, NGT;
};

DEV Ctx make_ctx(const Args& a, size_t z) {
    Ctx c;
    c.x_prompt = a.in[0] + z; c.x_sample = a.in[1] + z; c.c_prompt = a.in[2] + z; c.c_sample = a.in[3] + z; c.state_conv = a.in[4] + z; c.state_pool = a.in[5] + z; c.w_ada = a.in[6] + z; c.b_ada = a.in[7] + z;
    c.norm_g = a.in[8] + z; c.w_in = a.in[9] + z; c.conv_w = a.in[10] + z; c.conv_b = a.in[11] + z; c.lnv_g = a.in[12] + z; c.lnv_b = a.in[13] + z; c.sgu_w = a.in[14] + z; c.sgu_b = a.in[15] + z;
    c.pool_w = a.in[16] + z; c.pool_b = a.in[17] + z; c.pool_scale = a.in[18] + z; c.w_branch = a.in[19] + z; c.w_out = a.in[20] + z; c.final_g = a.in[21] + z;
    c.out = a.out + z; unsigned char* ws = a.ws + z;
    c.WinT = (bf16_t*)(ws + WS_WIN); c.WbT = (bf16_t*)(ws + WS_WB); c.WoT = (bf16_t*)(ws + WS_WO);
    c.mod = (float*)(ws + WS_MOD); c.atab = (float*)(ws + WS_ATAB); c.shb = (bf16_t*)(ws + WS_SHB); c.SW = (float*)(ws + WS_SW);
    c.xa = (bf16_t*)(ws + WS_XA); c.ssq = (float*)(ws + WS_SSQ); c.pbuf = (bf16_t*)(ws + WS_PBUF); c.y = (bf16_t*)(ws + WS_Y); c.mg = (bf16_t*)(ws + WS_MG);
    c.WadaT = (bf16_t*)(ws + WS_WADA); c.scb = (bf16_t*)(ws + WS_SCB); c.xb = (bf16_t*)(ws + WS_XB); c.xa2 = (bf16_t*)(ws + WS_XA2); c.lnst = (float*)(ws + WS_LNST); c.SguW = (bf16_t*)(ws + WS_SGUW); c.PoolWT = (bf16_t*)(ws + WS_POOLW);
    c.lds = nullptr; c.tid = 0; c.lane = 0; c.wave = 0; c.gw = 0; c.NGW = 0; c.gtid = 0; c.NGT = 0;
    return c;
}
#define LAUNDER_CTX(a) size_t z_ = 0; asm volatile("" : "+s"(z_)); Ctx c = make_ctx(a, z_); { int t_ = threadIdx.x; asm volatile("" : "+v"(t_)); c.tid = t_; c.lane = t_ & 63; c.wave = __builtin_amdgcn_readfirstlane(t_ >> 6); \
    c.gw = blockIdx.x * NWAVES + c.wave; c.NGW = gridDim.x * NWAVES; c.gtid = blockIdx.x * NTHREADS + t_; c.NGT = gridDim.x * NTHREADS; }
#define VB_LOAD(ldsp) const int vb_ = __builtin_amdgcn_readfirstlane((int)((volatile LAS unsigned*)((ldsp) + LDSCTL_OFF))[2]); const int vx_ = vb_ >> 5, vr_ = vb_ & 31;
struct MapWin { DEV int operator()(int g) const { return src_win((g & ~31) + perm32(g & 31)); } };
struct MapPerm { DEV int operator()(int g) const { return (g & ~31) + perm32(g & 31); } };
template <class Map>
DEV void transpose_item(const float* Wsrc, int ldw, int K, bf16_t* WT, int nblk, int item, float* scr, int lane, Map map) {
    const int kb = item / nblk, nb = item % nblk, k0 = 64 * kb, g0 = 32 * nb;
    const int scol = map(g0 + (lane & 31));
#pragma unroll 8
    for (int i = 0; i < 32; ++i) { const int kk = 2 * i + (lane >> 5); scr[kk * 33 + (lane & 31)] = Wsrc[(size_t)(k0 + kk) * ldw + scol]; }
    asm volatile("s_waitcnt lgkmcnt(0)" ::: "memory");
    const int c = lane & 7;
#pragma unroll
    for (int j = 0; j < 4; ++j) { const int n = (lane >> 3) + 8 * j; const float* s = scr + (8 * c) * 33 + n;
        u32x4 o; o.x = pk2(s[0 * 33], s[1 * 33]); o.y = pk2(s[2 * 33], s[3 * 33]); o.z = pk2(s[4 * 33], s[5 * 33]); o.w = pk2(s[6 * 33], s[7 * 33]);
        *(u32x4*)(WT + (size_t)(g0 + n) * K + k0 + 8 * c) = o; }
    asm volatile("s_waitcnt lgkmcnt(0)" ::: "memory");
}
constexpr int IT_WIN = (D / 64) * (NIN / 32), IT_WB = (W / 64) * (D / 32), IT_WO = (D / 64) * (D / 32);
constexpr int IT_PW = (128 / 64) * (128 / 32);
constexpr int IT_WADA = (D / 64) * (3072 / 32);
constexpr int IT_TOTAL = DEPTH * IT_WIN + DEPTH * 3 * IT_WB + DEPTH * IT_WO + DEPTH * 4 * IT_PW + DEPTH * IT_WADA;
DEV void ph_convert(const Args& a, unsigned char* lds, const int stage, const int b0) {
    LAUNDER_CTX(a);
    float* scr = (float*)(lds + c.wave * 16384);
    const int nb = (int)gridDim.x - b0, bw = ((int)blockIdx.x - b0) * NWAVES + c.wave, nw = nb * NWAVES, bt = ((int)blockIdx.x - b0) * NTHREADS + c.tid, nthr = nb * NTHREADS;
    if ((int)blockIdx.x < b0) return;
    if (stage == 0) {
        for (int r = bw; r < DEPTH * IT_WADA; r += nw) { const int l = r / IT_WADA; transpose_item(c.w_ada + (size_t)l * D * 3072, 3072, D, c.WadaT + (size_t)l * 3072 * D, 3072 / 32, r - l * IT_WADA, scr, c.lane, MapPerm()); }
        for (int idx = bt; idx < 256 * D / 4; idx += nthr) { const int n = idx >> 8, k4 = (idx & 255) * 4; f32x4 v = (f32x4){0.f, 0.f, 0.f, 0.f};
            if (n < NBT) { v = *(const f32x4*)((n < NBP ? c.c_prompt + (size_t)n * D : c.c_sample + (size_t)(n - NBP) * D) + k4); v = silu4(v); }
            *((u32x2*)c.scb + idx) = (u32x2){pk2(v.x, v.y), pk2(v.z, v.w)}; }
        return;
    }
    for (int it = bw; it < IT_TOTAL - DEPTH * IT_WADA; it += nw) {
        int r = it;
        if (r < DEPTH * IT_WIN) { const int l = r / IT_WIN; r -= l * IT_WIN; transpose_item(c.w_in + (size_t)l * D * NIN, NIN, D, c.WinT + (size_t)l * NIN * D, NIN / 32, r, scr, c.lane, MapWin()); continue; }
        r -= DEPTH * IT_WIN;
        if (r < DEPTH * 3 * IT_WB) { const int li = r / IT_WB; r -= li * IT_WB; transpose_item(c.w_branch + (size_t)li * W * D, D, W, c.WbT + (size_t)li * D * W, D / 32, r, scr, c.lane, MapPerm()); continue; }
        r -= DEPTH * 3 * IT_WB;
        if (r < DEPTH * IT_WO) { const int l = r / IT_WO; r -= l * IT_WO; transpose_item(c.w_out + (size_t)l * D * D, D, D, c.WoT + (size_t)l * D * D, D / 32, r, scr, c.lane, MapPerm()); continue; }
        r -= DEPTH * IT_WO;
        { const int lg = r / IT_PW; r -= lg * IT_PW; transpose_item(c.pool_w + (size_t)lg * 128 * 128, 128, 128, c.PoolWT + (size_t)lg * 128 * 128, 4, r, scr, c.lane, MapPerm()); }
    }
    for (int idx = bt; idx < DEPTH * 8 * 128 * 128 / 4; idx += nthr) { const int s4 = (idx & 31) * 4, t = (idx >> 5) & 127; const f32x4 v = *((const f32x4*)c.sgu_w + idx);
        *((u32x2*)c.SguW + idx) = (u32x2){pk2(s4 <= t ? v.x : 0.f, s4 + 1 <= t ? v.y : 0.f), pk2(s4 + 2 <= t ? v.z : 0.f, s4 + 3 <= t ? v.w : 0.f)}; }
}
DEV void ph_xa0(const Args& a) {
    LAUNDER_CTX(a);
    const int lane = c.lane, NSW = DEPTH * 30;
    if ((int)gridDim.x <= NSW || (int)blockIdx.x < NSW) { if ((int)gridDim.x > NSW) return; }
    const int w0 = ((int)gridDim.x > NSW) ? ((int)blockIdx.x - NSW) * NWAVES + c.wave : c.gw, nw = ((int)gridDim.x > NSW) ? ((int)gridDim.x - NSW) * NWAVES : c.NGW;
    for (int row = MV + w0; row < MP; row += nw) { u32x2* xo = (u32x2*)(c.xa + (size_t)row * D) + lane;
#pragma unroll
        for (int j = 0; j < 4; ++j) { xo[64 * j] = (u32x2){0u, 0u}; ((u32x2*)(c.xa2 + (size_t)row * D) + lane)[64 * j] = (u32x2){0u, 0u}; }
        if (lane < 16) c.ssq[row * 16 + lane] = 0.f; }
#pragma unroll 2
    for (int row = w0; row < MV; row += nw) {
        u32x2* xo = (u32x2*)(c.xa + (size_t)row * D) + lane;
        const float* xr = row < MPR ? c.x_prompt + (size_t)row * D : c.x_sample + (size_t)(row - MPR) * D;
        const float* ar = c.atab + (size_t)nidx_of(row) * D;
#pragma unroll
        for (int j = 0; j < 4; ++j) {
            const f32x4 v = *((const f32x4*)xr + lane + 64 * j), at = *((const f32x4*)ar + lane + 64 * j);
            const u32x2 pv = (u32x2){pk2(v.x * at.x, v.y * at.y), pk2(v.z * at.z, v.w * at.w)};
            if (row >= MPR) st_sc8(&xo[64 * j], pv); else xo[64 * j] = pv;
            float s = (v.x * v.x + v.y * v.y) + (v.z * v.z + v.w * v.w);
            s += __shfl_xor(s, 1); s += __shfl_xor(s, 2); s += __shfl_xor(s, 4); s += __shfl_xor(s, 32);
            if ((lane & 39) == 0) { if (row >= MPR) __hip_atomic_store(c.ssq + row * 16 + 4 * j + (lane >> 3), s, __ATOMIC_RELAXED, __HIP_MEMORY_SCOPE_AGENT); else c.ssq[row * 16 + 4 * j + (lane >> 3)] = s; }
        }
    }
}
DEV float row_rstd(const float* ssq, int row) {
    const f32x4* p = (const f32x4*)(ssq + (size_t)row * 16); const f32x4 a = p[0], b = p[1], c = p[2], d = p[3];
    const float s = ((a.x + a.y) + (a.z + a.w)) + ((b.x + b.y) + (b.z + b.w)) + ((c.x + c.y) + (c.z + c.w)) + ((d.x + d.y) + (d.z + d.w));
    return __builtin_amdgcn_rsqf(s * (1.f / D) + EPS);
}

DEV void store8(bf16_t* p, f32x4 a, f32x4 b) { u32x4 w; w.x = pk2(a.x, a.y); w.y = pk2(a.z, a.w); w.z = pk2(b.x, b.y); w.w = pk2(b.z, b.w); *(u32x4*)p = w; }

#define LAS __attribute__((address_space(3)))
constexpr int BK = 64, HALF = 128, HTB = HALF * BK * 2, STAGE_BYTES = 8 * HTB;
DEV int lds_byte(int r, int c) { const int st = (r >> 4) * 2 + (c >> 5), rr = r & 15, cc = c & 31, ob = rr * 64 + cc * 2; return st * 1024 + (ob ^ (((ob >> 9) & 1) << 5)); }
DEV void stage_rc(int b, int& R, int& C) { const int st = b / 1024, sb = b % 1024, swz = sb ^ (((sb >> 9) & 1) << 5); R = (st >> 1) * 16 + swz / 64; C = (st & 1) * 32 + (swz % 64) / 2; }
struct UnitD { const char* A; const char* B; int pm, pn, aux; };
constexpr int NXCD = 8;
constexpr int WGM_P1 = 4, WGM_P3 = 4, WGM_P4 = 8;
struct TileOrder {
    int nM, nN, nwg, G, c, pm0;
    DEV void init(int nM_, int nN_, int G_, int c_, int pm0_) { nM = nM_; nN = nN_; nwg = nM * nN; G = G_; c = c_; pm0 = pm0_; }
    template <int WGM> DEV bool tile(int i, int& pm, int& pn) const {
        const int wgid = i * G + c; if (wgid >= nwg) return false;
        const int nig = WGM * nN, gid = wgid / nig, fm = gid * WGM, gsz = (nM - fm) < WGM ? (nM - fm) : WGM;
        pm = pm0 + fm + ((wgid % nig) % gsz); pn = (wgid % nig) / gsz; return true;
    }
};
template <class Epi, class Sched, int NBH = 2>
DEV void gemm_phase(LAS unsigned char* lds, const int lda  , const int ldb  , const int nt  , const Sched& S, const Epi& E) {
    int tid = threadIdx.x; asm volatile("" : "+v"(tid));
    const int wid = __builtin_amdgcn_readfirstlane(tid >> 6), lane = tid & 63, wr = wid >> 2, wc = wid & 3, fr = lane & 15, fq = lane >> 4;
    unsigned voffA[2], voffB[2];
#pragma unroll
    for (int i = 0; i < 2; ++i) { int R, C; stage_rc(tid * 16 + i * 8192, R, C); voffA[i] = (unsigned)(R * lda + C * 2); voffB[i] = (unsigned)(R * ldb + C * 2); }
    const size_t kstep = (size_t)(BK * 2);
    const size_t hstepA = (size_t)HALF * lda, hstepB = (size_t)HALF * ldb;
    const unsigned ldsw = (unsigned)wid * 1024u;
    const int aoff = lds_byte(wr * 64 + fr, fq * 8), boff = lds_byte(wc * 32 + fr, fq * 8);
#define PG8_SA(b, h) (((b) * 2 + (h)) * HTB)
#define PG8_SB(b, h) ((4 + (b) * 2 + (h)) * HTB)
#define PG8_STAGE(bufoff, gbase, voff) do { _Pragma("unroll") for (int _i = 0; _i < 2; ++_i) \
        __builtin_amdgcn_global_load_lds((const unsigned*)((const char*)(gbase) + (voff)[_i]), (LAS unsigned*)(lds + (bufoff) + ldsw + _i * 8192), 16, 0, 0); } while (0)
#define PG8_LDA(dst, b, h) do { _Pragma("unroll") for (int m = 0; m < 4; ++m) _Pragma("unroll") for (int k = 0; k < 2; ++k) dst[m][k] = *(const LAS bf16x8*)(lds + PG8_SA(b, h) + aoff + m * 2048 + k * 1024); } while (0)
#define PG8_LDB(dst, b, h) do { _Pragma("unroll") for (int n = 0; n < 2; ++n) _Pragma("unroll") for (int k = 0; k < 2; ++k) dst[n][k] = *(const LAS bf16x8*)(lds + PG8_SB(b, h) + boff + n * 2048 + k * 1024); } while (0)
#define PG8_MMA(ai, bj, At, Bt) do { __builtin_amdgcn_s_setprio(1); _Pragma("unroll") for (int m = 0; m < 4; ++m) _Pragma("unroll") for (int n = 0; n < 2; ++n) _Pragma("unroll") for (int k = 0; k < 2; ++k) \
        acc[ai][bj][m][n] = __builtin_amdgcn_mfma_f32_16x16x32_bf16(Bt[n][k], At[m][k], acc[ai][bj][m][n], 0, 0, 0); __builtin_amdgcn_s_setprio(0); } while (0)
#define PG8_WAIT_V(n) asm volatile("s_waitcnt vmcnt(" #n ")" ::: "memory")
#define PG8_WAIT_VN() do { if constexpr (NBH == 2) PG8_WAIT_V(8); else PG8_WAIT_V(6); } while (0)
#define PG8_WAIT_L(n) asm volatile("s_waitcnt lgkmcnt(" #n ")" ::: "memory")
#define PG8_BAR __builtin_amdgcn_s_barrier()
#define PG8_SCHED __builtin_amdgcn_sched_barrier(0)
    UnitD cur, nxt; int ui = 0;
    if (!S.next(0, cur)) return;
    f32x4 acc[2][NBH][4][2];
#pragma unroll
    for (int a = 0; a < 2; ++a)
#pragma unroll
        for (int b = 0; b < NBH; ++b)
#pragma unroll
            for (int m = 0; m < 4; ++m)
#pragma unroll
                for (int n = 0; n < 2; ++n) acc[a][b][m][n] = (f32x4){0.f, 0.f, 0.f, 0.f};
    bf16x8 At[4][2], B0[2][2], B1[2][2];
    const char* cA = cur.A; const char* cB = cur.B;
    PG8_STAGE(PG8_SB(0, 0), cB, voffB); if constexpr (NBH == 2) PG8_STAGE(PG8_SB(0, 1), cB + hstepB, voffB); PG8_STAGE(PG8_SA(0, 0), cA, voffA); PG8_STAGE(PG8_SA(0, 1), cA + hstepA, voffA);
    if (wr == 1) PG8_BAR;
    PG8_WAIT_V(2); PG8_BAR;
    PG8_STAGE(PG8_SB(1, 0), cB + kstep, voffB); PG8_STAGE(PG8_SA(1, 0), cA + kstep, voffA); if constexpr (NBH == 2) PG8_STAGE(PG8_SB(1, 1), cB + hstepB + kstep, voffB);
    if constexpr (NBH == 2) PG8_WAIT_V(6); else PG8_WAIT_V(4);
    PG8_BAR;
    for (;;) {
        const bool has_next = S.next(ui + 1, nxt);
        const char* nA = has_next ? nxt.A : cA; const char* nB = has_next ? nxt.B : cB;
        for (int t = 0; t < nt; t += 2) {
            const bool last = (t == nt - 2);
            const char* a1 = cA + (size_t)(t + 1) * kstep;
            const char* a2 = last ? nA : cA + (size_t)(t + 2) * kstep; const char* b2 = last ? nB : cB + (size_t)(t + 2) * kstep;
            const char* a3 = a2 + kstep; const char* b3 = b2 + kstep;
            PG8_LDB(B0, 0, 0); if constexpr (NBH == 2) PG8_LDB(B1, 0, 1); PG8_SCHED; PG8_LDA(At, 0, 0); PG8_STAGE(PG8_SA(1, 1), a1 + hstepA, voffA);
            PG8_WAIT_VN(); PG8_WAIT_L(0); PG8_BAR; PG8_MMA(0, 0, At, B0); if constexpr (NBH == 2) PG8_MMA(0, 1, At, B1); PG8_BAR; PG8_SCHED;
            PG8_LDA(At, 0, 1); PG8_STAGE(PG8_SB(0, 0), b2, voffB); if constexpr (NBH == 2) PG8_STAGE(PG8_SB(0, 1), b2 + hstepB, voffB); PG8_STAGE(PG8_SA(0, 0), a2, voffA);
            PG8_WAIT_VN(); PG8_WAIT_L(0); PG8_BAR; PG8_MMA(1, 0, At, B0); if constexpr (NBH == 2) PG8_MMA(1, 1, At, B1); PG8_BAR; PG8_SCHED;
            PG8_LDB(B0, 1, 0); if constexpr (NBH == 2) PG8_LDB(B1, 1, 1); PG8_SCHED; PG8_LDA(At, 1, 0); PG8_STAGE(PG8_SA(0, 1), a2 + hstepA, voffA);
            PG8_WAIT_VN(); PG8_WAIT_L(0); PG8_BAR; PG8_MMA(0, 0, At, B0); if constexpr (NBH == 2) PG8_MMA(0, 1, At, B1); PG8_BAR; PG8_SCHED;
            PG8_LDA(At, 1, 1); PG8_STAGE(PG8_SB(1, 0), b3, voffB); if constexpr (NBH == 2) PG8_STAGE(PG8_SB(1, 1), b3 + hstepB, voffB); PG8_STAGE(PG8_SA(1, 0), a3, voffA);
            PG8_WAIT_VN(); PG8_WAIT_L(0); PG8_BAR; PG8_MMA(1, 0, At, B0); if constexpr (NBH == 2) PG8_MMA(1, 1, At, B1); PG8_BAR; PG8_SCHED;
        }
        if (wr == 0) PG8_BAR;
        E(acc, cur, nxt, has_next, wr, wc, fr, fq);
        if (!has_next) break;
#pragma unroll
        for (int a = 0; a < 2; ++a)
#pragma unroll
            for (int b = 0; b < NBH; ++b)
#pragma unroll
                for (int m = 0; m < 4; ++m)
#pragma unroll
                    for (int n = 0; n < 2; ++n) acc[a][b][m][n] = (f32x4){0.f, 0.f, 0.f, 0.f};
        cur = nxt; cA = nA; cB = nB; ++ui;
        if (wr == 1) PG8_BAR;
    }
    PG8_WAIT_V(0);
    PG8_BAR;
#undef PG8_SA
#undef PG8_SB
#undef PG8_STAGE
#undef PG8_LDA
#undef PG8_LDB
#undef PG8_MMA
#undef PG8_WAIT_V
#undef PG8_WAIT_L
#undef PG8_WAIT_VN
#undef PG8_BAR
#undef PG8_SCHED
}


struct SchedMod { int G, c; const char* A; const char* B;
    DEV bool next(int i, UnitD& u) const { const int idx = i * G + c; if (idx >= 48) return false; u.pm = 0; u.pn = idx; u.aux = 0; u.A = A; u.B = B + (size_t)idx * 256 * (D * 2); return true; } };
struct EpiMod { float* mod; float* atab; bf16_t* shb; const float* b_ada; const float* norm_g;
    DEV void operator()(int pn, int row, int wc, int fq, f32x4 (&v)[2][2]) const {
#pragma unroll
        for (int bj = 0; bj < 2; ++bj) { const int gc = 256 * pn + 128 * bj + 32 * wc + 8 * fq, l = gc / 3072, j3 = gc - l * 3072;
            const f32x4 v0 = v[bj][0] + *(const f32x4*)(b_ada + gc), v1 = v[bj][1] + *(const f32x4*)(b_ada + gc + 4);
            if (row < NBT) { float* o = mod + ((size_t)l * NBT + row) * 3072 + j3; *(f32x4*)o = v0; *(f32x4*)(o + 4) = v1; }
            if (j3 < D) { const f32x4 z = (f32x4){0.f, 0.f, 0.f, 0.f}; store8(shb + ((size_t)l * 256 + row) * D + j3, row < NBT ? v0 : z, row < NBT ? v1 : z); }
            else if (j3 < 2 * D && row < NBT) { const float* ng = norm_g + l * D + (j3 - D); float* o = atab + ((size_t)l * NBT + row) * D + (j3 - D);
                f32x4 a0 = *(const f32x4*)ng * (v0 + 1.f), a1 = *(const f32x4*)(ng + 4) * (v1 + 1.f);
#pragma unroll
                for (int j = 0; j < 4; ++j) { a0[j] = __builtin_fabsf(a0[j]) < 1e-20f ? 1e-20f : a0[j]; a1[j] = __builtin_fabsf(a1[j]) < 1e-20f ? 1e-20f : a1[j]; }
                *(f32x4*)o = a0; *(f32x4*)(o + 4) = a1; }
        }
    } };
template <int NSEG, int KS  , class RowEpi>
DEV void mini_gemm(const Args& a, LAS unsigned char* lds, int u, const bf16_t* A, int lda, int a_seg, const bf16_t* Bt, int ldb, size_t b_seg, const RowEpi& e) {
    LAUNDER_CTX(a);
    const int lane = c.lane, w = c.wave, fr = lane & 15, fq = lane >> 4, rb = u & 7, pn = u >> 5, wc = (u >> 3) & 3, row = MPR + 16 * rb + fr, kw = 32 * KS;
    bf16x8 af[NSEG][KS], bf[NSEG][KS][4];
#pragma unroll
    for (int s = 0; s < NSEG; ++s) { const bf16_t* ap = A + (size_t)row * lda + s * a_seg + w * kw + 8 * fq; const bf16_t* bp = Bt + s * b_seg + (size_t)(256 * pn + 32 * wc + fr) * ldb + w * kw + 8 * fq;
#pragma unroll
        for (int k = 0; k < KS; ++k) { af[s][k] = *(const bf16x8*)(ap + 32 * k);
#pragma unroll
            for (int q = 0; q < 4; ++q) bf[s][k][q] = *(const bf16x8*)(bp + (size_t)(128 * (q >> 1) + 16 * (q & 1)) * ldb + 32 * k); } }
    f32x4 acc[NSEG][4];
#pragma unroll
    for (int s = 0; s < NSEG; ++s) {
#pragma unroll
        for (int q = 0; q < 4; ++q) acc[s][q] = (f32x4){0.f, 0.f, 0.f, 0.f};
#pragma unroll
        for (int k = 0; k < KS; ++k)
#pragma unroll
            for (int q = 0; q < 4; ++q) acc[s][q] = __builtin_amdgcn_mfma_f32_16x16x32_bf16(bf[s][k][q], af[s][k], acc[s][q], 0, 0, 0);
    }
#pragma unroll
    for (int s = 0; s < NSEG; ++s)
#pragma unroll
        for (int q = 0; q < 4; ++q) *(LAS f32x4*)(lds + (((w * NSEG + s) * 4 + q) * 64 + lane) * 16) = acc[s][q];
    __syncthreads();
    if (w == 0) {
        f32x4 v[NSEG][2][2];
#pragma unroll
        for (int s = 0; s < NSEG; ++s)
#pragma unroll
            for (int q = 0; q < 4; ++q) { f32x4 t = *(const LAS f32x4*)(lds + (((0 * NSEG + s) * 4 + q) * 64 + lane) * 16);
#pragma unroll
                for (int ww = 1; ww < 8; ++ww) t += *(const LAS f32x4*)(lds + (((ww * NSEG + s) * 4 + q) * 64 + lane) * 16);
                v[s][q >> 1][q & 1] = t; }
        e(pn, row, wc, fq, v);
    }
    __syncthreads();
}

constexpr int RTAB_OFF = STAGE_BYTES;
constexpr int SWT_OFF = RTAB_OFF + 8192;
template <int TY, bool SMP> DEV void p1_rows(const f32x4 (&acc)[2][2][4][2], bf16_t* pb  , const LAS float* rt, const float* swb, const int row0, f32x4 s00, f32x4 s01, f32x4 s10, f32x4 s11, float* st = nullptr  ) {
    f32x4 n00 = s00, n01 = s01, n10 = s10, n11 = s11;
    if (SMP) { const float* sw = swb + (size_t)nidx_of(row0) * NIN; n00 = *(const f32x4*)(sw); n01 = *(const f32x4*)(sw + 4); n10 = *(const f32x4*)(sw + 128); n11 = *(const f32x4*)(sw + 132); }
#pragma unroll
    for (int ai = 0; ai < 2; ++ai) {
#pragma unroll
        for (int m = 0; m < 4; ++m) { const int rl = ai * HALF + m * 16; const float r = rt[rl];
            if (SMP) { s00 = n00; s01 = n01; s10 = n10; s11 = n11;
                if (ai * 4 + m < 7) { const int rn = ((ai * 4 + m + 1) >> 2) * HALF + ((ai * 4 + m + 1) & 3) * 16; const float* sw = swb + (size_t)nidx_of(row0 + rn) * NIN; n00 = *(const f32x4*)(sw); n01 = *(const f32x4*)(sw + 4); n10 = *(const f32x4*)(sw + 128); n11 = *(const f32x4*)(sw + 132); } }
            f32x4 a0 = acc[ai][0][m][0] * r + s00, a1 = acc[ai][0][m][1] * r + s01, b0 = acc[ai][1][m][0] * r + s10, b1 = acc[ai][1][m][1] * r + s11;
            bf16_t* pr = pb + (size_t)rl * PC;
            if (TY == 0) { store8(pr, a0 * b0, a1 * b1); }
            else if (TY == 1) { store8(pr, a0 * silu4(b0), a1 * silu4(b1)); }
            else if (TY == 2) { store8(pr, gelu4(a0) * silu4(b0), gelu4(a1) * silu4(b1)); }
            else {
                if (TY == 3) { a0 = gelu4(a0); a1 = gelu4(a1); b0 = gelu4(b0); b1 = gelu4(b1); }
                if (TY == 3) {
                    const f32x4 sv = (a0 + a1) + (b0 + b1), qv = (a0 * a0 + a1 * a1) + (b0 * b0 + b1 * b1);
                    float s = (sv.x + sv.y) + (sv.z + sv.w), q = (qv.x + qv.y) + (qv.z + qv.w);
                    s += __shfl_xor(s, 16); q += __shfl_xor(q, 16); s += __shfl_xor(s, 32); q += __shfl_xor(q, 32);
                    if (st) *(f32x2_t*)(st + (size_t)rl * 16) = (f32x2_t){s, q}; }
                if (TY == 5) { a0 = silu4(a0); a1 = silu4(a1); b0 = silu4(b0); b1 = silu4(b1); }
                if (TY == 6) { a0 = sigmoid4(a0); a1 = sigmoid4(a1); b0 = sigmoid4(b0); b1 = sigmoid4(b1); }
                if (TY == 6) { unsigned char* gq = (unsigned char*)pr; *(u32x2*)gq = (u32x2){pku8(a0), pku8(a1)}; *(u32x2*)(gq + 128) = (u32x2){pku8(b0), pku8(b1)}; }
                else { store8(pr, a0, a1); store8(pr + 128, b0, b1); } }
        }
        if (!SMP) asm volatile("" ::: "memory");
    }
}
struct EpiP1T { bf16_t* pbuf; const float* SWl; const LAS float* rtab; const LAS float* swt; float* lnst;
    DEV void operator()(f32x4 (&acc)[2][2][4][2], const UnitD& u, const UnitD& un, const bool has_next, int wr, int wc, int fr, int fq) const {
        const int pn = u.pn, cb = 32 * wc + 8 * fq, row0 = u.pm * 256 + wr * 64 + fr; const bool smp = u.pm >= MPR / 256;
        const float* swb = SWl + 256 * pn + cb; const LAS float* sw = swt + u.aux * 256 + cb;
        const f32x4 s00 = *(const LAS f32x4*)(sw), s01 = *(const LAS f32x4*)(sw + 4), s10 = *(const LAS f32x4*)(sw + 128), s11 = *(const LAS f32x4*)(sw + 132);
        const LAS float* rt = rtab + u.aux * 256 + wr * 64 + fr;
        bf16_t* pb = pbuf + (size_t)row0 * PC + cb;
#define P1_DISPATCH(SM) \
        if (pn < 4) p1_rows<0, SM>(acc, pb + PZ + 128 * pn, rt, swb, row0, s00, s01, s10, s11); \
        else if (pn < 8) p1_rows<1, SM>(acc, pb + PABG + 128 * (pn - 4), rt, swb, row0, s00, s01, s10, s11); \
        else if (pn < 12) p1_rows<2, SM>(acc, pb + PUG + 128 * (pn - 8), rt, swb, row0, s00, s01, s10, s11); \
        else if (pn < 14) p1_rows<3, SM>(acc, pb + PGV + 256 * (pn - 12), rt, swb, row0, s00, s01, s10, s11, fq == 0 ? lnst + (size_t)row0 * 16 + 2 * (4 * (pn - 12) + wc) : nullptr); \
        else if (pn < 16) p1_rows<4, SM>(acc, pb + PCX + 256 * (pn - 14), rt, swb, row0, s00, s01, s10, s11); \
        else if (pn < 18) p1_rows<5, SM>(acc, pb + PSG + 256 * (pn - 16), rt, swb, row0, s00, s01, s10, s11); \
        else p1_rows<6, SM>(acc, (bf16_t*)((unsigned char*)(pb - cb + PGATE) + 256 * (pn - 18) + cb), rt, swb, row0, s00, s01, s10, s11);
        P1_DISPATCH(false)
#undef P1_DISPATCH
    } };
struct EpiP1S { bf16_t* pbuf; const float* SWl; const float* ssq;
    DEV void operator()(int pn, int row, int wc, int fq, f32x4 (&v)[1][2][2]) const {
        const int cb = 32 * wc + 8 * fq; const float r = row_rstd_sc(ssq, row);
        const float* sw = SWl + (size_t)nidx_of(row) * NIN + 256 * pn + cb;
        const f32x4 a0 = v[0][0][0] * r + *(const f32x4*)(sw), a1 = v[0][0][1] * r + *(const f32x4*)(sw + 4), b0 = v[0][1][0] * r + *(const f32x4*)(sw + 128), b1 = v[0][1][1] * r + *(const f32x4*)(sw + 132);
        bf16_t* pr = pbuf + (size_t)row * PC + cb;
        if (pn < 4) store8_sc(pr + PZ + 128 * pn, a0 * b0, a1 * b1);
        else if (pn < 8) store8_sc(pr + PABG + 128 * (pn - 4), a0 * silu4(b0), a1 * silu4(b1));
        else if (pn < 12) store8_sc(pr + PUG + 128 * (pn - 8), gelu4(a0) * silu4(b0), gelu4(a1) * silu4(b1));
        else if (pn < 14) { bf16_t* o = pr + PGV + 256 * (pn - 12); store8_sc(o, gelu4(a0), gelu4(a1)); store8_sc(o + 128, gelu4(b0), gelu4(b1)); }
        else if (pn < 16) { bf16_t* o = pr + PCX + 256 * (pn - 14); store8_sc(o, a0, a1); store8_sc(o + 128, b0, b1); }
        else if (pn < 18) { bf16_t* o = pr + PSG + 256 * (pn - 16); store8_sc(o, silu4(a0), silu4(a1)); store8_sc(o + 128, silu4(b0), silu4(b1)); }
        else { unsigned char* gq = (unsigned char*)(pbuf + (size_t)row * PC + PGATE) + 256 * (pn - 18) + cb;
            st_sc8(gq, (u32x2){pku8(sigmoid4(a0)), pku8(sigmoid4(a1))}); st_sc8(gq + 128, (u32x2){pku8(sigmoid4(b0)), pku8(sigmoid4(b1))}); }
    } };
DEV void p1_sample_slice(const int tid, const int slice  , const bf16_t* xa, const bf16_t* Wl, const EpiP1S& e, LAS unsigned char* lds) {
    const int lane = tid & 63, w = __builtin_amdgcn_readfirstlane(tid >> 6), fr = lane & 15, fq = lane >> 4, pn = slice >> 2, wc = slice & 3, row = MPR + 16 * w + fr;
    const bf16_t* ap = xa + (size_t)row * D + 8 * fq; const bf16_t* bp = Wl + (size_t)(256 * pn + 32 * wc + fr) * D + 8 * fq;
    __syncthreads();
#pragma unroll
    for (int j = 0; j < 16; ++j) { const int b = w * 16 + j, q = b >> 5, ks = b & 31;
        __builtin_amdgcn_global_load_lds((const unsigned*)(bp + (size_t)(128 * (q >> 1) + 16 * (q & 1)) * D + 32 * ks), (LAS unsigned*)(lds + b * 1024), 16, 0, 0); }
    bf16x8 af[32];
#pragma unroll
    for (int ks = 0; ks < 32; ++ks) af[ks] = __builtin_bit_cast(bf16x8, ld_sc16(ap + 32 * ks));
    f32x4 v[1][2][2];
#pragma unroll
    for (int q = 0; q < 4; ++q) v[0][q >> 1][q & 1] = (f32x4){0.f, 0.f, 0.f, 0.f};
    asm volatile("s_waitcnt vmcnt(0)" ::: "memory");
    __syncthreads();
#pragma unroll
    for (int ks = 0; ks < 32; ++ks)
#pragma unroll
        for (int q = 0; q < 4; ++q) { const bf16x8 bfr = *(const LAS bf16x8*)(lds + (q * 32 + ks) * 1024 + lane * 16);
            v[0][q >> 1][q & 1] = __builtin_amdgcn_mfma_f32_16x16x32_bf16(bfr, af[ks], v[0][q >> 1][q & 1], 0, 0, 0); }
    e(pn, row, wc, fq, v);
}
template <class Sched> DEV void p1_rtab(const Sched& S, const float* ssq, const float* SWl, LAS float* rtab, LAS float* swt) {
    int t = threadIdx.x; asm volatile("" : "+v"(t));
#pragma unroll
    for (int k = 0; k < 4; ++k) { const int q = t + 512 * k, i = q >> 8, rl = q & 255; UnitD u;
        if (S.next(i, u)) { rtab[q] = row_rstd(ssq, u.pm * 256 + rl); swt[q] = SWl[(size_t)(u.pm < MPR / 256 ? (u.pm >> 3) : NBP) * NIN + 256 * u.pn + rl]; } }
    __syncthreads();
}
template <bool IN16, bool LAST> struct EpiP4T { const float* gate; const float* atab_cur; const float* atab_next; const bf16_t* xa; bf16_t* xao; float* ssq; const float* xin; bf16_t* xb;
    DEV void operator()(f32x4 (&acc)[2][2][4][2], const UnitD& u, const UnitD& un, const bool has_next, int wr, int wc, int fr, int fq) const {
        const int pn = u.pn, nb = u.pm >> 3, col = 256 * pn + 32 * wc + 8 * fq, row0 = u.pm * 256 + wr * 64 + fr;
        const float* gp = gate + (size_t)nb * 3072 + col;
        f32x4 g[2][2], at[2][2], iv[2][2];
#pragma unroll
        for (int bj = 0; bj < 2; ++bj)
#pragma unroll
            for (int n = 0; n < 2; ++n) { g[bj][n] = *(const f32x4*)(gp + 128 * bj + 4 * n);
                at[bj][n] = LAST ? (f32x4){0.f, 0.f, 0.f, 0.f} : *(const f32x4*)(atab_next + (size_t)nb * D + col + 128 * bj + 4 * n);
                iv[bj][n] = IN16 ? rcp4(*(const f32x4*)(atab_cur + (size_t)nb * D + col + 128 * bj + 4 * n)) : (f32x4){0.f, 0.f, 0.f, 0.f}; }
        const size_t off0 = (size_t)row0 * D + col;
        f32x4 x[2][2], xn[2][2]; u32x4 xh[2], xhn[2];
#pragma unroll
        for (int bj = 0; bj < 2; ++bj) { if (IN16) xh[bj] = *(const u32x4*)(xa + off0 + 128 * bj); else { x[bj][0] = *(const f32x4*)(xin + off0 + 128 * bj); x[bj][1] = *(const f32x4*)(xin + off0 + 128 * bj + 4); } }
#pragma unroll
        for (int r = 0; r < 8; ++r) { const int ai = r >> 2, m = r & 3, rl = ai * HALF + m * 16, row = row0 + rl; float s = 0.f;
            if (r < 7) { const size_t offn = off0 + (size_t)(((r + 1) >> 2) * HALF + ((r + 1) & 3) * 16) * D;
#pragma unroll
                for (int bj = 0; bj < 2; ++bj) { if (IN16) xhn[bj] = *(const u32x4*)(xa + offn + 128 * bj); else { xn[bj][0] = *(const f32x4*)(xin + offn + 128 * bj); xn[bj][1] = *(const f32x4*)(xin + offn + 128 * bj + 4); } } }
            const size_t off = off0 + (size_t)rl * D;
#pragma unroll
            for (int bj = 0; bj < 2; ++bj) {
                if (IN16) { unpk8(xh[bj], x[bj][0], x[bj][1]); x[bj][0] *= iv[bj][0]; x[bj][1] *= iv[bj][1]; }
#pragma unroll
                for (int n = 0; n < 2; ++n) { const f32x4 t = x[bj][n] + g[bj][n] * acc[ai][bj][m][n]; x[bj][n] = t; s += (t.x * t.x + t.y * t.y) + (t.z * t.z + t.w * t.w); }
                if (LAST) store8(xb + off + 128 * bj, x[bj][0], x[bj][1]);
                else store8(xao + off + 128 * bj, x[bj][0] * at[bj][0], x[bj][1] * at[bj][1]); }
            s += __shfl_xor(s, 16); s += __shfl_xor(s, 32);
            if (fq == 0) ssq[row * 16 + 4 * pn + wc] = s;
#pragma unroll
            for (int bj = 0; bj < 2; ++bj) { xh[bj] = xhn[bj]; x[bj][0] = xn[bj][0]; x[bj][1] = xn[bj][1]; }
        }
    } };

struct SchedP3R { TileOrder T; const char* A; const char* B;
    DEV bool next(int i, UnitD& u) const { int pm, pc; const int seg = i % 3; if (!T.tile<WGM_P3>(i / 3, pm, pc)) return false; u.pm = pm; u.pn = pc; u.aux = seg;
        u.A = A + (size_t)pm * 256 * (1536 * 2) + (size_t)seg * (W * 2); u.B = B + (size_t)seg * D * (W * 2) + (size_t)pc * 128 * (W * 2); return true; } };
struct EpiP3R { f32x4 (&tot)[2][4][2]; u32x2 (&gpre)[8]; const bf16_t* pbuf; bf16_t* mg;
    DEV void prefetch(const UnitD& u, int wr, int wc, int fr, int fq) const {
        const unsigned char* gp = (const unsigned char*)(pbuf + (size_t)(u.pm * 256 + wr * 64 + fr) * PC + PGATE) + 1024 * u.aux + 128 * u.pn + 32 * wc + 8 * fq;
#pragma unroll
        for (int r = 0; r < 8; ++r) gpre[r] = *(const u32x2*)(gp + (size_t)((r >> 2) * HALF + (r & 3) * 16) * (PC * 2));
    }
    DEV void operator()(f32x4 (&acc)[2][1][4][2], const UnitD& u, const UnitD& un, const bool has_next, int wr, int wc, int fr, int fq) const {
        const int seg = u.aux, cb = 128 * u.pn + 32 * wc + 8 * fq, row0 = u.pm * 256 + wr * 64 + fr;
        bf16_t* o = mg + (size_t)row0 * D + cb;
        u32x2 g[8];
#pragma unroll
        for (int r = 0; r < 8; ++r) g[r] = gpre[r];
        if (has_next) prefetch(un, wr, wc, fr, fq);
        const float keep = seg ? 1.f : 0.f;
#pragma unroll
        for (int r = 0; r < 8; ++r) { const int ai = r >> 2, m = r & 3; const f32x4 g0 = gate4(g[r].x), g1 = gate4(g[r].y);
            const f32x4 t0 = acc[ai][0][m][0] * g0 + tot[ai][m][0] * keep, t1 = acc[ai][0][m][1] * g1 + tot[ai][m][1] * keep;
            tot[ai][m][0] = t0; tot[ai][m][1] = t1;
            if (seg == 2) store8(o + (size_t)(ai * HALF + m * 16) * D, t0, t1); }
    } };
#define XB_TMO      128
#define XB_XCNT(j)  (256  + 64 * (j))
#define XB_XSUB(j)  (1280 + 64 * (j))
#define XB_XGEN(j)  (2304 + 64 * (j))
#define XB_TOP      3328
#define XB_TOPGEN   3392
#define XCD_BAR_WORDS 3456
#define XB_LSUB(j)  (3456 + 64 * (j))
#define XB_LGEN(j)  (3968 + 64 * (j))
#define XB_CNT_P4S  4480
#define XB_CNT_P1S  4544
#define XB_SPIN_CAP (1u << 18)
DEV unsigned xb_ld(unsigned* p)              { return __hip_atomic_load(p, __ATOMIC_RELAXED, __HIP_MEMORY_SCOPE_AGENT); }
DEV unsigned xb_add(unsigned* p, unsigned v) { return __hip_atomic_fetch_add(p, v, __ATOMIC_RELAXED, __HIP_MEMORY_SCOPE_AGENT); }
DEV unsigned xb_xcc_id() { return (unsigned)__builtin_amdgcn_s_getreg((3 << 11) | 20) & 0xFu; }
#define XB_SPIN(cond, bar) do { unsigned _sp = 0; while (cond) { __builtin_amdgcn_s_sleep(1); \
    if ((++_sp & 255u) == 0u) { if (xb_ld(&(bar)[XB_TMO])) break; if (_sp > XB_SPIN_CAP) { atomicAdd(&(bar)[XB_TMO], 1u); break; } } } } while (0)
struct XcdBarrier { unsigned* bar; unsigned x; volatile LAS unsigned* st; };
DEV XcdBarrier xcd_barrier_post(unsigned* bar, volatile LAS unsigned* st) {
    XcdBarrier b; b.bar = bar; b.x = xb_xcc_id(); b.st = st;
    if (threadIdx.x == 0) st[4] = xb_add(&bar[XB_XCNT(b.x)], 1u);
    return b;
}
DEV void xcd_barrier_complete(unsigned* bar, unsigned x, unsigned& nloc, unsigned& nx, unsigned& even) {
    const unsigned G = gridDim.x * gridDim.y * gridDim.z;
    unsigned sum, cnt, mine, n32, sp = 0u;
    for (;;) {
        sum = 0u; cnt = 0u; mine = 0u; n32 = 0u;
#pragma unroll
        for (unsigned j = 0; j < 16; ++j) { const unsigned c = xb_ld(&bar[XB_XCNT(j)]); sum += c; cnt += (c > 0u) ? 1u : 0u; n32 += (j < 8u && c == 32u) ? 1u : 0u; mine = (j == x) ? c : mine; }
        if (sum == G) break;
        __builtin_amdgcn_s_sleep(1);
        if ((++sp & 255u) == 0u) { if (xb_ld(&bar[XB_TMO])) break; if (sp > XB_SPIN_CAP) { atomicAdd(&bar[XB_TMO], 1u); break; } }
    }
    nloc = mine > 0u ? mine : 1u; nx = cnt > 0u ? cnt : 1u;
    even = (sum == G && G == 256u && n32 == 8u) ? 1u : 0u;
}
DEV void xcd_barrier(const XcdBarrier& b) {
    asm volatile("s_waitcnt vmcnt(0)" ::: "memory");
    __syncthreads();
    if (threadIdx.x == 0) {
        unsigned* bar = b.bar; unsigned bx = b.x; asm volatile("" : "+s"(bar), "+s"(bx));
        __builtin_amdgcn_s_waitcnt(0);
        unsigned nloc = b.st[0], nx = b.st[1];
        if (nloc == 0u) { unsigned even; xcd_barrier_complete(bar, bx, nloc, nx, even); b.st[0] = nloc; b.st[1] = nx;
            b.st[2] = even ? bx * 32u + b.st[4] : (unsigned)blockIdx.x;
            b.st[3] = even; }
        const unsigned old = xb_add(&bar[XB_XSUB(bx)], 1u);
        const unsigned gen = old / nloc;
        if (old + 1u == (gen + 1u) * nloc) {
            __builtin_amdgcn_fence(__ATOMIC_RELEASE, "agent");
            asm volatile("s_waitcnt vmcnt(0)" ::: "memory");
            const unsigned og = xb_add(&bar[XB_TOP], 1u);
            const unsigned tg = og / nx;
            if (og + 1u == (tg + 1u) * nx) xb_add(&bar[XB_TOPGEN], 1u);
            else XB_SPIN(xb_ld(&bar[XB_TOPGEN]) == tg, bar);
            __builtin_amdgcn_fence(__ATOMIC_ACQUIRE, "agent");
            xb_add(&bar[XB_XGEN(bx)], 1u);
            asm volatile("s_waitcnt vmcnt(0)" ::: "memory");
        } else {
            XB_SPIN(xb_ld(&bar[XB_XGEN(bx)]) == gen, bar);
            __builtin_amdgcn_fence(__ATOMIC_ACQUIRE, "agent");
            asm volatile("s_waitcnt vmcnt(0)" ::: "memory");
        }
    }
    __syncthreads();
}
DEV void xcd_local_barrier(const XcdBarrier& b) {
    asm volatile("s_waitcnt vmcnt(0)" ::: "memory");
    __syncthreads();
    if (threadIdx.x == 0) {
        unsigned* bar = b.bar; unsigned bx = b.x; asm volatile("" : "+s"(bar), "+s"(bx));
        __builtin_amdgcn_s_waitcnt(0);
        const unsigned old = xb_add(&bar[XB_LSUB(bx)], 1u);
        const unsigned gen = old >> 5;
        if ((old & 31u) == 31u) xb_add(&bar[XB_LGEN(bx)], 1u);
        else XB_SPIN(xb_ld(&bar[XB_LGEN(bx)]) == gen, bar);
        __builtin_amdgcn_fence(__ATOMIC_ACQUIRE, "agent");
        asm volatile("s_waitcnt vmcnt(0)" ::: "memory");
    }
    __syncthreads();
}
constexpr bool LOCAL_BAR = true;
DEV void layer_barrier(const XcdBarrier& b) { if (LOCAL_BAR && b.st[3]) xcd_local_barrier(b); else xcd_barrier(b); }
template <class RowEpi> struct EpiRows { RowEpi e;
    DEV void operator()(f32x4 (&acc)[2][2][4][2], const UnitD& u, const UnitD& un, const bool has_next, int wr, int wc, int fr, int fq) const {
#pragma unroll
        for (int ai = 0; ai < 2; ++ai)
#pragma unroll
            for (int m = 0; m < 4; ++m) { f32x4 v[2][2] = {{acc[ai][0][m][0], acc[ai][0][m][1]}, {acc[ai][1][m][0], acc[ai][1][m][1]}};
                e(u.pn, u.pm * 256 + ai * HALF + wr * 64 + m * 16 + fr, wc, fq, v); asm volatile("" ::: "memory"); }
    } };
struct SchedP1 { TileOrder T; const char* A; const char* B;
    DEV bool next(int i, UnitD& u) const { int pm, pn; if (!T.tile<WGM_P1>(i, pm, pn)) return false; pn += (T.pm0 >> 3) * 4; pn -= pn >= 30 ? 30 : 0;   u.pm = pm; u.pn = pn; u.aux = i; u.A = A + (size_t)pm * 256 * (D * 2); u.B = B + (size_t)pn * 256 * (D * 2); return true; } };

struct SchedP4 { TileOrder T; const char* A; const char* B;
    DEV bool next(int i, UnitD& u) const { int pm, pn; if (!T.tile<WGM_P4>(i, pm, pn)) return false; u.pm = pm; u.pn = pn; u.aux = 0; u.A = A + (size_t)pm * 256 * (D * 2); u.B = B + (size_t)pn * 256 * (D * 2); return true; } };
struct EpiP3 { const bf16_t* pbuf; bf16_t* mg;
    DEV void operator()(int pn, int row, int wc, int fq, f32x4 (&v)[3][2][2]) const {
        const int cb = 256 * pn + 32 * wc + 8 * fq;
        const unsigned char* gp = (const unsigned char*)(pbuf + (size_t)row * PC + PGATE) + cb; bf16_t* o = mg + (size_t)row * D + cb;
        u32x2 g[3][2];
#pragma unroll
        for (int s = 0; s < 3; ++s) { g[s][0] = ld_sc8(gp + 1024 * s); g[s][1] = ld_sc8(gp + 1024 * s + 128); }
#pragma unroll
        for (int bj = 0; bj < 2; ++bj) { f32x4 t0 = v[0][bj][0] * gate4(g[0][bj].x), t1 = v[0][bj][1] * gate4(g[0][bj].y);
#pragma unroll
            for (int s = 1; s < 3; ++s) { t0 += v[s][bj][0] * gate4(g[s][bj].x); t1 += v[s][bj][1] * gate4(g[s][bj].y); }
            store8(o + 128 * bj, t0, t1); }
    } };
struct SchedSW { int G, c; const char* A; const char* B;
    DEV bool next(int i, UnitD& u) const { const int idx = i * G + c; if (idx >= DEPTH * 30) return false; const int l = idx / 30, pn = idx % 30; u.pm = 0; u.pn = pn + 32 * l; u.aux = l;
        u.A = A + (size_t)l * 256 * (D * 2); u.B = B + (size_t)l * NIN * (D * 2) + (size_t)pn * 256 * (D * 2); return true; } };
struct EpiSWx { float* SW;
    DEV void operator()(int pnx, int row, int wc, int fq, f32x4 (&v)[2][2]) const {
        if (row >= NBT) return;
        const int l = pnx >> 5, pn = pnx & 31;
        float* o = SW + (size_t)l * NBT * NIN + (size_t)row * NIN + 256 * pn + 32 * wc + 8 * fq;
        *(f32x4*)(o) = v[0][0]; *(f32x4*)(o + 4) = v[0][1]; *(f32x4*)(o + 128) = v[1][0]; *(f32x4*)(o + 132) = v[1][1];
    } };
struct EpiP4 { const float* gate  ; const float* atab_cur; const float* atab_next  ; const bf16_t* xa; bf16_t* xao; float* ssq; const float* xin  ; bf16_t* xb; int in16;
    DEV void operator()(int pn, int row, int wc, int fq, f32x4 (&vv)[1][2][2]) const {
        f32x4 (&v)[2][2] = vv[0];
        const int nb = nidx_of(row), col = 256 * pn + 32 * wc + 8 * fq;
        const float* gp = gate + (size_t)nb * 3072 + col;
        float s = 0.f;
#pragma unroll
        for (int bj = 0; bj < 2; ++bj) {
            f32x4 x0, x1;
            if (in16) { unpk8(*(const u32x4*)(xa + (size_t)row * D + col + 128 * bj), x0, x1); const float* ac = atab_cur + (size_t)nb * D + col + 128 * bj; x0 *= rcp4(*(const f32x4*)ac); x1 *= rcp4(*(const f32x4*)(ac + 4)); }
            else { x0 = *(const f32x4*)(xin + (size_t)row * D + col + 128 * bj); x1 = *(const f32x4*)(xin + (size_t)row * D + col + 128 * bj + 4); }
            const f32x4 t0 = x0 + *(const f32x4*)(gp + 128 * bj) * v[bj][0], t1 = x1 + *(const f32x4*)(gp + 128 * bj + 4) * v[bj][1];
            s += ((t0.x * t0.x + t0.y * t0.y) + (t0.z * t0.z + t0.w * t0.w)) + ((t1.x * t1.x + t1.y * t1.y) + (t1.z * t1.z + t1.w * t1.w));
            if (atab_next) { const float* ap = atab_next + (size_t)nb * D + col + 128 * bj; store8_sc(xao + (size_t)row * D + col + 128 * bj, t0 * *(const f32x4*)ap, t1 * *(const f32x4*)(ap + 4)); }
            else store8(xb + (size_t)row * D + col + 128 * bj, t0, t1);
        }
        s += __shfl_xor(s, 16); s += __shfl_xor(s, 32);
        if (fq == 0) __hip_atomic_store(ssq + row * 16 + 4 * pn + wc, s, __ATOMIC_RELAXED, __HIP_MEMORY_SCOPE_AGENT);
    } };


typedef short v4i16 __attribute__((ext_vector_type(4)));
constexpr int TP = 528, VT_OFF = 0, PM_OFF = 128 * TP;
DEV f32x4 unpk4(u32x2 r) { return (f32x4){bflo(r.x), bfhi(r.x), bflo(r.y), bfhi(r.y)}; }
DEV void p2_ln(const Ctx& c, int l, int ck, int hh, const bf16_t* pb, LAS unsigned char* lds) {
    int lane_ = c.lane; asm volatile("" : "+v"(lane_));
    const int lane = lane_, w = c.wave, p = lane >> 5, ch = 256 * hh + 8 * (lane & 31); const bool lastck = (ck & 15) == 15;
    const float* st = c.lnst + ((size_t)ck * 128 + 16 * w + (lane & 15)) * 16;
    const f32x4 t0 = *(const f32x4*)st, t1 = *(const f32x4*)(st + 4), t2 = *(const f32x4*)(st + 8), t3 = *(const f32x4*)(st + 12);
    u32x4 gv[8];
#pragma unroll
    for (int k = 0; k < 8; ++k) gv[k] = *(const u32x4*)(pb + (size_t)(16 * w + 2 * k + p) * PC + PGV + ch);
    const f32x4 g0 = *(const f32x4*)(c.lnv_g + l * W + ch), g1 = *(const f32x4*)(c.lnv_g + l * W + ch + 4), b0 = *(const f32x4*)(c.lnv_b + l * W + ch), b1 = *(const f32x4*)(c.lnv_b + l * W + ch + 4);
    const float s = ((t0.x + t0.z) + (t1.x + t1.z)) + ((t2.x + t2.z) + (t3.x + t3.z)), q = ((t0.y + t0.w) + (t1.y + t1.w)) + ((t2.y + t2.w) + (t3.y + t3.w));
    const float mu_l = s * (1.f / W), rstd_l = __builtin_amdgcn_rsqf(fmaxf(q * (1.f / W) - mu_l * mu_l, 0.f) + EPS);
    float* vout = c.out + O_VP + ((size_t)(l * NBP + (ck >> 4)) * 128) * W + ch;
#pragma unroll
    for (int k = 0; k < 8; ++k) { const int t = 16 * w + 2 * k + p;
        const float mu = __shfl(mu_l, 2 * k + p), rstd = __shfl(rstd_l, 2 * k + p);
        f32x4 x0 = (f32x4){bflo(gv[k].x), bfhi(gv[k].x), bflo(gv[k].y), bfhi(gv[k].y)}, x1 = (f32x4){bflo(gv[k].z), bfhi(gv[k].z), bflo(gv[k].w), bfhi(gv[k].w)};
        x0 = (x0 - mu) * rstd * g0 + b0; x1 = (x1 - mu) * rstd * g1 + b1;
        u32x4 o; o.x = pk2(x0.x, x0.y); o.y = pk2(x0.z, x0.w); o.z = pk2(x1.x, x1.y); o.w = pk2(x1.z, x1.w);
        *(LAS u32x4*)(lds + VT_OFF + t * TP + (lane & 31) * 16) = o;
        if (lastck) { *(f32x4*)(vout + (size_t)t * W) = x0; *(f32x4*)(vout + (size_t)t * W + 4) = x1; }
    }
}
template <int HH> DEV void p2_pool(const Ctx& c, int l, int ck, const bf16_t* pb, LAS unsigned char* lds) {
    constexpr int W0 = 2 << (2 * HH), W1 = 2 * W0, H = W1 - 1, NX = H + 16;
    int lane_ = c.lane; asm volatile("" : "+v"(lane_));
    const int lane = lane_, w = c.wave, gi = lane >> 5, cpos = (ck & 15) * 128, ch = 256 * HH + 4 * lane; const bool lastck = (ck & 15) == 15;
    f32x4 x[NX];
#pragma unroll
    for (int k = 0; k < NX; ++k) { const int tt = 16 * w - H + k; const bool valid = cpos + tt >= 0; const int tc = valid ? tt : 0;
        const u32x2 r = *(const u32x2*)(pb + (ptrdiff_t)tc * PC + PCX + ch); const f32x4 v = unpk4(r); x[k] = valid ? v : (f32x4){0.f, 0.f, 0.f, 0.f}; }
    f32x4 slo = x[H];
#pragma unroll
    for (int j = 1; j < W0; ++j) slo += x[H - j];
    f32x4 shi = slo;
#pragma unroll
    for (int j = W0; j < W1; ++j) shi += x[H - j];
    float* pout = c.out + O_POOLP + ((size_t)(l * NBP + (ck >> 4)) * 15) * W + ch;
#pragma unroll
    for (int i = 0; i < 16; ++i) { const int t = 16 * w + i, pos = cpos + t, wd = gi ? W1 : W0;
        const f32x4 s = gi ? shi : slo; const float inv = __builtin_amdgcn_rcpf((float)(wd < pos + 1 ? wd : pos + 1));
        const f32x4 pm = s * inv - x[H + i];
        *(LAS u32x2*)(lds + PM_OFF + t * TP + 8 * lane) = (u32x2){pk2(pm.x, pm.y), pk2(pm.z, pm.w)};
        if (lastck && t >= 113) *(f32x4*)(pout + (size_t)(t - 113) * W) = x[H + i];
        if (i < 15) { slo += x[H + i + 1] - x[H + i + 1 - W0]; shi += x[H + i + 1] - x[H + i + 1 - W1]; }
    }
}
DEV void p2_conv(const Ctx& c, int l, int ck, int hh, const bf16_t* pb) {
    int lane_ = c.lane; asm volatile("" : "+v"(lane_));
    const int lane = lane_, w = c.wave, cpos = (ck & 15) * 128, ch = 256 * hh + 4 * lane, row0 = ck * 128; const bool lastck = (ck & 15) == 15;
    const f32x4 cb = *(const f32x4*)(c.conv_b + l * W + ch), w0 = *(const f32x4*)(c.conv_w + (l * 3 + 0) * W + ch), w1 = *(const f32x4*)(c.conv_w + (l * 3 + 1) * W + ch), w2 = *(const f32x4*)(c.conv_w + (l * 3 + 2) * W + ch);
    f32x4 z[18];
#pragma unroll
    for (int k = 0; k < 18; ++k) { const int tt = 16 * w - 2 + k; const bool valid = cpos + tt >= 0; const int tc = valid ? tt : 0;
        const f32x4 v = unpk4(*(const u32x2*)(pb + (ptrdiff_t)tc * PC + PZ + ch)); z[k] = valid ? v : (f32x4){0.f, 0.f, 0.f, 0.f}; }
    float* cout = c.out + O_CONVP + ((size_t)(l * NBP + (ck >> 4)) * 2) * W + ch;
#pragma unroll
    for (int i = 0; i < 16; ++i) { const int t = 16 * w + i;
        const f32x4 abg = unpk4(*(const u32x2*)(pb + (size_t)t * PC + PABG + ch));
        const f32x4 o = abg * (cb + w0 * z[i] + w1 * z[i + 1] + w2 * z[i + 2]);
        *(u32x2*)(c.y + (size_t)(row0 + t) * 1536 + ch) = (u32x2){pk2(o.x, o.y), pk2(o.z, o.w)};
        if (lastck && t >= 126) *(f32x4*)(cout + (size_t)(t - 126) * W) = z[i + 2];
    }
}
constexpr int TPS = 1040;
DEV void p2_sample_block(const Ctx& c, int l, int sb, LAS unsigned char* ldsw) {
    const int lane = c.lane, fr = lane & 15, fq = lane >> 4, ch = 8 * lane, h = lane >> 3, g = lane >> 4;
    {
        const int i = c.wave, n = 8 * sb + i, row = MPR + n; const bf16_t* pr = c.pbuf + (size_t)row * PC; bf16_t* yr = c.y + (size_t)row * 1536;
        const float* sc = c.state_conv + ((size_t)(l * NSM + n) * 2) * W + ch; const float* sp = c.state_pool + ((size_t)(l * NSM + n) * 15) * W + ch;
        const u32x4 qz = ld_sc16(pr + PZ + ch), qa = ld_sc16(pr + PABG + ch), qg = ld_sc16(pr + PGV + ch), qu = ld_sc16(pr + PUG + ch), qc = ld_sc16(pr + PCX + ch);
        const f32x4 s00 = *(const f32x4*)(sc), s01 = *(const f32x4*)(sc + 4), s10 = *(const f32x4*)(sc + W), s11 = *(const f32x4*)(sc + W + 4);
        f32x4 st0[15], st1[15];
#pragma unroll
        for (int k = 7; k < 15; ++k) { st0[k] = *(const f32x4*)(sp + (size_t)k * W); st1[k] = *(const f32x4*)(sp + (size_t)k * W + 4); }
        const f32x4 cb0 = *(const f32x4*)(c.conv_b + l * W + ch), cb1 = *(const f32x4*)(c.conv_b + l * W + ch + 4);
        const f32x4 w0a = *(const f32x4*)(c.conv_w + (l * 3 + 0) * W + ch), w0b = *(const f32x4*)(c.conv_w + (l * 3 + 0) * W + ch + 4);
        const f32x4 w1a = *(const f32x4*)(c.conv_w + (l * 3 + 1) * W + ch), w1b = *(const f32x4*)(c.conv_w + (l * 3 + 1) * W + ch + 4);
        const f32x4 w2a = *(const f32x4*)(c.conv_w + (l * 3 + 2) * W + ch), w2b = *(const f32x4*)(c.conv_w + (l * 3 + 2) * W + ch + 4);
        const f32x4 lg0 = *(const f32x4*)(c.lnv_g + l * W + ch), lg1 = *(const f32x4*)(c.lnv_g + l * W + ch + 4), lb0 = *(const f32x4*)(c.lnv_b + l * W + ch), lb1 = *(const f32x4*)(c.lnv_b + l * W + ch + 4);
        const float w00 = c.sgu_w[(size_t)(l * 8 + h) * 128 * 128], b00 = c.sgu_b[(l * 8 + h) * 128], invw = 1.f / (float)(2 << g);
        asm volatile("" ::: "memory");
        {
            f32x4 z0, z1, a0, a1; unpk8(qz, z0, z1); unpk8(qa, a0, a1);
            const f32x4 ya = a0 * (cb0 + w0a * s00 + w1a * s10 + w2a * z0), yb = a1 * (cb1 + w0b * s01 + w1b * s11 + w2b * z1);
#pragma unroll
            for (int k = 0; k < 7; ++k) { st0[k] = *(const f32x4*)(sp + (size_t)k * W); st1[k] = *(const f32x4*)(sp + (size_t)k * W + 4); }
            store8(yr + ch, ya, yb);
            float* o = c.out + O_CONVS + ((size_t)(l * NSM + n) * 2) * W + ch;
            *(f32x4*)(o) = s10; *(f32x4*)(o + 4) = s11; *(f32x4*)(o + W) = z0; *(f32x4*)(o + W + 4) = z1;
        }
        {
            f32x4 x0, x1, u0, u1; unpk8(qg, x0, x1); unpk8(qu, u0, u1);
            float s = ((x0.x + x0.y) + (x0.z + x0.w)) + ((x1.x + x1.y) + (x1.z + x1.w));
            float q = ((x0.x * x0.x + x0.y * x0.y) + (x0.z * x0.z + x0.w * x0.w)) + ((x1.x * x1.x + x1.y * x1.y) + (x1.z * x1.z + x1.w * x1.w));
#pragma unroll
            for (int o = 1; o < 64; o <<= 1) { s += __shfl_xor(s, o); q += __shfl_xor(q, o); }
            const float mu = s * (1.f / W), var = fmaxf(q * (1.f / W) - mu * mu, 0.f), rstd = __builtin_amdgcn_rsqf(var + EPS);
            x0 = (x0 - mu) * rstd * lg0 + lb0; x1 = (x1 - mu) * rstd * lg1 + lb1;
            float* vo = c.out + O_VS + (size_t)(l * NSM + n) * W + ch; *(f32x4*)(vo) = x0; *(f32x4*)(vo + 4) = x1;
            store8(yr + 512 + ch, u0 * (x0 * w00 + b00), u1 * (x1 * w00 + b00));
        }
        {
            f32x4 c0, c1; unpk8(qc, c0, c1);
            float* po = c.out + O_POOLS + ((size_t)(l * NSM + n) * 15) * W + ch;
            f32x4 r0 = c0, r1 = c1, s2a, s2b, s4a, s4b, s8a, s8b;
#pragma unroll
            for (int k = 14; k >= 0; --k) {
                if (k >= 1) { *(f32x4*)(po + (size_t)(k - 1) * W) = st0[k]; *(f32x4*)(po + (size_t)(k - 1) * W + 4) = st1[k]; }
                r0 += st0[k]; r1 += st1[k];
                if (k == 14) { s2a = r0; s2b = r1; } if (k == 12) { s4a = r0; s4b = r1; } if (k == 8) { s8a = r0; s8b = r1; } }
            *(f32x4*)(po + (size_t)14 * W) = c0; *(f32x4*)(po + (size_t)14 * W + 4) = c1;
            const f32x4 sa = g == 0 ? s2a : g == 1 ? s4a : g == 2 ? s8a : r0, sb2 = g == 0 ? s2b : g == 1 ? s4b : g == 2 ? s8b : r1;
            const f32x4 p0 = sa * invw - c0, p1 = sb2 * invw - c1;
            u32x4 o; o.x = pk2(p0.x, p0.y); o.y = pk2(p0.z, p0.w); o.z = pk2(p1.x, p1.y); o.w = pk2(p1.z, p1.w);
            *(LAS u32x4*)(ldsw + i * TPS + 16 * lane) = o;
        }
    }
    __syncthreads();
    const int row = MPR + 8 * sb + (fr & 7); const bf16_t* pr = c.pbuf + (size_t)row * PC; bf16_t* yr = c.y + (size_t)row * 1536;
    bf16x8 bw[2][4][2]; u32x4 sgv[2]; f32x4 pbv[2][2], psv[2][2];
#pragma unroll
    for (int gi2 = 0; gi2 < 2; ++gi2) { const int gq = 2 * c.wave + gi2, g2 = gq >> 2, nq = gq & 3, cc = 128 * g2 + 32 * nq + 8 * fq;
        const bf16_t* pw = c.PoolWT + ((size_t)(l * 4 + g2) * 128 + 32 * nq + fr) * 128 + 8 * fq;
#pragma unroll
        for (int ks = 0; ks < 4; ++ks) { bw[gi2][ks][0] = *(const bf16x8*)(pw + 32 * ks); bw[gi2][ks][1] = *(const bf16x8*)(pw + 16 * 128 + 32 * ks); }
        sgv[gi2] = ld_sc16(pr + PSG + cc);
        pbv[gi2][0] = *(const f32x4*)(c.pool_b + l * W + cc); pbv[gi2][1] = *(const f32x4*)(c.pool_b + l * W + cc + 4); psv[gi2][0] = *(const f32x4*)(c.pool_scale + l * W + cc); psv[gi2][1] = *(const f32x4*)(c.pool_scale + l * W + cc + 4); }
#pragma unroll
    for (int gi2 = 0; gi2 < 2; ++gi2) { const int gq = 2 * c.wave + gi2, g2 = gq >> 2, nq = gq & 3, cc = 128 * g2 + 32 * nq + 8 * fq;
        f32x4 a0 = (f32x4){0.f, 0.f, 0.f, 0.f}, a1 = (f32x4){0.f, 0.f, 0.f, 0.f};
#pragma unroll
        for (int ks = 0; ks < 4; ++ks) { const bf16x8 af = *(const LAS bf16x8*)(ldsw + fr * TPS + 2 * (128 * g2 + 32 * ks + 8 * fq));
            a0 = __builtin_amdgcn_mfma_f32_16x16x32_bf16(bw[gi2][ks][0], af, a0, 0, 0, 0); a1 = __builtin_amdgcn_mfma_f32_16x16x32_bf16(bw[gi2][ks][1], af, a1, 0, 0, 0); }
        f32x4 g0v, g1v; unpk8(sgv[gi2], g0v, g1v);
        if (fr < 8) store8(yr + 1024 + cc, (a0 + pbv[gi2][0]) * psv[gi2][0] * g0v, (a1 + pbv[gi2][1]) * psv[gi2][1] * g1v);
    }
}

DEV void p2_mm(const Ctx& c, const int l, const int ck, const int hh, const bf16_t* pb, LAS unsigned char* lds) {
    int lane_ = c.lane; asm volatile("" : "+v"(lane_));
    const int lane = lane_, w = c.wave, fr = lane & 15, fq = lane >> 4, row0 = ck * 128;
    const int hq = w >> 1, a = w & 1, h = 4 * hh + hq;
    bf16x8 wf[4][4]; u32x4 ug[4][2]; float bias[4];
    { const bf16_t* wm = c.SguW + ((size_t)(l * 8 + h) * 128) * 128;
#pragma unroll
      for (int i = 0; i < 4; ++i) { const int tb = a ? (i == 0 ? 1 : i == 1 ? 2 : i == 2 ? 5 : 6) : (i == 0 ? 0 : i == 1 ? 3 : i == 2 ? 4 : 7), t = 16 * tb + fr;
#pragma unroll
          for (int ks = 0; ks < 4; ++ks) wf[i][ks] = *(const bf16x8*)(wm + (size_t)t * 128 + 32 * ks + 8 * fq);
      } }
    __syncthreads();
#pragma unroll
    for (int i = 0; i < 4; ++i) { const int tb = a ? (i == 0 ? 1 : i == 1 ? 2 : i == 2 ? 5 : 6) : (i == 0 ? 0 : i == 1 ? 3 : i == 2 ? 4 : 7), t = 16 * tb + fr;
        bias[i] = c.sgu_b[(l * 8 + h) * 128 + t];
#pragma unroll
        for (int c2 = 0; c2 < 2; ++c2) ug[i][c2] = *(const u32x4*)(pb + (size_t)t * PC + PUG + 256 * hh + 64 * hq + 32 * c2 + 8 * fq); }
    f32x4 acc[4][4];
#pragma unroll
    for (int i = 0; i < 4; ++i)
#pragma unroll
        for (int cc = 0; cc < 4; ++cc) acc[i][cc] = (f32x4){0.f, 0.f, 0.f, 0.f};
    { const int q = fr >> 2, p = fr & 3;
#pragma unroll
      for (int ks = 0; ks < 4; ++ks) {
        bf16x8 vb[4];
#pragma unroll
        for (int cc = 0; cc < 4; ++cc) { const int col = 64 * hq + 32 * (cc >> 1) + 8 * p + 4 * (cc & 1);
            const v4i16 lo = __builtin_amdgcn_ds_read_tr16_b64_v4i16((LAS v4i16*)(lds + VT_OFF + (32 * ks + 8 * fq + q) * TP + 2 * col));
            const v4i16 hi = __builtin_amdgcn_ds_read_tr16_b64_v4i16((LAS v4i16*)(lds + VT_OFF + (32 * ks + 8 * fq + 4 + q) * TP + 2 * col));
            vb[cc] = (bf16x8){lo[0], lo[1], lo[2], lo[3], hi[0], hi[1], hi[2], hi[3]}; }
#pragma unroll
        for (int i = 0; i < 4; ++i) { const int tb = a ? (i == 0 ? 1 : i == 1 ? 2 : i == 2 ? 5 : 6) : (i == 0 ? 0 : i == 1 ? 3 : i == 2 ? 4 : 7);
            if (ks <= (tb >> 1)) {
#pragma unroll
                for (int cc = 0; cc < 4; ++cc) acc[i][cc] = __builtin_amdgcn_mfma_f32_16x16x32_bf16(vb[cc], wf[i][ks], acc[i][cc], 0, 0, 0); } }
      } }
    asm volatile("" ::: "memory");
    const int gi2 = w >> 2, nq = w & 3, chc = 256 * hh + 128 * gi2 + 32 * nq + 8 * fq;
    bf16x8 pw0[4], pw1[4]; u32x4 sgv[8];
    { const bf16_t* pw = c.PoolWT + ((size_t)(l * 4 + 2 * hh + gi2) * 128 + 32 * nq + fr) * 128 + 8 * fq;
#pragma unroll
      for (int ks = 0; ks < 4; ++ks) { pw0[ks] = *(const bf16x8*)(pw + 32 * ks); pw1[ks] = *(const bf16x8*)(pw + 16 * 128 + 32 * ks); }
#pragma unroll
      for (int m = 0; m < 8; ++m) sgv[m] = *(const u32x4*)(pb + (size_t)(16 * m + fr) * PC + PSG + chc); }
    const f32x4 pb0 = *(const f32x4*)(c.pool_b + l * W + chc), pb1 = *(const f32x4*)(c.pool_b + l * W + chc + 4), ps0 = *(const f32x4*)(c.pool_scale + l * W + chc), ps1 = *(const f32x4*)(c.pool_scale + l * W + chc + 4);
#pragma unroll
    for (int i = 0; i < 4; ++i) { const int tb = a ? (i == 0 ? 1 : i == 1 ? 2 : i == 2 ? 5 : 6) : (i == 0 ? 0 : i == 1 ? 3 : i == 2 ? 4 : 7), t = 16 * tb + fr;
#pragma unroll
        for (int c2 = 0; c2 < 2; ++c2) { f32x4 u0, u1; unpk8(ug[i][c2], u0, u1);
            store8(c.y + (size_t)(row0 + t) * 1536 + 512 + 256 * hh + 64 * hq + 32 * c2 + 8 * fq, (acc[i][2 * c2] + bias[i]) * u0, (acc[i][2 * c2 + 1] + bias[i]) * u1); } }
    f32x4 ac2[8][2];
#pragma unroll
    for (int m = 0; m < 8; ++m) { ac2[m][0] = (f32x4){0.f, 0.f, 0.f, 0.f}; ac2[m][1] = (f32x4){0.f, 0.f, 0.f, 0.f}; }
#pragma unroll
    for (int ks = 0; ks < 4; ++ks)
#pragma unroll
        for (int m = 0; m < 8; ++m) { const bf16x8 af = *(const LAS bf16x8*)(lds + PM_OFF + (16 * m + fr) * TP + 2 * (128 * gi2 + 32 * ks + 8 * fq));
            ac2[m][0] = __builtin_amdgcn_mfma_f32_16x16x32_bf16(pw0[ks], af, ac2[m][0], 0, 0, 0); ac2[m][1] = __builtin_amdgcn_mfma_f32_16x16x32_bf16(pw1[ks], af, ac2[m][1], 0, 0, 0); }
#pragma unroll
    for (int m = 0; m < 8; ++m) { f32x4 s0, s1; unpk8(sgv[m], s0, s1);
        store8(c.y + (size_t)(row0 + 16 * m + fr) * 1536 + 1024 + chc, (ac2[m][0] + pb0) * ps0 * s0, (ac2[m][1] + pb1) * ps1 * s1); }
    __syncthreads();
}
DEV void ph_p2_prompt(const Args& a, int l, LAS unsigned char* lds) {
    LAUNDER_CTX(a);
    VB_LOAD(lds);
    {
        const int ck = 16 * vx_ + (vr_ >> 1), hh = vr_ & 1; const bf16_t* pb = c.pbuf + (size_t)ck * 128 * PC;
        p2_ln(c, l, ck, hh, pb, lds);
        { if (hh) p2_pool<1>(c, l, ck, pb, lds); else p2_pool<0>(c, l, ck, pb, lds); }
        p2_conv(c, l, ck, hh, pb);
        p2_mm(c, l, ck, hh, pb, lds);
    }
    if (vr_ >= 30) {
        unsigned* ctl = (unsigned*)(a.ws + WS_CTL + z_);
        if (threadIdx.x == 0) { XB_SPIN(xb_ld(&ctl[XB_CNT_P1S]) < 960u * (unsigned)(l + 1), ctl); __builtin_amdgcn_fence(__ATOMIC_ACQUIRE, "agent"); asm volatile("s_waitcnt vmcnt(0)" ::: "memory"); }
        __syncthreads();
        p2_sample_block(c, l, 2 * vx_ + (vr_ - 30), lds); __syncthreads(); }
}
DEV void ph_final(const Args& a, LAS unsigned char* lds) {
    LAUNDER_CTX(a); VB_LOAD(lds);
    const int lane = c.lane;
#pragma unroll 2
    for (int i = 8 * vr_ + c.wave; i < 2048 + 16; i += 256) { const int row = i < 2048 ? 2048 * vx_ + i : MPR + 16 * vx_ + (i - 2048);
        const float r = row_rstd(c.ssq, row);
#pragma unroll
        for (int j = 0; j < 2; ++j) { f32x4 x0, x1; unpk8(*((const u32x4*)(c.xb + (size_t)row * D) + lane + 64 * j), x0, x1);
            const f32x4* gp = (const f32x4*)c.final_g + 2 * lane + 128 * j; f32x4* o = (f32x4*)(c.out + (size_t)row * D) + 2 * lane + 128 * j;
            o[0] = x0 * r * gp[0]; o[1] = x1 * r * gp[1]; }
    }
}

__global__ __launch_bounds__(NTHREADS, 2) void mega_fwd(Args a) {
    extern __shared__ __attribute__((aligned(16))) unsigned char lds[];
    LAS unsigned char* ldsp = (LAS unsigned char*)lds;
    if (threadIdx.x < 16) ((LAS unsigned*)(ldsp + LDSCTL_OFF))[threadIdx.x] = 0u;
    __syncthreads();
    const XcdBarrier bar = xcd_barrier_post((unsigned*)(a.ws + WS_CTL), (volatile LAS unsigned*)(ldsp + LDSCTL_OFF));
    ph_convert(a, lds, 0, 0);
    xcd_barrier(bar);
    { LAUNDER_CTX(a); int bx_ = blockIdx.x, gx_ = gridDim.x; asm volatile("" : "+s"(bx_), "+s"(gx_)); SchedMod S{gx_, bx_, (const char*)c.scb, (const char*)c.WadaT}; EpiRows<EpiMod> E{EpiMod{c.mod, c.atab, c.shb, c.b_ada, c.norm_g}}; gemm_phase(ldsp, D * 2, D * 2, D / BK, S, E); }
    ph_convert(a, lds, 1, (int)gridDim.x > 96 ? 48 : 0);
    xcd_barrier(bar);
    { LAUNDER_CTX(a); int bx_ = blockIdx.x, gx_ = gridDim.x; asm volatile("" : "+s"(bx_), "+s"(gx_)); SchedSW S{gx_, bx_, (const char*)c.shb, (const char*)c.WinT}; EpiRows<EpiSWx> E{EpiSWx{c.SW}}; gemm_phase(ldsp, D * 2, D * 2, D / BK, S, E); }
    ph_xa0(a);
    xcd_barrier(bar);
#pragma unroll 1
    for (int l = 0; l < DEPTH; ++l) {
        { LAUNDER_CTX(a); VB_LOAD(ldsp); SchedP1 S; S.T.init(8, NIN / 256, 32, vr_, 8 * vx_); S.A = (const char*)((l & 1) ? c.xa2 : c.xa); S.B = (const char*)(c.WinT + (size_t)l * NIN * D);
          p1_rtab(S, c.ssq, c.SW + (size_t)l * NBT * NIN, (LAS float*)(ldsp + RTAB_OFF), (LAS float*)(ldsp + SWT_OFF));
          EpiP1T E{c.pbuf, c.SW + (size_t)l * NBT * NIN, (const LAS float*)(ldsp + RTAB_OFF), (const LAS float*)(ldsp + SWT_OFF), c.lnst};
          gemm_phase(ldsp, D * 2, D * 2, D / BK, S, E);
          if (vr_ >= 16) {
              const EpiP1S es{c.pbuf, c.SW + (size_t)l * NBT * NIN, c.ssq};
              const int spn = vx_ + 8 * ((vr_ - 16) >> 2), sl = 4 * spn + (vr_ & 3);
              if (spn < 30) { unsigned* ctl = (unsigned*)(a.ws + WS_CTL + z_);
                  XB_SPIN(xb_ld(&ctl[XB_CNT_P4S]) < 128u * (unsigned)l, ctl);
                  __builtin_amdgcn_fence(__ATOMIC_ACQUIRE, "agent"); asm volatile("s_waitcnt vmcnt(0)" ::: "memory");
                  p1_sample_slice(c.tid, sl, (l & 1) ? c.xa2 : c.xa, c.WinT + (size_t)l * NIN * D, es, ldsp);
                  asm volatile("s_waitcnt vmcnt(0)" ::: "memory");
                  if (c.lane == 0) xb_add(&ctl[XB_CNT_P1S], 1u); } } }
        layer_barrier(bar);
        ph_p2_prompt(a, l, ldsp);
        layer_barrier(bar);
        { LAUNDER_CTX(a); VB_LOAD(ldsp); const EpiP3 e3{c.pbuf, c.mg};
          if (vr_ < 16) mini_gemm<3, 2>(a, ldsp, vx_ | (vr_ << 3), c.y, 1536, W, c.WbT + (size_t)l * 3 * D * W, W, (size_t)D * W, e3);
          SchedP3R S; S.T.init(8, 8, 32, vr_, 8 * vx_); S.A = (const char*)c.y; S.B = (const char*)(c.WbT + (size_t)l * 3 * D * W);
          f32x4 tot[2][4][2];
#pragma unroll
          for (int i0 = 0; i0 < 2; ++i0)
#pragma unroll
              for (int i1 = 0; i1 < 4; ++i1) { tot[i0][i1][0] = (f32x4){0.f, 0.f, 0.f, 0.f}; tot[i0][i1][1] = (f32x4){0.f, 0.f, 0.f, 0.f}; }
          u32x2 gpre[8]; EpiP3R E{tot, gpre, c.pbuf, c.mg};
          { UnitD u0; int t_ = threadIdx.x; asm volatile("" : "+v"(t_)); const int wv = __builtin_amdgcn_readfirstlane(t_ >> 6); if (S.next(0, u0)) E.prefetch(u0, wv >> 2, wv & 3, t_ & 15, (t_ & 63) >> 4); }
          gemm_phase<EpiP3R, SchedP3R, 1>(ldsp, 1536 * 2, W * 2, W / BK, S, E); }
        layer_barrier(bar);
        { LAUNDER_CTX(a); VB_LOAD(ldsp); const float* gate = c.mod + (size_t)l * NBT * 3072 + 2048;
          const float* atc = c.atab + (size_t)l * NBT * D; const float* atn = l + 1 < DEPTH ? c.atab + (size_t)(l + 1) * NBT * D : nullptr;
          const bf16_t* xai = (l & 1) ? c.xa2 : c.xa; bf16_t* xao = (l & 1) ? c.xa : c.xa2;
          const EpiP4 e4{gate, atc, atn, xai, xao, c.ssq, c.x_sample - (size_t)MPR * D, c.xb, l > 0};
          if (vr_ < 16) { mini_gemm<1, 4>(a, ldsp, vx_ | (vr_ << 3), c.mg, D, 0, c.WoT + (size_t)l * D * D, D, (size_t)0, e4);
              if (threadIdx.x == 0) { asm volatile("s_waitcnt vmcnt(0)" ::: "memory"); xb_add((unsigned*)(a.ws + WS_CTL + z_) + XB_CNT_P4S, 1u); } }
          SchedP4 S; S.T.init(8, 4, 32, vr_, 8 * vx_); S.A = (const char*)c.mg; S.B = (const char*)(c.WoT + (size_t)l * D * D);
          if (l == 0) { EpiP4T<false, false> E{gate, atc, atn, xai, xao, c.ssq, c.x_prompt, c.xb}; gemm_phase(ldsp, D * 2, D * 2, D / BK, S, E); }
          else if (l + 1 < DEPTH) { EpiP4T<true, false> E{gate, atc, atn, xai, xao, c.ssq, c.x_prompt, c.xb}; gemm_phase(ldsp, D * 2, D * 2, D / BK, S, E); }
          else { EpiP4T<true, true> E{gate, atc, atn, xai, xao, c.ssq, c.x_prompt, c.xb}; gemm_phase(ldsp, D * 2, D * 2, D / BK, S, E); } }
        layer_barrier(bar);
    }
    ph_final(a, ldsp);
}

extern "C" void kernel_launch(void* const* d_in, const int* in_sizes, int n_in, void* d_out, int out_size, void* d_ws, size_t ws_size, hipStream_t stream) {
    static int grid_blocks = 0;
    if (grid_blocks == 0) {
        if (n_in != 22 || ws_size < WS_END) { fprintf(stderr, "kernel_launch: unexpected n_in %d or ws_size %zu < %zu\n", n_in, ws_size, (size_t)WS_END); grid_blocks = -1; return; }
        int dev = 0, cus = 0, per_cu = 0;
        (void)hipGetDevice(&dev); (void)hipDeviceGetAttribute(&cus, hipDeviceAttributeMultiprocessorCount, dev);
        if (hipFuncSetAttribute((const void*)mega_fwd, hipFuncAttributeMaxDynamicSharedMemorySize, LDS_BYTES) != hipSuccess) { fprintf(stderr, "kernel_launch: hipFuncSetAttribute failed\n"); grid_blocks = -1; return; }
        if (hipOccupancyMaxActiveBlocksPerMultiprocessor(&per_cu, (const void*)mega_fwd, NTHREADS, LDS_BYTES) != hipSuccess || per_cu < 1) { fprintf(stderr, "kernel_launch: occupancy query gave %d\n", per_cu); grid_blocks = -1; return; }
        if (cus < 256) { fprintf(stderr, "kernel_launch: this kernel is laid out for >= 256 CUs (found %d)\n", cus); grid_blocks = -1; return; }
        grid_blocks = 256;
        fprintf(stderr, "kernel_launch: cus %d per_cu %d grid %d\n", cus, per_cu, grid_blocks);
    }
    if (grid_blocks < 0) return;
    Args a{};
    for (int i = 0; i < 22; ++i) a.in[i] = (const float*)d_in[i];
    a.out = (float*)d_out; a.ws = (unsigned char*)d_ws;
    if (hipMemsetAsync((char*)d_ws + WS_CTL, 0, CTL_BYTES, stream) != hipSuccess) { fprintf(stderr, "kernel_launch: memset failed\n"); return; }
    void* args[] = {&a};
    hipError_t e = hipLaunchCooperativeKernel((const void*)mega_fwd, dim3(grid_blocks), dim3(NTHREADS), args, LDS_BYTES, stream);
    if (e != hipSuccess) fprintf(stderr, "kernel_launch: cooperative launch failed: %s (grid %d)\n", hipGetErrorString(e), grid_blocks);
}
```

```cpp
#include <hip/hip_runtime.h>
#include <cstdio>
#include <cstdint>

#define DEV __device__ __forceinline__
typedef unsigned short bf16_t;
typedef short bf16x8 __attribute__((ext_vector_type(8)));
typedef float f32x4 __attribute__((ext_vector_type(4)));
typedef unsigned u32x4 __attribute__((ext_vector_type(4)));
typedef unsigned u32x2 __attribute__((ext_vector_type(2)));

constexpr int D = 1024, TSEQ = 2048, NBP = 8, MPR = NBP * TSEQ  , NSM = 128, MV = MPR + NSM  , MP = 16640  , NBT = NBP + NSM  ;
constexpr int W = 512, NIN = 7680, PC = 4608  , DEPTH = 4;
constexpr int PZ = 0, PABG = 512, PUG = 1024, PGV = 1536, PCX = 2048, PSG = 2560, PGATE = 3072;
constexpr float EPS = 1e-6f;
constexpr size_t O_Y = 0, O_YS = 16777216, O_CONVP = 16908288, O_CONVS = 16941056, O_POOLP = 17465344, O_POOLS = 17711104, O_VP = 21643264, O_VS = 23740416;

constexpr size_t al256(size_t x) { return (x + 255) & ~(size_t)255; }
constexpr size_t WS_WIN = 0;
constexpr size_t WS_WB = al256(WS_WIN + (size_t)DEPTH * NIN * D * 2);
constexpr size_t WS_WO = al256(WS_WB + (size_t)DEPTH * 3 * D * W * 2);
constexpr size_t WS_MOD = al256(WS_WO + (size_t)DEPTH * D * D * 2);
constexpr size_t WS_ATAB = al256(WS_MOD + (size_t)DEPTH * NBT * 3 * D * 4);
constexpr size_t WS_SHB = al256(WS_ATAB + (size_t)DEPTH * NBT * D * 4);
constexpr size_t WS_SW = al256(WS_SHB + (size_t)DEPTH * 256 * D * 2);
constexpr size_t WS_XA = al256(WS_SW + (size_t)DEPTH * NBT * NIN * 4);
constexpr size_t WS_SSQ = al256(WS_XA + (size_t)MP * D * 2);
constexpr size_t WS_PBUF = al256(WS_SSQ + (size_t)MP * 16 * 4);
constexpr size_t WS_Y = al256(WS_PBUF + (size_t)MP * PC * 2);
constexpr size_t WS_MG = al256(WS_Y + (size_t)MP * 1536 * 2);
constexpr size_t WS_SGUW = al256(WS_MG + (size_t)MP * D * 2);
constexpr size_t WS_POOLW = al256(WS_SGUW + (size_t)DEPTH * 8 * 128 * 128 * 2);
constexpr size_t WS_WADA = al256(WS_POOLW + (size_t)DEPTH * 4 * 128 * 128 * 2);
constexpr size_t WS_SCB = al256(WS_WADA + (size_t)DEPTH * 3072 * D * 2);
constexpr size_t WS_XB = al256(WS_SCB + (size_t)256 * D * 2);
constexpr size_t WS_XA2 = al256(WS_XB + (size_t)MV * D * 2);
constexpr size_t WS_LNST = al256(WS_XA2 + (size_t)MP * D * 2);
constexpr size_t WS_CTL = al256(WS_LNST + (size_t)MP * 16 * 4);
constexpr size_t CTL_BYTES = 32768;
constexpr size_t WS_END = al256(WS_CTL + CTL_BYTES);

constexpr int NTHREADS = 512, NWAVES = 8;
constexpr int LDS_BYTES = 155648;
constexpr int LDSCTL_OFF = LDS_BYTES - 256;

typedef __bf16 bf16x2_t __attribute__((ext_vector_type(2)));
typedef float f32x2_t __attribute__((ext_vector_type(2)));
DEV unsigned pk2(float lo, float hi) { const f32x2_t v = {lo, hi}; const bf16x2_t b = __builtin_convertvector(v, bf16x2_t); return __builtin_bit_cast(unsigned, b); }
typedef unsigned long long u64_t;
DEV u32x2 ld_sc8(const void* p) { const u64_t v = __hip_atomic_load((const u64_t*)p, __ATOMIC_RELAXED, __HIP_MEMORY_SCOPE_AGENT); return (u32x2){(unsigned)v, (unsigned)(v >> 32)}; }
DEV u32x4 ld_sc16(const void* p) { const u32x2 a = ld_sc8(p), b = ld_sc8((const char*)p + 8); return (u32x4){a.x, a.y, b.x, b.y}; }
DEV void st_sc8(void* p, u32x2 v) { __hip_atomic_store((u64_t*)p, (u64_t)v.x | ((u64_t)v.y << 32), __ATOMIC_RELAXED, __HIP_MEMORY_SCOPE_AGENT); }
DEV void st_sc16(void* p, u32x4 v) { st_sc8(p, (u32x2){v.x, v.y}); st_sc8((char*)p + 8, (u32x2){v.z, v.w}); }
DEV void store8_sc(bf16_t* p, f32x4 a, f32x4 b) { u32x4 w; w.x = pk2(a.x, a.y); w.y = pk2(a.z, a.w); w.z = pk2(b.x, b.y); w.w = pk2(b.z, b.w); st_sc16(p, w); }
DEV float row_rstd_sc(const float* ssq, int row) {
    float s = 0.f;
#pragma unroll
    for (int i = 0; i < 8; ++i) { const u32x2 v = ld_sc8(ssq + (size_t)row * 16 + 2 * i); const unsigned lo = v.x, hi = v.y; s += __builtin_bit_cast(float, lo) + __builtin_bit_cast(float, hi); }
    return __builtin_amdgcn_rsqf(s * (1.f / D) + EPS);
}
DEV float bflo(unsigned u) { return __builtin_bit_cast(float, u << 16); }
DEV float bfhi(unsigned u) { return __builtin_bit_cast(float, u & 0xffff0000u); }
DEV void unpk8(const u32x4 u, f32x4& a, f32x4& b) { a = (f32x4){bflo(u.x), bfhi(u.x), bflo(u.y), bfhi(u.y)}; b = (f32x4){bflo(u.z), bfhi(u.z), bflo(u.w), bfhi(u.w)}; }
DEV f32x4 gate4(unsigned u) { return (f32x4){(float)(u & 0xffu), (float)((u >> 8) & 0xffu), (float)((u >> 16) & 0xffu), (float)(u >> 24)} * (1.f / 255.f); }
DEV unsigned pku8(f32x4 s) { const unsigned a = (unsigned)(s.x * 255.f + 0.5f), b = (unsigned)(s.y * 255.f + 0.5f), c = (unsigned)(s.z * 255.f + 0.5f), d = (unsigned)(s.w * 255.f + 0.5f); return a | (b << 8) | (c << 16) | (d << 24); }
DEV f32x4 exp2_4(f32x4 t) { return (f32x4){__builtin_amdgcn_exp2f(t.x), __builtin_amdgcn_exp2f(t.y), __builtin_amdgcn_exp2f(t.z), __builtin_amdgcn_exp2f(t.w)}; }
DEV unsigned pku8_t(f32x4 t);
DEV f32x4 rcp4(f32x4 d) { return (f32x4){__builtin_amdgcn_rcpf(d.x), __builtin_amdgcn_rcpf(d.y), __builtin_amdgcn_rcpf(d.z), __builtin_amdgcn_rcpf(d.w)}; }
DEV unsigned pku8_t(f32x4 t) {
    const f32x4 g = rcp4(exp2_4(t) * (1.f / 255.f) + (1.f / 255.f)) + 8388608.f;
    const u32x4 gu = __builtin_bit_cast(u32x4, g);
    const unsigned p01 = __builtin_amdgcn_perm(gu.y, gu.x, 0x0c0c0400u), p23 = __builtin_amdgcn_perm(gu.w, gu.z, 0x0c0c0400u);
    return __builtin_amdgcn_perm(p23, p01, 0x05040100u);
}
DEV f32x4 sigmoid4(f32x4 x) { return rcp4(exp2_4(x * -1.44269504f) + 1.f); }
DEV f32x4 silu4(f32x4 x) { return x * sigmoid4(x); }
DEV f32x4 gelu4(f32x4 x) { const f32x4 t = x * (x * x * (-2.f * 0.7978845608f * 0.044715f * 1.44269504f) + (-2.f * 0.7978845608f * 1.44269504f)); return x * rcp4(exp2_4(t) + 1.f); }
DEV int perm32(int rho) { const int n = rho >> 4, i = rho & 15; return 8 * (i >> 2) + 4 * n + (i & 3); }
DEV int nidx_of(int row) { return row < MPR ? (row >> 11) : (row < MV ? NBP + (row - MPR) : NBT - 1); }
DEV int src_win(int j) {
    const int pn = j >> 8, c = j & 255, bj = c >> 7, cc = c & 127;
    if (pn < 4) return (bj ? 1024 : 512) + 128 * pn + cc;
    if (pn < 8) return (bj ? 1536 : 0) + 128 * (pn - 4) + cc;
    if (pn < 12) return (bj ? 3072 : 2048) + 128 * (pn - 8) + cc;
    if (pn < 14) return 2560 + 256 * (pn - 12) + c;
    if (pn < 16) return 3584 + 256 * (pn - 14) + c;
    if (pn < 18) return 4096 + 256 * (pn - 16) + c;
    return 4608 + 256 * (pn - 18) + c;
}

struct Args { const float* in[22]; float* out; unsigned char* ws; };
struct Ctx {
    const float *x_prompt, *x_sample, *c_prompt, *c_sample, *state_conv, *state_pool, *w_ada, *b_ada, *norm_g, *w_in, *conv_w, *conv_b, *lnv_g, *lnv_b, *sgu_w, *sgu_b, *pool_w, *pool_b, *pool_scale, *w_branch, *w_out, *final_g;
    float* out; bf16_t *WinT, *WbT, *WoT; float *mod, *atab; bf16_t* shb; float* SW; bf16_t* xa; float* ssq; bf16_t *pbuf, *y, *mg; bf16_t *SguW, *PoolWT, *WadaT, *scb, *xb, *xa2; float* lnst;
    unsigned char* lds;
    int tid, lane, wave, gw, NGW, gtid, NGT;
};

DEV Ctx make_ctx(const Args& a, size_t z) {
    Ctx c;
    c.x_prompt = a.in[0] + z; c.x_sample = a.in[1] + z; c.c_prompt = a.in[2] + z; c.c_sample = a.in[3] + z; c.state_conv = a.in[4] + z; c.state_pool = a.in[5] + z; c.w_ada = a.in[6] + z; c.b_ada = a.in[7] + z;
    c.norm_g = a.in[8] + z; c.w_in = a.in[9] + z; c.conv_w = a.in[10] + z; c.conv_b = a.in[11] + z; c.lnv_g = a.in[12] + z; c.lnv_b = a.in[13] + z; c.sgu_w = a.in[14] + z; c.sgu_b = a.in[15] + z;
    c.pool_w = a.in[16] + z; c.pool_b = a.in[17] + z; c.pool_scale = a.in[18] + z; c.w_branch = a.in[19] + z; c.w_out = a.in[20] + z; c.final_g = a.in[21] + z;
    c.out = a.out + z; unsigned char* ws = a.ws + z;
    c.WinT = (bf16_t*)(ws + WS_WIN); c.WbT = (bf16_t*)(ws + WS_WB); c.WoT = (bf16_t*)(ws + WS_WO);
    c.mod = (float*)(ws + WS_MOD); c.atab = (float*)(ws + WS_ATAB); c.shb = (bf16_t*)(ws + WS_SHB); c.SW = (float*)(ws + WS_SW);
    c.xa = (bf16_t*)(ws + WS_XA); c.ssq = (float*)(ws + WS_SSQ); c.pbuf = (bf16_t*)(ws + WS_PBUF); c.y = (bf16_t*)(ws + WS_Y); c.mg = (bf16_t*)(ws + WS_MG);
    c.WadaT = (bf16_t*)(ws + WS_WADA); c.scb = (bf16_t*)(ws + WS_SCB); c.xb = (bf16_t*)(ws + WS_XB); c.xa2 = (bf16_t*)(ws + WS_XA2); c.lnst = (float*)(ws + WS_LNST); c.SguW = (bf16_t*)(ws + WS_SGUW); c.PoolWT = (bf16_t*)(ws + WS_POOLW);
    c.lds = nullptr; c.tid = 0; c.lane = 0; c.wave = 0; c.gw = 0; c.NGW = 0; c.gtid = 0; c.NGT = 0;
    return c;
}
#define LAUNDER_CTX(a) size_t z_ = 0; asm volatile("" : "+s"(z_)); Ctx c = make_ctx(a, z_); { int t_ = threadIdx.x; asm volatile("" : "+v"(t_)); c.tid = t_; c.lane = t_ & 63; c.wave = __builtin_amdgcn_readfirstlane(t_ >> 6); \
    c.gw = blockIdx.x * NWAVES + c.wave; c.NGW = gridDim.x * NWAVES; c.gtid = blockIdx.x * NTHREADS + t_; c.NGT = gridDim.x * NTHREADS; }
#define VB_LOAD(ldsp) const int vb_ = __builtin_amdgcn_readfirstlane((int)((volatile LAS unsigned*)((ldsp) + LDSCTL_OFF))[2]); const int vx_ = vb_ >> 5, vr_ = vb_ & 31;
struct MapWin { DEV int operator()(int g) const { return src_win((g & ~31) + perm32(g & 31)); } };
struct MapPerm { DEV int operator()(int g) const { return (g & ~31) + perm32(g & 31); } };
template <class Map>
DEV void transpose_item(const float* Wsrc, int ldw, int K, bf16_t* WT, int nblk, int item, float* scr, int lane, Map map) {
    const int kb = item / nblk, nb = item % nblk, k0 = 64 * kb, g0 = 32 * nb;
    const int scol = map(g0 + (lane & 31));
#pragma unroll 8
    for (int i = 0; i < 32; ++i) { const int kk = 2 * i + (lane >> 5); scr[kk * 33 + (lane & 31)] = Wsrc[(size_t)(k0 + kk) * ldw + scol]; }
    asm volatile("s_waitcnt lgkmcnt(0)" ::: "memory");
    const int c = lane & 7;
#pragma unroll
    for (int j = 0; j < 4; ++j) { const int n = (lane >> 3) + 8 * j; const float* s = scr + (8 * c) * 33 + n;
        u32x4 o; o.x = pk2(s[0 * 33], s[1 * 33]); o.y = pk2(s[2 * 33], s[3 * 33]); o.z = pk2(s[4 * 33], s[5 * 33]); o.w = pk2(s[6 * 33], s[7 * 33]);
        *(u32x4*)(WT + (size_t)(g0 + n) * K + k0 + 8 * c) = o; }
    asm volatile("s_waitcnt lgkmcnt(0)" ::: "memory");
}
constexpr int IT_WIN = (D / 64) * (NIN / 32), IT_WB = (W / 64) * (D / 32), IT_WO = (D / 64) * (D / 32);
constexpr int IT_PW = (128 / 64) * (128 / 32);
constexpr int IT_WADA = (D / 64) * (3072 / 32);
constexpr int IT_TOTAL = DEPTH * IT_WIN + DEPTH * 3 * IT_WB + DEPTH * IT_WO + DEPTH * 4 * IT_PW + DEPTH * IT_WADA;
DEV void ph_convert(const Args& a, unsigned char* lds, const int stage, const int b0) {
    LAUNDER_CTX(a);
    float* scr = (float*)(lds + c.wave * 16384);
    const int nb = (int)gridDim.x - b0, bw = ((int)blockIdx.x - b0) * NWAVES + c.wave, nw = nb * NWAVES, bt = ((int)blockIdx.x - b0) * NTHREADS + c.tid, nthr = nb * NTHREADS;
    if ((int)blockIdx.x < b0) return;
    if (stage == 0) {
        for (int r = bw; r < DEPTH * IT_WADA; r += nw) { const int l = r / IT_WADA; transpose_item(c.w_ada + (size_t)l * D * 3072, 3072, D, c.WadaT + (size_t)l * 3072 * D, 3072 / 32, r - l * IT_WADA, scr, c.lane, MapPerm()); }
        for (int idx = bt; idx < 256 * D / 4; idx += nthr) { const int n = idx >> 8, k4 = (idx & 255) * 4; f32x4 v = (f32x4){0.f, 0.f, 0.f, 0.f};
            if (n < NBT) { v = *(const f32x4*)((n < NBP ? c.c_prompt + (size_t)n * D : c.c_sample + (size_t)(n - NBP) * D) + k4); v = silu4(v); }
            *((u32x2*)c.scb + idx) = (u32x2){pk2(v.x, v.y), pk2(v.z, v.w)}; }
        return;
    }
    for (int it = bw; it < IT_TOTAL - DEPTH * IT_WADA; it += nw) {
        int r = it;
        if (r < DEPTH * IT_WIN) { const int l = r / IT_WIN; r -= l * IT_WIN; transpose_item(c.w_in + (size_t)l * D * NIN, NIN, D, c.WinT + (size_t)l * NIN * D, NIN / 32, r, scr, c.lane, MapWin()); continue; }
        r -= DEPTH * IT_WIN;
        if (r < DEPTH * 3 * IT_WB) { const int li = r / IT_WB; r -= li * IT_WB; transpose_item(c.w_branch + (size_t)li * W * D, D, W, c.WbT + (size_t)li * D * W, D / 32, r, scr, c.lane, MapPerm()); continue; }
        r -= DEPTH * 3 * IT_WB;
        if (r < DEPTH * IT_WO) { const int l = r / IT_WO; r -= l * IT_WO; transpose_item(c.w_out + (size_t)l * D * D, D, D, c.WoT + (size_t)l * D * D, D / 32, r, scr, c.lane, MapPerm()); continue; }
        r -= DEPTH * IT_WO;
        { const int lg = r / IT_PW; r -= lg * IT_PW; transpose_item(c.pool_w + (size_t)lg * 128 * 128, 128, 128, c.PoolWT + (size_t)lg * 128 * 128, 4, r, scr, c.lane, MapPerm()); }
    }
    for (int idx = bt; idx < DEPTH * 8 * 128 * 128 / 4; idx += nthr) { const int s4 = (idx & 31) * 4, t = (idx >> 5) & 127; const f32x4 v = *((const f32x4*)c.sgu_w + idx);
        *((u32x2*)c.SguW + idx) = (u32x2){pk2(s4 <= t ? v.x : 0.f, s4 + 1 <= t ? v.y : 0.f), pk2(s4 + 2 <= t ? v.z : 0.f, s4 + 3 <= t ? v.w : 0.f)}; }
}
DEV void ph_xa0(const Args& a) {
    LAUNDER_CTX(a);
    const int lane = c.lane, NSW = DEPTH * 30;
    if ((int)gridDim.x <= NSW || (int)blockIdx.x < NSW) { if ((int)gridDim.x > NSW) return; }
    const int w0 = ((int)gridDim.x > NSW) ? ((int)blockIdx.x - NSW) * NWAVES + c.wave : c.gw, nw = ((int)gridDim.x > NSW) ? ((int)gridDim.x - NSW) * NWAVES : c.NGW;
    for (int row = MV + w0; row < MP; row += nw) { u32x2* xo = (u32x2*)(c.xa + (size_t)row * D) + lane;
#pragma unroll
        for (int j = 0; j < 4; ++j) { xo[64 * j] = (u32x2){0u, 0u}; ((u32x2*)(c.xa2 + (size_t)row * D) + lane)[64 * j] = (u32x2){0u, 0u}; }
        if (lane < 16) c.ssq[row * 16 + lane] = 0.f; }
#pragma unroll 2
    for (int row = w0; row < MV; row += nw) {
        u32x2* xo = (u32x2*)(c.xa + (size_t)row * D) + lane;
        const float* xr = row < MPR ? c.x_prompt + (size_t)row * D : c.x_sample + (size_t)(row - MPR) * D;
        const float* ar = c.atab + (size_t)nidx_of(row) * D;
#pragma unroll
        for (int j = 0; j < 4; ++j) {
            const f32x4 v = *((const f32x4*)xr + lane + 64 * j), at = *((const f32x4*)ar + lane + 64 * j);
            const u32x2 pv = (u32x2){pk2(v.x * at.x, v.y * at.y), pk2(v.z * at.z, v.w * at.w)};
            if (row >= MPR) st_sc8(&xo[64 * j], pv); else xo[64 * j] = pv;
            float s = (v.x * v.x + v.y * v.y) + (v.z * v.z + v.w * v.w);
            s += __shfl_xor(s, 1); s += __shfl_xor(s, 2); s += __shfl_xor(s, 4); s += __shfl_xor(s, 32);
            if ((lane & 39) == 0) { if (row >= MPR) __hip_atomic_store(c.ssq + row * 16 + 4 * j + (lane >> 3), s, __ATOMIC_RELAXED, __HIP_MEMORY_SCOPE_AGENT); else c.ssq[row * 16 + 4 * j + (lane >> 3)] = s; }
        }
    }
}
DEV float row_rstd(const float* ssq, int row) {
    const f32x4* p = (const f32x4*)(ssq + (size_t)row * 16); const f32x4 a = p[0], b = p[1], c = p[2], d = p[3];
    const float s = ((a.x + a.y) + (a.z + a.w)) + ((b.x + b.y) + (b.z + b.w)) + ((c.x + c.y) + (c.z + c.w)) + ((d.x + d.y) + (d.z + d.w));
    return __builtin_amdgcn_rsqf(s * (1.f / D) + EPS);
}

DEV void store8(bf16_t* p, f32x4 a, f32x4 b) { u32x4 w; w.x = pk2(a.x, a.y); w.y = pk2(a.z, a.w); w.z = pk2(b.x, b.y); w.w = pk2(b.z, b.w); *(u32x4*)p = w; }

#define LAS __attribute__((address_space(3)))
constexpr int BK = 64, HALF = 128, HTB = HALF * BK * 2, STAGE_BYTES = 8 * HTB;
DEV int lds_byte(int r, int c) { const int st = (r >> 4) * 2 + (c >> 5), rr = r & 15, cc = c & 31, ob = rr * 64 + cc * 2; return st * 1024 + (ob ^ (((ob >> 9) & 1) << 5)); }
DEV void stage_rc(int b, int& R, int& C) { const int st = b / 1024, sb = b % 1024, swz = sb ^ (((sb >> 9) & 1) << 5); R = (st >> 1) * 16 + swz / 64; C = (st & 1) * 32 + (swz % 64) / 2; }
struct UnitD { const char* A; const char* B; int pm, pn, aux; };
constexpr int NXCD = 8;
constexpr int WGM_P1 = 4, WGM_P3 = 4, WGM_P4 = 8;
struct TileOrder {
    int nM, nN, nwg, G, c, pm0;
    DEV void init(int nM_, int nN_, int G_, int c_, int pm0_) { nM = nM_; nN = nN_; nwg = nM * nN; G = G_; c = c_; pm0 = pm0_; }
    template <int WGM> DEV bool tile(int i, int& pm, int& pn) const {
        const int wgid = i * G + c; if (wgid >= nwg) return false;
        const int nig = WGM * nN, gid = wgid / nig, fm = gid * WGM, gsz = (nM - fm) < WGM ? (nM - fm) : WGM;
        pm = pm0 + fm + ((wgid % nig) % gsz); pn = (wgid % nig) / gsz; return true;
    }
};
template <class Epi, class Sched, int NBH = 2>
DEV void gemm_phase(LAS unsigned char* lds, const int lda  , const int ldb  , const int nt  , const Sched& S, const Epi& E) {
    int tid = threadIdx.x; asm volatile("" : "+v"(tid));
    const int wid = __builtin_amdgcn_readfirstlane(tid >> 6), lane = tid & 63, wr = wid >> 2, wc = wid & 3, fr = lane & 15, fq = lane >> 4;
    unsigned voffA[2], voffB[2];
#pragma unroll
    for (int i = 0; i < 2; ++i) { int R, C; stage_rc(tid * 16 + i * 8192, R, C); voffA[i] = (unsigned)(R * lda + C * 2); voffB[i] = (unsigned)(R * ldb + C * 2); }
    const size_t kstep = (size_t)(BK * 2);
    const size_t hstepA = (size_t)HALF * lda, hstepB = (size_t)HALF * ldb;
    const unsigned ldsw = (unsigned)wid * 1024u;
    const int aoff = lds_byte(wr * 64 + fr, fq * 8), boff = lds_byte(wc * 32 + fr, fq * 8);
#define PG8_SA(b, h) (((b) * 2 + (h)) * HTB)
#define PG8_SB(b, h) ((4 + (b) * 2 + (h)) * HTB)
#define PG8_STAGE(bufoff, gbase, voff) do { _Pragma("unroll") for (int _i = 0; _i < 2; ++_i) \
        __builtin_amdgcn_global_load_lds((const unsigned*)((const char*)(gbase) + (voff)[_i]), (LAS unsigned*)(lds + (bufoff) + ldsw + _i * 8192), 16, 0, 0); } while (0)
#define PG8_LDA(dst, b, h) do { _Pragma("unroll") for (int m = 0; m < 4; ++m) _Pragma("unroll") for (int k = 0; k < 2; ++k) dst[m][k] = *(const LAS bf16x8*)(lds + PG8_SA(b, h) + aoff + m * 2048 + k * 1024); } while (0)
#define PG8_LDB(dst, b, h) do { _Pragma("unroll") for (int n = 0; n < 2; ++n) _Pragma("unroll") for (int k = 0; k < 2; ++k) dst[n][k] = *(const LAS bf16x8*)(lds + PG8_SB(b, h) + boff + n * 2048 + k * 1024); } while (0)
#define PG8_MMA(ai, bj, At, Bt) do { __builtin_amdgcn_s_setprio(1); _Pragma("unroll") for (int m = 0; m < 4; ++m) _Pragma("unroll") for (int n = 0; n < 2; ++n) _Pragma("unroll") for (int k = 0; k < 2; ++k) \
        acc[ai][bj][m][n] = __builtin_amdgcn_mfma_f32_16x16x32_bf16(Bt[n][k], At[m][k], acc[ai][bj][m][n], 0, 0, 0); __builtin_amdgcn_s_setprio(0); } while (0)
#define PG8_WAIT_V(n) asm volatile("s_waitcnt vmcnt(" #n ")" ::: "memory")
#define PG8_WAIT_VN() do { if constexpr (NBH == 2) PG8_WAIT_V(8); else PG8_WAIT_V(6); } while (0)
#define PG8_WAIT_L(n) asm volatile("s_waitcnt lgkmcnt(" #n ")" ::: "memory")
#define PG8_BAR __builtin_amdgcn_s_barrier()
#define PG8_SCHED __builtin_amdgcn_sched_barrier(0)
    UnitD cur, nxt; int ui = 0;
    if (!S.next(0, cur)) return;
    f32x4 acc[2][NBH][4][2];
#pragma unroll
    for (int a = 0; a < 2; ++a)
#pragma unroll
        for (int b = 0; b < NBH; ++b)
#pragma unroll
            for (int m = 0; m < 4; ++m)
#pragma unroll
                for (int n = 0; n < 2; ++n) acc[a][b][m][n] = (f32x4){0.f, 0.f, 0.f, 0.f};
    bf16x8 At[4][2], B0[2][2], B1[2][2];
    const char* cA = cur.A; const char* cB = cur.B;
    PG8_STAGE(PG8_SB(0, 0), cB, voffB); if constexpr (NBH == 2) PG8_STAGE(PG8_SB(0, 1), cB + hstepB, voffB); PG8_STAGE(PG8_SA(0, 0), cA, voffA); PG8_STAGE(PG8_SA(0, 1), cA + hstepA, voffA);
    if (wr == 1) PG8_BAR;
    PG8_WAIT_V(2); PG8_BAR;
    PG8_STAGE(PG8_SB(1, 0), cB + kstep, voffB); PG8_STAGE(PG8_SA(1, 0), cA + kstep, voffA); if constexpr (NBH == 2) PG8_STAGE(PG8_SB(1, 1), cB + hstepB + kstep, voffB);
    if constexpr (NBH == 2) PG8_WAIT_V(6); else PG8_WAIT_V(4);
    PG8_BAR;
    for (;;) {
        const bool has_next = S.next(ui + 1, nxt);
        const char* nA = has_next ? nxt.A : cA; const char* nB = has_next ? nxt.B : cB;
        for (int t = 0; t < nt; t += 2) {
            const bool last = (t == nt - 2);
            const char* a1 = cA + (size_t)(t + 1) * kstep;
            const char* a2 = last ? nA : cA + (size_t)(t + 2) * kstep; const char* b2 = last ? nB : cB + (size_t)(t + 2) * kstep;
            const char* a3 = a2 + kstep; const char* b3 = b2 + kstep;
            PG8_LDB(B0, 0, 0); if constexpr (NBH == 2) PG8_LDB(B1, 0, 1); PG8_SCHED; PG8_LDA(At, 0, 0); PG8_STAGE(PG8_SA(1, 1), a1 + hstepA, voffA);
            PG8_WAIT_VN(); PG8_WAIT_L(0); PG8_BAR; PG8_MMA(0, 0, At, B0); if constexpr (NBH == 2) PG8_MMA(0, 1, At, B1); PG8_BAR; PG8_SCHED;
            PG8_LDA(At, 0, 1); PG8_STAGE(PG8_SB(0, 0), b2, voffB); if constexpr (NBH == 2) PG8_STAGE(PG8_SB(0, 1), b2 + hstepB, voffB); PG8_STAGE(PG8_SA(0, 0), a2, voffA);
            PG8_WAIT_VN(); PG8_WAIT_L(0); PG8_BAR; PG8_MMA(1, 0, At, B0); if constexpr (NBH == 2) PG8_MMA(1, 1, At, B1); PG8_BAR; PG8_SCHED;
            PG8_LDB(B0, 1, 0); if constexpr (NBH == 2) PG8_LDB(B1, 1, 1); PG8_SCHED; PG8_LDA(At, 1, 0); PG8_STAGE(PG8_SA(0, 1), a2 + hstepA, voffA);
            PG8_WAIT_VN(); PG8_WAIT_L(0); PG8_BAR; PG8_MMA(0, 0, At, B0); if constexpr (NBH == 2) PG8_MMA(0, 1, At, B1); PG8_BAR; PG8_SCHED;
            PG8_LDA(At, 1, 1); PG8_STAGE(PG8_SB(1, 0), b3, voffB); if constexpr (NBH == 2) PG8_STAGE(PG8_SB(1, 1), b3 + hstepB, voffB); PG8_STAGE(PG8_SA(1, 0), a3, voffA);
            PG8_WAIT_VN(); PG8_WAIT_L(0); PG8_BAR; PG8_MMA(1, 0, At, B0); if constexpr (NBH == 2) PG8_MMA(1, 1, At, B1); PG8_BAR; PG8_SCHED;
        }
        if (wr == 0) PG8_BAR;
        E(acc, cur, nxt, has_next, wr, wc, fr, fq);
        if (!has_next) break;
#pragma unroll
        for (int a = 0; a < 2; ++a)
#pragma unroll
            for (int b = 0; b < NBH; ++b)
#pragma unroll
                for (int m = 0; m < 4; ++m)
#pragma unroll
                    for (int n = 0; n < 2; ++n) acc[a][b][m][n] = (f32x4){0.f, 0.f, 0.f, 0.f};
        cur = nxt; cA = nA; cB = nB; ++ui;
        if (wr == 1) PG8_BAR;
    }
    PG8_WAIT_V(0);
    PG8_BAR;
#undef PG8_SA
#undef PG8_SB
#undef PG8_STAGE
#undef PG8_LDA
#undef PG8_LDB
#undef PG8_MMA
#undef PG8_WAIT_V
#undef PG8_WAIT_L
#undef PG8_WAIT_VN
#undef PG8_BAR
#undef PG8_SCHED
}


struct SchedMod { int G, c; const char* A; const char* B;
    DEV bool next(int i, UnitD& u) const { const int idx = i * G + c; if (idx >= 48) return false; u.pm = 0; u.pn = idx; u.aux = 0; u.A = A; u.B = B + (size_t)idx * 256 * (D * 2); return true; } };
struct EpiMod { float* mod; float* atab; bf16_t* shb; const float* b_ada; const float* norm_g;
    DEV void operator()(int pn, int row, int wc, int fq, f32x4 (&v)[2][2]) const {
#pragma unroll
        for (int bj = 0; bj < 2; ++bj) { const int gc = 256 * pn + 128 * bj + 32 * wc + 8 * fq, l = gc / 3072, j3 = gc - l * 3072;
            const f32x4 v0 = v[bj][0] + *(const f32x4*)(b_ada + gc), v1 = v[bj][1] + *(const f32x4*)(b_ada + gc + 4);
            if (row < NBT) { float* o = mod + ((size_t)l * NBT + row) * 3072 + j3; *(f32x4*)o = v0; *(f32x4*)(o + 4) = v1; }
            if (j3 < D) { const f32x4 z = (f32x4){0.f, 0.f, 0.f, 0.f}; store8(shb + ((size_t)l * 256 + row) * D + j3, row < NBT ? v0 : z, row < NBT ? v1 : z); }
            else if (j3 < 2 * D && row < NBT) { const float* ng = norm_g + l * D + (j3 - D); float* o = atab + ((size_t)l * NBT + row) * D + (j3 - D);
                f32x4 a0 = *(const f32x4*)ng * (v0 + 1.f), a1 = *(const f32x4*)(ng + 4) * (v1 + 1.f);
#pragma unroll
                for (int j = 0; j < 4; ++j) { a0[j] = __builtin_fabsf(a0[j]) < 1e-20f ? 1e-20f : a0[j]; a1[j] = __builtin_fabsf(a1[j]) < 1e-20f ? 1e-20f : a1[j]; }
                *(f32x4*)o = a0; *(f32x4*)(o + 4) = a1; }
        }
    } };
template <int NSEG, int KS  , class RowEpi>
DEV void mini_gemm(const Args& a, LAS unsigned char* lds, int u, const bf16_t* A, int lda, int a_seg, const bf16_t* Bt, int ldb, size_t b_seg, const RowEpi& e) {
    LAUNDER_CTX(a);
    const int lane = c.lane, w = c.wave, fr = lane & 15, fq = lane >> 4, rb = u & 7, pn = u >> 5, wc = (u >> 3) & 3, row = MPR + 16 * rb + fr, kw = 32 * KS;
    bf16x8 af[NSEG][KS], bf[NSEG][KS][4];
#pragma unroll
    for (int s = 0; s < NSEG; ++s) { const bf16_t* ap = A + (size_t)row * lda + s * a_seg + w * kw + 8 * fq; const bf16_t* bp = Bt + s * b_seg + (size_t)(256 * pn + 32 * wc + fr) * ldb + w * kw + 8 * fq;
#pragma unroll
        for (int k = 0; k < KS; ++k) { af[s][k] = *(const bf16x8*)(ap + 32 * k);
#pragma unroll
            for (int q = 0; q < 4; ++q) bf[s][k][q] = *(const bf16x8*)(bp + (size_t)(128 * (q >> 1) + 16 * (q & 1)) * ldb + 32 * k); } }
    f32x4 acc[NSEG][4];
#pragma unroll
    for (int s = 0; s < NSEG; ++s) {
#pragma unroll
        for (int q = 0; q < 4; ++q) acc[s][q] = (f32x4){0.f, 0.f, 0.f, 0.f};
#pragma unroll
        for (int k = 0; k < KS; ++k)
#pragma unroll
            for (int q = 0; q < 4; ++q) acc[s][q] = __builtin_amdgcn_mfma_f32_16x16x32_bf16(bf[s][k][q], af[s][k], acc[s][q], 0, 0, 0);
    }
#pragma unroll
    for (int s = 0; s < NSEG; ++s)
#pragma unroll
        for (int q = 0; q < 4; ++q) *(LAS f32x4*)(lds + (((w * NSEG + s) * 4 + q) * 64 + lane) * 16) = acc[s][q];
    __syncthreads();
    if (w == 0) {
        f32x4 v[NSEG][2][2];
#pragma unroll
        for (int s = 0; s < NSEG; ++s)
#pragma unroll
            for (int q = 0; q < 4; ++q) { f32x4 t = *(const LAS f32x4*)(lds + (((0 * NSEG + s) * 4 + q) * 64 + lane) * 16);
#pragma unroll
                for (int ww = 1; ww < 8; ++ww) t += *(const LAS f32x4*)(lds + (((ww * NSEG + s) * 4 + q) * 64 + lane) * 16);
                v[s][q >> 1][q & 1] = t; }
        e(pn, row, wc, fq, v);
    }
    __syncthreads();
}

constexpr int RTAB_OFF = STAGE_BYTES;
constexpr int SWT_OFF = RTAB_OFF + 8192;
template <int TY, bool SMP> DEV void p1_rows(const f32x4 (&acc)[2][2][4][2], bf16_t* pb  , const LAS float* rt, const float* swb, const int row0, f32x4 s00, f32x4 s01, f32x4 s10, f32x4 s11, float* st = nullptr  ) {
    if (TY == 6 && !SMP) { s00 *= -1.44269504f; s01 *= -1.44269504f; s10 *= -1.44269504f; s11 *= -1.44269504f; }
    f32x4 n00 = s00, n01 = s01, n10 = s10, n11 = s11;
    if (SMP) { const float* sw = swb + (size_t)nidx_of(row0) * NIN; n00 = *(const f32x4*)(sw); n01 = *(const f32x4*)(sw + 4); n10 = *(const f32x4*)(sw + 128); n11 = *(const f32x4*)(sw + 132); }
#pragma unroll
    for (int ai = 0; ai < 2; ++ai) {
#pragma unroll
        for (int m = 0; m < 4; ++m) { const int rl = ai * HALF + m * 16; const float r = (TY == 6 && !SMP) ? rt[rl] * -1.44269504f : rt[rl];
            if (SMP) { s00 = n00; s01 = n01; s10 = n10; s11 = n11;
                if (ai * 4 + m < 7) { const int rn = ((ai * 4 + m + 1) >> 2) * HALF + ((ai * 4 + m + 1) & 3) * 16; const float* sw = swb + (size_t)nidx_of(row0 + rn) * NIN; n00 = *(const f32x4*)(sw); n01 = *(const f32x4*)(sw + 4); n10 = *(const f32x4*)(sw + 128); n11 = *(const f32x4*)(sw + 132); } }
            f32x4 a0 = acc[ai][0][m][0] * r + s00, a1 = acc[ai][0][m][1] * r + s01, b0 = acc[ai][1][m][0] * r + s10, b1 = acc[ai][1][m][1] * r + s11;
            bf16_t* pr = pb + (size_t)rl * PC;
            if (TY == 0) { store8(pr, a0 * b0, a1 * b1); }
            else if (TY == 1) { store8(pr, a0 * silu4(b0), a1 * silu4(b1)); }
            else if (TY == 2) { store8(pr, gelu4(a0) * silu4(b0), gelu4(a1) * silu4(b1)); }
            else {
                if (TY == 3) { a0 = gelu4(a0); a1 = gelu4(a1); b0 = gelu4(b0); b1 = gelu4(b1); }
                if (TY == 3) {
                    const f32x4 sv = (a0 + a1) + (b0 + b1), qv = (a0 * a0 + a1 * a1) + (b0 * b0 + b1 * b1);
                    float s = (sv.x + sv.y) + (sv.z + sv.w), q = (qv.x + qv.y) + (qv.z + qv.w);
                    s += __shfl_xor(s, 16); q += __shfl_xor(q, 16); s += __shfl_xor(s, 32); q += __shfl_xor(q, 32);
                    if (st) *(f32x2_t*)(st + (size_t)rl * 16) = (f32x2_t){s, q}; }
                if (TY == 5) { a0 = silu4(a0); a1 = silu4(a1); b0 = silu4(b0); b1 = silu4(b1); }
                if (TY == 6 && SMP) { a0 = sigmoid4(a0); a1 = sigmoid4(a1); b0 = sigmoid4(b0); b1 = sigmoid4(b1); }
                if (TY == 6) { unsigned char* gq = (unsigned char*)pr; if (SMP) { *(u32x2*)gq = (u32x2){pku8(a0), pku8(a1)}; *(u32x2*)(gq + 128) = (u32x2){pku8(b0), pku8(b1)}; } else { *(u32x2*)gq = (u32x2){pku8_t(a0), pku8_t(a1)}; *(u32x2*)(gq + 128) = (u32x2){pku8_t(b0), pku8_t(b1)}; } }
                else { store8(pr, a0, a1); store8(pr + 128, b0, b1); } }
        }
        if (!SMP) asm volatile("" ::: "memory");
    }
}
struct EpiP1T { bf16_t* pbuf; const float* SWl; const LAS float* rtab; const LAS float* swt; float* lnst;
    DEV void operator()(f32x4 (&acc)[2][2][4][2], const UnitD& u, const UnitD& un, const bool has_next, int wr, int wc, int fr, int fq) const {
        const int pn = u.pn, cb = 32 * wc + 8 * fq, row0 = u.pm * 256 + wr * 64 + fr; const bool smp = u.pm >= MPR / 256;
        const float* swb = SWl + 256 * pn + cb; const LAS float* sw = swt + u.aux * 256 + cb;
        const f32x4 s00 = *(const LAS f32x4*)(sw), s01 = *(const LAS f32x4*)(sw + 4), s10 = *(const LAS f32x4*)(sw + 128), s11 = *(const LAS f32x4*)(sw + 132);
        const LAS float* rt = rtab + u.aux * 256 + wr * 64 + fr;
        bf16_t* pb = pbuf + (size_t)row0 * PC + cb;
#define P1_DISPATCH(SM) \
        if (pn < 4) p1_rows<0, SM>(acc, pb + PZ + 128 * pn, rt, swb, row0, s00, s01, s10, s11); \
        else if (pn < 8) p1_rows<1, SM>(acc, pb + PABG + 128 * (pn - 4), rt, swb, row0, s00, s01, s10, s11); \
        else if (pn < 12) p1_rows<2, SM>(acc, pb + PUG + 128 * (pn - 8), rt, swb, row0, s00, s01, s10, s11); \
        else if (pn < 14) p1_rows<3, SM>(acc, pb + PGV + 256 * (pn - 12), rt, swb, row0, s00, s01, s10, s11, fq == 0 ? lnst + (size_t)row0 * 16 + 2 * (4 * (pn - 12) + wc) : nullptr); \
        else if (pn < 16) p1_rows<4, SM>(acc, pb + PCX + 256 * (pn - 14), rt, swb, row0, s00, s01, s10, s11); \
        else if (pn < 18) p1_rows<5, SM>(acc, pb + PSG + 256 * (pn - 16), rt, swb, row0, s00, s01, s10, s11); \
        else p1_rows<6, SM>(acc, (bf16_t*)((unsigned char*)(pb - cb + PGATE) + 256 * (pn - 18) + cb), rt, swb, row0, s00, s01, s10, s11);
        P1_DISPATCH(false)
#undef P1_DISPATCH
    } };
struct EpiP1S { bf16_t* pbuf; const float* SWl; const float* ssq;
    DEV void operator()(int pn, int row, int wc, int fq, f32x4 (&v)[1][2][2]) const {
        const int cb = 32 * wc + 8 * fq; const float r = row_rstd_sc(ssq, row);
        const float* sw = SWl + (size_t)nidx_of(row) * NIN + 256 * pn + cb;
        const f32x4 a0 = v[0][0][0] * r + *(const f32x4*)(sw), a1 = v[0][0][1] * r + *(const f32x4*)(sw + 4), b0 = v[0][1][0] * r + *(const f32x4*)(sw + 128), b1 = v[0][1][1] * r + *(const f32x4*)(sw + 132);
        bf16_t* pr = pbuf + (size_t)row * PC + cb;
        if (pn < 4) store8_sc(pr + PZ + 128 * pn, a0 * b0, a1 * b1);
        else if (pn < 8) store8_sc(pr + PABG + 128 * (pn - 4), a0 * silu4(b0), a1 * silu4(b1));
        else if (pn < 12) store8_sc(pr + PUG + 128 * (pn - 8), gelu4(a0) * silu4(b0), gelu4(a1) * silu4(b1));
        else if (pn < 14) { bf16_t* o = pr + PGV + 256 * (pn - 12); store8_sc(o, gelu4(a0), gelu4(a1)); store8_sc(o + 128, gelu4(b0), gelu4(b1)); }
        else if (pn < 16) { bf16_t* o = pr + PCX + 256 * (pn - 14); store8_sc(o, a0, a1); store8_sc(o + 128, b0, b1); }
        else if (pn < 18) { bf16_t* o = pr + PSG + 256 * (pn - 16); store8_sc(o, silu4(a0), silu4(a1)); store8_sc(o + 128, silu4(b0), silu4(b1)); }
        else { unsigned char* gq = (unsigned char*)(pbuf + (size_t)row * PC + PGATE) + 256 * (pn - 18) + cb;
            st_sc8(gq, (u32x2){pku8(sigmoid4(a0)), pku8(sigmoid4(a1))}); st_sc8(gq + 128, (u32x2){pku8(sigmoid4(b0)), pku8(sigmoid4(b1))}); }
    } };
DEV void p1_sample_slice(const int tid, const int slice  , const bf16_t* xa, const bf16_t* Wl, const EpiP1S& e, LAS unsigned char* lds) {
    const int lane = tid & 63, w = __builtin_amdgcn_readfirstlane(tid >> 6), fr = lane & 15, fq = lane >> 4, pn = slice >> 2, wc = slice & 3, row = MPR + 16 * w + fr;
    const bf16_t* ap = xa + (size_t)row * D + 8 * fq; const bf16_t* bp = Wl + (size_t)(256 * pn + 32 * wc + fr) * D + 8 * fq;
    __syncthreads();
#pragma unroll
    for (int j = 0; j < 16; ++j) { const int b = w * 16 + j, q = b >> 5, ks = b & 31;
        __builtin_amdgcn_global_load_lds((const unsigned*)(bp + (size_t)(128 * (q >> 1) + 16 * (q & 1)) * D + 32 * ks), (LAS unsigned*)(lds + b * 1024), 16, 0, 0); }
    bf16x8 af[32];
#pragma unroll
    for (int ks = 0; ks < 32; ++ks) af[ks] = __builtin_bit_cast(bf16x8, ld_sc16(ap + 32 * ks));
    f32x4 v[1][2][2];
#pragma unroll
    for (int q = 0; q < 4; ++q) v[0][q >> 1][q & 1] = (f32x4){0.f, 0.f, 0.f, 0.f};
    asm volatile("s_waitcnt vmcnt(0)" ::: "memory");
    __syncthreads();
#pragma unroll
    for (int ks = 0; ks < 32; ++ks)
#pragma unroll
        for (int q = 0; q < 4; ++q) { const bf16x8 bfr = *(const LAS bf16x8*)(lds + (q * 32 + ks) * 1024 + lane * 16);
            v[0][q >> 1][q & 1] = __builtin_amdgcn_mfma_f32_16x16x32_bf16(bfr, af[ks], v[0][q >> 1][q & 1], 0, 0, 0); }
    e(pn, row, wc, fq, v);
}
template <class Sched> DEV void p1_rtab(const Sched& S, const float* ssq, const float* SWl, LAS float* rtab, LAS float* swt) {
    int t = threadIdx.x; asm volatile("" : "+v"(t));
#pragma unroll
    for (int k = 0; k < 4; ++k) { const int q = t + 512 * k, i = q >> 8, rl = q & 255; UnitD u;
        if (S.next(i, u)) { rtab[q] = row_rstd(ssq, u.pm * 256 + rl); swt[q] = SWl[(size_t)(u.pm < MPR / 256 ? (u.pm >> 3) : NBP) * NIN + 256 * u.pn + rl]; } }
    __syncthreads();
}
template <bool IN16, bool LAST> struct EpiP4T { const float* gate; const float* atab_cur; const float* atab_next; const bf16_t* xa; bf16_t* xao; float* ssq; const float* xin; bf16_t* xb;
    DEV void operator()(f32x4 (&acc)[2][2][4][2], const UnitD& u, const UnitD& un, const bool has_next, int wr, int wc, int fr, int fq) const {
        const int pn = u.pn, nb = u.pm >> 3, col = 256 * pn + 32 * wc + 8 * fq, row0 = u.pm * 256 + wr * 64 + fr;
        const float* gp = gate + (size_t)nb * 3072 + col;
        f32x4 g[2][2], at[2][2], iv[2][2];
#pragma unroll
        for (int bj = 0; bj < 2; ++bj)
#pragma unroll
            for (int n = 0; n < 2; ++n) { g[bj][n] = *(const f32x4*)(gp + 128 * bj + 4 * n);
                at[bj][n] = LAST ? (f32x4){0.f, 0.f, 0.f, 0.f} : *(const f32x4*)(atab_next + (size_t)nb * D + col + 128 * bj + 4 * n);
                iv[bj][n] = IN16 ? rcp4(*(const f32x4*)(atab_cur + (size_t)nb * D + col + 128 * bj + 4 * n)) : (f32x4){0.f, 0.f, 0.f, 0.f}; }
        const size_t off0 = (size_t)row0 * D + col;
        f32x4 x[2][2], xn[2][2]; u32x4 xh[2], xhn[2];
#pragma unroll
        for (int bj = 0; bj < 2; ++bj) { if (IN16) xh[bj] = *(const u32x4*)(xa + off0 + 128 * bj); else { x[bj][0] = *(const f32x4*)(xin + off0 + 128 * bj); x[bj][1] = *(const f32x4*)(xin + off0 + 128 * bj + 4); } }
#pragma unroll
        for (int r = 0; r < 8; ++r) { const int ai = r >> 2, m = r & 3, rl = ai * HALF + m * 16, row = row0 + rl; float s = 0.f;
            if (r < 7) { const size_t offn = off0 + (size_t)(((r + 1) >> 2) * HALF + ((r + 1) & 3) * 16) * D;
#pragma unroll
                for (int bj = 0; bj < 2; ++bj) { if (IN16) xhn[bj] = *(const u32x4*)(xa + offn + 128 * bj); else { xn[bj][0] = *(const f32x4*)(xin + offn + 128 * bj); xn[bj][1] = *(const f32x4*)(xin + offn + 128 * bj + 4); } } }
            const size_t off = off0 + (size_t)rl * D;
#pragma unroll
            for (int bj = 0; bj < 2; ++bj) {
                if (IN16) { unpk8(xh[bj], x[bj][0], x[bj][1]); x[bj][0] *= iv[bj][0]; x[bj][1] *= iv[bj][1]; }
#pragma unroll
                for (int n = 0; n < 2; ++n) { const f32x4 t = x[bj][n] + g[bj][n] * acc[ai][bj][m][n]; x[bj][n] = t; s += (t.x * t.x + t.y * t.y) + (t.z * t.z + t.w * t.w); }
                if (LAST) store8(xb + off + 128 * bj, x[bj][0], x[bj][1]);
                else store8(xao + off + 128 * bj, x[bj][0] * at[bj][0], x[bj][1] * at[bj][1]); }
            s += __shfl_xor(s, 16); s += __shfl_xor(s, 32);
            if (fq == 0) ssq[row * 16 + 4 * pn + wc] = s;
#pragma unroll
            for (int bj = 0; bj < 2; ++bj) { xh[bj] = xhn[bj]; x[bj][0] = xn[bj][0]; x[bj][1] = xn[bj][1]; }
        }
    } };

struct SchedP3R { TileOrder T; const char* A; const char* B;
    DEV bool next(int i, UnitD& u) const { int pm, pc; const int seg = i % 3; if (!T.tile<WGM_P3>(i / 3, pm, pc)) return false; u.pm = pm; u.pn = pc; u.aux = seg;
        u.A = A + (size_t)pm * 256 * (1536 * 2) + (size_t)seg * (W * 2); u.B = B + (size_t)seg * D * (W * 2) + (size_t)pc * 128 * (W * 2); return true; } };
struct EpiP3R { f32x4 (&tot)[2][4][2]; u32x2 (&gpre)[8]; const bf16_t* pbuf; bf16_t* mg;
    DEV void prefetch(const UnitD& u, int wr, int wc, int fr, int fq) const {
        const unsigned char* gp = (const unsigned char*)(pbuf + (size_t)(u.pm * 256 + wr * 64 + fr) * PC + PGATE) + 1024 * u.aux + 128 * u.pn + 32 * wc + 8 * fq;
#pragma unroll
        for (int r = 0; r < 8; ++r) gpre[r] = *(const u32x2*)(gp + (size_t)((r >> 2) * HALF + (r & 3) * 16) * (PC * 2));
    }
    DEV void operator()(f32x4 (&acc)[2][1][4][2], const UnitD& u, const UnitD& un, const bool has_next, int wr, int wc, int fr, int fq) const {
        const int seg = u.aux, cb = 128 * u.pn + 32 * wc + 8 * fq, row0 = u.pm * 256 + wr * 64 + fr;
        bf16_t* o = mg + (size_t)row0 * D + cb;
        u32x2 g[8];
#pragma unroll
        for (int r = 0; r < 8; ++r) g[r] = gpre[r];
        if (has_next) prefetch(un, wr, wc, fr, fq);
        const float keep = seg ? 1.f : 0.f;
#pragma unroll
        for (int r = 0; r < 8; ++r) { const int ai = r >> 2, m = r & 3; const f32x4 g0 = gate4(g[r].x), g1 = gate4(g[r].y);
            const f32x4 t0 = acc[ai][0][m][0] * g0 + tot[ai][m][0] * keep, t1 = acc[ai][0][m][1] * g1 + tot[ai][m][1] * keep;
            tot[ai][m][0] = t0; tot[ai][m][1] = t1;
            if (seg == 2) store8(o + (size_t)(ai * HALF + m * 16) * D, t0, t1); }
    } };
#define XB_TMO      128
#define XB_XCNT(j)  (256  + 64 * (j))
#define XB_XSUB(j)  (1280 + 64 * (j))
#define XB_XGEN(j)  (2304 + 64 * (j))
#define XB_TOP      3328
#define XB_TOPGEN   3392
#define XCD_BAR_WORDS 3456
#define XB_LSUB(j)  (3456 + 64 * (j))
#define XB_LGEN(j)  (3968 + 64 * (j))
#define XB_CNT_P4S  4480
#define XB_CNT_P1S  4544
#define XB_SPIN_CAP (1u << 18)
DEV unsigned xb_ld(unsigned* p)              { return __hip_atomic_load(p, __ATOMIC_RELAXED, __HIP_MEMORY_SCOPE_AGENT); }
DEV unsigned xb_add(unsigned* p, unsigned v) { return __hip_atomic_fetch_add(p, v, __ATOMIC_RELAXED, __HIP_MEMORY_SCOPE_AGENT); }
DEV unsigned xb_xcc_id() { return (unsigned)__builtin_amdgcn_s_getreg((3 << 11) | 20) & 0xFu; }
#define XB_SPIN(cond, bar) do { unsigned _sp = 0; while (cond) { __builtin_amdgcn_s_sleep(1); \
    if ((++_sp & 255u) == 0u) { if (xb_ld(&(bar)[XB_TMO])) break; if (_sp > XB_SPIN_CAP) { atomicAdd(&(bar)[XB_TMO], 1u); break; } } } } while (0)
struct XcdBarrier { unsigned* bar; unsigned x; volatile LAS unsigned* st; };
DEV XcdBarrier xcd_barrier_post(unsigned* bar, volatile LAS unsigned* st) {
    XcdBarrier b; b.bar = bar; b.x = xb_xcc_id(); b.st = st;
    if (threadIdx.x == 0) st[4] = xb_add(&bar[XB_XCNT(b.x)], 1u);
    return b;
}
DEV void xcd_barrier_complete(unsigned* bar, unsigned x, unsigned& nloc, unsigned& nx, unsigned& even) {
    const unsigned G = gridDim.x * gridDim.y * gridDim.z;
    unsigned sum, cnt, mine, n32, sp = 0u;
    for (;;) {
        sum = 0u; cnt = 0u; mine = 0u; n32 = 0u;
#pragma unroll
        for (unsigned j = 0; j < 16; ++j) { const unsigned c = xb_ld(&bar[XB_XCNT(j)]); sum += c; cnt += (c > 0u) ? 1u : 0u; n32 += (j < 8u && c == 32u) ? 1u : 0u; mine = (j == x) ? c : mine; }
        if (sum == G) break;
        __builtin_amdgcn_s_sleep(1);
        if ((++sp & 255u) == 0u) { if (xb_ld(&bar[XB_TMO])) break; if (sp > XB_SPIN_CAP) { atomicAdd(&bar[XB_TMO], 1u); break; } }
    }
    nloc = mine > 0u ? mine : 1u; nx = cnt > 0u ? cnt : 1u;
    even = (sum == G && G == 256u && n32 == 8u) ? 1u : 0u;
}
DEV void xcd_barrier(const XcdBarrier& b) {
    asm volatile("s_waitcnt vmcnt(0)" ::: "memory");
    __syncthreads();
    if (threadIdx.x == 0) {
        unsigned* bar = b.bar; unsigned bx = b.x; asm volatile("" : "+s"(bar), "+s"(bx));
        __builtin_amdgcn_s_waitcnt(0);
        unsigned nloc = b.st[0], nx = b.st[1];
        if (nloc == 0u) { unsigned even; xcd_barrier_complete(bar, bx, nloc, nx, even); b.st[0] = nloc; b.st[1] = nx;
            b.st[2] = even ? bx * 32u + b.st[4] : (unsigned)blockIdx.x;
            b.st[3] = even; }
        const unsigned old = xb_add(&bar[XB_XSUB(bx)], 1u);
        const unsigned gen = old / nloc;
        if (old + 1u == (gen + 1u) * nloc) {
            __builtin_amdgcn_fence(__ATOMIC_RELEASE, "agent");
            asm volatile("s_waitcnt vmcnt(0)" ::: "memory");
            const unsigned og = xb_add(&bar[XB_TOP], 1u);
            const unsigned tg = og / nx;
            if (og + 1u == (tg + 1u) * nx) xb_add(&bar[XB_TOPGEN], 1u);
            else XB_SPIN(xb_ld(&bar[XB_TOPGEN]) == tg, bar);
            __builtin_amdgcn_fence(__ATOMIC_ACQUIRE, "agent");
            xb_add(&bar[XB_XGEN(bx)], 1u);
            asm volatile("s_waitcnt vmcnt(0)" ::: "memory");
        } else {
            XB_SPIN(xb_ld(&bar[XB_XGEN(bx)]) == gen, bar);
            __builtin_amdgcn_fence(__ATOMIC_ACQUIRE, "agent");
            asm volatile("s_waitcnt vmcnt(0)" ::: "memory");
        }
    }
    __syncthreads();
}
DEV void xcd_local_barrier(const XcdBarrier& b) {
    asm volatile("s_waitcnt vmcnt(0)" ::: "memory");
    __syncthreads();
    if (threadIdx.x == 0) {
        unsigned* bar = b.bar; unsigned bx = b.x; asm volatile("" : "+s"(bar), "+s"(bx));
        __builtin_amdgcn_s_waitcnt(0);
        const unsigned old = xb_add(&bar[XB_LSUB(bx)], 1u);
        const unsigned gen = old >> 5;
        if ((old & 31u) == 31u) xb_add(&bar[XB_LGEN(bx)], 1u);
        else XB_SPIN(xb_ld(&bar[XB_LGEN(bx)]) == gen, bar);
        __builtin_amdgcn_fence(__ATOMIC_ACQUIRE, "agent");
        asm volatile("s_waitcnt vmcnt(0)" ::: "memory");
    }
    __syncthreads();
}
constexpr bool LOCAL_BAR = true;
DEV void layer_barrier(const XcdBarrier& b) { if (LOCAL_BAR && b.st[3]) xcd_local_barrier(b); else xcd_barrier(b); }
template <class RowEpi> struct EpiRows { RowEpi e;
    DEV void operator()(f32x4 (&acc)[2][2][4][2], const UnitD& u, const UnitD& un, const bool has_next, int wr, int wc, int fr, int fq) const {
#pragma unroll
        for (int ai = 0; ai < 2; ++ai)
#pragma unroll
            for (int m = 0; m < 4; ++m) { f32x4 v[2][2] = {{acc[ai][0][m][0], acc[ai][0][m][1]}, {acc[ai][1][m][0], acc[ai][1][m][1]}};
                e(u.pn, u.pm * 256 + ai * HALF + wr * 64 + m * 16 + fr, wc, fq, v); asm volatile("" ::: "memory"); }
    } };
struct SchedP1 { TileOrder T; const char* A; const char* B;
    DEV bool next(int i, UnitD& u) const { int pm, pn; if (!T.tile<WGM_P1>(i, pm, pn)) return false; pn += (T.pm0 >> 3) * 4; pn -= pn >= 30 ? 30 : 0;   u.pm = pm; u.pn = pn; u.aux = i; u.A = A + (size_t)pm * 256 * (D * 2); u.B = B + (size_t)pn * 256 * (D * 2); return true; } };

struct SchedP4 { TileOrder T; const char* A; const char* B;
    DEV bool next(int i, UnitD& u) const { int pm, pn; if (!T.tile<WGM_P4>(i, pm, pn)) return false; u.pm = pm; u.pn = pn; u.aux = 0; u.A = A + (size_t)pm * 256 * (D * 2); u.B = B + (size_t)pn * 256 * (D * 2); return true; } };
struct EpiP3 { const bf16_t* pbuf; bf16_t* mg;
    DEV void operator()(int pn, int row, int wc, int fq, f32x4 (&v)[3][2][2]) const {
        const int cb = 256 * pn + 32 * wc + 8 * fq;
        const unsigned char* gp = (const unsigned char*)(pbuf + (size_t)row * PC + PGATE) + cb; bf16_t* o = mg + (size_t)row * D + cb;
        u32x2 g[3][2];
#pragma unroll
        for (int s = 0; s < 3; ++s) { g[s][0] = ld_sc8(gp + 1024 * s); g[s][1] = ld_sc8(gp + 1024 * s + 128); }
#pragma unroll
        for (int bj = 0; bj < 2; ++bj) { f32x4 t0 = v[0][bj][0] * gate4(g[0][bj].x), t1 = v[0][bj][1] * gate4(g[0][bj].y);
#pragma unroll
            for (int s = 1; s < 3; ++s) { t0 += v[s][bj][0] * gate4(g[s][bj].x); t1 += v[s][bj][1] * gate4(g[s][bj].y); }
            store8(o + 128 * bj, t0, t1); }
    } };
struct SchedSW { int G, c; const char* A; const char* B;
    DEV bool next(int i, UnitD& u) const { const int idx = i * G + c; if (idx >= DEPTH * 30) return false; const int l = idx / 30, pn = idx % 30; u.pm = 0; u.pn = pn + 32 * l; u.aux = l;
        u.A = A + (size_t)l * 256 * (D * 2); u.B = B + (size_t)l * NIN * (D * 2) + (size_t)pn * 256 * (D * 2); return true; } };
struct EpiSWx { float* SW;
    DEV void operator()(int pnx, int row, int wc, int fq, f32x4 (&v)[2][2]) const {
        if (row >= NBT) return;
        const int l = pnx >> 5, pn = pnx & 31;
        float* o = SW + (size_t)l * NBT * NIN + (size_t)row * NIN + 256 * pn + 32 * wc + 8 * fq;
        *(f32x4*)(o) = v[0][0]; *(f32x4*)(o + 4) = v[0][1]; *(f32x4*)(o + 128) = v[1][0]; *(f32x4*)(o + 132) = v[1][1];
    } };
struct EpiP4 { const float* gate  ; const float* atab_cur; const float* atab_next  ; const bf16_t* xa; bf16_t* xao; float* ssq; const float* xin  ; bf16_t* xb; int in16;
    DEV void operator()(int pn, int row, int wc, int fq, f32x4 (&vv)[1][2][2]) const {
        f32x4 (&v)[2][2] = vv[0];
        const int nb = nidx_of(row), col = 256 * pn + 32 * wc + 8 * fq;
        const float* gp = gate + (size_t)nb * 3072 + col;
        float s = 0.f;
#pragma unroll
        for (int bj = 0; bj < 2; ++bj) {
            f32x4 x0, x1;
            if (in16) { unpk8(*(const u32x4*)(xa + (size_t)row * D + col + 128 * bj), x0, x1); const float* ac = atab_cur + (size_t)nb * D + col + 128 * bj; x0 *= rcp4(*(const f32x4*)ac); x1 *= rcp4(*(const f32x4*)(ac + 4)); }
            else { x0 = *(const f32x4*)(xin + (size_t)row * D + col + 128 * bj); x1 = *(const f32x4*)(xin + (size_t)row * D + col + 128 * bj + 4); }
            const f32x4 t0 = x0 + *(const f32x4*)(gp + 128 * bj) * v[bj][0], t1 = x1 + *(const f32x4*)(gp + 128 * bj + 4) * v[bj][1];
            s += ((t0.x * t0.x + t0.y * t0.y) + (t0.z * t0.z + t0.w * t0.w)) + ((t1.x * t1.x + t1.y * t1.y) + (t1.z * t1.z + t1.w * t1.w));
            if (atab_next) { const float* ap = atab_next + (size_t)nb * D + col + 128 * bj; store8_sc(xao + (size_t)row * D + col + 128 * bj, t0 * *(const f32x4*)ap, t1 * *(const f32x4*)(ap + 4)); }
            else store8(xb + (size_t)row * D + col + 128 * bj, t0, t1);
        }
        s += __shfl_xor(s, 16); s += __shfl_xor(s, 32);
        if (fq == 0) __hip_atomic_store(ssq + row * 16 + 4 * pn + wc, s, __ATOMIC_RELAXED, __HIP_MEMORY_SCOPE_AGENT);
    } };


typedef short v4i16 __attribute__((ext_vector_type(4)));
constexpr int TP = 528, VT_OFF = 0, PM_OFF = 128 * TP;
DEV f32x4 unpk4(u32x2 r) { return (f32x4){bflo(r.x), bfhi(r.x), bflo(r.y), bfhi(r.y)}; }
DEV void p2_ln(const Ctx& c, int l, int ck, int hh, const bf16_t* pb, LAS unsigned char* lds) {
    int lane_ = c.lane; asm volatile("" : "+v"(lane_));
    const int lane = lane_, w = c.wave, p = lane >> 5, ch = 256 * hh + 8 * (lane & 31); const bool lastck = (ck & 15) == 15;
    const float* st = c.lnst + ((size_t)ck * 128 + 16 * w + (lane & 15)) * 16;
    const f32x4 t0 = *(const f32x4*)st, t1 = *(const f32x4*)(st + 4), t2 = *(const f32x4*)(st + 8), t3 = *(const f32x4*)(st + 12);
    u32x4 gv[8];
#pragma unroll
    for (int k = 0; k < 8; ++k) gv[k] = *(const u32x4*)(pb + (size_t)(16 * w + 2 * k + p) * PC + PGV + ch);
    const f32x4 g0 = *(const f32x4*)(c.lnv_g + l * W + ch), g1 = *(const f32x4*)(c.lnv_g + l * W + ch + 4), b0 = *(const f32x4*)(c.lnv_b + l * W + ch), b1 = *(const f32x4*)(c.lnv_b + l * W + ch + 4);
    const float s = ((t0.x + t0.z) + (t1.x + t1.z)) + ((t2.x + t2.z) + (t3.x + t3.z)), q = ((t0.y + t0.w) + (t1.y + t1.w)) + ((t2.y + t2.w) + (t3.y + t3.w));
    const float mu_l = s * (1.f / W), rstd_l = __builtin_amdgcn_rsqf(fmaxf(q * (1.f / W) - mu_l * mu_l, 0.f) + EPS);
    float* vout = c.out + O_VP + ((size_t)(l * NBP + (ck >> 4)) * 128) * W + ch;
#pragma unroll
    for (int k = 0; k < 8; ++k) { const int t = 16 * w + 2 * k + p;
        const float mu = __shfl(mu_l, 2 * k + p), rstd = __shfl(rstd_l, 2 * k + p);
        f32x4 x0 = (f32x4){bflo(gv[k].x), bfhi(gv[k].x), bflo(gv[k].y), bfhi(gv[k].y)}, x1 = (f32x4){bflo(gv[k].z), bfhi(gv[k].z), bflo(gv[k].w), bfhi(gv[k].w)};
        x0 = (x0 - mu) * rstd * g0 + b0; x1 = (x1 - mu) * rstd * g1 + b1;
        u32x4 o; o.x = pk2(x0.x, x0.y); o.y = pk2(x0.z, x0.w); o.z = pk2(x1.x, x1.y); o.w = pk2(x1.z, x1.w);
        *(LAS u32x4*)(lds + VT_OFF + t * TP + (lane & 31) * 16) = o;
        if (lastck) { *(f32x4*)(vout + (size_t)t * W) = x0; *(f32x4*)(vout + (size_t)t * W + 4) = x1; }
    }
}
template <int HH> DEV void p2_pool(const Ctx& c, int l, int ck, const bf16_t* pb, LAS unsigned char* lds) {
    constexpr int W0 = 2 << (2 * HH), W1 = 2 * W0, H = W1 - 1, NX = H + 16;
    int lane_ = c.lane; asm volatile("" : "+v"(lane_));
    const int lane = lane_, w = c.wave, gi = lane >> 5, cpos = (ck & 15) * 128, ch = 256 * HH + 4 * lane; const bool lastck = (ck & 15) == 15;
    f32x4 x[NX];
#pragma unroll
    for (int k = 0; k < NX; ++k) { const int tt = 16 * w - H + k; const bool valid = cpos + tt >= 0; const int tc = valid ? tt : 0;
        const u32x2 r = *(const u32x2*)(pb + (ptrdiff_t)tc * PC + PCX + ch); const f32x4 v = unpk4(r); x[k] = valid ? v : (f32x4){0.f, 0.f, 0.f, 0.f}; }
    f32x4 slo = x[H];
#pragma unroll
    for (int j = 1; j < W0; ++j) slo += x[H - j];
    f32x4 shi = slo;
#pragma unroll
    for (int j = W0; j < W1; ++j) shi += x[H - j];
    float* pout = c.out + O_POOLP + ((size_t)(l * NBP + (ck >> 4)) * 15) * W + ch;
#pragma unroll
    for (int i = 0; i < 16; ++i) { const int t = 16 * w + i, pos = cpos + t, wd = gi ? W1 : W0;
        const f32x4 s = gi ? shi : slo; const float inv = __builtin_amdgcn_rcpf((float)(wd < pos + 1 ? wd : pos + 1));
        const f32x4 pm = s * inv - x[H + i];
        *(LAS u32x2*)(lds + PM_OFF + t * TP + 8 * lane) = (u32x2){pk2(pm.x, pm.y), pk2(pm.z, pm.w)};
        if (lastck && t >= 113) *(f32x4*)(pout + (size_t)(t - 113) * W) = x[H + i];
        if (i < 15) { slo += x[H + i + 1] - x[H + i + 1 - W0]; shi += x[H + i + 1] - x[H + i + 1 - W1]; }
    }
}
DEV void p2_conv(const Ctx& c, int l, int ck, int hh, const bf16_t* pb) {
    int lane_ = c.lane; asm volatile("" : "+v"(lane_));
    const int lane = lane_, w = c.wave, cpos = (ck & 15) * 128, ch = 256 * hh + 4 * lane, row0 = ck * 128; const bool lastck = (ck & 15) == 15;
    const f32x4 cb = *(const f32x4*)(c.conv_b + l * W + ch), w0 = *(const f32x4*)(c.conv_w + (l * 3 + 0) * W + ch), w1 = *(const f32x4*)(c.conv_w + (l * 3 + 1) * W + ch), w2 = *(const f32x4*)(c.conv_w + (l * 3 + 2) * W + ch);
    f32x4 z[18];
#pragma unroll
    for (int k = 0; k < 18; ++k) { const int tt = 16 * w - 2 + k; const bool valid = cpos + tt >= 0; const int tc = valid ? tt : 0;
        const f32x4 v = unpk4(*(const u32x2*)(pb + (ptrdiff_t)tc * PC + PZ + ch)); z[k] = valid ? v : (f32x4){0.f, 0.f, 0.f, 0.f}; }
    float* cout = c.out + O_CONVP + ((size_t)(l * NBP + (ck >> 4)) * 2) * W + ch;
#pragma unroll
    for (int i = 0; i < 16; ++i) { const int t = 16 * w + i;
        const f32x4 abg = unpk4(*(const u32x2*)(pb + (size_t)t * PC + PABG + ch));
        const f32x4 o = abg * (cb + w0 * z[i] + w1 * z[i + 1] + w2 * z[i + 2]);
        *(u32x2*)(c.y + (size_t)(row0 + t) * 1536 + ch) = (u32x2){pk2(o.x, o.y), pk2(o.z, o.w)};
        if (lastck && t >= 126) *(f32x4*)(cout + (size_t)(t - 126) * W) = z[i + 2];
    }
}
constexpr int TPS = 1040;
DEV void p2_sample_block(const Ctx& c, int l, int sb, LAS unsigned char* ldsw) {
    const int lane = c.lane, fr = lane & 15, fq = lane >> 4, ch = 8 * lane, h = lane >> 3, g = lane >> 4;
    {
        const int i = c.wave, n = 8 * sb + i, row = MPR + n; const bf16_t* pr = c.pbuf + (size_t)row * PC; bf16_t* yr = c.y + (size_t)row * 1536;
        const float* sc = c.state_conv + ((size_t)(l * NSM + n) * 2) * W + ch; const float* sp = c.state_pool + ((size_t)(l * NSM + n) * 15) * W + ch;
        const u32x4 qz = ld_sc16(pr + PZ + ch), qa = ld_sc16(pr + PABG + ch), qg = ld_sc16(pr + PGV + ch), qu = ld_sc16(pr + PUG + ch), qc = ld_sc16(pr + PCX + ch);
        const f32x4 s00 = *(const f32x4*)(sc), s01 = *(const f32x4*)(sc + 4), s10 = *(const f32x4*)(sc + W), s11 = *(const f32x4*)(sc + W + 4);
        f32x4 st0[15], st1[15];
#pragma unroll
        for (int k = 7; k < 15; ++k) { st0[k] = *(const f32x4*)(sp + (size_t)k * W); st1[k] = *(const f32x4*)(sp + (size_t)k * W + 4); }
        const f32x4 cb0 = *(const f32x4*)(c.conv_b + l * W + ch), cb1 = *(const f32x4*)(c.conv_b + l * W + ch + 4);
        const f32x4 w0a = *(const f32x4*)(c.conv_w + (l * 3 + 0) * W + ch), w0b = *(const f32x4*)(c.conv_w + (l * 3 + 0) * W + ch + 4);
        const f32x4 w1a = *(const f32x4*)(c.conv_w + (l * 3 + 1) * W + ch), w1b = *(const f32x4*)(c.conv_w + (l * 3 + 1) * W + ch + 4);
        const f32x4 w2a = *(const f32x4*)(c.conv_w + (l * 3 + 2) * W + ch), w2b = *(const f32x4*)(c.conv_w + (l * 3 + 2) * W + ch + 4);
        const f32x4 lg0 = *(const f32x4*)(c.lnv_g + l * W + ch), lg1 = *(const f32x4*)(c.lnv_g + l * W + ch + 4), lb0 = *(const f32x4*)(c.lnv_b + l * W + ch), lb1 = *(const f32x4*)(c.lnv_b + l * W + ch + 4);
        const float w00 = c.sgu_w[(size_t)(l * 8 + h) * 128 * 128], b00 = c.sgu_b[(l * 8 + h) * 128], invw = 1.f / (float)(2 << g);
        asm volatile("" ::: "memory");
        {
            f32x4 z0, z1, a0, a1; unpk8(qz, z0, z1); unpk8(qa, a0, a1);
            const f32x4 ya = a0 * (cb0 + w0a * s00 + w1a * s10 + w2a * z0), yb = a1 * (cb1 + w0b * s01 + w1b * s11 + w2b * z1);
#pragma unroll
            for (int k = 0; k < 7; ++k) { st0[k] = *(const f32x4*)(sp + (size_t)k * W); st1[k] = *(const f32x4*)(sp + (size_t)k * W + 4); }
            store8(yr + ch, ya, yb);
            float* o = c.out + O_CONVS + ((size_t)(l * NSM + n) * 2) * W + ch;
            *(f32x4*)(o) = s10; *(f32x4*)(o + 4) = s11; *(f32x4*)(o + W) = z0; *(f32x4*)(o + W + 4) = z1;
        }
        {
            f32x4 x0, x1, u0, u1; unpk8(qg, x0, x1); unpk8(qu, u0, u1);
            float s = ((x0.x + x0.y) + (x0.z + x0.w)) + ((x1.x + x1.y) + (x1.z + x1.w));
            float q = ((x0.x * x0.x + x0.y * x0.y) + (x0.z * x0.z + x0.w * x0.w)) + ((x1.x * x1.x + x1.y * x1.y) + (x1.z * x1.z + x1.w * x1.w));
#pragma unroll
            for (int o = 1; o < 64; o <<= 1) { s += __shfl_xor(s, o); q += __shfl_xor(q, o); }
            const float mu = s * (1.f / W), var = fmaxf(q * (1.f / W) - mu * mu, 0.f), rstd = __builtin_amdgcn_rsqf(var + EPS);
            x0 = (x0 - mu) * rstd * lg0 + lb0; x1 = (x1 - mu) * rstd * lg1 + lb1;
            float* vo = c.out + O_VS + (size_t)(l * NSM + n) * W + ch; *(f32x4*)(vo) = x0; *(f32x4*)(vo + 4) = x1;
            store8(yr + 512 + ch, u0 * (x0 * w00 + b00), u1 * (x1 * w00 + b00));
        }
        {
            f32x4 c0, c1; unpk8(qc, c0, c1);
            float* po = c.out + O_POOLS + ((size_t)(l * NSM + n) * 15) * W + ch;
            f32x4 r0 = c0, r1 = c1, s2a, s2b, s4a, s4b, s8a, s8b;
#pragma unroll
            for (int k = 14; k >= 0; --k) {
                if (k >= 1) { *(f32x4*)(po + (size_t)(k - 1) * W) = st0[k]; *(f32x4*)(po + (size_t)(k - 1) * W + 4) = st1[k]; }
                r0 += st0[k]; r1 += st1[k];
                if (k == 14) { s2a = r0; s2b = r1; } if (k == 12) { s4a = r0; s4b = r1; } if (k == 8) { s8a = r0; s8b = r1; } }
            *(f32x4*)(po + (size_t)14 * W) = c0; *(f32x4*)(po + (size_t)14 * W + 4) = c1;
            const f32x4 sa = g == 0 ? s2a : g == 1 ? s4a : g == 2 ? s8a : r0, sb2 = g == 0 ? s2b : g == 1 ? s4b : g == 2 ? s8b : r1;
            const f32x4 p0 = sa * invw - c0, p1 = sb2 * invw - c1;
            u32x4 o; o.x = pk2(p0.x, p0.y); o.y = pk2(p0.z, p0.w); o.z = pk2(p1.x, p1.y); o.w = pk2(p1.z, p1.w);
            *(LAS u32x4*)(ldsw + i * TPS + 16 * lane) = o;
        }
    }
    __syncthreads();
    const int row = MPR + 8 * sb + (fr & 7); const bf16_t* pr = c.pbuf + (size_t)row * PC; bf16_t* yr = c.y + (size_t)row * 1536;
    bf16x8 bw[2][4][2]; u32x4 sgv[2]; f32x4 pbv[2][2], psv[2][2];
#pragma unroll
    for (int gi2 = 0; gi2 < 2; ++gi2) { const int gq = 2 * c.wave + gi2, g2 = gq >> 2, nq = gq & 3, cc = 128 * g2 + 32 * nq + 8 * fq;
        const bf16_t* pw = c.PoolWT + ((size_t)(l * 4 + g2) * 128 + 32 * nq + fr) * 128 + 8 * fq;
#pragma unroll
        for (int ks = 0; ks < 4; ++ks) { bw[gi2][ks][0] = *(const bf16x8*)(pw + 32 * ks); bw[gi2][ks][1] = *(const bf16x8*)(pw + 16 * 128 + 32 * ks); }
        sgv[gi2] = ld_sc16(pr + PSG + cc);
        pbv[gi2][0] = *(const f32x4*)(c.pool_b + l * W + cc); pbv[gi2][1] = *(const f32x4*)(c.pool_b + l * W + cc + 4); psv[gi2][0] = *(const f32x4*)(c.pool_scale + l * W + cc); psv[gi2][1] = *(const f32x4*)(c.pool_scale + l * W + cc + 4); }
#pragma unroll
    for (int gi2 = 0; gi2 < 2; ++gi2) { const int gq = 2 * c.wave + gi2, g2 = gq >> 2, nq = gq & 3, cc = 128 * g2 + 32 * nq + 8 * fq;
        f32x4 a0 = (f32x4){0.f, 0.f, 0.f, 0.f}, a1 = (f32x4){0.f, 0.f, 0.f, 0.f};
#pragma unroll
        for (int ks = 0; ks < 4; ++ks) { const bf16x8 af = *(const LAS bf16x8*)(ldsw + fr * TPS + 2 * (128 * g2 + 32 * ks + 8 * fq));
            a0 = __builtin_amdgcn_mfma_f32_16x16x32_bf16(bw[gi2][ks][0], af, a0, 0, 0, 0); a1 = __builtin_amdgcn_mfma_f32_16x16x32_bf16(bw[gi2][ks][1], af, a1, 0, 0, 0); }
        f32x4 g0v, g1v; unpk8(sgv[gi2], g0v, g1v);
        if (fr < 8) store8(yr + 1024 + cc, (a0 + pbv[gi2][0]) * psv[gi2][0] * g0v, (a1 + pbv[gi2][1]) * psv[gi2][1] * g1v);
    }
}

DEV void p2_mm(const Ctx& c, const int l, const int ck, const int hh, const bf16_t* pb, LAS unsigned char* lds) {
    int lane_ = c.lane; asm volatile("" : "+v"(lane_));
    const int lane = lane_, w = c.wave, fr = lane & 15, fq = lane >> 4, row0 = ck * 128;
    const int hq = w >> 1, a = w & 1, h = 4 * hh + hq;
    bf16x8 wf[4][4]; u32x4 ug[4][2]; float bias[4];
    { const bf16_t* wm = c.SguW + ((size_t)(l * 8 + h) * 128) * 128;
#pragma unroll
      for (int i = 0; i < 4; ++i) { const int tb = a ? (i == 0 ? 1 : i == 1 ? 2 : i == 2 ? 5 : 6) : (i == 0 ? 0 : i == 1 ? 3 : i == 2 ? 4 : 7), t = 16 * tb + fr;
#pragma unroll
          for (int ks = 0; ks < 4; ++ks) wf[i][ks] = *(const bf16x8*)(wm + (size_t)t * 128 + 32 * ks + 8 * fq);
      } }
    __syncthreads();
#pragma unroll
    for (int i = 0; i < 4; ++i) { const int tb = a ? (i == 0 ? 1 : i == 1 ? 2 : i == 2 ? 5 : 6) : (i == 0 ? 0 : i == 1 ? 3 : i == 2 ? 4 : 7), t = 16 * tb + fr;
        bias[i] = c.sgu_b[(l * 8 + h) * 128 + t];
#pragma unroll
        for (int c2 = 0; c2 < 2; ++c2) ug[i][c2] = *(const u32x4*)(pb + (size_t)t * PC + PUG + 256 * hh + 64 * hq + 32 * c2 + 8 * fq); }
    f32x4 acc[4][4];
#pragma unroll
    for (int i = 0; i < 4; ++i)
#pragma unroll
        for (int cc = 0; cc < 4; ++cc) acc[i][cc] = (f32x4){0.f, 0.f, 0.f, 0.f};
    { const int q = fr >> 2, p = fr & 3;
#pragma unroll
      for (int ks = 0; ks < 4; ++ks) {
        bf16x8 vb[4];
#pragma unroll
        for (int cc = 0; cc < 4; ++cc) { const int col = 64 * hq + 32 * (cc >> 1) + 8 * p + 4 * (cc & 1);
            const v4i16 lo = __builtin_amdgcn_ds_read_tr16_b64_v4i16((LAS v4i16*)(lds + VT_OFF + (32 * ks + 8 * fq + q) * TP + 2 * col));
            const v4i16 hi = __builtin_amdgcn_ds_read_tr16_b64_v4i16((LAS v4i16*)(lds + VT_OFF + (32 * ks + 8 * fq + 4 + q) * TP + 2 * col));
            vb[cc] = (bf16x8){lo[0], lo[1], lo[2], lo[3], hi[0], hi[1], hi[2], hi[3]}; }
#pragma unroll
        for (int i = 0; i < 4; ++i) { const int tb = a ? (i == 0 ? 1 : i == 1 ? 2 : i == 2 ? 5 : 6) : (i == 0 ? 0 : i == 1 ? 3 : i == 2 ? 4 : 7);
            if (ks <= (tb >> 1)) {
#pragma unroll
                for (int cc = 0; cc < 4; ++cc) acc[i][cc] = __builtin_amdgcn_mfma_f32_16x16x32_bf16(vb[cc], wf[i][ks], acc[i][cc], 0, 0, 0); } }
      } }
    asm volatile("" ::: "memory");
    const int gi2 = w >> 2, nq = w & 3, chc = 256 * hh + 128 * gi2 + 32 * nq + 8 * fq;
    bf16x8 pw0[4], pw1[4]; u32x4 sgv[8];
    { const bf16_t* pw = c.PoolWT + ((size_t)(l * 4 + 2 * hh + gi2) * 128 + 32 * nq + fr) * 128 + 8 * fq;
#pragma unroll
      for (int ks = 0; ks < 4; ++ks) { pw0[ks] = *(const bf16x8*)(pw + 32 * ks); pw1[ks] = *(const bf16x8*)(pw + 16 * 128 + 32 * ks); }
#pragma unroll
      for (int m = 0; m < 8; ++m) sgv[m] = *(const u32x4*)(pb + (size_t)(16 * m + fr) * PC + PSG + chc); }
    const f32x4 pb0 = *(const f32x4*)(c.pool_b + l * W + chc), pb1 = *(const f32x4*)(c.pool_b + l * W + chc + 4), ps0 = *(const f32x4*)(c.pool_scale + l * W + chc), ps1 = *(const f32x4*)(c.pool_scale + l * W + chc + 4);
#pragma unroll
    for (int i = 0; i < 4; ++i) { const int tb = a ? (i == 0 ? 1 : i == 1 ? 2 : i == 2 ? 5 : 6) : (i == 0 ? 0 : i == 1 ? 3 : i == 2 ? 4 : 7), t = 16 * tb + fr;
#pragma unroll
        for (int c2 = 0; c2 < 2; ++c2) { f32x4 u0, u1; unpk8(ug[i][c2], u0, u1);
            store8(c.y + (size_t)(row0 + t) * 1536 + 512 + 256 * hh + 64 * hq + 32 * c2 + 8 * fq, (acc[i][2 * c2] + bias[i]) * u0, (acc[i][2 * c2 + 1] + bias[i]) * u1); } }
    f32x4 ac2[8][2];
#pragma unroll
    for (int m = 0; m < 8; ++m) { ac2[m][0] = (f32x4){0.f, 0.f, 0.f, 0.f}; ac2[m][1] = (f32x4){0.f, 0.f, 0.f, 0.f}; }
#pragma unroll
    for (int ks = 0; ks < 4; ++ks)
#pragma unroll
        for (int m = 0; m < 8; ++m) { const bf16x8 af = *(const LAS bf16x8*)(lds + PM_OFF + (16 * m + fr) * TP + 2 * (128 * gi2 + 32 * ks + 8 * fq));
            ac2[m][0] = __builtin_amdgcn_mfma_f32_16x16x32_bf16(pw0[ks], af, ac2[m][0], 0, 0, 0); ac2[m][1] = __builtin_amdgcn_mfma_f32_16x16x32_bf16(pw1[ks], af, ac2[m][1], 0, 0, 0); }
#pragma unroll
    for (int m = 0; m < 8; ++m) { f32x4 s0, s1; unpk8(sgv[m], s0, s1);
        store8(c.y + (size_t)(row0 + 16 * m + fr) * 1536 + 1024 + chc, (ac2[m][0] + pb0) * ps0 * s0, (ac2[m][1] + pb1) * ps1 * s1); }
    __syncthreads();
}
DEV void ph_p2_prompt(const Args& a, int l, LAS unsigned char* lds) {
    LAUNDER_CTX(a);
    VB_LOAD(lds);
    {
        const int ck = 16 * vx_ + (vr_ >> 1), hh = vr_ & 1; const bf16_t* pb = c.pbuf + (size_t)ck * 128 * PC;
        p2_ln(c, l, ck, hh, pb, lds);
        { if (hh) p2_pool<1>(c, l, ck, pb, lds); else p2_pool<0>(c, l, ck, pb, lds); }
        p2_conv(c, l, ck, hh, pb);
        p2_mm(c, l, ck, hh, pb, lds);
    }
    if (vr_ >= 30) {
        unsigned* ctl = (unsigned*)(a.ws + WS_CTL + z_);
        if (threadIdx.x == 0) { XB_SPIN(xb_ld(&ctl[XB_CNT_P1S]) < 960u * (unsigned)(l + 1), ctl); __builtin_amdgcn_fence(__ATOMIC_ACQUIRE, "agent"); asm volatile("s_waitcnt vmcnt(0)" ::: "memory"); }
        __syncthreads();
        p2_sample_block(c, l, 2 * vx_ + (vr_ - 30), lds); __syncthreads(); }
}
DEV void ph_final(const Args& a, LAS unsigned char* lds) {
    LAUNDER_CTX(a); VB_LOAD(lds);
    const int lane = c.lane;
#pragma unroll 2
    for (int i = 8 * vr_ + c.wave; i < 2048 + 16; i += 256) { const int row = i < 2048 ? 2048 * vx_ + i : MPR + 16 * vx_ + (i - 2048);
        const float r = row_rstd(c.ssq, row);
#pragma unroll
        for (int j = 0; j < 2; ++j) { f32x4 x0, x1; unpk8(*((const u32x4*)(c.xb + (size_t)row * D) + lane + 64 * j), x0, x1);
            const f32x4* gp = (const f32x4*)c.final_g + 2 * lane + 128 * j; f32x4* o = (f32x4*)(c.out + (size_t)row * D) + 2 * lane + 128 * j;
            o[0] = x0 * r * gp[0]; o[1] = x1 * r * gp[1]; }
    }
}

__global__ __launch_bounds__(NTHREADS, 2) void mega_fwd(Args a) {
    extern __shared__ __attribute__((aligned(16))) unsigned char lds[];
    LAS unsigned char* ldsp = (LAS unsigned char*)lds;
    if (threadIdx.x < 16) ((LAS unsigned*)(ldsp + LDSCTL_OFF))[threadIdx.x] = 0u;
    __syncthreads();
    const XcdBarrier bar = xcd_barrier_post((unsigned*)(a.ws + WS_CTL), (volatile LAS unsigned*)(ldsp + LDSCTL_OFF));
    ph_convert(a, lds, 0, 0);
    xcd_barrier(bar);
    { LAUNDER_CTX(a); int bx_ = blockIdx.x, gx_ = gridDim.x; asm volatile("" : "+s"(bx_), "+s"(gx_)); SchedMod S{gx_, bx_, (const char*)c.scb, (const char*)c.WadaT}; EpiRows<EpiMod> E{EpiMod{c.mod, c.atab, c.shb, c.b_ada, c.norm_g}}; gemm_phase(ldsp, D * 2, D * 2, D / BK, S, E); }
    ph_convert(a, lds, 1, (int)gridDim.x > 96 ? 48 : 0);
    xcd_barrier(bar);
    { LAUNDER_CTX(a); int bx_ = blockIdx.x, gx_ = gridDim.x; asm volatile("" : "+s"(bx_), "+s"(gx_)); SchedSW S{gx_, bx_, (const char*)c.shb, (const char*)c.WinT}; EpiRows<EpiSWx> E{EpiSWx{c.SW}}; gemm_phase(ldsp, D * 2, D * 2, D / BK, S, E); }
    ph_xa0(a);
    xcd_barrier(bar);
#pragma unroll 1
    for (int l = 0; l < DEPTH; ++l) {
        { LAUNDER_CTX(a); VB_LOAD(ldsp); SchedP1 S; S.T.init(8, NIN / 256, 32, vr_, 8 * vx_); S.A = (const char*)((l & 1) ? c.xa2 : c.xa); S.B = (const char*)(c.WinT + (size_t)l * NIN * D);
          p1_rtab(S, c.ssq, c.SW + (size_t)l * NBT * NIN, (LAS float*)(ldsp + RTAB_OFF), (LAS float*)(ldsp + SWT_OFF));
          EpiP1T E{c.pbuf, c.SW + (size_t)l * NBT * NIN, (const LAS float*)(ldsp + RTAB_OFF), (const LAS float*)(ldsp + SWT_OFF), c.lnst};
          gemm_phase(ldsp, D * 2, D * 2, D / BK, S, E);
          if (vr_ >= 16) {
              const EpiP1S es{c.pbuf, c.SW + (size_t)l * NBT * NIN, c.ssq};
              const int spn = vx_ + 8 * ((vr_ - 16) >> 2), sl = 4 * spn + (vr_ & 3);
              if (spn < 30) { unsigned* ctl = (unsigned*)(a.ws + WS_CTL + z_);
                  XB_SPIN(xb_ld(&ctl[XB_CNT_P4S]) < 128u * (unsigned)l, ctl);
                  __builtin_amdgcn_fence(__ATOMIC_ACQUIRE, "agent"); asm volatile("s_waitcnt vmcnt(0)" ::: "memory");
                  p1_sample_slice(c.tid, sl, (l & 1) ? c.xa2 : c.xa, c.WinT + (size_t)l * NIN * D, es, ldsp);
                  asm volatile("s_waitcnt vmcnt(0)" ::: "memory");
                  if (c.lane == 0) xb_add(&ctl[XB_CNT_P1S], 1u); } } }
        layer_barrier(bar);
        ph_p2_prompt(a, l, ldsp);
        layer_barrier(bar);
        { LAUNDER_CTX(a); VB_LOAD(ldsp); const EpiP3 e3{c.pbuf, c.mg};
          if (vr_ < 16) mini_gemm<3, 2>(a, ldsp, vx_ | (vr_ << 3), c.y, 1536, W, c.WbT + (size_t)l * 3 * D * W, W, (size_t)D * W, e3);
          SchedP3R S; S.T.init(8, 8, 32, vr_, 8 * vx_); S.A = (const char*)c.y; S.B = (const char*)(c.WbT + (size_t)l * 3 * D * W);
          f32x4 tot[2][4][2];
#pragma unroll
          for (int i0 = 0; i0 < 2; ++i0)
#pragma unroll
              for (int i1 = 0; i1 < 4; ++i1) { tot[i0][i1][0] = (f32x4){0.f, 0.f, 0.f, 0.f}; tot[i0][i1][1] = (f32x4){0.f, 0.f, 0.f, 0.f}; }
          u32x2 gpre[8]; EpiP3R E{tot, gpre, c.pbuf, c.mg};
          { UnitD u0; int t_ = threadIdx.x; asm volatile("" : "+v"(t_)); const int wv = __builtin_amdgcn_readfirstlane(t_ >> 6); if (S.next(0, u0)) E.prefetch(u0, wv >> 2, wv & 3, t_ & 15, (t_ & 63) >> 4); }
          gemm_phase<EpiP3R, SchedP3R, 1>(ldsp, 1536 * 2, W * 2, W / BK, S, E); }
        layer_barrier(bar);
        { LAUNDER_CTX(a); VB_LOAD(ldsp); const float* gate = c.mod + (size_t)l * NBT * 3072 + 2048;
          const float* atc = c.atab + (size_t)l * NBT * D; const float* atn = l + 1 < DEPTH ? c.atab + (size_t)(l + 1) * NBT * D : nullptr;
          const bf16_t* xai = (l & 1) ? c.xa2 : c.xa; bf16_t* xao = (l & 1) ? c.xa : c.xa2;
          const EpiP4 e4{gate, atc, atn, xai, xao, c.ssq, c.x_sample - (size_t)MPR * D, c.xb, l > 0};
          if (vr_ < 16) { mini_gemm<1, 4>(a, ldsp, vx_ | (vr_ << 3), c.mg, D, 0, c.WoT + (size_t)l * D * D, D, (size_t)0, e4);
              if (threadIdx.x == 0) { asm volatile("s_waitcnt vmcnt(0)" ::: "memory"); xb_add((unsigned*)(a.ws + WS_CTL + z_) + XB_CNT_P4S, 1u); } }
          SchedP4 S; S.T.init(8, 4, 32, vr_, 8 * vx_); S.A = (const char*)c.mg; S.B = (const char*)(c.WoT + (size_t)l * D * D);
          if (l == 0) { EpiP4T<false, false> E{gate, atc, atn, xai, xao, c.ssq, c.x_prompt, c.xb}; gemm_phase(ldsp, D * 2, D * 2, D / BK, S, E); }
          else if (l + 1 < DEPTH) { EpiP4T<true, false> E{gate, atc, atn, xai, xao, c.ssq, c.x_prompt, c.xb}; gemm_phase(ldsp, D * 2, D * 2, D / BK, S, E); }
          else { EpiP4T<true, true> E{gate, atc, atn, xai, xao, c.ssq, c.x_prompt, c.xb}; gemm_phase(ldsp, D * 2, D * 2, D / BK, S, E); } }
        layer_barrier(bar);
    }
    ph_final(a, ldsp);
}

extern "C" void kernel_launch(void* const* d_in, const int* in_sizes, int n_in, void* d_out, int out_size, void* d_ws, size_t ws_size, hipStream_t stream) {
    static int grid_blocks = 0;
    if (grid_blocks == 0) {
        if (n_in != 22 || ws_size < WS_END) { fprintf(stderr, "kernel_launch: unexpected n_in %d or ws_size %zu < %zu\n", n_in, ws_size, (size_t)WS_END); grid_blocks = -1; return; }
        int dev = 0, cus = 0, per_cu = 0;
        (void)hipGetDevice(&dev); (void)hipDeviceGetAttribute(&cus, hipDeviceAttributeMultiprocessorCount, dev);
        if (hipFuncSetAttribute((const void*)mega_fwd, hipFuncAttributeMaxDynamicSharedMemorySize, LDS_BYTES) != hipSuccess) { fprintf(stderr, "kernel_launch: hipFuncSetAttribute failed\n"); grid_blocks = -1; return; }
        if (hipOccupancyMaxActiveBlocksPerMultiprocessor(&per_cu, (const void*)mega_fwd, NTHREADS, LDS_BYTES) != hipSuccess || per_cu < 1) { fprintf(stderr, "kernel_launch: occupancy query gave %d\n", per_cu); grid_blocks = -1; return; }
        if (cus < 256) { fprintf(stderr, "kernel_launch: this kernel is laid out for >= 256 CUs (found %d)\n", cus); grid_blocks = -1; return; }
        grid_blocks = 256;
        fprintf(stderr, "kernel_launch: cus %d per_cu %d grid %d\n", cus, per_cu, grid_blocks);
    }
    if (grid_blocks < 0) return;
    Args a{};
    for (int i = 0; i < 22; ++i) a.in[i] = (const float*)d_in[i];
    a.out = (float*)d_out; a.ws = (unsigned char*)d_ws;
    if (hipMemsetAsync((char*)d_ws + WS_CTL, 0, CTL_BYTES, stream) != hipSuccess) { fprintf(stderr, "kernel_launch: memset failed\n"); return; }
    void* args[] = {&a};
    hipError_t e = hipLaunchCooperativeKernel((const void*)mega_fwd, dim3(grid_blocks), dim3(NTHREADS), args, LDS_BYTES, stream);
    if (e != hipSuccess) fprintf(stderr, "kernel_launch: cooperative launch failed: %s (grid %d)\n", hipGetErrorString(e), grid_blocks);
}
```

```cpp
#include <hip/hip_runtime.h>
#include <cstdio>
#include <cstdint>

#define DEV __device__ __forceinline__
typedef unsigned short bf16_t;
typedef short bf16x8 __attribute__((ext_vector_type(8)));
typedef float f32x4 __attribute__((ext_vector_type(4)));
typedef unsigned u32x4 __attribute__((ext_vector_type(4)));
typedef unsigned u32x2 __attribute__((ext_vector_type(2)));

constexpr int D = 1024, TSEQ = 2048, NBP = 8, MPR = NBP * TSEQ  , NSM = 128, MV = MPR + NSM  , MP = 16640  , NBT = NBP + NSM  ;
constexpr int W = 512, NIN = 7680, PC = 4608  , DEPTH = 4;
constexpr int PZ = 0, PABG = 512, PUG = 1024, PGV = 1536, PCX = 2048, PSG = 2560, PGATE = 3072;
constexpr float EPS = 1e-6f;
constexpr size_t O_Y = 0, O_YS = 16777216, O_CONVP = 16908288, O_CONVS = 16941056, O_POOLP = 17465344, O_POOLS = 17711104, O_VP = 21643264, O_VS = 23740416;

constexpr size_t al256(size_t x) { return (x + 255) & ~(size_t)255; }
constexpr size_t WS_WIN = 0;
constexpr size_t WS_WB = al256(WS_WIN + (size_t)DEPTH * NIN * D * 2);
constexpr size_t WS_WO = al256(WS_WB + (size_t)DEPTH * 3 * D * W * 2);
constexpr size_t WS_MOD = al256(WS_WO + (size_t)DEPTH * D * D * 2);
constexpr size_t WS_ATAB = al256(WS_MOD + (size_t)DEPTH * NBT * 3 * D * 4);
constexpr size_t WS_SHB = al256(WS_ATAB + (size_t)DEPTH * NBT * D * 4);
constexpr size_t WS_SW = al256(WS_SHB + (size_t)DEPTH * 256 * D * 2);
constexpr size_t WS_XA = al256(WS_SW + (size_t)DEPTH * NBT * NIN * 4);
constexpr size_t WS_SSQ = al256(WS_XA + (size_t)MP * D * 2);
constexpr size_t WS_PBUF = al256(WS_SSQ + (size_t)MP * 16 * 4);
constexpr size_t WS_Y = al256(WS_PBUF + (size_t)MP * PC * 2);
constexpr size_t WS_MG = al256(WS_Y + (size_t)MP * 1536 * 2);
constexpr size_t WS_SGUW = al256(WS_MG + (size_t)MP * D * 2);
constexpr size_t WS_POOLW = al256(WS_SGUW + (size_t)DEPTH * 8 * 128 * 128 * 2);
constexpr size_t WS_WADA = al256(WS_POOLW + (size_t)DEPTH * 4 * 128 * 128 * 2);
constexpr size_t WS_SCB = al256(WS_WADA + (size_t)DEPTH * 3072 * D * 2);
constexpr size_t WS_XB = al256(WS_SCB + (size_t)256 * D * 2);
constexpr size_t WS_XA2 = al256(WS_XB + (size_t)MV * D * 2);
constexpr size_t WS_LNST = al256(WS_XA2 + (size_t)MP * D * 2);
constexpr size_t WS_CTL = al256(WS_LNST + (size_t)MP * 16 * 4);
constexpr size_t CTL_BYTES = 32768;
constexpr size_t WS_END = al256(WS_CTL + CTL_BYTES);

constexpr int NTHREADS = 512, NWAVES = 8;
constexpr int LDS_BYTES = 155648;
constexpr int LDSCTL_OFF = LDS_BYTES - 256;

typedef __bf16 bf16x2_t __attribute__((ext_vector_type(2)));
typedef float f32x2_t __attribute__((ext_vector_type(2)));
DEV unsigned pk2(float lo, float hi) { const f32x2_t v = {lo, hi}; const bf16x2_t b = __builtin_convertvector(v, bf16x2_t); return __builtin_bit_cast(unsigned, b); }
typedef unsigned long long u64_t;
DEV u32x2 ld_sc8(const void* p) { const u64_t v = __hip_atomic_load((const u64_t*)p, __ATOMIC_RELAXED, __HIP_MEMORY_SCOPE_AGENT); return (u32x2){(unsigned)v, (unsigned)(v >> 32)}; }
DEV u32x4 ld_sc16(const void* p) { const u32x2 a = ld_sc8(p), b = ld_sc8((const char*)p + 8); return (u32x4){a.x, a.y, b.x, b.y}; }
DEV void st_sc8(void* p, u32x2 v) { __hip_atomic_store((u64_t*)p, (u64_t)v.x | ((u64_t)v.y << 32), __ATOMIC_RELAXED, __HIP_MEMORY_SCOPE_AGENT); }
DEV void st_sc16(void* p, u32x4 v) { st_sc8(p, (u32x2){v.x, v.y}); st_sc8((char*)p + 8, (u32x2){v.z, v.w}); }
DEV void store8_sc(bf16_t* p, f32x4 a, f32x4 b) { u32x4 w; w.x = pk2(a.x, a.y); w.y = pk2(a.z, a.w); w.z = pk2(b.x, b.y); w.w = pk2(b.z, b.w); st_sc16(p, w); }
DEV float row_rstd_sc(const float* ssq, int row) {
    float s = 0.f;
#pragma unroll
    for (int i = 0; i < 8; ++i) { const u32x2 v = ld_sc8(ssq + (size_t)row * 16 + 2 * i); const unsigned lo = v.x, hi = v.y; s += __builtin_bit_cast(float, lo) + __builtin_bit_cast(float, hi); }
    return __builtin_amdgcn_rsqf(s * (1.f / D) + EPS);
}
DEV float bflo(unsigned u) { return __builtin_bit_cast(float, u << 16); }
DEV float bfhi(unsigned u) { return __builtin_bit_cast(float, u & 0xffff0000u); }
DEV void unpk8(const u32x4 u, f32x4& a, f32x4& b) { a = (f32x4){bflo(u.x), bfhi(u.x), bflo(u.y), bfhi(u.y)}; b = (f32x4){bflo(u.z), bfhi(u.z), bflo(u.w), bfhi(u.w)}; }
DEV f32x4 gate4(unsigned u) { return (f32x4){(float)(u & 0xffu), (float)((u >> 8) & 0xffu), (float)((u >> 16) & 0xffu), (float)(u >> 24)} * (1.f / 255.f); }
DEV unsigned pku8(f32x4 s) { const unsigned a = (unsigned)(s.x * 255.f + 0.5f), b = (unsigned)(s.y * 255.f + 0.5f), c = (unsigned)(s.z * 255.f + 0.5f), d = (unsigned)(s.w * 255.f + 0.5f); return a | (b << 8) | (c << 16) | (d << 24); }
DEV f32x4 exp2_4(f32x4 t) { return (f32x4){__builtin_amdgcn_exp2f(t.x), __builtin_amdgcn_exp2f(t.y), __builtin_amdgcn_exp2f(t.z), __builtin_amdgcn_exp2f(t.w)}; }
DEV unsigned pku8_t(f32x4 t);
DEV f32x4 rcp4(f32x4 d) { return (f32x4){__builtin_amdgcn_rcpf(d.x), __builtin_amdgcn_rcpf(d.y), __builtin_amdgcn_rcpf(d.z), __builtin_amdgcn_rcpf(d.w)}; }
DEV unsigned pku8_t(f32x4 t) {
    const f32x4 g = rcp4(exp2_4(t) * (1.f / 255.f) + (1.f / 255.f)) + 8388608.f;
    const u32x4 gu = __builtin_bit_cast(u32x4, g);
    const unsigned p01 = __builtin_amdgcn_perm(gu.y, gu.x, 0x0c0c0400u), p23 = __builtin_amdgcn_perm(gu.w, gu.z, 0x0c0c0400u);
    return __builtin_amdgcn_perm(p23, p01, 0x05040100u);
}
DEV f32x4 sigmoid4(f32x4 x) { return rcp4(exp2_4(x * -1.44269504f) + 1.f); }
DEV f32x4 silu4(f32x4 x) { return x * sigmoid4(x); }
DEV f32x4 gelu4(f32x4 x) { const f32x4 t = x * (x * x * (-2.f * 0.7978845608f * 0.044715f * 1.44269504f) + (-2.f * 0.7978845608f * 1.44269504f)); return x * rcp4(exp2_4(t) + 1.f); }
DEV int perm32(int rho) { const int n = rho >> 4, i = rho & 15; return 8 * (i >> 2) + 4 * n + (i & 3); }
DEV int nidx_of(int row) { return row < MPR ? (row >> 11) : (row < MV ? NBP + (row - MPR) : NBT - 1); }
DEV int src_win(int j) {
    const int pn = j >> 8, c = j & 255, bj = c >> 7, cc = c & 127;
    if (pn < 4) return (bj ? 1024 : 512) + 128 * pn + cc;
    if (pn < 8) return (bj ? 1536 : 0) + 128 * (pn - 4) + cc;
    if (pn < 12) return (bj ? 3072 : 2048) + 128 * (pn - 8) + cc;
    if (pn < 14) return 2560 + 256 * (pn - 12) + c;
    if (pn < 16) return 3584 + 256 * (pn - 14) + c;
    if (pn < 18) return 4096 + 256 * (pn - 16) + c;
    return 4608 + 256 * (pn - 18) + c;
}

struct Args { const float* in[22]; float* out; unsigned char* ws; };
struct Ctx {
    const float *x_prompt, *x_sample, *c_prompt, *c_sample, *state_conv, *state_pool, *w_ada, *b_ada, *norm_g, *w_in, *conv_w, *conv_b, *lnv_g, *lnv_b, *sgu_w, *sgu_b, *pool_w, *pool_b, *pool_scale, *w_branch, *w_out, *final_g;
    float* out; bf16_t *WinT, *WbT, *WoT; float *mod, *atab; bf16_t* shb; float* SW; bf16_t* xa; float* ssq; bf16_t *pbuf, *y, *mg; bf16_t *SguW, *PoolWT, *WadaT, *scb, *xb, *xa2; float* lnst;
    unsigned char* lds;
    int tid, lane, wave, gw, NGW, gtid, NGT;
};

DEV Ctx make_ctx(const Args& a, size_t z) {
    Ctx c;
    c.x_prompt = a.in[0] + z; c.x_sample = a.in[1] + z; c.c_prompt = a.in[2] + z; c.c_sample = a.in[3] + z; c.state_conv = a.in[4] + z; c.state_pool = a.in[5] + z; c.w_ada = a.in[6] + z; c.b_ada = a.in[7] + z;
    c.norm_g = a.in[8] + z; c.w_in = a.in[9] + z; c.conv_w = a.in[10] + z; c.conv_b = a.in[11] + z; c.lnv_g = a.in[12] + z; c.lnv_b = a.in[13] + z; c.sgu_w = a.in[14] + z; c.sgu_b = a.in[15] + z;
    c.pool_w = a.in[16] + z; c.pool_b = a.in[17] + z; c.pool_scale = a.in[18] + z; c.w_branch = a.in[19] + z; c.w_out = a.in[20] + z; c.final_g = a.in[21] + z;
    c.out = a.out + z; unsigned char* ws = a.ws + z;
    c.WinT = (bf16_t*)(ws + WS_WIN); c.WbT = (bf16_t*)(ws + WS_WB); c.WoT = (bf16_t*)(ws + WS_WO);
    c.mod = (float*)(ws + WS_MOD); c.atab = (float*)(ws + WS_ATAB); c.shb = (bf16_t*)(ws + WS_SHB); c.SW = (float*)(ws + WS_SW);
    c.xa = (bf16_t*)(ws + WS_XA); c.ssq = (float*)(ws + WS_SSQ); c.pbuf = (bf16_t*)(ws + WS_PBUF); c.y = (bf16_t*)(ws + WS_Y); c.mg = (bf16_t*)(ws + WS_MG);
    c.WadaT = (bf16_t*)(ws + WS_WADA); c.scb = (bf16_t*)(ws + WS_SCB); c.xb = (bf16_t*)(ws + WS_XB); c.xa2 = (bf16_t*)(ws + WS_XA2); c.lnst = (float*)(ws + WS_LNST); c.SguW = (bf16_t*)(ws + WS_SGUW); c.PoolWT = (bf16_t*)(ws + WS_POOLW);
    c.lds = nullptr; c.tid = 0; c.lane = 0; c.wave = 0; c.gw = 0; c.NGW = 0; c.gtid = 0; c.NGT = 0;
    return c;
}
#define LAUNDER_CTX(a) size_t z_ = 0; asm volatile("" : "+s"(z_)); Ctx c = make_ctx(a, z_); { int t_ = threadIdx.x; asm volatile("" : "+v"(t_)); c.tid = t_; c.lane = t_ & 63; c.wave = __builtin_amdgcn_readfirstlane(t_ >> 6); \
    c.gw = blockIdx.x * NWAVES + c.wave; c.NGW = gridDim.x * NWAVES; c.gtid = blockIdx.x * NTHREADS + t_; c.NGT = gridDim.x * NTHREADS; }
#define VB_LOAD(ldsp) const int vb_ = __builtin_amdgcn_readfirstlane((int)((volatile LAS unsigned*)((ldsp) + LDSCTL_OFF))[2]); const int vx_ = vb_ >> 5, vr_ = vb_ & 31;
struct MapWin { DEV int operator()(int g) const { return src_win((g & ~31) + perm32(g & 31)); } };
struct MapPerm { DEV int operator()(int g) const { return (g & ~31) + perm32(g & 31); } };
template <class Map>
DEV void transpose_item(const float* Wsrc, int ldw, int K, bf16_t* WT, int nblk, int item, float* scr, int lane, Map map) {
    const int kb = item / nblk, nb = item % nblk, k0 = 64 * kb, g0 = 32 * nb;
    const int scol = map(g0 + (lane & 31));
#pragma unroll 8
    for (int i = 0; i < 32; ++i) { const int kk = 2 * i + (lane >> 5); scr[kk * 33 + (lane & 31)] = Wsrc[(size_t)(k0 + kk) * ldw + scol]; }
    asm volatile("s_waitcnt lgkmcnt(0)" ::: "memory");
    const int c = lane & 7;
#pragma unroll
    for (int j = 0; j < 4; ++j) { const int n = (lane >> 3) + 8 * j; const float* s = scr + (8 * c) * 33 + n;
        u32x4 o; o.x = pk2(s[0 * 33], s[1 * 33]); o.y = pk2(s[2 * 33], s[3 * 33]); o.z = pk2(s[4 * 33], s[5 * 33]); o.w = pk2(s[6 * 33], s[7 * 33]);
        *(u32x4*)(WT + (size_t)(g0 + n) * K + k0 + 8 * c) = o; }
    asm volatile("s_waitcnt lgkmcnt(0)" ::: "memory");
}
constexpr int IT_WIN = (D / 64) * (NIN / 32), IT_WB = (W / 64) * (D / 32), IT_WO = (D / 64) * (D / 32);
constexpr int IT_PW = (128 / 64) * (128 / 32);
constexpr int IT_WADA = (D / 64) * (3072 / 32);
constexpr int IT_TOTAL = DEPTH * IT_WIN + DEPTH * 3 * IT_WB + DEPTH * IT_WO + DEPTH * 4 * IT_PW + DEPTH * IT_WADA;
DEV void ph_convert(const Args& a, unsigned char* lds, const int stage, const int b0) {
    LAUNDER_CTX(a);
    float* scr = (float*)(lds + c.wave * 16384);
    const int nb = (int)gridDim.x - b0, bw = ((int)blockIdx.x - b0) * NWAVES + c.wave, nw = nb * NWAVES, bt = ((int)blockIdx.x - b0) * NTHREADS + c.tid, nthr = nb * NTHREADS;
    if ((int)blockIdx.x < b0) return;
    if (stage == 0) {
        for (int r = bw; r < DEPTH * IT_WADA; r += nw) { const int l = r / IT_WADA; transpose_item(c.w_ada + (size_t)l * D * 3072, 3072, D, c.WadaT + (size_t)l * 3072 * D, 3072 / 32, r - l * IT_WADA, scr, c.lane, MapPerm()); }
        for (int idx = bt; idx < 256 * D / 4; idx += nthr) { const int n = idx >> 8, k4 = (idx & 255) * 4; f32x4 v = (f32x4){0.f, 0.f, 0.f, 0.f};
            if (n < NBT) { v = *(const f32x4*)((n < NBP ? c.c_prompt + (size_t)n * D : c.c_sample + (size_t)(n - NBP) * D) + k4); v = silu4(v); }
            *((u32x2*)c.scb + idx) = (u32x2){pk2(v.x, v.y), pk2(v.z, v.w)}; }
        return;
    }
    for (int it = bw; it < IT_TOTAL - DEPTH * IT_WADA; it += nw) {
        int r = it;
        if (r < DEPTH * IT_WIN) { const int l = r / IT_WIN; r -= l * IT_WIN; transpose_item(c.w_in + (size_t)l * D * NIN, NIN, D, c.WinT + (size_t)l * NIN * D, NIN / 32, r, scr, c.lane, MapWin()); continue; }
        r -= DEPTH * IT_WIN;
        if (r < DEPTH * 3 * IT_WB) { const int li = r / IT_WB; r -= li * IT_WB; transpose_item(c.w_branch + (size_t)li * W * D, D, W, c.WbT + (size_t)li * D * W, D / 32, r, scr, c.lane, MapPerm()); continue; }
        r -= DEPTH * 3 * IT_WB;
        if (r < DEPTH * IT_WO) { const int l = r / IT_WO; r -= l * IT_WO; transpose_item(c.w_out + (size_t)l * D * D, D, D, c.WoT + (size_t)l * D * D, D / 32, r, scr, c.lane, MapPerm()); continue; }
        r -= DEPTH * IT_WO;
        { const int lg = r / IT_PW; r -= lg * IT_PW; transpose_item(c.pool_w + (size_t)lg * 128 * 128, 128, 128, c.PoolWT + (size_t)lg * 128 * 128, 4, r, scr, c.lane, MapPerm()); }
    }
    for (int idx = bt; idx < DEPTH * 8 * 128 * 128 / 4; idx += nthr) { const int s4 = (idx & 31) * 4, t = (idx >> 5) & 127; const f32x4 v = *((const f32x4*)c.sgu_w + idx);
        *((u32x2*)c.SguW + idx) = (u32x2){pk2(s4 <= t ? v.x : 0.f, s4 + 1 <= t ? v.y : 0.f), pk2(s4 + 2 <= t ? v.z : 0.f, s4 + 3 <= t ? v.w : 0.f)}; }
}
DEV void ph_xa0(const Args& a) {
    LAUNDER_CTX(a);
    const int lane = c.lane, NSW = DEPTH * 30;
    if ((int)gridDim.x <= NSW || (int)blockIdx.x < NSW) { if ((int)gridDim.x > NSW) return; }
    const int w0 = ((int)gridDim.x > NSW) ? ((int)blockIdx.x - NSW) * NWAVES + c.wave : c.gw, nw = ((int)gridDim.x > NSW) ? ((int)gridDim.x - NSW) * NWAVES : c.NGW;
    for (int row = MV + w0; row < MP; row += nw) { u32x2* xo = (u32x2*)(c.xa + (size_t)row * D) + lane;
#pragma unroll
        for (int j = 0; j < 4; ++j) { xo[64 * j] = (u32x2){0u, 0u}; ((u32x2*)(c.xa2 + (size_t)row * D) + lane)[64 * j] = (u32x2){0u, 0u}; }
        if (lane < 16) c.ssq[row * 16 + lane] = 0.f; }
#pragma unroll 2
    for (int row = w0; row < MV; row += nw) {
        u32x2* xo = (u32x2*)(c.xa + (size_t)row * D) + lane;
        const float* xr = row < MPR ? c.x_prompt + (size_t)row * D : c.x_sample + (size_t)(row - MPR) * D;
        const float* ar = c.atab + (size_t)nidx_of(row) * D;
#pragma unroll
        for (int j = 0; j < 4; ++j) {
            const f32x4 v = *((const f32x4*)xr + lane + 64 * j), at = *((const f32x4*)ar + lane + 64 * j);
            const u32x2 pv = (u32x2){pk2(v.x * at.x, v.y * at.y), pk2(v.z * at.z, v.w * at.w)};
            if (row >= MPR) st_sc8(&xo[64 * j], pv); else xo[64 * j] = pv;
            float s = (v.x * v.x + v.y * v.y) + (v.z * v.z + v.w * v.w);
            s += __shfl_xor(s, 1); s += __shfl_xor(s, 2); s += __shfl_xor(s, 4); s += __shfl_xor(s, 32);
            if ((lane & 39) == 0) { if (row >= MPR) __hip_atomic_store(c.ssq + row * 16 + 4 * j + (lane >> 3), s, __ATOMIC_RELAXED, __HIP_MEMORY_SCOPE_AGENT); else c.ssq[row * 16 + 4 * j + (lane >> 3)] = s; }
        }
    }
}
DEV float row_rstd(const float* ssq, int row) {
    const f32x4* p = (const f32x4*)(ssq + (size_t)row * 16); const f32x4 a = p[0], b = p[1], c = p[2], d = p[3];
    const float s = ((a.x + a.y) + (a.z + a.w)) + ((b.x + b.y) + (b.z + b.w)) + ((c.x + c.y) + (c.z + c.w)) + ((d.x + d.y) + (d.z + d.w));
    return __builtin_amdgcn_rsqf(s * (1.f / D) + EPS);
}

DEV void store8(bf16_t* p, f32x4 a, f32x4 b) { u32x4 w; w.x = pk2(a.x, a.y); w.y = pk2(a.z, a.w); w.z = pk2(b.x, b.y); w.w = pk2(b.z, b.w); *(u32x4*)p = w; }

#define LAS __attribute__((address_space(3)))
constexpr int BK = 64, HALF = 128, HTB = HALF * BK * 2, STAGE_BYTES = 8 * HTB;
DEV int lds_byte(int r, int c) { const int st = (r >> 4) * 2 + (c >> 5), rr = r & 15, cc = c & 31, ob = rr * 64 + cc * 2; return st * 1024 + (ob ^ (((ob >> 9) & 1) << 5)); }
DEV void stage_rc(int b, int& R, int& C) { const int st = b / 1024, sb = b % 1024, swz = sb ^ (((sb >> 9) & 1) << 5); R = (st >> 1) * 16 + swz / 64; C = (st & 1) * 32 + (swz % 64) / 2; }
struct UnitD { const char* A; const char* B; int pm, pn, aux; };
constexpr int NXCD = 8;
constexpr int WGM_P1 = 4, WGM_P3 = 4, WGM_P4 = 8;
struct TileOrder {
    int nM, nN, nwg, G, c, pm0;
    DEV void init(int nM_, int nN_, int G_, int c_, int pm0_) { nM = nM_; nN = nN_; nwg = nM * nN; G = G_; c = c_; pm0 = pm0_; }
    template <int WGM> DEV bool tile(int i, int& pm, int& pn) const {
        const int wgid = i * G + c; if (wgid >= nwg) return false;
        const int nig = WGM * nN, gid = wgid / nig, fm = gid * WGM, gsz = (nM - fm) < WGM ? (nM - fm) : WGM;
        pm = pm0 + fm + ((wgid % nig) % gsz); pn = (wgid % nig) / gsz; return true;
    }
};
template <class Epi, class Sched, int NBH = 2>
DEV void gemm_phase(LAS unsigned char* lds, const int lda  , const int ldb  , const int nt  , const Sched& S, const Epi& E) {
    int tid = threadIdx.x; asm volatile("" : "+v"(tid));
    const int wid = __builtin_amdgcn_readfirstlane(tid >> 6), lane = tid & 63, wr = wid >> 2, wc = wid & 3, fr = lane & 15, fq = lane >> 4;
    unsigned voffA[2], voffB[2];
#pragma unroll
    for (int i = 0; i < 2; ++i) { int R, C; stage_rc(tid * 16 + i * 8192, R, C); voffA[i] = (unsigned)(R * lda + C * 2); voffB[i] = (unsigned)(R * ldb + C * 2); }
    const size_t kstep = (size_t)(BK * 2);
    const size_t hstepA = (size_t)HALF * lda, hstepB = (size_t)HALF * ldb;
    const unsigned ldsw = (unsigned)wid * 1024u;
    const int aoff = lds_byte(wr * 64 + fr, fq * 8), boff = lds_byte(wc * 32 + fr, fq * 8);
#define PG8_SA(b, h) (((b) * 2 + (h)) * HTB)
#define PG8_SB(b, h) ((4 + (b) * 2 + (h)) * HTB)
#define PG8_STAGE(bufoff, gbase, voff) do { _Pragma("unroll") for (int _i = 0; _i < 2; ++_i) \
        __builtin_amdgcn_global_load_lds((const unsigned*)((const char*)(gbase) + (voff)[_i]), (LAS unsigned*)(lds + (bufoff) + ldsw + _i * 8192), 16, 0, 0); } while (0)
#define PG8_LDA(dst, b, h) do { _Pragma("unroll") for (int m = 0; m < 4; ++m) _Pragma("unroll") for (int k = 0; k < 2; ++k) dst[m][k] = *(const LAS bf16x8*)(lds + PG8_SA(b, h) + aoff + m * 2048 + k * 1024); } while (0)
#define PG8_LDB(dst, b, h) do { _Pragma("unroll") for (int n = 0; n < 2; ++n) _Pragma("unroll") for (int k = 0; k < 2; ++k) dst[n][k] = *(const LAS bf16x8*)(lds + PG8_SB(b, h) + boff + n * 2048 + k * 1024); } while (0)
#define PG8_MMA(ai, bj, At, Bt) do { __builtin_amdgcn_s_setprio(1); _Pragma("unroll") for (int m = 0; m < 4; ++m) _Pragma("unroll") for (int n = 0; n < 2; ++n) _Pragma("unroll") for (int k = 0; k < 2; ++k) \
        acc[ai][bj][m][n] = __builtin_amdgcn_mfma_f32_16x16x32_bf16(Bt[n][k], At[m][k], acc[ai][bj][m][n], 0, 0, 0); __builtin_amdgcn_s_setprio(0); } while (0)
#define PG8_WAIT_V(n) asm volatile("s_waitcnt vmcnt(" #n ")" ::: "memory")
#define PG8_WAIT_VN() do { if constexpr (NBH == 2) PG8_WAIT_V(8); else PG8_WAIT_V(6); } while (0)
#define PG8_WAIT_L(n) asm volatile("s_waitcnt lgkmcnt(" #n ")" ::: "memory")
#define PG8_BAR __builtin_amdgcn_s_barrier()
#define PG8_SCHED __builtin_amdgcn_sched_barrier(0)
    UnitD cur, nxt; int ui = 0;
    if (!S.next(0, cur)) return;
    f32x4 acc[2][NBH][4][2];
#pragma unroll
    for (int a = 0; a < 2; ++a)
#pragma unroll
        for (int b = 0; b < NBH; ++b)
#pragma unroll
            for (int m = 0; m < 4; ++m)
#pragma unroll
                for (int n = 0; n < 2; ++n) acc[a][b][m][n] = (f32x4){0.f, 0.f, 0.f, 0.f};
    bf16x8 At[4][2], B0[2][2], B1[2][2];
    const char* cA = cur.A; const char* cB = cur.B;
    PG8_STAGE(PG8_SB(0, 0), cB, voffB); if constexpr (NBH == 2) PG8_STAGE(PG8_SB(0, 1), cB + hstepB, voffB); PG8_STAGE(PG8_SA(0, 0), cA, voffA); PG8_STAGE(PG8_SA(0, 1), cA + hstepA, voffA);
    if (wr == 1) PG8_BAR;
    PG8_WAIT_V(2); PG8_BAR;
    PG8_STAGE(PG8_SB(1, 0), cB + kstep, voffB); PG8_STAGE(PG8_SA(1, 0), cA + kstep, voffA); if constexpr (NBH == 2) PG8_STAGE(PG8_SB(1, 1), cB + hstepB + kstep, voffB);
    if constexpr (NBH == 2) PG8_WAIT_V(6); else PG8_WAIT_V(4);
    PG8_BAR;
    for (;;) {
        const bool has_next = S.next(ui + 1, nxt);
        const char* nA = has_next ? nxt.A : cA; const char* nB = has_next ? nxt.B : cB;
        for (int t = 0; t < nt; t += 2) {
            const bool last = (t == nt - 2);
            const char* a1 = cA + (size_t)(t + 1) * kstep;
            const char* a2 = last ? nA : cA + (size_t)(t + 2) * kstep; const char* b2 = last ? nB : cB + (size_t)(t + 2) * kstep;
            const char* a3 = a2 + kstep; const char* b3 = b2 + kstep;
            PG8_LDB(B0, 0, 0); if constexpr (NBH == 2) PG8_LDB(B1, 0, 1); PG8_SCHED; PG8_LDA(At, 0, 0); PG8_STAGE(PG8_SA(1, 1), a1 + hstepA, voffA);
            PG8_WAIT_VN(); PG8_WAIT_L(0); PG8_BAR; PG8_MMA(0, 0, At, B0); if constexpr (NBH == 2) PG8_MMA(0, 1, At, B1); PG8_BAR; PG8_SCHED;
            PG8_LDA(At, 0, 1); PG8_STAGE(PG8_SB(0, 0), b2, voffB); if constexpr (NBH == 2) PG8_STAGE(PG8_SB(0, 1), b2 + hstepB, voffB); PG8_STAGE(PG8_SA(0, 0), a2, voffA);
            PG8_WAIT_VN(); PG8_WAIT_L(0); PG8_BAR; PG8_MMA(1, 0, At, B0); if constexpr (NBH == 2) PG8_MMA(1, 1, At, B1); PG8_BAR; PG8_SCHED;
            PG8_LDB(B0, 1, 0); if constexpr (NBH == 2) PG8_LDB(B1, 1, 1); PG8_SCHED; PG8_LDA(At, 1, 0); PG8_STAGE(PG8_SA(0, 1), a2 + hstepA, voffA);
            PG8_WAIT_VN(); PG8_WAIT_L(0); PG8_BAR; PG8_MMA(0, 0, At, B0); if constexpr (NBH == 2) PG8_MMA(0, 1, At, B1); PG8_BAR; PG8_SCHED;
            PG8_LDA(At, 1, 1); PG8_STAGE(PG8_SB(1, 0), b3, voffB); if constexpr (NBH == 2) PG8_STAGE(PG8_SB(1, 1), b3 + hstepB, voffB); PG8_STAGE(PG8_SA(1, 0), a3, voffA);
            PG8_WAIT_VN(); PG8_WAIT_L(0); PG8_BAR; PG8_MMA(1, 0, At, B0); if constexpr (NBH == 2) PG8_MMA(1, 1, At, B1); PG8_BAR; PG8_SCHED;
        }
        if (wr == 0) PG8_BAR;
        E(acc, cur, nxt, has_next, wr, wc, fr, fq);
        if (!has_next) break;
#pragma unroll
        for (int a = 0; a < 2; ++a)
#pragma unroll
            for (int b = 0; b < NBH; ++b)
#pragma unroll
                for (int m = 0; m < 4; ++m)
#pragma unroll
                    for (int n = 0; n < 2; ++n) acc[a][b][m][n] = (f32x4){0.f, 0.f, 0.f, 0.f};
        cur = nxt; cA = nA; cB = nB; ++ui;
        if (wr == 1) PG8_BAR;
    }
    PG8_WAIT_V(0);
    PG8_BAR;
#undef PG8_SA
#undef PG8_SB
#undef PG8_STAGE
#undef PG8_LDA
#undef PG8_LDB
#undef PG8_MMA
#undef PG8_WAIT_V
#undef PG8_WAIT_L
#undef PG8_WAIT_VN
#undef PG8_BAR
#undef PG8_SCHED
}


struct SchedMod { int G, c; const char* A; const char* B;
    DEV bool next(int i, UnitD& u) const { const int idx = i * G + c; if (idx >= 48) return false; u.pm = 0; u.pn = idx; u.aux = 0; u.A = A; u.B = B + (size_t)idx * 256 * (D * 2); return true; } };
struct EpiMod { float* mod; float* atab; bf16_t* shb; const float* b_ada; const float* norm_g;
    DEV void operator()(int pn, int row, int wc, int fq, f32x4 (&v)[2][2]) const {
#pragma unroll
        for (int bj = 0; bj < 2; ++bj) { const int gc = 256 * pn + 128 * bj + 32 * wc + 8 * fq, l = gc / 3072, j3 = gc - l * 3072;
            const f32x4 v0 = v[bj][0] + *(const f32x4*)(b_ada + gc), v1 = v[bj][1] + *(const f32x4*)(b_ada + gc + 4);
            if (row < NBT) { float* o = mod + ((size_t)l * NBT + row) * 3072 + j3; *(f32x4*)o = v0; *(f32x4*)(o + 4) = v1; }
            if (j3 < D) { const f32x4 z = (f32x4){0.f, 0.f, 0.f, 0.f}; store8(shb + ((size_t)l * 256 + row) * D + j3, row < NBT ? v0 : z, row < NBT ? v1 : z); }
            else if (j3 < 2 * D && row < NBT) { const float* ng = norm_g + l * D + (j3 - D); float* o = atab + ((size_t)l * NBT + row) * D + (j3 - D);
                f32x4 a0 = *(const f32x4*)ng * (v0 + 1.f), a1 = *(const f32x4*)(ng + 4) * (v1 + 1.f);
#pragma unroll
                for (int j = 0; j < 4; ++j) { a0[j] = __builtin_fabsf(a0[j]) < 1e-20f ? 1e-20f : a0[j]; a1[j] = __builtin_fabsf(a1[j]) < 1e-20f ? 1e-20f : a1[j]; }
                *(f32x4*)o = a0; *(f32x4*)(o + 4) = a1; }
        }
    } };
template <int NSEG, int KS  , class RowEpi>
DEV void mini_gemm(const Args& a, LAS unsigned char* lds, int u, const bf16_t* A, int lda, int a_seg, const bf16_t* Bt, int ldb, size_t b_seg, const RowEpi& e) {
    LAUNDER_CTX(a);
    const int lane = c.lane, w = c.wave, fr = lane & 15, fq = lane >> 4, rb = u & 7, pn = u >> 5, wc = (u >> 3) & 3, row = MPR + 16 * rb + fr, kw = 32 * KS;
    bf16x8 af[NSEG][KS], bf[NSEG][KS][4];
#pragma unroll
    for (int s = 0; s < NSEG; ++s) { const bf16_t* ap = A + (size_t)row * lda + s * a_seg + w * kw + 8 * fq; const bf16_t* bp = Bt + s * b_seg + (size_t)(256 * pn + 32 * wc + fr) * ldb + w * kw + 8 * fq;
#pragma unroll
        for (int k = 0; k < KS; ++k) { af[s][k] = *(const bf16x8*)(ap + 32 * k);
#pragma unroll
            for (int q = 0; q < 4; ++q) bf[s][k][q] = *(const bf16x8*)(bp + (size_t)(128 * (q >> 1) + 16 * (q & 1)) * ldb + 32 * k); } }
    f32x4 acc[NSEG][4];
#pragma unroll
    for (int s = 0; s < NSEG; ++s) {
#pragma unroll
        for (int q = 0; q < 4; ++q) acc[s][q] = (f32x4){0.f, 0.f, 0.f, 0.f};
#pragma unroll
        for (int k = 0; k < KS; ++k)
#pragma unroll
            for (int q = 0; q < 4; ++q) acc[s][q] = __builtin_amdgcn_mfma_f32_16x16x32_bf16(bf[s][k][q], af[s][k], acc[s][q], 0, 0, 0);
    }
#pragma unroll
    for (int s = 0; s < NSEG; ++s)
#pragma unroll
        for (int q = 0; q < 4; ++q) *(LAS f32x4*)(lds + (((w * NSEG + s) * 4 + q) * 64 + lane) * 16) = acc[s][q];
    __syncthreads();
    if (w == 0) {
        f32x4 v[NSEG][2][2];
#pragma unroll
        for (int s = 0; s < NSEG; ++s)
#pragma unroll
            for (int q = 0; q < 4; ++q) { f32x4 t = *(const LAS f32x4*)(lds + (((0 * NSEG + s) * 4 + q) * 64 + lane) * 16);
#pragma unroll
                for (int ww = 1; ww < 8; ++ww) t += *(const LAS f32x4*)(lds + (((ww * NSEG + s) * 4 + q) * 64 + lane) * 16);
                v[s][q >> 1][q & 1] = t; }
        e(pn, row, wc, fq, v);
    }
    __syncthreads();
}

constexpr int RTAB_OFF = STAGE_BYTES;
constexpr int SWT_OFF = RTAB_OFF + 8192;
template <int TY, bool SMP> DEV void p1_rows(const f32x4 (&acc)[2][2][4][2], bf16_t* pb  , const LAS float* rt, const float* swb, const int row0, f32x4 s00, f32x4 s01, f32x4 s10, f32x4 s11, float* st = nullptr  ) {
    if (TY == 6 && !SMP) { s00 *= -1.44269504f; s01 *= -1.44269504f; s10 *= -1.44269504f; s11 *= -1.44269504f; }
    f32x4 n00 = s00, n01 = s01, n10 = s10, n11 = s11;
    if (SMP) { const float* sw = swb + (size_t)nidx_of(row0) * NIN; n00 = *(const f32x4*)(sw); n01 = *(const f32x4*)(sw + 4); n10 = *(const f32x4*)(sw + 128); n11 = *(const f32x4*)(sw + 132); }
#pragma unroll
    for (int ai = 0; ai < 2; ++ai) {
#pragma unroll
        for (int m = 0; m < 4; ++m) { const int rl = ai * HALF + m * 16; const float r = (TY == 6 && !SMP) ? rt[rl] * -1.44269504f : rt[rl];
            if (SMP) { s00 = n00; s01 = n01; s10 = n10; s11 = n11;
                if (ai * 4 + m < 7) { const int rn = ((ai * 4 + m + 1) >> 2) * HALF + ((ai * 4 + m + 1) & 3) * 16; const float* sw = swb + (size_t)nidx_of(row0 + rn) * NIN; n00 = *(const f32x4*)(sw); n01 = *(const f32x4*)(sw + 4); n10 = *(const f32x4*)(sw + 128); n11 = *(const f32x4*)(sw + 132); } }
            f32x4 a0 = acc[ai][0][m][0] * r + s00, a1 = acc[ai][0][m][1] * r + s01, b0 = acc[ai][1][m][0] * r + s10, b1 = acc[ai][1][m][1] * r + s11;
            bf16_t* pr = pb + (size_t)rl * PC;
            if (TY == 0) { store8(pr, a0 * b0, a1 * b1); }
            else if (TY == 1) { store8(pr, a0 * silu4(b0), a1 * silu4(b1)); }
            else if (TY == 2) { store8(pr, gelu4(a0) * silu4(b0), gelu4(a1) * silu4(b1)); }
            else {
                if (TY == 3) { a0 = gelu4(a0); a1 = gelu4(a1); b0 = gelu4(b0); b1 = gelu4(b1); }
                if (TY == 3) {
                    const f32x4 sv = (a0 + a1) + (b0 + b1), qv = (a0 * a0 + a1 * a1) + (b0 * b0 + b1 * b1);
                    float s = (sv.x + sv.y) + (sv.z + sv.w), q = (qv.x + qv.y) + (qv.z + qv.w);
                    s += __shfl_xor(s, 16); q += __shfl_xor(q, 16); s += __shfl_xor(s, 32); q += __shfl_xor(q, 32);
                    if (st) *(f32x2_t*)(st + (size_t)rl * 16) = (f32x2_t){s, q}; }
                if (TY == 5) { a0 = silu4(a0); a1 = silu4(a1); b0 = silu4(b0); b1 = silu4(b1); }
                if (TY == 6 && SMP) { a0 = sigmoid4(a0); a1 = sigmoid4(a1); b0 = sigmoid4(b0); b1 = sigmoid4(b1); }
                if (TY == 6) { unsigned char* gq = (unsigned char*)pr; if (SMP) { *(u32x2*)gq = (u32x2){pku8(a0), pku8(a1)}; *(u32x2*)(gq + 128) = (u32x2){pku8(b0), pku8(b1)}; } else { *(u32x2*)gq = (u32x2){pku8_t(a0), pku8_t(a1)}; *(u32x2*)(gq + 128) = (u32x2){pku8_t(b0), pku8_t(b1)}; } }
                else { store8(pr, a0, a1); store8(pr + 128, b0, b1); } }
        }
        if (!SMP) asm volatile("" ::: "memory");
    }
}
struct EpiP1T { bf16_t* pbuf; const float* SWl; const LAS float* rtab; const LAS float* swt; float* lnst;
    DEV void operator()(f32x4 (&acc)[2][2][4][2], const UnitD& u, const UnitD& un, const bool has_next, int wr, int wc, int fr, int fq) const {
        const int pn = u.pn, cb = 32 * wc + 8 * fq, row0 = u.pm * 256 + wr * 64 + fr; const bool smp = u.pm >= MPR / 256;
        const float* swb = SWl + 256 * pn + cb; const LAS float* sw = swt + u.aux * 256 + cb;
        const f32x4 s00 = *(const LAS f32x4*)(sw), s01 = *(const LAS f32x4*)(sw + 4), s10 = *(const LAS f32x4*)(sw + 128), s11 = *(const LAS f32x4*)(sw + 132);
        const LAS float* rt = rtab + u.aux * 256 + wr * 64 + fr;
        bf16_t* pb = pbuf + (size_t)row0 * PC + cb;
#define P1_DISPATCH(SM) \
        if (pn < 4) p1_rows<0, SM>(acc, pb + PZ + 128 * pn, rt, swb, row0, s00, s01, s10, s11); \
        else if (pn < 8) p1_rows<1, SM>(acc, pb + PABG + 128 * (pn - 4), rt, swb, row0, s00, s01, s10, s11); \
        else if (pn < 12) p1_rows<2, SM>(acc, pb + PUG + 128 * (pn - 8), rt, swb, row0, s00, s01, s10, s11); \
        else if (pn < 14) p1_rows<3, SM>(acc, pb + PGV + 256 * (pn - 12), rt, swb, row0, s00, s01, s10, s11, fq == 0 ? lnst + (size_t)row0 * 16 + 2 * (4 * (pn - 12) + wc) : nullptr); \
        else if (pn < 16) p1_rows<4, SM>(acc, pb + PCX + 256 * (pn - 14), rt, swb, row0, s00, s01, s10, s11); \
        else if (pn < 18) p1_rows<5, SM>(acc, pb + PSG + 256 * (pn - 16), rt, swb, row0, s00, s01, s10, s11); \
        else p1_rows<6, SM>(acc, (bf16_t*)((unsigned char*)(pb - cb + PGATE) + 256 * (pn - 18) + cb), rt, swb, row0, s00, s01, s10, s11);
        P1_DISPATCH(false)
#undef P1_DISPATCH
    } };
struct EpiP1S { bf16_t* pbuf; const float* SWl; const float* ssq;
    DEV void operator()(int pn, int row, int wc, int fq, f32x4 (&v)[1][2][2]) const {
        const int cb = 32 * wc + 8 * fq; const float r = row_rstd_sc(ssq, row);
        const float* sw = SWl + (size_t)nidx_of(row) * NIN + 256 * pn + cb;
        const f32x4 a0 = v[0][0][0] * r + *(const f32x4*)(sw), a1 = v[0][0][1] * r + *(const f32x4*)(sw + 4), b0 = v[0][1][0] * r + *(const f32x4*)(sw + 128), b1 = v[0][1][1] * r + *(const f32x4*)(sw + 132);
        bf16_t* pr = pbuf + (size_t)row * PC + cb;
        if (pn < 4) store8_sc(pr + PZ + 128 * pn, a0 * b0, a1 * b1);
        else if (pn < 8) store8_sc(pr + PABG + 128 * (pn - 4), a0 * silu4(b0), a1 * silu4(b1));
        else if (pn < 12) store8_sc(pr + PUG + 128 * (pn - 8), gelu4(a0) * silu4(b0), gelu4(a1) * silu4(b1));
        else if (pn < 14) { bf16_t* o = pr + PGV + 256 * (pn - 12); store8_sc(o, gelu4(a0), gelu4(a1)); store8_sc(o + 128, gelu4(b0), gelu4(b1)); }
        else if (pn < 16) { bf16_t* o = pr + PCX + 256 * (pn - 14); store8_sc(o, a0, a1); store8_sc(o + 128, b0, b1); }
        else if (pn < 18) { bf16_t* o = pr + PSG + 256 * (pn - 16); store8_sc(o, silu4(a0), silu4(a1)); store8_sc(o + 128, silu4(b0), silu4(b1)); }
        else { unsigned char* gq = (unsigned char*)(pbuf + (size_t)row * PC + PGATE) + 256 * (pn - 18) + cb;
            st_sc8(gq, (u32x2){pku8(sigmoid4(a0)), pku8(sigmoid4(a1))}); st_sc8(gq + 128, (u32x2){pku8(sigmoid4(b0)), pku8(sigmoid4(b1))}); }
    } };
DEV void p1_sample_slice(const int tid, const int slice  , const bf16_t* xa, const bf16_t* Wl, const EpiP1S& e, LAS unsigned char* lds) {
    const int lane = tid & 63, w = __builtin_amdgcn_readfirstlane(tid >> 6), fr = lane & 15, fq = lane >> 4, pn = slice >> 2, wc = slice & 3, row = MPR + 16 * w + fr;
    const bf16_t* ap = xa + (size_t)row * D + 8 * fq; const bf16_t* bp = Wl + (size_t)(256 * pn + 32 * wc + fr) * D + 8 * fq;
    __syncthreads();
#pragma unroll
    for (int j = 0; j < 16; ++j) { const int b = w * 16 + j, q = b >> 5, ks = b & 31;
        __builtin_amdgcn_global_load_lds((const unsigned*)(bp + (size_t)(128 * (q >> 1) + 16 * (q & 1)) * D + 32 * ks), (LAS unsigned*)(lds + b * 1024), 16, 0, 0); }
    bf16x8 af[32];
#pragma unroll
    for (int ks = 0; ks < 32; ++ks) af[ks] = __builtin_bit_cast(bf16x8, ld_sc16(ap + 32 * ks));
    f32x4 v[1][2][2];
#pragma unroll
    for (int q = 0; q < 4; ++q) v[0][q >> 1][q & 1] = (f32x4){0.f, 0.f, 0.f, 0.f};
    asm volatile("s_waitcnt vmcnt(0)" ::: "memory");
    __syncthreads();
#pragma unroll
    for (int ks = 0; ks < 32; ++ks)
#pragma unroll
        for (int q = 0; q < 4; ++q) { const bf16x8 bfr = *(const LAS bf16x8*)(lds + (q * 32 + ks) * 1024 + lane * 16);
            v[0][q >> 1][q & 1] = __builtin_amdgcn_mfma_f32_16x16x32_bf16(bfr, af[ks], v[0][q >> 1][q & 1], 0, 0, 0); }
    e(pn, row, wc, fq, v);
}
template <class Sched> DEV void p1_rtab(const Sched& S, const float* ssq, const float* SWl, LAS float* rtab, LAS float* swt) {
    int t = threadIdx.x; asm volatile("" : "+v"(t));
#pragma unroll
    for (int k = 0; k < 4; ++k) { const int q = t + 512 * k, i = q >> 8, rl = q & 255; UnitD u;
        if (S.next(i, u)) { rtab[q] = row_rstd(ssq, u.pm * 256 + rl); swt[q] = SWl[(size_t)(u.pm < MPR / 256 ? (u.pm >> 3) : NBP) * NIN + 256 * u.pn + rl]; } }
    __syncthreads();
}
template <bool IN16, bool LAST> struct EpiP4T { const float* gate; const float* atab_cur; const float* atab_next; const bf16_t* xa; bf16_t* xao; float* ssq; const float* xin; bf16_t* xb;
    DEV void operator()(f32x4 (&acc)[2][2][4][2], const UnitD& u, const UnitD& un, const bool has_next, int wr, int wc, int fr, int fq) const {
        const int pn = u.pn, nb = u.pm >> 3, col = 256 * pn + 32 * wc + 8 * fq, row0 = u.pm * 256 + wr * 64 + fr;
        const float* gp = gate + (size_t)nb * 3072 + col;
        f32x4 g[2][2], at[2][2], iv[2][2];
#pragma unroll
        for (int bj = 0; bj < 2; ++bj)
#pragma unroll
            for (int n = 0; n < 2; ++n) { g[bj][n] = *(const f32x4*)(gp + 128 * bj + 4 * n);
                at[bj][n] = LAST ? (f32x4){0.f, 0.f, 0.f, 0.f} : *(const f32x4*)(atab_next + (size_t)nb * D + col + 128 * bj + 4 * n);
                iv[bj][n] = IN16 ? rcp4(*(const f32x4*)(atab_cur + (size_t)nb * D + col + 128 * bj + 4 * n)) : (f32x4){0.f, 0.f, 0.f, 0.f}; }
        const size_t off0 = (size_t)row0 * D + col;
        f32x4 x[2][2], xn[2][2]; u32x4 xh[2], xhn[2];
#pragma unroll
        for (int bj = 0; bj < 2; ++bj) { if (IN16) xh[bj] = *(const u32x4*)(xa + off0 + 128 * bj); else { x[bj][0] = *(const f32x4*)(xin + off0 + 128 * bj); x[bj][1] = *(const f32x4*)(xin + off0 + 128 * bj + 4); } }
#pragma unroll
        for (int r = 0; r < 8; ++r) { const int ai = r >> 2, m = r & 3, rl = ai * HALF + m * 16, row = row0 + rl; float s = 0.f;
            if (r < 7) { const size_t offn = off0 + (size_t)(((r + 1) >> 2) * HALF + ((r + 1) & 3) * 16) * D;
#pragma unroll
                for (int bj = 0; bj < 2; ++bj) { if (IN16) xhn[bj] = *(const u32x4*)(xa + offn + 128 * bj); else { xn[bj][0] = *(const f32x4*)(xin + offn + 128 * bj); xn[bj][1] = *(const f32x4*)(xin + offn + 128 * bj + 4); } } }
            const size_t off = off0 + (size_t)rl * D;
#pragma unroll
            for (int bj = 0; bj < 2; ++bj) {
                if (IN16) { unpk8(xh[bj], x[bj][0], x[bj][1]); x[bj][0] *= iv[bj][0]; x[bj][1] *= iv[bj][1]; }
#pragma unroll
                for (int n = 0; n < 2; ++n) { const f32x4 t = x[bj][n] + g[bj][n] * acc[ai][bj][m][n]; x[bj][n] = t; s += (t.x * t.x + t.y * t.y) + (t.z * t.z + t.w * t.w); }
                if (LAST) store8(xb + off + 128 * bj, x[bj][0], x[bj][1]);
                else store8(xao + off + 128 * bj, x[bj][0] * at[bj][0], x[bj][1] * at[bj][1]); }
            s += __shfl_xor(s, 16); s += __shfl_xor(s, 32);
            if (fq == 0) ssq[row * 16 + 4 * pn + wc] = s;
#pragma unroll
            for (int bj = 0; bj < 2; ++bj) { xh[bj] = xhn[bj]; x[bj][0] = xn[bj][0]; x[bj][1] = xn[bj][1]; }
        }
    } };

struct SchedP3R { TileOrder T; const char* A; const char* B;
    DEV bool next(int i, UnitD& u) const { int pm, pc; const int seg = i % 3; if (!T.tile<WGM_P3>(i / 3, pm, pc)) return false; u.pm = pm; u.pn = pc; u.aux = seg;
        u.A = A + (size_t)pm * 256 * (1536 * 2) + (size_t)seg * (W * 2); u.B = B + (size_t)seg * D * (W * 2) + (size_t)pc * 128 * (W * 2); return true; } };
struct EpiP3R { f32x4 (&tot)[2][4][2]; u32x2 (&gpre)[8]; const bf16_t* pbuf; bf16_t* mg;
    DEV void prefetch(const UnitD& u, int wr, int wc, int fr, int fq) const {
        const unsigned char* gp = (const unsigned char*)(pbuf + (size_t)(u.pm * 256 + wr * 64 + fr) * PC + PGATE) + 1024 * u.aux + 128 * u.pn + 32 * wc + 8 * fq;
#pragma unroll
        for (int r = 0; r < 8; ++r) gpre[r] = *(const u32x2*)(gp + (size_t)((r >> 2) * HALF + (r & 3) * 16) * (PC * 2));
    }
    DEV void operator()(f32x4 (&acc)[2][1][4][2], const UnitD& u, const UnitD& un, const bool has_next, int wr, int wc, int fr, int fq) const {
        const int seg = u.aux, cb = 128 * u.pn + 32 * wc + 8 * fq, row0 = u.pm * 256 + wr * 64 + fr;
        bf16_t* o = mg + (size_t)row0 * D + cb;
        u32x2 g[8];
#pragma unroll
        for (int r = 0; r < 8; ++r) g[r] = gpre[r];
        if (has_next) prefetch(un, wr, wc, fr, fq);
        const float keep = seg ? 1.f : 0.f;
#pragma unroll
        for (int r = 0; r < 8; ++r) { const int ai = r >> 2, m = r & 3; const f32x4 g0 = gate4(g[r].x), g1 = gate4(g[r].y);
            const f32x4 t0 = acc[ai][0][m][0] * g0 + tot[ai][m][0] * keep, t1 = acc[ai][0][m][1] * g1 + tot[ai][m][1] * keep;
            tot[ai][m][0] = t0; tot[ai][m][1] = t1;
            if (seg == 2) store8(o + (size_t)(ai * HALF + m * 16) * D, t0, t1); }
    } };
#define XB_TMO      128
#define XB_XCNT(j)  (256  + 64 * (j))
#define XB_XSUB(j)  (1280 + 64 * (j))
#define XB_XGEN(j)  (2304 + 64 * (j))
#define XB_TOP      3328
#define XB_TOPGEN   3392
#define XCD_BAR_WORDS 3456
#define XB_LSUB(j)  (3456 + 64 * (j))
#define XB_LGEN(j)  (3968 + 64 * (j))
#define XB_CNT_P4S  4480
#define XB_CNT_P1S  4544
#define XB_SPIN_CAP (1u << 18)
DEV unsigned xb_ld(unsigned* p)              { return __hip_atomic_load(p, __ATOMIC_RELAXED, __HIP_MEMORY_SCOPE_AGENT); }
DEV unsigned xb_add(unsigned* p, unsigned v) { return __hip_atomic_fetch_add(p, v, __ATOMIC_RELAXED, __HIP_MEMORY_SCOPE_AGENT); }
DEV unsigned xb_xcc_id() { return (unsigned)__builtin_amdgcn_s_getreg((3 << 11) | 20) & 0xFu; }
#define XB_SPIN(cond, bar) do { unsigned _sp = 0; while (cond) { __builtin_amdgcn_s_sleep(1); \
    if ((++_sp & 255u) == 0u) { if (xb_ld(&(bar)[XB_TMO])) break; if (_sp > XB_SPIN_CAP) { atomicAdd(&(bar)[XB_TMO], 1u); break; } } } } while (0)
struct XcdBarrier { unsigned* bar; unsigned x; volatile LAS unsigned* st; };
DEV XcdBarrier xcd_barrier_post(unsigned* bar, volatile LAS unsigned* st) {
    XcdBarrier b; b.bar = bar; b.x = xb_xcc_id(); b.st = st;
    if (threadIdx.x == 0) st[4] = xb_add(&bar[XB_XCNT(b.x)], 1u);
    return b;
}
DEV void xcd_barrier_complete(unsigned* bar, unsigned x, unsigned& nloc, unsigned& nx, unsigned& even) {
    const unsigned G = gridDim.x * gridDim.y * gridDim.z;
    unsigned sum, cnt, mine, n32, sp = 0u;
    for (;;) {
        sum = 0u; cnt = 0u; mine = 0u; n32 = 0u;
#pragma unroll
        for (unsigned j = 0; j < 16; ++j) { const unsigned c = xb_ld(&bar[XB_XCNT(j)]); sum += c; cnt += (c > 0u) ? 1u : 0u; n32 += (j < 8u && c == 32u) ? 1u : 0u; mine = (j == x) ? c : mine; }
        if (sum == G) break;
        __builtin_amdgcn_s_sleep(1);
        if ((++sp & 255u) == 0u) { if (xb_ld(&bar[XB_TMO])) break; if (sp > XB_SPIN_CAP) { atomicAdd(&bar[XB_TMO], 1u); break; } }
    }
    nloc = mine > 0u ? mine : 1u; nx = cnt > 0u ? cnt : 1u;
    even = (sum == G && G == 256u && n32 == 8u) ? 1u : 0u;
}
DEV void xcd_barrier(const XcdBarrier& b) {
    asm volatile("s_waitcnt vmcnt(0)" ::: "memory");
    __syncthreads();
    if (threadIdx.x == 0) {
        unsigned* bar = b.bar; unsigned bx = b.x; asm volatile("" : "+s"(bar), "+s"(bx));
        __builtin_amdgcn_s_waitcnt(0);
        unsigned nloc = b.st[0], nx = b.st[1];
        if (nloc == 0u) { unsigned even; xcd_barrier_complete(bar, bx, nloc, nx, even); b.st[0] = nloc; b.st[1] = nx;
            b.st[2] = even ? bx * 32u + b.st[4] : (unsigned)blockIdx.x;
            b.st[3] = even; }
        const unsigned old = xb_add(&bar[XB_XSUB(bx)], 1u);
        const unsigned gen = old / nloc;
        if (old + 1u == (gen + 1u) * nloc) {
            __builtin_amdgcn_fence(__ATOMIC_RELEASE, "agent");
            asm volatile("s_waitcnt vmcnt(0)" ::: "memory");
            const unsigned og = xb_add(&bar[XB_TOP], 1u);
            const unsigned tg = og / nx;
            if (og + 1u == (tg + 1u) * nx) xb_add(&bar[XB_TOPGEN], 1u);
            else XB_SPIN(xb_ld(&bar[XB_TOPGEN]) == tg, bar);
            __builtin_amdgcn_fence(__ATOMIC_ACQUIRE, "agent");
            xb_add(&bar[XB_XGEN(bx)], 1u);
            asm volatile("s_waitcnt vmcnt(0)" ::: "memory");
        } else {
            XB_SPIN(xb_ld(&bar[XB_XGEN(bx)]) == gen, bar);
            __builtin_amdgcn_fence(__ATOMIC_ACQUIRE, "agent");
            asm volatile("s_waitcnt vmcnt(0)" ::: "memory");
        }
    }
    __syncthreads();
}
DEV void xcd_local_barrier(const XcdBarrier& b) {
    asm volatile("s_waitcnt vmcnt(0)" ::: "memory");
    __syncthreads();
    if (threadIdx.x == 0) {
        unsigned* bar = b.bar; unsigned bx = b.x; asm volatile("" : "+s"(bar), "+s"(bx));
        __builtin_amdgcn_s_waitcnt(0);
        const unsigned old = xb_add(&bar[XB_LSUB(bx)], 1u);
        const unsigned gen = old >> 5;
        if ((old & 31u) == 31u) xb_add(&bar[XB_LGEN(bx)], 1u);
        else XB_SPIN(xb_ld(&bar[XB_LGEN(bx)]) == gen, bar);
        __builtin_amdgcn_fence(__ATOMIC_ACQUIRE, "agent");
        asm volatile("s_waitcnt vmcnt(0)" ::: "memory");
    }
    __syncthreads();
}
constexpr bool LOCAL_BAR = true;
DEV void layer_barrier(const XcdBarrier& b) { if (LOCAL_BAR && b.st[3]) xcd_local_barrier(b); else xcd_barrier(b); }
template <class RowEpi> struct EpiRows { RowEpi e;
    DEV void operator()(f32x4 (&acc)[2][2][4][2], const UnitD& u, const UnitD& un, const bool has_next, int wr, int wc, int fr, int fq) const {
#pragma unroll
        for (int ai = 0; ai < 2; ++ai)
#pragma unroll
            for (int m = 0; m < 4; ++m) { f32x4 v[2][2] = {{acc[ai][0][m][0], acc[ai][0][m][1]}, {acc[ai][1][m][0], acc[ai][1][m][1]}};
                e(u.pn, u.pm * 256 + ai * HALF + wr * 64 + m * 16 + fr, wc, fq, v); asm volatile("" ::: "memory"); }
    } };
struct SchedP1 { TileOrder T; const char* A; const char* B;
    DEV bool next(int i, UnitD& u) const { int pm, pn; if (!T.tile<WGM_P1>(i, pm, pn)) return false; pn += (T.pm0 >> 3) * 4; pn -= pn >= 30 ? 30 : 0;   u.pm = pm; u.pn = pn; u.aux = i; u.A = A + (size_t)pm * 256 * (D * 2); u.B = B + (size_t)pn * 256 * (D * 2); return true; } };

struct SchedP4 { TileOrder T; const char* A; const char* B;
    DEV bool next(int i, UnitD& u) const { int pm, pn; if (!T.tile<WGM_P4>(i, pm, pn)) return false; u.pm = pm; u.pn = pn; u.aux = 0; u.A = A + (size_t)pm * 256 * (D * 2); u.B = B + (size_t)pn * 256 * (D * 2); return true; } };
struct EpiP3 { const bf16_t* pbuf; bf16_t* mg;
    DEV void operator()(int pn, int row, int wc, int fq, f32x4 (&v)[3][2][2]) const {
        const int cb = 256 * pn + 32 * wc + 8 * fq;
        const unsigned char* gp = (const unsigned char*)(pbuf + (size_t)row * PC + PGATE) + cb; bf16_t* o = mg + (size_t)row * D + cb;
        u32x2 g[3][2];
#pragma unroll
        for (int s = 0; s < 3; ++s) { g[s][0] = ld_sc8(gp + 1024 * s); g[s][1] = ld_sc8(gp + 1024 * s + 128); }
#pragma unroll
        for (int bj = 0; bj < 2; ++bj) { f32x4 t0 = v[0][bj][0] * gate4(g[0][bj].x), t1 = v[0][bj][1] * gate4(g[0][bj].y);
#pragma unroll
            for (int s = 1; s < 3; ++s) { t0 += v[s][bj][0] * gate4(g[s][bj].x); t1 += v[s][bj][1] * gate4(g[s][bj].y); }
            store8(o + 128 * bj, t0, t1); }
    } };
struct SchedSW { int G, c; const char* A; const char* B;
    DEV bool next(int i, UnitD& u) const { const int idx = i * G + c; if (idx >= DEPTH * 30) return false; const int l = idx / 30, pn = idx % 30; u.pm = 0; u.pn = pn + 32 * l; u.aux = l;
        u.A = A + (size_t)l * 256 * (D * 2); u.B = B + (size_t)l * NIN * (D * 2) + (size_t)pn * 256 * (D * 2); return true; } };
struct EpiSWx { float* SW;
    DEV void operator()(int pnx, int row, int wc, int fq, f32x4 (&v)[2][2]) const {
        if (row >= NBT) return;
        const int l = pnx >> 5, pn = pnx & 31;
        float* o = SW + (size_t)l * NBT * NIN + (size_t)row * NIN + 256 * pn + 32 * wc + 8 * fq;
        *(f32x4*)(o) = v[0][0]; *(f32x4*)(o + 4) = v[0][1]; *(f32x4*)(o + 128) = v[1][0]; *(f32x4*)(o + 132) = v[1][1];
    } };
struct EpiP4 { const float* gate  ; const float* atab_cur; const float* atab_next  ; const bf16_t* xa; bf16_t* xao; float* ssq; const float* xin  ; bf16_t* xb; int in16;
    DEV void operator()(int pn, int row, int wc, int fq, f32x4 (&vv)[1][2][2]) const {
        f32x4 (&v)[2][2] = vv[0];
        const int nb = nidx_of(row), col = 256 * pn + 32 * wc + 8 * fq;
        const float* gp = gate + (size_t)nb * 3072 + col;
        float s = 0.f;
#pragma unroll
        for (int bj = 0; bj < 2; ++bj) {
            f32x4 x0, x1;
            if (in16) { unpk8(*(const u32x4*)(xa + (size_t)row * D + col + 128 * bj), x0, x1); const float* ac = atab_cur + (size_t)nb * D + col + 128 * bj; x0 *= rcp4(*(const f32x4*)ac); x1 *= rcp4(*(const f32x4*)(ac + 4)); }
            else { x0 = *(const f32x4*)(xin + (size_t)row * D + col + 128 * bj); x1 = *(const f32x4*)(xin + (size_t)row * D + col + 128 * bj + 4); }
            const f32x4 t0 = x0 + *(const f32x4*)(gp + 128 * bj) * v[bj][0], t1 = x1 + *(const f32x4*)(gp + 128 * bj + 4) * v[bj][1];
            s += ((t0.x * t0.x + t0.y * t0.y) + (t0.z * t0.z + t0.w * t0.w)) + ((t1.x * t1.x + t1.y * t1.y) + (t1.z * t1.z + t1.w * t1.w));
            if (atab_next) { const float* ap = atab_next + (size_t)nb * D + col + 128 * bj; store8_sc(xao + (size_t)row * D + col + 128 * bj, t0 * *(const f32x4*)ap, t1 * *(const f32x4*)(ap + 4)); }
            else store8(xb + (size_t)row * D + col + 128 * bj, t0, t1);
        }
        s += __shfl_xor(s, 16); s += __shfl_xor(s, 32);
        if (fq == 0) __hip_atomic_store(ssq + row * 16 + 4 * pn + wc, s, __ATOMIC_RELAXED, __HIP_MEMORY_SCOPE_AGENT);
    } };


typedef short v4i16 __attribute__((ext_vector_type(4)));
constexpr int TP = 528, VT_OFF = 0, PM_OFF = 128 * TP;
DEV f32x4 unpk4(u32x2 r) { return (f32x4){bflo(r.x), bfhi(r.x), bflo(r.y), bfhi(r.y)}; }
DEV void p2_ln(const Ctx& c, int l, int ck, int hh, const bf16_t* pb, LAS unsigned char* lds) {
    int lane_ = c.lane; asm volatile("" : "+v"(lane_));
    const int lane = lane_, w = c.wave, p = lane >> 5, ch = 256 * hh + 8 * (lane & 31); const bool lastck = (ck & 15) == 15;
    const float* st = c.lnst + ((size_t)ck * 128 + 16 * w + (lane & 15)) * 16;
    const f32x4 t0 = *(const f32x4*)st, t1 = *(const f32x4*)(st + 4), t2 = *(const f32x4*)(st + 8), t3 = *(const f32x4*)(st + 12);
    u32x4 gv[8];
#pragma unroll
    for (int k = 0; k < 8; ++k) gv[k] = *(const u32x4*)(pb + (size_t)(16 * w + 2 * k + p) * PC + PGV + ch);
    const f32x4 g0 = *(const f32x4*)(c.lnv_g + l * W + ch), g1 = *(const f32x4*)(c.lnv_g + l * W + ch + 4), b0 = *(const f32x4*)(c.lnv_b + l * W + ch), b1 = *(const f32x4*)(c.lnv_b + l * W + ch + 4);
    const float s = ((t0.x + t0.z) + (t1.x + t1.z)) + ((t2.x + t2.z) + (t3.x + t3.z)), q = ((t0.y + t0.w) + (t1.y + t1.w)) + ((t2.y + t2.w) + (t3.y + t3.w));
    const float mu_l = s * (1.f / W), rstd_l = __builtin_amdgcn_rsqf(fmaxf(q * (1.f / W) - mu_l * mu_l, 0.f) + EPS);
    float* vout = c.out + O_VP + ((size_t)(l * NBP + (ck >> 4)) * 128) * W + ch;
#pragma unroll
    for (int k = 0; k < 8; ++k) { const int t = 16 * w + 2 * k + p;
        const float mu = __shfl(mu_l, 2 * k + p), rstd = __shfl(rstd_l, 2 * k + p);
        f32x4 x0 = (f32x4){bflo(gv[k].x), bfhi(gv[k].x), bflo(gv[k].y), bfhi(gv[k].y)}, x1 = (f32x4){bflo(gv[k].z), bfhi(gv[k].z), bflo(gv[k].w), bfhi(gv[k].w)};
        x0 = (x0 - mu) * rstd * g0 + b0; x1 = (x1 - mu) * rstd * g1 + b1;
        u32x4 o; o.x = pk2(x0.x, x0.y); o.y = pk2(x0.z, x0.w); o.z = pk2(x1.x, x1.y); o.w = pk2(x1.z, x1.w);
        *(LAS u32x4*)(lds + VT_OFF + t * TP + (lane & 31) * 16) = o;
        if (lastck) { *(f32x4*)(vout + (size_t)t * W) = x0; *(f32x4*)(vout + (size_t)t * W + 4) = x1; }
    }
}
template <int HH> DEV void p2_pool(const Ctx& c, int l, int ck, const bf16_t* pb, LAS unsigned char* lds) {
    constexpr int W0 = 2 << (2 * HH), W1 = 2 * W0, H = W1 - 1, NX = H + 16;
    int lane_ = c.lane; asm volatile("" : "+v"(lane_));
    const int lane = lane_, w = c.wave, gi = lane >> 5, cpos = (ck & 15) * 128, ch = 256 * HH + 4 * lane; const bool lastck = (ck & 15) == 15;
    f32x4 x[NX];
#pragma unroll
    for (int k = 0; k < NX; ++k) { const int tt = 16 * w - H + k; const bool valid = cpos + tt >= 0; const int tc = valid ? tt : 0;
        const u32x2 r = *(const u32x2*)(pb + (ptrdiff_t)tc * PC + PCX + ch); const f32x4 v = unpk4(r); x[k] = valid ? v : (f32x4){0.f, 0.f, 0.f, 0.f}; }
    f32x4 slo = x[H];
#pragma unroll
    for (int j = 1; j < W0; ++j) slo += x[H - j];
    f32x4 shi = slo;
#pragma unroll
    for (int j = W0; j < W1; ++j) shi += x[H - j];
    float* pout = c.out + O_POOLP + ((size_t)(l * NBP + (ck >> 4)) * 15) * W + ch;
#pragma unroll
    for (int i = 0; i < 16; ++i) { const int t = 16 * w + i, pos = cpos + t, wd = gi ? W1 : W0;
        const f32x4 s = gi ? shi : slo; const float inv = __builtin_amdgcn_rcpf((float)(wd < pos + 1 ? wd : pos + 1));
        const f32x4 pm = s * inv - x[H + i];
        *(LAS u32x2*)(lds + PM_OFF + t * TP + 8 * lane) = (u32x2){pk2(pm.x, pm.y), pk2(pm.z, pm.w)};
        if (lastck && t >= 113) *(f32x4*)(pout + (size_t)(t - 113) * W) = x[H + i];
        if (i < 15) { slo += x[H + i + 1] - x[H + i + 1 - W0]; shi += x[H + i + 1] - x[H + i + 1 - W1]; }
    }
}
DEV void p2_conv(const Ctx& c, int l, int ck, int hh, const bf16_t* pb) {
    int lane_ = c.lane; asm volatile("" : "+v"(lane_));
    const int lane = lane_, w = c.wave, cpos = (ck & 15) * 128, ch = 256 * hh + 4 * lane, row0 = ck * 128; const bool lastck = (ck & 15) == 15;
    const f32x4 cb = *(const f32x4*)(c.conv_b + l * W + ch), w0 = *(const f32x4*)(c.conv_w + (l * 3 + 0) * W + ch), w1 = *(const f32x4*)(c.conv_w + (l * 3 + 1) * W + ch), w2 = *(const f32x4*)(c.conv_w + (l * 3 + 2) * W + ch);
    f32x4 z[18];
#pragma unroll
    for (int k = 0; k < 18; ++k) { const int tt = 16 * w - 2 + k; const bool valid = cpos + tt >= 0; const int tc = valid ? tt : 0;
        const f32x4 v = unpk4(*(const u32x2*)(pb + (ptrdiff_t)tc * PC + PZ + ch)); z[k] = valid ? v : (f32x4){0.f, 0.f, 0.f, 0.f}; }
    float* cout = c.out + O_CONVP + ((size_t)(l * NBP + (ck >> 4)) * 2) * W + ch;
#pragma unroll
    for (int i = 0; i < 16; ++i) { const int t = 16 * w + i;
        const f32x4 abg = unpk4(*(const u32x2*)(pb + (size_t)t * PC + PABG + ch));
        const f32x4 o = abg * (cb + w0 * z[i] + w1 * z[i + 1] + w2 * z[i + 2]);
        *(u32x2*)(c.y + (size_t)(row0 + t) * 1536 + ch) = (u32x2){pk2(o.x, o.y), pk2(o.z, o.w)};
        if (lastck && t >= 126) *(f32x4*)(cout + (size_t)(t - 126) * W) = z[i + 2];
    }
}
constexpr int TPS = 1040;
DEV void p2_sample_block(const Ctx& c, int l, int sb, LAS unsigned char* ldsw) {
    const int lane = c.lane, fr = lane & 15, fq = lane >> 4, ch = 8 * lane, h = lane >> 3, g = lane >> 4;
    {
        const int i = c.wave, n = 8 * sb + i, row = MPR + n; const bf16_t* pr = c.pbuf + (size_t)row * PC; bf16_t* yr = c.y + (size_t)row * 1536;
        const float* sc = c.state_conv + ((size_t)(l * NSM + n) * 2) * W + ch; const float* sp = c.state_pool + ((size_t)(l * NSM + n) * 15) * W + ch;
        const u32x4 qz = ld_sc16(pr + PZ + ch), qa = ld_sc16(pr + PABG + ch), qg = ld_sc16(pr + PGV + ch), qu = ld_sc16(pr + PUG + ch), qc = ld_sc16(pr + PCX + ch);
        const f32x4 s00 = *(const f32x4*)(sc), s01 = *(const f32x4*)(sc + 4), s10 = *(const f32x4*)(sc + W), s11 = *(const f32x4*)(sc + W + 4);
        f32x4 st0[15], st1[15];
#pragma unroll
        for (int k = 7; k < 15; ++k) { st0[k] = *(const f32x4*)(sp + (size_t)k * W); st1[k] = *(const f32x4*)(sp + (size_t)k * W + 4); }
        const f32x4 cb0 = *(const f32x4*)(c.conv_b + l * W + ch), cb1 = *(const f32x4*)(c.conv_b + l * W + ch + 4);
        const f32x4 w0a = *(const f32x4*)(c.conv_w + (l * 3 + 0) * W + ch), w0b = *(const f32x4*)(c.conv_w + (l * 3 + 0) * W + ch + 4);
        const f32x4 w1a = *(const f32x4*)(c.conv_w + (l * 3 + 1) * W + ch), w1b = *(const f32x4*)(c.conv_w + (l * 3 + 1) * W + ch + 4);
        const f32x4 w2a = *(const f32x4*)(c.conv_w + (l * 3 + 2) * W + ch), w2b = *(const f32x4*)(c.conv_w + (l * 3 + 2) * W + ch + 4);
        const f32x4 lg0 = *(const f32x4*)(c.lnv_g + l * W + ch), lg1 = *(const f32x4*)(c.lnv_g + l * W + ch + 4), lb0 = *(const f32x4*)(c.lnv_b + l * W + ch), lb1 = *(const f32x4*)(c.lnv_b + l * W + ch + 4);
        const float w00 = c.sgu_w[(size_t)(l * 8 + h) * 128 * 128], b00 = c.sgu_b[(l * 8 + h) * 128], invw = 1.f / (float)(2 << g);
        asm volatile("" ::: "memory");
        {
            f32x4 z0, z1, a0, a1; unpk8(qz, z0, z1); unpk8(qa, a0, a1);
            const f32x4 ya = a0 * (cb0 + w0a * s00 + w1a * s10 + w2a * z0), yb = a1 * (cb1 + w0b * s01 + w1b * s11 + w2b * z1);
#pragma unroll
            for (int k = 0; k < 7; ++k) { st0[k] = *(const f32x4*)(sp + (size_t)k * W); st1[k] = *(const f32x4*)(sp + (size_t)k * W + 4); }
            store8(yr + ch, ya, yb);
            float* o = c.out + O_CONVS + ((size_t)(l * NSM + n) * 2) * W + ch;
            *(f32x4*)(o) = s10; *(f32x4*)(o + 4) = s11; *(f32x4*)(o + W) = z0; *(f32x4*)(o + W + 4) = z1;
        }
        {
            f32x4 x0, x1, u0, u1; unpk8(qg, x0, x1); unpk8(qu, u0, u1);
            float s = ((x0.x + x0.y) + (x0.z + x0.w)) + ((x1.x + x1.y) + (x1.z + x1.w));
            float q = ((x0.x * x0.x + x0.y * x0.y) + (x0.z * x0.z + x0.w * x0.w)) + ((x1.x * x1.x + x1.y * x1.y) + (x1.z * x1.z + x1.w * x1.w));
#pragma unroll
            for (int o = 1; o < 64; o <<= 1) { s += __shfl_xor(s, o); q += __shfl_xor(q, o); }
            const float mu = s * (1.f / W), var = fmaxf(q * (1.f / W) - mu * mu, 0.f), rstd = __builtin_amdgcn_rsqf(var + EPS);
            x0 = (x0 - mu) * rstd * lg0 + lb0; x1 = (x1 - mu) * rstd * lg1 + lb1;
            float* vo = c.out + O_VS + (size_t)(l * NSM + n) * W + ch; *(f32x4*)(vo) = x0; *(f32x4*)(vo + 4) = x1;
            store8(yr + 512 + ch, u0 * (x0 * w00 + b00), u1 * (x1 * w00 + b00));
        }
        {
            f32x4 c0, c1; unpk8(qc, c0, c1);
            float* po = c.out + O_POOLS + ((size_t)(l * NSM + n) * 15) * W + ch;
            f32x4 r0 = c0, r1 = c1, s2a, s2b, s4a, s4b, s8a, s8b;
#pragma unroll
            for (int k = 14; k >= 0; --k) {
                if (k >= 1) { *(f32x4*)(po + (size_t)(k - 1) * W) = st0[k]; *(f32x4*)(po + (size_t)(k - 1) * W + 4) = st1[k]; }
                r0 += st0[k]; r1 += st1[k];
                if (k == 14) { s2a = r0; s2b = r1; } if (k == 12) { s4a = r0; s4b = r1; } if (k == 8) { s8a = r0; s8b = r1; } }
            *(f32x4*)(po + (size_t)14 * W) = c0; *(f32x4*)(po + (size_t)14 * W + 4) = c1;
            const f32x4 sa = g == 0 ? s2a : g == 1 ? s4a : g == 2 ? s8a : r0, sb2 = g == 0 ? s2b : g == 1 ? s4b : g == 2 ? s8b : r1;
            const f32x4 p0 = sa * invw - c0, p1 = sb2 * invw - c1;
            u32x4 o; o.x = pk2(p0.x, p0.y); o.y = pk2(p0.z, p0.w); o.z = pk2(p1.x, p1.y); o.w = pk2(p1.z, p1.w);
            *(LAS u32x4*)(ldsw + i * TPS + 16 * lane) = o;
        }
    }
    __syncthreads();
    const int row = MPR + 8 * sb + (fr & 7); const bf16_t* pr = c.pbuf + (size_t)row * PC; bf16_t* yr = c.y + (size_t)row * 1536;
    bf16x8 bw[2][4][2]; u32x4 sgv[2]; f32x4 pbv[2][2], psv[2][2];
#pragma unroll
    for (int gi2 = 0; gi2 < 2; ++gi2) { const int gq = 2 * c.wave + gi2, g2 = gq >> 2, nq = gq & 3, cc = 128 * g2 + 32 * nq + 8 * fq;
        const bf16_t* pw = c.PoolWT + ((size_t)(l * 4 + g2) * 128 + 32 * nq + fr) * 128 + 8 * fq;
#pragma unroll
        for (int ks = 0; ks < 4; ++ks) { bw[gi2][ks][0] = *(const bf16x8*)(pw + 32 * ks); bw[gi2][ks][1] = *(const bf16x8*)(pw + 16 * 128 + 32 * ks); }
        sgv[gi2] = ld_sc16(pr + PSG + cc);
        pbv[gi2][0] = *(const f32x4*)(c.pool_b + l * W + cc); pbv[gi2][1] = *(const f32x4*)(c.pool_b + l * W + cc + 4); psv[gi2][0] = *(const f32x4*)(c.pool_scale + l * W + cc); psv[gi2][1] = *(const f32x4*)(c.pool_scale + l * W + cc + 4); }
#pragma unroll
    for (int gi2 = 0; gi2 < 2; ++gi2) { const int gq = 2 * c.wave + gi2, g2 = gq >> 2, nq = gq & 3, cc = 128 * g2 + 32 * nq + 8 * fq;
        f32x4 a0 = (f32x4){0.f, 0.f, 0.f, 0.f}, a1 = (f32x4){0.f, 0.f, 0.f, 0.f};
#pragma unroll
        for (int ks = 0; ks < 4; ++ks) { const bf16x8 af = *(const LAS bf16x8*)(ldsw + fr * TPS + 2 * (128 * g2 + 32 * ks + 8 * fq));
            a0 = __builtin_amdgcn_mfma_f32_16x16x32_bf16(bw[gi2][ks][0], af, a0, 0, 0, 0); a1 = __builtin_amdgcn_mfma_f32_16x16x32_bf16(bw[gi2][ks][1], af, a1, 0, 0, 0); }
        f32x4 g0v, g1v; unpk8(sgv[gi2], g0v, g1v);
        if (fr < 8) store8(yr + 1024 + cc, (a0 + pbv[gi2][0]) * psv[gi2][0] * g0v, (a1 + pbv[gi2][1]) * psv[gi2][1] * g1v);
    }
}

DEV void p2_mm(const Ctx& c, const int l, const int ck, const int hh, const bf16_t* pb, LAS unsigned char* lds) {
    int lane_ = c.lane; asm volatile("" : "+v"(lane_));
    const int lane = lane_, w = c.wave, fr = lane & 15, fq = lane >> 4, row0 = ck * 128;
    const int hq = w >> 1, a = w & 1, h = 4 * hh + hq;
    bf16x8 wf[4][4]; u32x4 ug[4][2]; float bias[4];
    { const bf16_t* wm = c.SguW + ((size_t)(l * 8 + h) * 128) * 128;
#pragma unroll
      for (int i = 0; i < 4; ++i) { const int tb = a ? (i == 0 ? 1 : i == 1 ? 2 : i == 2 ? 5 : 6) : (i == 0 ? 0 : i == 1 ? 3 : i == 2 ? 4 : 7), t = 16 * tb + fr;
#pragma unroll
          for (int ks = 0; ks < 4; ++ks) wf[i][ks] = *(const bf16x8*)(wm + (size_t)t * 128 + 32 * ks + 8 * fq);
      } }
    __syncthreads();
#pragma unroll
    for (int i = 0; i < 4; ++i) { const int tb = a ? (i == 0 ? 1 : i == 1 ? 2 : i == 2 ? 5 : 6) : (i == 0 ? 0 : i == 1 ? 3 : i == 2 ? 4 : 7), t = 16 * tb + fr;
        bias[i] = c.sgu_b[(l * 8 + h) * 128 + t];
#pragma unroll
        for (int c2 = 0; c2 < 2; ++c2) ug[i][c2] = *(const u32x4*)(pb + (size_t)t * PC + PUG + 256 * hh + 64 * hq + 32 * c2 + 8 * fq); }
    f32x4 acc[4][4];
#pragma unroll
    for (int i = 0; i < 4; ++i)
#pragma unroll
        for (int cc = 0; cc < 4; ++cc) acc[i][cc] = (f32x4){0.f, 0.f, 0.f, 0.f};
    { const int q = fr >> 2, p = fr & 3;
#pragma unroll
      for (int ks = 0; ks < 4; ++ks) {
        bf16x8 vb[4];
#pragma unroll
        for (int cc = 0; cc < 4; ++cc) { const int col = 64 * hq + 32 * (cc >> 1) + 8 * p + 4 * (cc & 1);
            const v4i16 lo = __builtin_amdgcn_ds_read_tr16_b64_v4i16((LAS v4i16*)(lds + VT_OFF + (32 * ks + 8 * fq + q) * TP + 2 * col));
            const v4i16 hi = __builtin_amdgcn_ds_read_tr16_b64_v4i16((LAS v4i16*)(lds + VT_OFF + (32 * ks + 8 * fq + 4 + q) * TP + 2 * col));
            vb[cc] = (bf16x8){lo[0], lo[1], lo[2], lo[3], hi[0], hi[1], hi[2], hi[3]}; }
#pragma unroll
        for (int i = 0; i < 4; ++i) { const int tb = a ? (i == 0 ? 1 : i == 1 ? 2 : i == 2 ? 5 : 6) : (i == 0 ? 0 : i == 1 ? 3 : i == 2 ? 4 : 7);
            if (ks <= (tb >> 1)) {
#pragma unroll
                for (int cc = 0; cc < 4; ++cc) acc[i][cc] = __builtin_amdgcn_mfma_f32_16x16x32_bf16(vb[cc], wf[i][ks], acc[i][cc], 0, 0, 0); } }
      } }
    asm volatile("" ::: "memory");
    const int gi2 = w >> 2, nq = w & 3, chc = 256 * hh + 128 * gi2 + 32 * nq + 8 * fq;
    bf16x8 pw0[4], pw1[4]; u32x4 sgv[8];
    { const bf16_t* pw = c.PoolWT + ((size_t)(l * 4 + 2 * hh + gi2) * 128 + 32 * nq + fr) * 128 + 8 * fq;
#pragma unroll
      for (int ks = 0; ks < 4; ++ks) { pw0[ks] = *(const bf16x8*)(pw + 32 * ks); pw1[ks] = *(const bf16x8*)(pw + 16 * 128 + 32 * ks); }
#pragma unroll
      for (int m = 0; m < 8; ++m) sgv[m] = *(const u32x4*)(pb + (size_t)(16 * m + fr) * PC + PSG + chc); }
    const f32x4 pb0 = *(const f32x4*)(c.pool_b + l * W + chc), pb1 = *(const f32x4*)(c.pool_b + l * W + chc + 4), ps0 = *(const f32x4*)(c.pool_scale + l * W + chc), ps1 = *(const f32x4*)(c.pool_scale + l * W + chc + 4);
#pragma unroll
    for (int i = 0; i < 4; ++i) { const int tb = a ? (i == 0 ? 1 : i == 1 ? 2 : i == 2 ? 5 : 6) : (i == 0 ? 0 : i == 1 ? 3 : i == 2 ? 4 : 7), t = 16 * tb + fr;
#pragma unroll
        for (int c2 = 0; c2 < 2; ++c2) { f32x4 u0, u1; unpk8(ug[i][c2], u0, u1);
            store8(c.y + (size_t)(row0 + t) * 1536 + 512 + 256 * hh + 64 * hq + 32 * c2 + 8 * fq, (acc[i][2 * c2] + bias[i]) * u0, (acc[i][2 * c2 + 1] + bias[i]) * u1); } }
    f32x4 ac2[8][2];
#pragma unroll
    for (int m = 0; m < 8; ++m) { ac2[m][0] = (f32x4){0.f, 0.f, 0.f, 0.f}; ac2[m][1] = (f32x4){0.f, 0.f, 0.f, 0.f}; }
#pragma unroll
    for (int ks = 0; ks < 4; ++ks)
#pragma unroll
        for (int m = 0; m < 8; ++m) { const bf16x8 af = *(const LAS bf16x8*)(lds + PM_OFF + (16 * m + fr) * TP + 2 * (128 * gi2 + 32 * ks + 8 * fq));
            ac2[m][0] = __builtin_amdgcn_mfma_f32_16x16x32_bf16(pw0[ks], af, ac2[m][0], 0, 0, 0); ac2[m][1] = __builtin_amdgcn_mfma_f32_16x16x32_bf16(pw1[ks], af, ac2[m][1], 0, 0, 0); }
#pragma unroll
    for (int m = 0; m < 8; ++m) { f32x4 s0, s1; unpk8(sgv[m], s0, s1);
        store8(c.y + (size_t)(row0 + 16 * m + fr) * 1536 + 1024 + chc, (ac2[m][0] + pb0) * ps0 * s0, (ac2[m][1] + pb1) * ps1 * s1); }
    __syncthreads();
}
template <int HH> DEV void p2_item_front(const Ctx& c, const int l, const int ck, const bf16_t* pb, LAS unsigned char* lds) {
    constexpr int W0 = 2 << (2 * HH), W1 = 2 * W0, H = W1 - 1, NX = H + 16;
    int lane_ = c.lane; asm volatile("" : "+v"(lane_));
    const int lane = lane_, w = c.wave, p = lane >> 5, gi = lane >> 5, cpos = (ck & 15) * 128, row0 = ck * 128; const bool lastck = (ck & 15) == 15;
    const int ch8 = 256 * HH + 8 * (lane & 31), ch4 = 256 * HH + 4 * lane;
    const float* st = c.lnst + ((size_t)ck * 128 + 16 * w + (lane & 15)) * 16;
    const f32x4 t0 = *(const f32x4*)st, t1 = *(const f32x4*)(st + 4), t2 = *(const f32x4*)(st + 8), t3 = *(const f32x4*)(st + 12);
    u32x4 gv[8];
#pragma unroll
    for (int k = 0; k < 8; ++k) gv[k] = *(const u32x4*)(pb + (size_t)(16 * w + 2 * k + p) * PC + PGV + ch8);
    const f32x4 g0 = *(const f32x4*)(c.lnv_g + l * W + ch8), g1 = *(const f32x4*)(c.lnv_g + l * W + ch8 + 4), b0 = *(const f32x4*)(c.lnv_b + l * W + ch8), b1 = *(const f32x4*)(c.lnv_b + l * W + ch8 + 4);
    u32x2 xr[NX];
#pragma unroll
    for (int k = 0; k < NX; ++k) { const int tt = 16 * w - H + k; const bool valid = cpos + tt >= 0; const int tc = valid ? tt : 0;
        const u32x2 r = *(const u32x2*)(pb + (ptrdiff_t)tc * PC + PCX + ch4); xr[k] = valid ? r : (u32x2){0u, 0u}; }
    {
        const float s = ((t0.x + t0.z) + (t1.x + t1.z)) + ((t2.x + t2.z) + (t3.x + t3.z)), q = ((t0.y + t0.w) + (t1.y + t1.w)) + ((t2.y + t2.w) + (t3.y + t3.w));
        const float mu_l = s * (1.f / W), rstd_l = __builtin_amdgcn_rsqf(fmaxf(q * (1.f / W) - mu_l * mu_l, 0.f) + EPS);
        float* vout = c.out + O_VP + ((size_t)(l * NBP + (ck >> 4)) * 128) * W + ch8;
#pragma unroll
        for (int k = 0; k < 8; ++k) { const int t = 16 * w + 2 * k + p;
            const float mu = __shfl(mu_l, 2 * k + p), rstd = __shfl(rstd_l, 2 * k + p);
            f32x4 x0 = (f32x4){bflo(gv[k].x), bfhi(gv[k].x), bflo(gv[k].y), bfhi(gv[k].y)}, x1 = (f32x4){bflo(gv[k].z), bfhi(gv[k].z), bflo(gv[k].w), bfhi(gv[k].w)};
            x0 = (x0 - mu) * rstd * g0 + b0; x1 = (x1 - mu) * rstd * g1 + b1;
            u32x4 o; o.x = pk2(x0.x, x0.y); o.y = pk2(x0.z, x0.w); o.z = pk2(x1.x, x1.y); o.w = pk2(x1.z, x1.w);
            *(LAS u32x4*)(lds + VT_OFF + t * TP + (lane & 31) * 16) = o;
            if (lastck) { *(f32x4*)(vout + (size_t)t * W) = x0; *(f32x4*)(vout + (size_t)t * W + 4) = x1; }
        }
    }
    const f32x4 cb = *(const f32x4*)(c.conv_b + l * W + ch4), w0 = *(const f32x4*)(c.conv_w + (l * 3 + 0) * W + ch4), w1 = *(const f32x4*)(c.conv_w + (l * 3 + 1) * W + ch4), w2 = *(const f32x4*)(c.conv_w + (l * 3 + 2) * W + ch4);
    u32x2 zr[18], ar[16];
#pragma unroll
    for (int k = 0; k < 18; ++k) { const int tt = 16 * w - 2 + k; const bool valid = cpos + tt >= 0; const int tc = valid ? tt : 0;
        const u32x2 r = *(const u32x2*)(pb + (ptrdiff_t)tc * PC + PZ + ch4); zr[k] = valid ? r : (u32x2){0u, 0u}; }
#pragma unroll
    for (int i = 0; i < 16; ++i) ar[i] = *(const u32x2*)(pb + (size_t)(16 * w + i) * PC + PABG + ch4);
    {
        f32x4 slo = unpk4(xr[H]);
#pragma unroll
        for (int j = 1; j < W0; ++j) slo += unpk4(xr[H - j]);
        f32x4 shi = slo;
#pragma unroll
        for (int j = W0; j < W1; ++j) shi += unpk4(xr[H - j]);
        float* pout = c.out + O_POOLP + ((size_t)(l * NBP + (ck >> 4)) * 15) * W + ch4;
#pragma unroll
        for (int i = 0; i < 16; ++i) { const int t = 16 * w + i, pos = cpos + t, wd = gi ? W1 : W0;
            const f32x4 sm = gi ? shi : slo, xc = unpk4(xr[H + i]); const float inv = __builtin_amdgcn_rcpf((float)(wd < pos + 1 ? wd : pos + 1));
            const f32x4 pm = sm * inv - xc;
            *(LAS u32x2*)(lds + PM_OFF + t * TP + 8 * lane) = (u32x2){pk2(pm.x, pm.y), pk2(pm.z, pm.w)};
            if (lastck && t >= 113) *(f32x4*)(pout + (size_t)(t - 113) * W) = xc;
            if (i < 15) { const f32x4 xn = unpk4(xr[H + i + 1]); slo += xn - unpk4(xr[H + i + 1 - W0]); shi += xn - unpk4(xr[H + i + 1 - W1]); }
        }
    }
    {
        float* cout = c.out + O_CONVP + ((size_t)(l * NBP + (ck >> 4)) * 2) * W + ch4;
#pragma unroll
        for (int i = 0; i < 16; ++i) { const int t = 16 * w + i;
            const f32x4 abg = unpk4(ar[i]), z2 = unpk4(zr[i + 2]);
            const f32x4 o = abg * (cb + w0 * unpk4(zr[i]) + w1 * unpk4(zr[i + 1]) + w2 * z2);
            *(u32x2*)(c.y + (size_t)(row0 + t) * 1536 + ch4) = (u32x2){pk2(o.x, o.y), pk2(o.z, o.w)};
            if (lastck && t >= 126) *(f32x4*)(cout + (size_t)(t - 126) * W) = z2;
        }
    }
}
DEV void ph_p2_prompt(const Args& a, int l, LAS unsigned char* lds) {
    LAUNDER_CTX(a);
    VB_LOAD(lds);
    {
        const int ck = 16 * vx_ + (vr_ >> 1), hh = vr_ & 1; const bf16_t* pb = c.pbuf + (size_t)ck * 128 * PC;
        { if (hh) p2_item_front<1>(c, l, ck, pb, lds); else p2_item_front<0>(c, l, ck, pb, lds); }
        p2_mm(c, l, ck, hh, pb, lds);
    }
    if (vr_ >= 30) {
        unsigned* ctl = (unsigned*)(a.ws + WS_CTL + z_);
        if (threadIdx.x == 0) { XB_SPIN(xb_ld(&ctl[XB_CNT_P1S]) < 960u * (unsigned)(l + 1), ctl); __builtin_amdgcn_fence(__ATOMIC_ACQUIRE, "agent"); asm volatile("s_waitcnt vmcnt(0)" ::: "memory"); }
        __syncthreads();
        p2_sample_block(c, l, 2 * vx_ + (vr_ - 30), lds); __syncthreads(); }
}
DEV void ph_final(const Args& a, LAS unsigned char* lds) {
    LAUNDER_CTX(a); VB_LOAD(lds);
    const int lane = c.lane;
#pragma unroll 2
    for (int i = 8 * vr_ + c.wave; i < 2048 + 16; i += 256) { const int row = i < 2048 ? 2048 * vx_ + i : MPR + 16 * vx_ + (i - 2048);
        const float r = row_rstd(c.ssq, row);
#pragma unroll
        for (int j = 0; j < 2; ++j) { f32x4 x0, x1; unpk8(*((const u32x4*)(c.xb + (size_t)row * D) + lane + 64 * j), x0, x1);
            const f32x4* gp = (const f32x4*)c.final_g + 2 * lane + 128 * j; f32x4* o = (f32x4*)(c.out + (size_t)row * D) + 2 * lane + 128 * j;
            o[0] = x0 * r * gp[0]; o[1] = x1 * r * gp[1]; }
    }
}

__global__ __launch_bounds__(NTHREADS, 2) void mega_fwd(Args a) {
    extern __shared__ __attribute__((aligned(16))) unsigned char lds[];
    LAS unsigned char* ldsp = (LAS unsigned char*)lds;
    if (threadIdx.x < 16) ((LAS unsigned*)(ldsp + LDSCTL_OFF))[threadIdx.x] = 0u;
    __syncthreads();
    const XcdBarrier bar = xcd_barrier_post((unsigned*)(a.ws + WS_CTL), (volatile LAS unsigned*)(ldsp + LDSCTL_OFF));
    ph_convert(a, lds, 0, 0);
    xcd_barrier(bar);
    { LAUNDER_CTX(a); int bx_ = blockIdx.x, gx_ = gridDim.x; asm volatile("" : "+s"(bx_), "+s"(gx_)); SchedMod S{gx_, bx_, (const char*)c.scb, (const char*)c.WadaT}; EpiRows<EpiMod> E{EpiMod{c.mod, c.atab, c.shb, c.b_ada, c.norm_g}}; gemm_phase(ldsp, D * 2, D * 2, D / BK, S, E); }
    ph_convert(a, lds, 1, (int)gridDim.x > 96 ? 48 : 0);
    xcd_barrier(bar);
    { LAUNDER_CTX(a); int bx_ = blockIdx.x, gx_ = gridDim.x; asm volatile("" : "+s"(bx_), "+s"(gx_)); SchedSW S{gx_, bx_, (const char*)c.shb, (const char*)c.WinT}; EpiRows<EpiSWx> E{EpiSWx{c.SW}}; gemm_phase(ldsp, D * 2, D * 2, D / BK, S, E); }
    ph_xa0(a);
    xcd_barrier(bar);
#pragma unroll 1
    for (int l = 0; l < DEPTH; ++l) {
        { LAUNDER_CTX(a); VB_LOAD(ldsp); SchedP1 S; S.T.init(8, NIN / 256, 32, vr_, 8 * vx_); S.A = (const char*)((l & 1) ? c.xa2 : c.xa); S.B = (const char*)(c.WinT + (size_t)l * NIN * D);
          p1_rtab(S, c.ssq, c.SW + (size_t)l * NBT * NIN, (LAS float*)(ldsp + RTAB_OFF), (LAS float*)(ldsp + SWT_OFF));
          EpiP1T E{c.pbuf, c.SW + (size_t)l * NBT * NIN, (const LAS float*)(ldsp + RTAB_OFF), (const LAS float*)(ldsp + SWT_OFF), c.lnst};
          gemm_phase(ldsp, D * 2, D * 2, D / BK, S, E);
          if (vr_ >= 16) {
              const EpiP1S es{c.pbuf, c.SW + (size_t)l * NBT * NIN, c.ssq};
              const int spn = vx_ + 8 * ((vr_ - 16) >> 2), sl = 4 * spn + (vr_ & 3);
              if (spn < 30) { unsigned* ctl = (unsigned*)(a.ws + WS_CTL + z_);
                  XB_SPIN(xb_ld(&ctl[XB_CNT_P4S]) < 128u * (unsigned)l, ctl);
                  __builtin_amdgcn_fence(__ATOMIC_ACQUIRE, "agent"); asm volatile("s_waitcnt vmcnt(0)" ::: "memory");
                  p1_sample_slice(c.tid, sl, (l & 1) ? c.xa2 : c.xa, c.WinT + (size_t)l * NIN * D, es, ldsp);
                  asm volatile("s_waitcnt vmcnt(0)" ::: "memory");
                  if (c.lane == 0) xb_add(&ctl[XB_CNT_P1S], 1u); } } }
        layer_barrier(bar);
        ph_p2_prompt(a, l, ldsp);
        layer_barrier(bar);
        { LAUNDER_CTX(a); VB_LOAD(ldsp); const EpiP3 e3{c.pbuf, c.mg};
          if (vr_ < 16) mini_gemm<3, 2>(a, ldsp, vx_ | (vr_ << 3), c.y, 1536, W, c.WbT + (size_t)l * 3 * D * W, W, (size_t)D * W, e3);
          SchedP3R S; S.T.init(8, 8, 32, vr_, 8 * vx_); S.A = (const char*)c.y; S.B = (const char*)(c.WbT + (size_t)l * 3 * D * W);
          f32x4 tot[2][4][2];
#pragma unroll
          for (int i0 = 0; i0 < 2; ++i0)
#pragma unroll
              for (int i1 = 0; i1 < 4; ++i1) { tot[i0][i1][0] = (f32x4){0.f, 0.f, 0.f, 0.f}; tot[i0][i1][1] = (f32x4){0.f, 0.f, 0.f, 0.f}; }
          u32x2 gpre[8]; EpiP3R E{tot, gpre, c.pbuf, c.mg};
          { UnitD u0; int t_ = threadIdx.x; asm volatile("" : "+v"(t_)); const int wv = __builtin_amdgcn_readfirstlane(t_ >> 6); if (S.next(0, u0)) E.prefetch(u0, wv >> 2, wv & 3, t_ & 15, (t_ & 63) >> 4); }
          gemm_phase<EpiP3R, SchedP3R, 1>(ldsp, 1536 * 2, W * 2, W / BK, S, E); }
        layer_barrier(bar);
        { LAUNDER_CTX(a); VB_LOAD(ldsp); const float* gate = c.mod + (size_t)l * NBT * 3072 + 2048;
          const float* atc = c.atab + (size_t)l * NBT * D; const float* atn = l + 1 < DEPTH ? c.atab + (size_t)(l + 1) * NBT * D : nullptr;
          const bf16_t* xai = (l & 1) ? c.xa2 : c.xa; bf16_t* xao = (l & 1) ? c.xa : c.xa2;
          const EpiP4 e4{gate, atc, atn, xai, xao, c.ssq, c.x_sample - (size_t)MPR * D, c.xb, l > 0};
          if (vr_ < 16) { mini_gemm<1, 4>(a, ldsp, vx_ | (vr_ << 3), c.mg, D, 0, c.WoT + (size_t)l * D * D, D, (size_t)0, e4);
              if (threadIdx.x == 0) { asm volatile("s_waitcnt vmcnt(0)" ::: "memory"); xb_add((unsigned*)(a.ws + WS_CTL + z_) + XB_CNT_P4S, 1u); } }
          SchedP4 S; S.T.init(8, 4, 32, vr_, 8 * vx_); S.A = (const char*)c.mg; S.B = (const char*)(c.WoT + (size_t)l * D * D);
          if (l == 0) { EpiP4T<false, false> E{gate, atc, atn, xai, xao, c.ssq, c.x_prompt, c.xb}; gemm_phase(ldsp, D * 2, D * 2, D / BK, S, E); }
          else if (l + 1 < DEPTH) { EpiP4T<true, false> E{gate, atc, atn, xai, xao, c.ssq, c.x_prompt, c.xb}; gemm_phase(ldsp, D * 2, D * 2, D / BK, S, E); }
          else { EpiP4T<true, true> E{gate, atc, atn, xai, xao, c.ssq, c.x_prompt, c.xb}; gemm_phase(ldsp, D * 2, D * 2, D / BK, S, E); } }
        layer_barrier(bar);
    }
    ph_final(a, ldsp);
}

extern "C" void kernel_launch(void* const* d_in, const int* in_sizes, int n_in, void* d_out, int out_size, void* d_ws, size_t ws_size, hipStream_t stream) {
    static int grid_blocks = 0;
    if (grid_blocks == 0) {
        if (n_in != 22 || ws_size < WS_END) { fprintf(stderr, "kernel_launch: unexpected n_in %d or ws_size %zu < %zu\n", n_in, ws_size, (size_t)WS_END); grid_blocks = -1; return; }
        int dev = 0, cus = 0, per_cu = 0;
        (void)hipGetDevice(&dev); (void)hipDeviceGetAttribute(&cus, hipDeviceAttributeMultiprocessorCount, dev);
        if (hipFuncSetAttribute((const void*)mega_fwd, hipFuncAttributeMaxDynamicSharedMemorySize, LDS_BYTES) != hipSuccess) { fprintf(stderr, "kernel_launch: hipFuncSetAttribute failed\n"); grid_blocks = -1; return; }
        if (hipOccupancyMaxActiveBlocksPerMultiprocessor(&per_cu, (const void*)mega_fwd, NTHREADS, LDS_BYTES) != hipSuccess || per_cu < 1) { fprintf(stderr, "kernel_launch: occupancy query gave %d\n", per_cu); grid_blocks = -1; return; }
        if (cus < 256) { fprintf(stderr, "kernel_launch: this kernel is laid out for >= 256 CUs (found %d)\n", cus); grid_blocks = -1; return; }
        grid_blocks = 256;
        fprintf(stderr, "kernel_launch: cus %d per_cu %d grid %d\n", cus, per_cu, grid_blocks);
    }
    if (grid_blocks < 0) return;
    Args a{};
    for (int i = 0; i < 22; ++i) a.in[i] = (const float*)d_in[i];
    a.out = (float*)d_out; a.ws = (unsigned char*)d_ws;
    if (hipMemsetAsync((char*)d_ws + WS_CTL, 0, CTL_BYTES, stream) != hipSuccess) { fprintf(stderr, "kernel_launch: memset failed\n"); return; }
    void* args[] = {&a};
    hipError_t e = hipLaunchCooperativeKernel((const void*)mega_fwd, dim3(grid_blocks), dim3(NTHREADS), args, LDS_BYTES, stream);
    if (e != hipSuccess) fprintf(stderr, "kernel_launch: cooperative launch failed: %s (grid %d)\n", hipGetErrorString(e), grid_blocks);
}
```

```cpp
#include <hip/hip_runtime.h>
#include <cstdio>
#include <cstdint>

#define DEV __device__ __forceinline__
typedef unsigned short bf16_t;
typedef short bf16x8 __attribute__((ext_vector_type(8)));
typedef float f32x4 __attribute__((ext_vector_type(4)));
typedef unsigned u32x4 __attribute__((ext_vector_type(4)));
typedef unsigned u32x2 __attribute__((ext_vector_type(2)));

constexpr int D = 1024, TSEQ = 2048, NBP = 8, MPR = NBP * TSEQ  , NSM = 128, MV = MPR + NSM  , MP = 16640  , NBT = NBP + NSM  ;
constexpr int W = 512, NIN = 7680, PC = 4608  , DEPTH = 4;
constexpr int PZ = 0, PABG = 512, PUG = 1024, PGV = 1536, PCX = 2048, PSG = 2560, PGATE = 3072;
constexpr float EPS = 1e-6f;
constexpr size_t O_Y = 0, O_YS = 16777216, O_CONVP = 16908288, O_CONVS = 16941056, O_POOLP = 17465344, O_POOLS = 17711104, O_VP = 21643264, O_VS = 23740416;

constexpr size_t al256(size_t x) { return (x + 255) & ~(size_t)255; }
constexpr size_t WS_WIN = 0;
constexpr size_t WS_WB = al256(WS_WIN + (size_t)DEPTH * NIN * D * 2);
constexpr size_t WS_WO = al256(WS_WB + (size_t)DEPTH * 3 * D * W * 2);
constexpr size_t WS_MOD = al256(WS_WO + (size_t)DEPTH * D * D * 2);
constexpr size_t WS_ATAB = al256(WS_MOD + (size_t)DEPTH * NBT * 3 * D * 4);
constexpr size_t WS_SHB = al256(WS_ATAB + (size_t)DEPTH * NBT * D * 4);
constexpr size_t WS_SW = al256(WS_SHB + (size_t)DEPTH * 256 * D * 2);
constexpr size_t WS_XA = al256(WS_SW + (size_t)DEPTH * NBT * NIN * 4);
constexpr size_t WS_SSQ = al256(WS_XA + (size_t)MP * D * 2);
constexpr size_t WS_PBUF = al256(WS_SSQ + (size_t)MP * 16 * 4);
constexpr size_t WS_Y = al256(WS_PBUF + (size_t)MP * PC * 2);
constexpr size_t WS_MG = al256(WS_Y + (size_t)MP * 1536 * 2);
constexpr size_t WS_SGUW = al256(WS_MG + (size_t)MP * D * 2);
constexpr size_t WS_POOLW = al256(WS_SGUW + (size_t)DEPTH * 8 * 128 * 128 * 2);
constexpr size_t WS_WADA = al256(WS_POOLW + (size_t)DEPTH * 4 * 128 * 128 * 2);
constexpr size_t WS_SCB = al256(WS_WADA + (size_t)DEPTH * 3072 * D * 2);
constexpr size_t WS_XB = al256(WS_SCB + (size_t)256 * D * 2);
constexpr size_t WS_XA2 = al256(WS_XB + (size_t)MV * D * 2);
constexpr size_t WS_LNST = al256(WS_XA2 + (size_t)MP * D * 2);
constexpr size_t WS_CTL = al256(WS_LNST + (size_t)MP * 16 * 4);
constexpr size_t CTL_BYTES = 32768;
constexpr size_t WS_END = al256(WS_CTL + CTL_BYTES);

constexpr int NTHREADS = 512, NWAVES = 8;
constexpr int LDS_BYTES = 155648;
constexpr int LDSCTL_OFF = LDS_BYTES - 256;

typedef __bf16 bf16x2_t __attribute__((ext_vector_type(2)));
typedef float f32x2_t __attribute__((ext_vector_type(2)));
DEV unsigned pk2(float lo, float hi) { const f32x2_t v = {lo, hi}; const bf16x2_t b = __builtin_convertvector(v, bf16x2_t); return __builtin_bit_cast(unsigned, b); }
typedef unsigned long long u64_t;
DEV u32x2 ld_sc8(const void* p) { const u64_t v = __hip_atomic_load((const u64_t*)p, __ATOMIC_RELAXED, __HIP_MEMORY_SCOPE_AGENT); return (u32x2){(unsigned)v, (unsigned)(v >> 32)}; }
DEV u32x4 ld_sc16(const void* p) { const u32x2 a = ld_sc8(p), b = ld_sc8((const char*)p + 8); return (u32x4){a.x, a.y, b.x, b.y}; }
DEV void st_sc8(void* p, u32x2 v) { __hip_atomic_store((u64_t*)p, (u64_t)v.x | ((u64_t)v.y << 32), __ATOMIC_RELAXED, __HIP_MEMORY_SCOPE_AGENT); }
DEV void st_sc16(void* p, u32x4 v) { st_sc8(p, (u32x2){v.x, v.y}); st_sc8((char*)p + 8, (u32x2){v.z, v.w}); }
DEV void store8_sc(bf16_t* p, f32x4 a, f32x4 b) { u32x4 w; w.x = pk2(a.x, a.y); w.y = pk2(a.z, a.w); w.z = pk2(b.x, b.y); w.w = pk2(b.z, b.w); st_sc16(p, w); }
DEV float row_rstd_sc(const float* ssq, int row) {
    float s = 0.f;
#pragma unroll
    for (int i = 0; i < 8; ++i) { const u32x2 v = ld_sc8(ssq + (size_t)row * 16 + 2 * i); const unsigned lo = v.x, hi = v.y; s += __builtin_bit_cast(float, lo) + __builtin_bit_cast(float, hi); }
    return __builtin_amdgcn_rsqf(s * (1.f / D) + EPS);
}
DEV float bflo(unsigned u) { return __builtin_bit_cast(float, u << 16); }
DEV float bfhi(unsigned u) { return __builtin_bit_cast(float, u & 0xffff0000u); }
DEV void unpk8(const u32x4 u, f32x4& a, f32x4& b) { a = (f32x4){bflo(u.x), bfhi(u.x), bflo(u.y), bfhi(u.y)}; b = (f32x4){bflo(u.z), bfhi(u.z), bflo(u.w), bfhi(u.w)}; }
DEV f32x4 gate4(unsigned u) { return (f32x4){(float)(u & 0xffu), (float)((u >> 8) & 0xffu), (float)((u >> 16) & 0xffu), (float)(u >> 24)} * (1.f / 255.f); }
DEV unsigned pku8(f32x4 s) { const unsigned a = (unsigned)(s.x * 255.f + 0.5f), b = (unsigned)(s.y * 255.f + 0.5f), c = (unsigned)(s.z * 255.f + 0.5f), d = (unsigned)(s.w * 255.f + 0.5f); return a | (b << 8) | (c << 16) | (d << 24); }
DEV f32x4 exp2_4(f32x4 t) { return (f32x4){__builtin_amdgcn_exp2f(t.x), __builtin_amdgcn_exp2f(t.y), __builtin_amdgcn_exp2f(t.z), __builtin_amdgcn_exp2f(t.w)}; }
DEV unsigned pku8_t(f32x4 t);
DEV f32x4 rcp4(f32x4 d) { return (f32x4){__builtin_amdgcn_rcpf(d.x), __builtin_amdgcn_rcpf(d.y), __builtin_amdgcn_rcpf(d.z), __builtin_amdgcn_rcpf(d.w)}; }
DEV unsigned pku8_t(f32x4 t) {
    const f32x4 g = rcp4(exp2_4(t) * (1.f / 255.f) + (1.f / 255.f)) + 8388608.f;
    const u32x4 gu = __builtin_bit_cast(u32x4, g);
    const unsigned p01 = __builtin_amdgcn_perm(gu.y, gu.x, 0x0c0c0400u), p23 = __builtin_amdgcn_perm(gu.w, gu.z, 0x0c0c0400u);
    return __builtin_amdgcn_perm(p23, p01, 0x05040100u);
}
DEV f32x4 sigmoid4(f32x4 x) { return rcp4(exp2_4(x * -1.44269504f) + 1.f); }
DEV f32x4 silu4(f32x4 x) { return x * sigmoid4(x); }
DEV f32x4 gelu4(f32x4 x) { const f32x4 t = x * (x * x * (-2.f * 0.7978845608f * 0.044715f * 1.44269504f) + (-2.f * 0.7978845608f * 1.44269504f)); return x * rcp4(exp2_4(t) + 1.f); }
DEV int perm32(int rho) { const int n = rho >> 4, i = rho & 15; return 8 * (i >> 2) + 4 * n + (i & 3); }
DEV int nidx_of(int row) { return row < MPR ? (row >> 11) : (row < MV ? NBP + (row - MPR) : NBT - 1); }
DEV int src_win(int j) {
    const int pn = j >> 8, c = j & 255, bj = c >> 7, cc = c & 127;
    if (pn < 4) return (bj ? 1024 : 512) + 128 * pn + cc;
    if (pn < 8) return (bj ? 1536 : 0) + 128 * (pn - 4) + cc;
    if (pn < 12) return (bj ? 3072 : 2048) + 128 * (pn - 8) + cc;
    if (pn < 14) return 2560 + 256 * (pn - 12) + c;
    if (pn < 16) return 3584 + 256 * (pn - 14) + c;
    if (pn < 18) return 4096 + 256 * (pn - 16) + c;
    return 4608 + 256 * (pn - 18) + c;
}

struct Args { const float* in[22]; float* out; unsigned char* ws; };
struct Ctx {
    const float *x_prompt, *x_sample, *c_prompt, *c_sample, *state_conv, *state_pool, *w_ada, *b_ada, *norm_g, *w_in, *conv_w, *conv_b, *lnv_g, *lnv_b, *sgu_w, *sgu_b, *pool_w, *pool_b, *pool_scale, *w_branch, *w_out, *final_g;
    float* out; bf16_t *WinT, *WbT, *WoT; float *mod, *atab; bf16_t* shb; float* SW; bf16_t* xa; float* ssq; bf16_t *pbuf, *y, *mg; bf16_t *SguW, *PoolWT, *WadaT, *scb, *xb, *xa2; float* lnst;
    unsigned char* lds;
    int tid, lane, wave, gw, NGW, gtid, NGT;
};

DEV Ctx make_ctx(const Args& a, size_t z) {
    Ctx c;
    c.x_prompt = a.in[0] + z; c.x_sample = a.in[1] + z; c.c_prompt = a.in[2] + z; c.c_sample = a.in[3] + z; c.state_conv = a.in[4] + z; c.state_pool = a.in[5] + z; c.w_ada = a.in[6] + z; c.b_ada = a.in[7] + z;
    c.norm_g = a.in[8] + z; c.w_in = a.in[9] + z; c.conv_w = a.in[10] + z; c.conv_b = a.in[11] + z; c.lnv_g = a.in[12] + z; c.lnv_b = a.in[13] + z; c.sgu_w = a.in[14] + z; c.sgu_b = a.in[15] + z;
    c.pool_w = a.in[16] + z; c.pool_b = a.in[17] + z; c.pool_scale = a.in[18] + z; c.w_branch = a.in[19] + z; c.w_out = a.in[20] + z; c.final_g = a.in[21] + z;
    c.out = a.out + z; unsigned char* ws = a.ws + z;
    c.WinT = (bf16_t*)(ws + WS_WIN); c.WbT = (bf16_t*)(ws + WS_WB); c.WoT = (bf16_t*)(ws + WS_WO);
    c.mod = (float*)(ws + WS_MOD); c.atab = (float*)(ws + WS_ATAB); c.shb = (bf16_t*)(ws + WS_SHB); c.SW = (float*)(ws + WS_SW);
    c.xa = (bf16_t*)(ws + WS_XA); c.ssq = (float*)(ws + WS_SSQ); c.pbuf = (bf16_t*)(ws + WS_PBUF); c.y = (bf16_t*)(ws + WS_Y); c.mg = (bf16_t*)(ws + WS_MG);
    c.WadaT = (bf16_t*)(ws + WS_WADA); c.scb = (bf16_t*)(ws + WS_SCB); c.xb = (bf16_t*)(ws + WS_XB); c.xa2 = (bf16_t*)(ws + WS_XA2); c.lnst = (float*)(ws + WS_LNST); c.SguW = (bf16_t*)(ws + WS_SGUW); c.PoolWT = (bf16_t*)(ws + WS_POOLW);
    c.lds = nullptr; c.tid = 0; c.lane = 0; c.wave = 0; c.gw = 0; c.NGW = 0; c.gtid = 0; c.NGT = 0;
    return c;
}
#define LAUNDER_CTX(a) size_t z_ = 0; asm volatile("" : "+s"(z_)); Ctx c = make_ctx(a, z_); { int t_ = threadIdx.x; asm volatile("" : "+v"(t_)); c.tid = t_; c.lane = t_ & 63; c.wave = __builtin_amdgcn_readfirstlane(t_ >> 6); \
    c.gw = blockIdx.x * NWAVES + c.wave; c.NGW = gridDim.x * NWAVES; c.gtid = blockIdx.x * NTHREADS + t_; c.NGT = gridDim.x * NTHREADS; }
#define VB_LOAD(ldsp) const int vb_ = __builtin_amdgcn_readfirstlane((int)((volatile LAS unsigned*)((ldsp) + LDSCTL_OFF))[2]); const int vx_ = vb_ >> 5, vr_ = vb_ & 31;
struct MapWin { DEV int operator()(int g) const { return src_win((g & ~31) + perm32(g & 31)); } };
struct MapPerm { DEV int operator()(int g) const { return (g & ~31) + perm32(g & 31); } };
template <class Map>
DEV void transpose_item(const float* Wsrc, int ldw, int K, bf16_t* WT, int nblk, int item, float* scr, int lane, Map map) {
    const int kb = item / nblk, nb = item % nblk, k0 = 64 * kb, g0 = 32 * nb;
    const int scol = map(g0 + (lane & 31));
#pragma unroll 8
    for (int i = 0; i < 32; ++i) { const int kk = 2 * i + (lane >> 5); scr[kk * 33 + (lane & 31)] = Wsrc[(size_t)(k0 + kk) * ldw + scol]; }
    asm volatile("s_waitcnt lgkmcnt(0)" ::: "memory");
    const int c = lane & 7;
#pragma unroll
    for (int j = 0; j < 4; ++j) { const int n = (lane >> 3) + 8 * j; const float* s = scr + (8 * c) * 33 + n;
        u32x4 o; o.x = pk2(s[0 * 33], s[1 * 33]); o.y = pk2(s[2 * 33], s[3 * 33]); o.z = pk2(s[4 * 33], s[5 * 33]); o.w = pk2(s[6 * 33], s[7 * 33]);
        *(u32x4*)(WT + (size_t)(g0 + n) * K + k0 + 8 * c) = o; }
    asm volatile("s_waitcnt lgkmcnt(0)" ::: "memory");
}
constexpr int IT_WIN = (D / 64) * (NIN / 32), IT_WB = (W / 64) * (D / 32), IT_WO = (D / 64) * (D / 32);
constexpr int IT_PW = (128 / 64) * (128 / 32);
constexpr int IT_WADA = (D / 64) * (3072 / 32);
constexpr int IT_TOTAL = DEPTH * IT_WIN + DEPTH * 3 * IT_WB + DEPTH * IT_WO + DEPTH * 4 * IT_PW + DEPTH * IT_WADA;
DEV void ph_convert(const Args& a, unsigned char* lds, const int stage, const int b0) {
    LAUNDER_CTX(a);
    float* scr = (float*)(lds + c.wave * 16384);
    const int nb = (int)gridDim.x - b0, bw = ((int)blockIdx.x - b0) * NWAVES + c.wave, nw = nb * NWAVES, bt = ((int)blockIdx.x - b0) * NTHREADS + c.tid, nthr = nb * NTHREADS;
    if ((int)blockIdx.x < b0) return;
    if (stage == 0) {
        for (int r = bw; r < DEPTH * IT_WADA; r += nw) { const int l = r / IT_WADA; transpose_item(c.w_ada + (size_t)l * D * 3072, 3072, D, c.WadaT + (size_t)l * 3072 * D, 3072 / 32, r - l * IT_WADA, scr, c.lane, MapPerm()); }
        for (int idx = bt; idx < 256 * D / 4; idx += nthr) { const int n = idx >> 8, k4 = (idx & 255) * 4; f32x4 v = (f32x4){0.f, 0.f, 0.f, 0.f};
            if (n < NBT) { v = *(const f32x4*)((n < NBP ? c.c_prompt + (size_t)n * D : c.c_sample + (size_t)(n - NBP) * D) + k4); v = silu4(v); }
            *((u32x2*)c.scb + idx) = (u32x2){pk2(v.x, v.y), pk2(v.z, v.w)}; }
        return;
    }
    for (int it = bw; it < IT_TOTAL - DEPTH * IT_WADA; it += nw) {
        int r = it;
        if (r < DEPTH * IT_WIN) { const int l = r / IT_WIN; r -= l * IT_WIN; transpose_item(c.w_in + (size_t)l * D * NIN, NIN, D, c.WinT + (size_t)l * NIN * D, NIN / 32, r, scr, c.lane, MapWin()); continue; }
        r -= DEPTH * IT_WIN;
        if (r < DEPTH * 3 * IT_WB) { const int li = r / IT_WB; r -= li * IT_WB; transpose_item(c.w_branch + (size_t)li * W * D, D, W, c.WbT + (size_t)li * D * W, D / 32, r, scr, c.lane, MapPerm()); continue; }
        r -= DEPTH * 3 * IT_WB;
        if (r < DEPTH * IT_WO) { const int l = r / IT_WO; r -= l * IT_WO; transpose_item(c.w_out + (size_t)l * D * D, D, D, c.WoT + (size_t)l * D * D, D / 32, r, scr, c.lane, MapPerm()); continue; }
        r -= DEPTH * IT_WO;
        { const int lg = r / IT_PW; r -= lg * IT_PW; transpose_item(c.pool_w + (size_t)lg * 128 * 128, 128, 128, c.PoolWT + (size_t)lg * 128 * 128, 4, r, scr, c.lane, MapPerm()); }
    }
    for (int idx = bt; idx < DEPTH * 8 * 128 * 128 / 4; idx += nthr) { const int s4 = (idx & 31) * 4, t = (idx >> 5) & 127; const f32x4 v = *((const f32x4*)c.sgu_w + idx);
        *((u32x2*)c.SguW + idx) = (u32x2){pk2(s4 <= t ? v.x : 0.f, s4 + 1 <= t ? v.y : 0.f), pk2(s4 + 2 <= t ? v.z : 0.f, s4 + 3 <= t ? v.w : 0.f)}; }
}
DEV void ph_xa0(const Args& a) {
    LAUNDER_CTX(a);
    const int lane = c.lane, NSW = DEPTH * 30;
    if ((int)gridDim.x <= NSW || (int)blockIdx.x < NSW) { if ((int)gridDim.x > NSW) return; }
    const int w0 = ((int)gridDim.x > NSW) ? ((int)blockIdx.x - NSW) * NWAVES + c.wave : c.gw, nw = ((int)gridDim.x > NSW) ? ((int)gridDim.x - NSW) * NWAVES : c.NGW;
    for (int row = MV + w0; row < MP; row += nw) { u32x2* xo = (u32x2*)(c.xa + (size_t)row * D) + lane;
#pragma unroll
        for (int j = 0; j < 4; ++j) { xo[64 * j] = (u32x2){0u, 0u}; ((u32x2*)(c.xa2 + (size_t)row * D) + lane)[64 * j] = (u32x2){0u, 0u}; }
        if (lane < 16) c.ssq[row * 16 + lane] = 0.f; }
#pragma unroll 2
    for (int row = w0; row < MV; row += nw) {
        u32x2* xo = (u32x2*)(c.xa + (size_t)row * D) + lane;
        const float* xr = row < MPR ? c.x_prompt + (size_t)row * D : c.x_sample + (size_t)(row - MPR) * D;
        const float* ar = c.atab + (size_t)nidx_of(row) * D;
#pragma unroll
        for (int j = 0; j < 4; ++j) {
            const f32x4 v = *((const f32x4*)xr + lane + 64 * j), at = *((const f32x4*)ar + lane + 64 * j);
            const u32x2 pv = (u32x2){pk2(v.x * at.x, v.y * at.y), pk2(v.z * at.z, v.w * at.w)};
            if (row >= MPR) st_sc8(&xo[64 * j], pv); else xo[64 * j] = pv;
            float s = (v.x * v.x + v.y * v.y) + (v.z * v.z + v.w * v.w);
            s += __shfl_xor(s, 1); s += __shfl_xor(s, 2); s += __shfl_xor(s, 4); s += __shfl_xor(s, 32);
            if ((lane & 39) == 0) { if (row >= MPR) __hip_atomic_store(c.ssq + row * 16 + 4 * j + (lane >> 3), s, __ATOMIC_RELAXED, __HIP_MEMORY_SCOPE_AGENT); else c.ssq[row * 16 + 4 * j + (lane >> 3)] = s; }
        }
    }
}
DEV float row_rstd(const float* ssq, int row) {
    const f32x4* p = (const f32x4*)(ssq + (size_t)row * 16); const f32x4 a = p[0], b = p[1], c = p[2], d = p[3];
    const float s = ((a.x + a.y) + (a.z + a.w)) + ((b.x + b.y) + (b.z + b.w)) + ((c.x + c.y) + (c.z + c.w)) + ((d.x + d.y) + (d.z + d.w));
    return __builtin_amdgcn_rsqf(s * (1.f / D) + EPS);
}

DEV void store8(bf16_t* p, f32x4 a, f32x4 b) { u32x4 w; w.x = pk2(a.x, a.y); w.y = pk2(a.z, a.w); w.z = pk2(b.x, b.y); w.w = pk2(b.z, b.w); *(u32x4*)p = w; }

#define LAS __attribute__((address_space(3)))
constexpr int BK = 64, HALF = 128, HTB = HALF * BK * 2, STAGE_BYTES = 8 * HTB;
DEV int lds_byte(int r, int c) { const int st = (r >> 4) * 2 + (c >> 5), rr = r & 15, cc = c & 31, ob = rr * 64 + cc * 2; return st * 1024 + (ob ^ (((ob >> 9) & 1) << 5)); }
DEV void stage_rc(int b, int& R, int& C) { const int st = b / 1024, sb = b % 1024, swz = sb ^ (((sb >> 9) & 1) << 5); R = (st >> 1) * 16 + swz / 64; C = (st & 1) * 32 + (swz % 64) / 2; }
struct UnitD { const char* A; const char* B; int pm, pn, aux; };
constexpr int NXCD = 8;
constexpr int WGM_P1 = 4, WGM_P3 = 4, WGM_P4 = 8;
struct TileOrder {
    int nM, nN, nwg, G, c, pm0;
    DEV void init(int nM_, int nN_, int G_, int c_, int pm0_) { nM = nM_; nN = nN_; nwg = nM * nN; G = G_; c = c_; pm0 = pm0_; }
    template <int WGM> DEV bool tile(int i, int& pm, int& pn) const {
        const int wgid = i * G + c; if (wgid >= nwg) return false;
        const int nig = WGM * nN, gid = wgid / nig, fm = gid * WGM, gsz = (nM - fm) < WGM ? (nM - fm) : WGM;
        pm = pm0 + fm + ((wgid % nig) % gsz); pn = (wgid % nig) / gsz; return true;
    }
};
template <class Epi, class Sched, int NBH = 2>
DEV void gemm_phase(LAS unsigned char* lds, const int lda  , const int ldb  , const int nt  , const Sched& S, const Epi& E) {
    int tid = threadIdx.x; asm volatile("" : "+v"(tid));
    const int wid = __builtin_amdgcn_readfirstlane(tid >> 6), lane = tid & 63, wr = wid >> 2, wc = wid & 3, fr = lane & 15, fq = lane >> 4;
    unsigned voffA[2], voffB[2];
#pragma unroll
    for (int i = 0; i < 2; ++i) { int R, C; stage_rc(tid * 16 + i * 8192, R, C); voffA[i] = (unsigned)(R * lda + C * 2); voffB[i] = (unsigned)(R * ldb + C * 2); }
    const size_t kstep = (size_t)(BK * 2);
    const size_t hstepA = (size_t)HALF * lda, hstepB = (size_t)HALF * ldb;
    const unsigned ldsw = (unsigned)wid * 1024u;
    const int aoff = lds_byte(wr * 64 + fr, fq * 8), boff = lds_byte(wc * 32 + fr, fq * 8);
#define PG8_SA(b, h) (((b) * 2 + (h)) * HTB)
#define PG8_SB(b, h) ((4 + (b) * 2 + (h)) * HTB)
#define PG8_STAGE(bufoff, gbase, voff) do { _Pragma("unroll") for (int _i = 0; _i < 2; ++_i) \
        __builtin_amdgcn_global_load_lds((const unsigned*)((const char*)(gbase) + (voff)[_i]), (LAS unsigned*)(lds + (bufoff) + ldsw + _i * 8192), 16, 0, 0); } while (0)
#define PG8_LDA(dst, b, h) do { _Pragma("unroll") for (int m = 0; m < 4; ++m) _Pragma("unroll") for (int k = 0; k < 2; ++k) dst[m][k] = *(const LAS bf16x8*)(lds + PG8_SA(b, h) + aoff + m * 2048 + k * 1024); } while (0)
#define PG8_LDB(dst, b, h) do { _Pragma("unroll") for (int n = 0; n < 2; ++n) _Pragma("unroll") for (int k = 0; k < 2; ++k) dst[n][k] = *(const LAS bf16x8*)(lds + PG8_SB(b, h) + boff + n * 2048 + k * 1024); } while (0)
#define PG8_MMA(ai, bj, At, Bt) do { __builtin_amdgcn_s_setprio(1); _Pragma("unroll") for (int m = 0; m < 4; ++m) _Pragma("unroll") for (int n = 0; n < 2; ++n) _Pragma("unroll") for (int k = 0; k < 2; ++k) \
        acc[ai][bj][m][n] = __builtin_amdgcn_mfma_f32_16x16x32_bf16(Bt[n][k], At[m][k], acc[ai][bj][m][n], 0, 0, 0); __builtin_amdgcn_s_setprio(0); } while (0)
#define PG8_WAIT_V(n) asm volatile("s_waitcnt vmcnt(" #n ")" ::: "memory")
#define PG8_WAIT_VN() do { if constexpr (NBH == 2) PG8_WAIT_V(8); else PG8_WAIT_V(6); } while (0)
#define PG8_WAIT_L(n) asm volatile("s_waitcnt lgkmcnt(" #n ")" ::: "memory")
#define PG8_BAR __builtin_amdgcn_s_barrier()
#define PG8_SCHED __builtin_amdgcn_sched_barrier(0)
    UnitD cur, nxt; int ui = 0;
    if (!S.next(0, cur)) return;
    f32x4 acc[2][NBH][4][2];
#pragma unroll
    for (int a = 0; a < 2; ++a)
#pragma unroll
        for (int b = 0; b < NBH; ++b)
#pragma unroll
            for (int m = 0; m < 4; ++m)
#pragma unroll
                for (int n = 0; n < 2; ++n) acc[a][b][m][n] = (f32x4){0.f, 0.f, 0.f, 0.f};
    bf16x8 At[4][2], B0[2][2], B1[2][2];
    const char* cA = cur.A; const char* cB = cur.B;
    PG8_STAGE(PG8_SB(0, 0), cB, voffB); if constexpr (NBH == 2) PG8_STAGE(PG8_SB(0, 1), cB + hstepB, voffB); PG8_STAGE(PG8_SA(0, 0), cA, voffA); PG8_STAGE(PG8_SA(0, 1), cA + hstepA, voffA);
    if (wr == 1) PG8_BAR;
    PG8_WAIT_V(2); PG8_BAR;
    PG8_STAGE(PG8_SB(1, 0), cB + kstep, voffB); PG8_STAGE(PG8_SA(1, 0), cA + kstep, voffA); if constexpr (NBH == 2) PG8_STAGE(PG8_SB(1, 1), cB + hstepB + kstep, voffB);
    if constexpr (NBH == 2) PG8_WAIT_V(6); else PG8_WAIT_V(4);
    PG8_BAR;
    for (;;) {
        const bool has_next = S.next(ui + 1, nxt);
        const char* nA = has_next ? nxt.A : cA; const char* nB = has_next ? nxt.B : cB;
        for (int t = 0; t < nt; t += 2) {
            const bool last = (t == nt - 2);
            const char* a1 = cA + (size_t)(t + 1) * kstep;
            const char* a2 = last ? nA : cA + (size_t)(t + 2) * kstep; const char* b2 = last ? nB : cB + (size_t)(t + 2) * kstep;
            const char* a3 = a2 + kstep; const char* b3 = b2 + kstep;
            PG8_LDB(B0, 0, 0); if constexpr (NBH == 2) PG8_LDB(B1, 0, 1); PG8_SCHED; PG8_LDA(At, 0, 0); PG8_STAGE(PG8_SA(1, 1), a1 + hstepA, voffA);
            PG8_WAIT_VN(); PG8_WAIT_L(0); PG8_BAR; PG8_MMA(0, 0, At, B0); if constexpr (NBH == 2) PG8_MMA(0, 1, At, B1); PG8_BAR; PG8_SCHED;
            PG8_LDA(At, 0, 1); PG8_STAGE(PG8_SB(0, 0), b2, voffB); if constexpr (NBH == 2) PG8_STAGE(PG8_SB(0, 1), b2 + hstepB, voffB); PG8_STAGE(PG8_SA(0, 0), a2, voffA);
            PG8_WAIT_VN(); PG8_WAIT_L(0); PG8_BAR; PG8_MMA(1, 0, At, B0); if constexpr (NBH == 2) PG8_MMA(1, 1, At, B1); PG8_BAR; PG8_SCHED;
            PG8_LDB(B0, 1, 0); if constexpr (NBH == 2) PG8_LDB(B1, 1, 1); PG8_SCHED; PG8_LDA(At, 1, 0); PG8_STAGE(PG8_SA(0, 1), a2 + hstepA, voffA);
            PG8_WAIT_VN(); PG8_WAIT_L(0); PG8_BAR; PG8_MMA(0, 0, At, B0); if constexpr (NBH == 2) PG8_MMA(0, 1, At, B1); PG8_BAR; PG8_SCHED;
            PG8_LDA(At, 1, 1); PG8_STAGE(PG8_SB(1, 0), b3, voffB); if constexpr (NBH == 2) PG8_STAGE(PG8_SB(1, 1), b3 + hstepB, voffB); PG8_STAGE(PG8_SA(1, 0), a3, voffA);
            PG8_WAIT_VN(); PG8_WAIT_L(0); PG8_BAR; PG8_MMA(1, 0, At, B0); if constexpr (NBH == 2) PG8_MMA(1, 1, At, B1); PG8_BAR; PG8_SCHED;
        }
        if (wr == 0) PG8_BAR;
        E(acc, cur, nxt, has_next, wr, wc, fr, fq);
        if (!has_next) break;
#pragma unroll
        for (int a = 0; a < 2; ++a)
#pragma unroll
            for (int b = 0; b < NBH; ++b)
#pragma unroll
                for (int m = 0; m < 4; ++m)
#pragma unroll
                    for (int n = 0; n < 2; ++n) acc[a][b][m][n] = (f32x4){0.f, 0.f, 0.f, 0.f};
        cur = nxt; cA = nA; cB = nB; ++ui;
        if (wr == 1) PG8_BAR;
    }
    PG8_WAIT_V(0);
    PG8_BAR;
#undef PG8_SA
#undef PG8_SB
#undef PG8_STAGE
#undef PG8_LDA
#undef PG8_LDB
#undef PG8_MMA
#undef PG8_WAIT_V
#undef PG8_WAIT_L
#undef PG8_WAIT_VN
#undef PG8_BAR
#undef PG8_SCHED
}


struct SchedMod { int G, c; const char* A; const char* B;
    DEV bool next(int i, UnitD& u) const { const int idx = i * G + c; if (idx >= 48) return false; u.pm = 0; u.pn = idx; u.aux = 0; u.A = A; u.B = B + (size_t)idx * 256 * (D * 2); return true; } };
struct EpiMod { float* mod; float* atab; bf16_t* shb; const float* b_ada; const float* norm_g;
    DEV void operator()(int pn, int row, int wc, int fq, f32x4 (&v)[2][2]) const {
#pragma unroll
        for (int bj = 0; bj < 2; ++bj) { const int gc = 256 * pn + 128 * bj + 32 * wc + 8 * fq, l = gc / 3072, j3 = gc - l * 3072;
            const f32x4 v0 = v[bj][0] + *(const f32x4*)(b_ada + gc), v1 = v[bj][1] + *(const f32x4*)(b_ada + gc + 4);
            if (row < NBT) { float* o = mod + ((size_t)l * NBT + row) * 3072 + j3; *(f32x4*)o = v0; *(f32x4*)(o + 4) = v1; }
            if (j3 < D) { const f32x4 z = (f32x4){0.f, 0.f, 0.f, 0.f}; store8(shb + ((size_t)l * 256 + row) * D + j3, row < NBT ? v0 : z, row < NBT ? v1 : z); }
            else if (j3 < 2 * D && row < NBT) { const float* ng = norm_g + l * D + (j3 - D); float* o = atab + ((size_t)l * NBT + row) * D + (j3 - D);
                f32x4 a0 = *(const f32x4*)ng * (v0 + 1.f), a1 = *(const f32x4*)(ng + 4) * (v1 + 1.f);
#pragma unroll
                for (int j = 0; j < 4; ++j) { a0[j] = __builtin_fabsf(a0[j]) < 1e-20f ? 1e-20f : a0[j]; a1[j] = __builtin_fabsf(a1[j]) < 1e-20f ? 1e-20f : a1[j]; }
                *(f32x4*)o = a0; *(f32x4*)(o + 4) = a1; }
        }
    } };
template <int NSEG, int KS  , class RowEpi>
DEV void mini_gemm(const Args& a, LAS unsigned char* lds, int u, const bf16_t* A, int lda, int a_seg, const bf16_t* Bt, int ldb, size_t b_seg, const RowEpi& e) {
    LAUNDER_CTX(a);
    const int lane = c.lane, w = c.wave, fr = lane & 15, fq = lane >> 4, rb = u & 7, pn = u >> 5, wc = (u >> 3) & 3, row = MPR + 16 * rb + fr, kw = 32 * KS;
    bf16x8 af[NSEG][KS], bf[NSEG][KS][4];
#pragma unroll
    for (int s = 0; s < NSEG; ++s) { const bf16_t* ap = A + (size_t)row * lda + s * a_seg + w * kw + 8 * fq; const bf16_t* bp = Bt + s * b_seg + (size_t)(256 * pn + 32 * wc + fr) * ldb + w * kw + 8 * fq;
#pragma unroll
        for (int k = 0; k < KS; ++k) { af[s][k] = *(const bf16x8*)(ap + 32 * k);
#pragma unroll
            for (int q = 0; q < 4; ++q) bf[s][k][q] = *(const bf16x8*)(bp + (size_t)(128 * (q >> 1) + 16 * (q & 1)) * ldb + 32 * k); } }
    f32x4 acc[NSEG][4];
#pragma unroll
    for (int s = 0; s < NSEG; ++s) {
#pragma unroll
        for (int q = 0; q < 4; ++q) acc[s][q] = (f32x4){0.f, 0.f, 0.f, 0.f};
#pragma unroll
        for (int k = 0; k < KS; ++k)
#pragma unroll
            for (int q = 0; q < 4; ++q) acc[s][q] = __builtin_amdgcn_mfma_f32_16x16x32_bf16(bf[s][k][q], af[s][k], acc[s][q], 0, 0, 0);
    }
#pragma unroll
    for (int s = 0; s < NSEG; ++s)
#pragma unroll
        for (int q = 0; q < 4; ++q) *(LAS f32x4*)(lds + (((w * NSEG + s) * 4 + q) * 64 + lane) * 16) = acc[s][q];
    __syncthreads();
    if (w == 0) {
        f32x4 v[NSEG][2][2];
#pragma unroll
        for (int s = 0; s < NSEG; ++s)
#pragma unroll
            for (int q = 0; q < 4; ++q) { f32x4 t = *(const LAS f32x4*)(lds + (((0 * NSEG + s) * 4 + q) * 64 + lane) * 16);
#pragma unroll
                for (int ww = 1; ww < 8; ++ww) t += *(const LAS f32x4*)(lds + (((ww * NSEG + s) * 4 + q) * 64 + lane) * 16);
                v[s][q >> 1][q & 1] = t; }
        e(pn, row, wc, fq, v);
    }
    __syncthreads();
}

constexpr int RTAB_OFF = STAGE_BYTES;
constexpr int SWT_OFF = RTAB_OFF + 8192;
template <int TY, bool SMP> DEV void p1_rows(const f32x4 (&acc)[2][2][4][2], bf16_t* pb  , const LAS float* rt, const float* swb, const int row0, f32x4 s00, f32x4 s01, f32x4 s10, f32x4 s11, float* st = nullptr  ) {
    if (TY == 6 && !SMP) { s00 *= -1.44269504f; s01 *= -1.44269504f; s10 *= -1.44269504f; s11 *= -1.44269504f; }
    f32x4 n00 = s00, n01 = s01, n10 = s10, n11 = s11;
    if (SMP) { const float* sw = swb + (size_t)nidx_of(row0) * NIN; n00 = *(const f32x4*)(sw); n01 = *(const f32x4*)(sw + 4); n10 = *(const f32x4*)(sw + 128); n11 = *(const f32x4*)(sw + 132); }
#pragma unroll
    for (int ai = 0; ai < 2; ++ai) {
#pragma unroll
        for (int m = 0; m < 4; ++m) { const int rl = ai * HALF + m * 16; const float r = (TY == 6 && !SMP) ? rt[rl] * -1.44269504f : rt[rl];
            if (SMP) { s00 = n00; s01 = n01; s10 = n10; s11 = n11;
                if (ai * 4 + m < 7) { const int rn = ((ai * 4 + m + 1) >> 2) * HALF + ((ai * 4 + m + 1) & 3) * 16; const float* sw = swb + (size_t)nidx_of(row0 + rn) * NIN; n00 = *(const f32x4*)(sw); n01 = *(const f32x4*)(sw + 4); n10 = *(const f32x4*)(sw + 128); n11 = *(const f32x4*)(sw + 132); } }
            f32x4 a0 = acc[ai][0][m][0] * r + s00, a1 = acc[ai][0][m][1] * r + s01, b0 = acc[ai][1][m][0] * r + s10, b1 = acc[ai][1][m][1] * r + s11;
            bf16_t* pr = pb + (size_t)rl * PC;
            if (TY == 0) { store8(pr, a0 * b0, a1 * b1); }
            else if (TY == 1) { store8(pr, a0 * silu4(b0), a1 * silu4(b1)); }
            else if (TY == 2) { store8(pr, gelu4(a0) * silu4(b0), gelu4(a1) * silu4(b1)); }
            else {
                if (TY == 3) { a0 = gelu4(a0); a1 = gelu4(a1); b0 = gelu4(b0); b1 = gelu4(b1); }
                if (TY == 3) {
                    const f32x4 sv = (a0 + a1) + (b0 + b1), qv = (a0 * a0 + a1 * a1) + (b0 * b0 + b1 * b1);
                    float s = (sv.x + sv.y) + (sv.z + sv.w), q = (qv.x + qv.y) + (qv.z + qv.w);
                    s += __shfl_xor(s, 16); q += __shfl_xor(q, 16); s += __shfl_xor(s, 32); q += __shfl_xor(q, 32);
                    if (st) *(f32x2_t*)(st + (size_t)rl * 16) = (f32x2_t){s, q}; }
                if (TY == 5) { a0 = silu4(a0); a1 = silu4(a1); b0 = silu4(b0); b1 = silu4(b1); }
                if (TY == 6 && SMP) { a0 = sigmoid4(a0); a1 = sigmoid4(a1); b0 = sigmoid4(b0); b1 = sigmoid4(b1); }
                if (TY == 6) { unsigned char* gq = (unsigned char*)pr; if (SMP) { *(u32x2*)gq = (u32x2){pku8(a0), pku8(a1)}; *(u32x2*)(gq + 128) = (u32x2){pku8(b0), pku8(b1)}; } else { *(u32x2*)gq = (u32x2){pku8_t(a0), pku8_t(a1)}; *(u32x2*)(gq + 128) = (u32x2){pku8_t(b0), pku8_t(b1)}; } }
                else { store8(pr, a0, a1); store8(pr + 128, b0, b1); } }
        }
        if (!SMP) asm volatile("" ::: "memory");
    }
}
struct EpiP1T { bf16_t* pbuf; const float* SWl; const LAS float* rtab; const LAS float* swt; float* lnst;
    DEV void operator()(f32x4 (&acc)[2][2][4][2], const UnitD& u, const UnitD& un, const bool has_next, int wr, int wc, int fr, int fq) const {
        const int pn = u.pn, cb = 32 * wc + 8 * fq, row0 = u.pm * 256 + wr * 64 + fr; const bool smp = u.pm >= MPR / 256;
        const float* swb = SWl + 256 * pn + cb; const LAS float* sw = swt + u.aux * 256 + cb;
        const f32x4 s00 = *(const LAS f32x4*)(sw), s01 = *(const LAS f32x4*)(sw + 4), s10 = *(const LAS f32x4*)(sw + 128), s11 = *(const LAS f32x4*)(sw + 132);
        const LAS float* rt = rtab + u.aux * 256 + wr * 64 + fr;
        bf16_t* pb = pbuf + (size_t)row0 * PC + cb;
#define P1_DISPATCH(SM) \
        if (pn < 4) p1_rows<0, SM>(acc, pb + PZ + 128 * pn, rt, swb, row0, s00, s01, s10, s11); \
        else if (pn < 8) p1_rows<1, SM>(acc, pb + PABG + 128 * (pn - 4), rt, swb, row0, s00, s01, s10, s11); \
        else if (pn < 12) p1_rows<2, SM>(acc, pb + PUG + 128 * (pn - 8), rt, swb, row0, s00, s01, s10, s11); \
        else if (pn < 14) p1_rows<3, SM>(acc, pb + PGV + 256 * (pn - 12), rt, swb, row0, s00, s01, s10, s11, fq == 0 ? lnst + (size_t)row0 * 16 + 2 * (4 * (pn - 12) + wc) : nullptr); \
        else if (pn < 16) p1_rows<4, SM>(acc, pb + PCX + 256 * (pn - 14), rt, swb, row0, s00, s01, s10, s11); \
        else if (pn < 18) p1_rows<5, SM>(acc, pb + PSG + 256 * (pn - 16), rt, swb, row0, s00, s01, s10, s11); \
        else p1_rows<6, SM>(acc, (bf16_t*)((unsigned char*)(pb - cb + PGATE) + 256 * (pn - 18) + cb), rt, swb, row0, s00, s01, s10, s11);
        P1_DISPATCH(false)
#undef P1_DISPATCH
    } };
struct EpiP1S { bf16_t* pbuf; const float* SWl; const float* ssq;
    DEV void operator()(int pn, int row, int wc, int fq, f32x4 (&v)[1][2][2]) const {
        const int cb = 32 * wc + 8 * fq; const float r = row_rstd_sc(ssq, row);
        const float* sw = SWl + (size_t)nidx_of(row) * NIN + 256 * pn + cb;
        const f32x4 a0 = v[0][0][0] * r + *(const f32x4*)(sw), a1 = v[0][0][1] * r + *(const f32x4*)(sw + 4), b0 = v[0][1][0] * r + *(const f32x4*)(sw + 128), b1 = v[0][1][1] * r + *(const f32x4*)(sw + 132);
        bf16_t* pr = pbuf + (size_t)row * PC + cb;
        if (pn < 4) store8_sc(pr + PZ + 128 * pn, a0 * b0, a1 * b1);
        else if (pn < 8) store8_sc(pr + PABG + 128 * (pn - 4), a0 * silu4(b0), a1 * silu4(b1));
        else if (pn < 12) store8_sc(pr + PUG + 128 * (pn - 8), gelu4(a0) * silu4(b0), gelu4(a1) * silu4(b1));
        else if (pn < 14) { bf16_t* o = pr + PGV + 256 * (pn - 12); store8_sc(o, gelu4(a0), gelu4(a1)); store8_sc(o + 128, gelu4(b0), gelu4(b1)); }
        else if (pn < 16) { bf16_t* o = pr + PCX + 256 * (pn - 14); store8_sc(o, a0, a1); store8_sc(o + 128, b0, b1); }
        else if (pn < 18) { bf16_t* o = pr + PSG + 256 * (pn - 16); store8_sc(o, silu4(a0), silu4(a1)); store8_sc(o + 128, silu4(b0), silu4(b1)); }
        else { unsigned char* gq = (unsigned char*)(pbuf + (size_t)row * PC + PGATE) + 256 * (pn - 18) + cb;
            st_sc8(gq, (u32x2){pku8(sigmoid4(a0)), pku8(sigmoid4(a1))}); st_sc8(gq + 128, (u32x2){pku8(sigmoid4(b0)), pku8(sigmoid4(b1))}); }
    } };
DEV void p1_sample_slice(const int tid, const int slice  , const bf16_t* xa, const bf16_t* Wl, const EpiP1S& e, LAS unsigned char* lds) {
    const int lane = tid & 63, w = __builtin_amdgcn_readfirstlane(tid >> 6), fr = lane & 15, fq = lane >> 4, pn = slice >> 2, wc = slice & 3, row = MPR + 16 * w + fr;
    const bf16_t* ap = xa + (size_t)row * D + 8 * fq; const bf16_t* bp = Wl + (size_t)(256 * pn + 32 * wc + fr) * D + 8 * fq;
    __syncthreads();
#pragma unroll
    for (int j = 0; j < 16; ++j) { const int b = w * 16 + j, q = b >> 5, ks = b & 31;
        __builtin_amdgcn_global_load_lds((const unsigned*)(bp + (size_t)(128 * (q >> 1) + 16 * (q & 1)) * D + 32 * ks), (LAS unsigned*)(lds + b * 1024), 16, 0, 0); }
    bf16x8 af[32];
#pragma unroll
    for (int ks = 0; ks < 32; ++ks) af[ks] = __builtin_bit_cast(bf16x8, ld_sc16(ap + 32 * ks));
    f32x4 v[1][2][2];
#pragma unroll
    for (int q = 0; q < 4; ++q) v[0][q >> 1][q & 1] = (f32x4){0.f, 0.f, 0.f, 0.f};
    asm volatile("s_waitcnt vmcnt(0)" ::: "memory");
    __syncthreads();
#pragma unroll
    for (int ks = 0; ks < 32; ++ks)
#pragma unroll
        for (int q = 0; q < 4; ++q) { const bf16x8 bfr = *(const LAS bf16x8*)(lds + (q * 32 + ks) * 1024 + lane * 16);
            v[0][q >> 1][q & 1] = __builtin_amdgcn_mfma_f32_16x16x32_bf16(bfr, af[ks], v[0][q >> 1][q & 1], 0, 0, 0); }
    e(pn, row, wc, fq, v);
}
template <class Sched> DEV void p1_rtab(const Sched& S, const float* ssq, const float* SWl, LAS float* rtab, LAS float* swt) {
    int t = threadIdx.x; asm volatile("" : "+v"(t));
#pragma unroll
    for (int k = 0; k < 4; ++k) { const int q = t + 512 * k, i = q >> 8, rl = q & 255; UnitD u;
        if (S.next(i, u)) { rtab[q] = row_rstd(ssq, u.pm * 256 + rl); swt[q] = SWl[(size_t)(u.pm < MPR / 256 ? (u.pm >> 3) : NBP) * NIN + 256 * u.pn + rl]; } }
    __syncthreads();
}
template <bool IN16, bool LAST> struct EpiP4T { const float* gate; const float* atab_cur; const float* atab_next; const bf16_t* xa; bf16_t* xao; float* ssq; const float* xin; bf16_t* xb;
    DEV void operator()(f32x4 (&acc)[2][2][4][2], const UnitD& u, const UnitD& un, const bool has_next, int wr, int wc, int fr, int fq) const {
        const int pn = u.pn, nb = u.pm >> 3, col = 256 * pn + 32 * wc + 8 * fq, row0 = u.pm * 256 + wr * 64 + fr;
        const float* gp = gate + (size_t)nb * 3072 + col;
        f32x4 g[2][2], at[2][2], iv[2][2];
#pragma unroll
        for (int bj = 0; bj < 2; ++bj)
#pragma unroll
            for (int n = 0; n < 2; ++n) { g[bj][n] = *(const f32x4*)(gp + 128 * bj + 4 * n);
                at[bj][n] = LAST ? (f32x4){0.f, 0.f, 0.f, 0.f} : *(const f32x4*)(atab_next + (size_t)nb * D + col + 128 * bj + 4 * n);
                iv[bj][n] = IN16 ? rcp4(*(const f32x4*)(atab_cur + (size_t)nb * D + col + 128 * bj + 4 * n)) : (f32x4){0.f, 0.f, 0.f, 0.f}; }
        const size_t off0 = (size_t)row0 * D + col;
        f32x4 x[2][2], xn[2][2]; u32x4 xh[2], xhn[2];
#pragma unroll
        for (int bj = 0; bj < 2; ++bj) { if (IN16) xh[bj] = *(const u32x4*)(xa + off0 + 128 * bj); else { x[bj][0] = *(const f32x4*)(xin + off0 + 128 * bj); x[bj][1] = *(const f32x4*)(xin + off0 + 128 * bj + 4); } }
#pragma unroll
        for (int r = 0; r < 8; ++r) { const int ai = r >> 2, m = r & 3, rl = ai * HALF + m * 16, row = row0 + rl; float s = 0.f;
            if (r < 7) { const size_t offn = off0 + (size_t)(((r + 1) >> 2) * HALF + ((r + 1) & 3) * 16) * D;
#pragma unroll
                for (int bj = 0; bj < 2; ++bj) { if (IN16) xhn[bj] = *(const u32x4*)(xa + offn + 128 * bj); else { xn[bj][0] = *(const f32x4*)(xin + offn + 128 * bj); xn[bj][1] = *(const f32x4*)(xin + offn + 128 * bj + 4); } } }
            const size_t off = off0 + (size_t)rl * D;
#pragma unroll
            for (int bj = 0; bj < 2; ++bj) {
                if (IN16) { unpk8(xh[bj], x[bj][0], x[bj][1]); x[bj][0] *= iv[bj][0]; x[bj][1] *= iv[bj][1]; }
#pragma unroll
                for (int n = 0; n < 2; ++n) { const f32x4 t = x[bj][n] + g[bj][n] * acc[ai][bj][m][n]; x[bj][n] = t; s += (t.x * t.x + t.y * t.y) + (t.z * t.z + t.w * t.w); }
                if (LAST) store8(xb + off + 128 * bj, x[bj][0], x[bj][1]);
                else store8(xao + off + 128 * bj, x[bj][0] * at[bj][0], x[bj][1] * at[bj][1]); }
            s += __shfl_xor(s, 16); s += __shfl_xor(s, 32);
            if (fq == 0) ssq[row * 16 + 4 * pn + wc] = s;
#pragma unroll
            for (int bj = 0; bj < 2; ++bj) { xh[bj] = xhn[bj]; x[bj][0] = xn[bj][0]; x[bj][1] = xn[bj][1]; }
        }
    } };

struct SchedP3R { TileOrder T; const char* A; const char* B;
    DEV bool next(int i, UnitD& u) const { int pm, pc; const int seg = i % 3; if (!T.tile<WGM_P3>(i / 3, pm, pc)) return false; u.pm = pm; u.pn = pc; u.aux = seg;
        u.A = A + (size_t)pm * 256 * (1536 * 2) + (size_t)seg * (W * 2); u.B = B + (size_t)seg * D * (W * 2) + (size_t)pc * 128 * (W * 2); return true; } };
struct EpiP3R { f32x4 (&tot)[2][4][2]; u32x2 (&gpre)[8]; const bf16_t* pbuf; bf16_t* mg;
    DEV void prefetch(const UnitD& u, int wr, int wc, int fr, int fq) const {
        const unsigned char* gp = (const unsigned char*)(pbuf + (size_t)(u.pm * 256 + wr * 64 + fr) * PC + PGATE) + 1024 * u.aux + 128 * u.pn + 32 * wc + 8 * fq;
#pragma unroll
        for (int r = 0; r < 8; ++r) gpre[r] = *(const u32x2*)(gp + (size_t)((r >> 2) * HALF + (r & 3) * 16) * (PC * 2));
    }
    DEV void operator()(f32x4 (&acc)[2][1][4][2], const UnitD& u, const UnitD& un, const bool has_next, int wr, int wc, int fr, int fq) const {
        const int seg = u.aux, cb = 128 * u.pn + 32 * wc + 8 * fq, row0 = u.pm * 256 + wr * 64 + fr;
        bf16_t* o = mg + (size_t)row0 * D + cb;
        u32x2 g[8];
#pragma unroll
        for (int r = 0; r < 8; ++r) g[r] = gpre[r];
        if (has_next) prefetch(un, wr, wc, fr, fq);
        const float keep = seg ? 1.f : 0.f;
#pragma unroll
        for (int r = 0; r < 8; ++r) { const int ai = r >> 2, m = r & 3; const f32x4 g0 = gate4(g[r].x), g1 = gate4(g[r].y);
            const f32x4 t0 = acc[ai][0][m][0] * g0 + tot[ai][m][0] * keep, t1 = acc[ai][0][m][1] * g1 + tot[ai][m][1] * keep;
            tot[ai][m][0] = t0; tot[ai][m][1] = t1;
            if (seg == 2) store8(o + (size_t)(ai * HALF + m * 16) * D, t0, t1); }
    } };
#define XB_TMO      128
#define XB_XCNT(j)  (256  + 64 * (j))
#define XB_XSUB(j)  (1280 + 64 * (j))
#define XB_XGEN(j)  (2304 + 64 * (j))
#define XB_TOP      3328
#define XB_TOPGEN   3392
#define XCD_BAR_WORDS 3456
#define XB_LSUB(j)  (3456 + 64 * (j))
#define XB_LGEN(j)  (3968 + 64 * (j))
#define XB_CNT_P4S  4480
#define XB_CNT_P3S(j) (4608 + 64 * (j))
#define XB_CNT_P1S  4544
#define XB_SPIN_CAP (1u << 18)
DEV unsigned xb_ld(unsigned* p)              { return __hip_atomic_load(p, __ATOMIC_RELAXED, __HIP_MEMORY_SCOPE_AGENT); }
DEV unsigned xb_add(unsigned* p, unsigned v) { return __hip_atomic_fetch_add(p, v, __ATOMIC_RELAXED, __HIP_MEMORY_SCOPE_AGENT); }
DEV unsigned xb_xcc_id() { return (unsigned)__builtin_amdgcn_s_getreg((3 << 11) | 20) & 0xFu; }
#define XB_SPIN(cond, bar) do { unsigned _sp = 0; while (cond) { __builtin_amdgcn_s_sleep(1); \
    if ((++_sp & 255u) == 0u) { if (xb_ld(&(bar)[XB_TMO])) break; if (_sp > XB_SPIN_CAP) { atomicAdd(&(bar)[XB_TMO], 1u); break; } } } } while (0)
struct XcdBarrier { unsigned* bar; unsigned x; volatile LAS unsigned* st; };
DEV XcdBarrier xcd_barrier_post(unsigned* bar, volatile LAS unsigned* st) {
    XcdBarrier b; b.bar = bar; b.x = xb_xcc_id(); b.st = st;
    if (threadIdx.x == 0) st[4] = xb_add(&bar[XB_XCNT(b.x)], 1u);
    return b;
}
DEV void xcd_barrier_complete(unsigned* bar, unsigned x, unsigned& nloc, unsigned& nx, unsigned& even) {
    const unsigned G = gridDim.x * gridDim.y * gridDim.z;
    unsigned sum, cnt, mine, n32, sp = 0u;
    for (;;) {
        sum = 0u; cnt = 0u; mine = 0u; n32 = 0u;
#pragma unroll
        for (unsigned j = 0; j < 16; ++j) { const unsigned c = xb_ld(&bar[XB_XCNT(j)]); sum += c; cnt += (c > 0u) ? 1u : 0u; n32 += (j < 8u && c == 32u) ? 1u : 0u; mine = (j == x) ? c : mine; }
        if (sum == G) break;
        __builtin_amdgcn_s_sleep(1);
        if ((++sp & 255u) == 0u) { if (xb_ld(&bar[XB_TMO])) break; if (sp > XB_SPIN_CAP) { atomicAdd(&bar[XB_TMO], 1u); break; } }
    }
    nloc = mine > 0u ? mine : 1u; nx = cnt > 0u ? cnt : 1u;
    even = (sum == G && G == 256u && n32 == 8u) ? 1u : 0u;
}
DEV void xcd_barrier(const XcdBarrier& b) {
    asm volatile("s_waitcnt vmcnt(0)" ::: "memory");
    __syncthreads();
    if (threadIdx.x == 0) {
        unsigned* bar = b.bar; unsigned bx = b.x; asm volatile("" : "+s"(bar), "+s"(bx));
        __builtin_amdgcn_s_waitcnt(0);
        unsigned nloc = b.st[0], nx = b.st[1];
        if (nloc == 0u) { unsigned even; xcd_barrier_complete(bar, bx, nloc, nx, even); b.st[0] = nloc; b.st[1] = nx;
            b.st[2] = even ? bx * 32u + b.st[4] : (unsigned)blockIdx.x;
            b.st[3] = even; }
        const unsigned old = xb_add(&bar[XB_XSUB(bx)], 1u);
        const unsigned gen = old / nloc;
        if (old + 1u == (gen + 1u) * nloc) {
            __builtin_amdgcn_fence(__ATOMIC_RELEASE, "agent");
            asm volatile("s_waitcnt vmcnt(0)" ::: "memory");
            const unsigned og = xb_add(&bar[XB_TOP], 1u);
            const unsigned tg = og / nx;
            if (og + 1u == (tg + 1u) * nx) xb_add(&bar[XB_TOPGEN], 1u);
            else XB_SPIN(xb_ld(&bar[XB_TOPGEN]) == tg, bar);
            __builtin_amdgcn_fence(__ATOMIC_ACQUIRE, "agent");
            xb_add(&bar[XB_XGEN(bx)], 1u);
            asm volatile("s_waitcnt vmcnt(0)" ::: "memory");
        } else {
            XB_SPIN(xb_ld(&bar[XB_XGEN(bx)]) == gen, bar);
            __builtin_amdgcn_fence(__ATOMIC_ACQUIRE, "agent");
            asm volatile("s_waitcnt vmcnt(0)" ::: "memory");
        }
    }
    __syncthreads();
}
DEV void xcd_local_barrier(const XcdBarrier& b) {
    asm volatile("s_waitcnt vmcnt(0)" ::: "memory");
    __syncthreads();
    if (threadIdx.x == 0) {
        unsigned* bar = b.bar; unsigned bx = b.x; asm volatile("" : "+s"(bar), "+s"(bx));
        __builtin_amdgcn_s_waitcnt(0);
        const unsigned old = xb_add(&bar[XB_LSUB(bx)], 1u);
        const unsigned gen = old >> 5;
        if ((old & 31u) == 31u) xb_add(&bar[XB_LGEN(bx)], 1u);
        else XB_SPIN(xb_ld(&bar[XB_LGEN(bx)]) == gen, bar);
        __builtin_amdgcn_fence(__ATOMIC_ACQUIRE, "agent");
        asm volatile("s_waitcnt vmcnt(0)" ::: "memory");
    }
    __syncthreads();
}
constexpr bool LOCAL_BAR = true;
DEV void layer_barrier(const XcdBarrier& b) { if (LOCAL_BAR && b.st[3]) xcd_local_barrier(b); else xcd_barrier(b); }
template <class RowEpi> struct EpiRows { RowEpi e;
    DEV void operator()(f32x4 (&acc)[2][2][4][2], const UnitD& u, const UnitD& un, const bool has_next, int wr, int wc, int fr, int fq) const {
#pragma unroll
        for (int ai = 0; ai < 2; ++ai)
#pragma unroll
            for (int m = 0; m < 4; ++m) { f32x4 v[2][2] = {{acc[ai][0][m][0], acc[ai][0][m][1]}, {acc[ai][1][m][0], acc[ai][1][m][1]}};
                e(u.pn, u.pm * 256 + ai * HALF + wr * 64 + m * 16 + fr, wc, fq, v); asm volatile("" ::: "memory"); }
    } };
struct SchedP1 { TileOrder T; const char* A; const char* B;
    DEV bool next(int i, UnitD& u) const { int pm, pn; if (!T.tile<WGM_P1>(i, pm, pn)) return false; pn += (T.pm0 >> 3) * 4; pn -= pn >= 30 ? 30 : 0;   u.pm = pm; u.pn = pn; u.aux = i; u.A = A + (size_t)pm * 256 * (D * 2); u.B = B + (size_t)pn * 256 * (D * 2); return true; } };

struct SchedP4 { TileOrder T; const char* A; const char* B;
    DEV bool next(int i, UnitD& u) const { int pm, pn; if (!T.tile<WGM_P4>(i, pm, pn)) return false; u.pm = pm; u.pn = pn; u.aux = 0; u.A = A + (size_t)pm * 256 * (D * 2); u.B = B + (size_t)pn * 256 * (D * 2); return true; } };
struct EpiP3 { const bf16_t* pbuf; bf16_t* mg;
    DEV void operator()(int pn, int row, int wc, int fq, f32x4 (&v)[3][2][2]) const {
        const int cb = 256 * pn + 32 * wc + 8 * fq;
        const unsigned char* gp = (const unsigned char*)(pbuf + (size_t)row * PC + PGATE) + cb; bf16_t* o = mg + (size_t)row * D + cb;
        u32x2 g[3][2];
#pragma unroll
        for (int s = 0; s < 3; ++s) { g[s][0] = ld_sc8(gp + 1024 * s); g[s][1] = ld_sc8(gp + 1024 * s + 128); }
#pragma unroll
        for (int bj = 0; bj < 2; ++bj) { f32x4 t0 = v[0][bj][0] * gate4(g[0][bj].x), t1 = v[0][bj][1] * gate4(g[0][bj].y);
#pragma unroll
            for (int s = 1; s < 3; ++s) { t0 += v[s][bj][0] * gate4(g[s][bj].x); t1 += v[s][bj][1] * gate4(g[s][bj].y); }
            store8(o + 128 * bj, t0, t1); }
    } };
struct SchedSW { int G, c; const char* A; const char* B;
    DEV bool next(int i, UnitD& u) const { const int idx = i * G + c; if (idx >= DEPTH * 30) return false; const int l = idx / 30, pn = idx % 30; u.pm = 0; u.pn = pn + 32 * l; u.aux = l;
        u.A = A + (size_t)l * 256 * (D * 2); u.B = B + (size_t)l * NIN * (D * 2) + (size_t)pn * 256 * (D * 2); return true; } };
struct EpiSWx { float* SW;
    DEV void operator()(int pnx, int row, int wc, int fq, f32x4 (&v)[2][2]) const {
        if (row >= NBT) return;
        const int l = pnx >> 5, pn = pnx & 31;
        float* o = SW + (size_t)l * NBT * NIN + (size_t)row * NIN + 256 * pn + 32 * wc + 8 * fq;
        *(f32x4*)(o) = v[0][0]; *(f32x4*)(o + 4) = v[0][1]; *(f32x4*)(o + 128) = v[1][0]; *(f32x4*)(o + 132) = v[1][1];
    } };
struct EpiP4 { const float* gate  ; const float* atab_cur; const float* atab_next  ; const bf16_t* xa; bf16_t* xao; float* ssq; const float* xin  ; bf16_t* xb; int in16;
    DEV void operator()(int pn, int row, int wc, int fq, f32x4 (&vv)[1][2][2]) const {
        f32x4 (&v)[2][2] = vv[0];
        const int nb = nidx_of(row), col = 256 * pn + 32 * wc + 8 * fq;
        const float* gp = gate + (size_t)nb * 3072 + col;
        float s = 0.f;
#pragma unroll
        for (int bj = 0; bj < 2; ++bj) {
            f32x4 x0, x1;
            if (in16) { unpk8(*(const u32x4*)(xa + (size_t)row * D + col + 128 * bj), x0, x1); const float* ac = atab_cur + (size_t)nb * D + col + 128 * bj; x0 *= rcp4(*(const f32x4*)ac); x1 *= rcp4(*(const f32x4*)(ac + 4)); }
            else { x0 = *(const f32x4*)(xin + (size_t)row * D + col + 128 * bj); x1 = *(const f32x4*)(xin + (size_t)row * D + col + 128 * bj + 4); }
            const f32x4 t0 = x0 + *(const f32x4*)(gp + 128 * bj) * v[bj][0], t1 = x1 + *(const f32x4*)(gp + 128 * bj + 4) * v[bj][1];
            s += ((t0.x * t0.x + t0.y * t0.y) + (t0.z * t0.z + t0.w * t0.w)) + ((t1.x * t1.x + t1.y * t1.y) + (t1.z * t1.z + t1.w * t1.w));
            if (atab_next) { const float* ap = atab_next + (size_t)nb * D + col + 128 * bj; store8_sc(xao + (size_t)row * D + col + 128 * bj, t0 * *(const f32x4*)ap, t1 * *(const f32x4*)(ap + 4)); }
            else store8(xb + (size_t)row * D + col + 128 * bj, t0, t1);
        }
        s += __shfl_xor(s, 16); s += __shfl_xor(s, 32);
        if (fq == 0) __hip_atomic_store(ssq + row * 16 + 4 * pn + wc, s, __ATOMIC_RELAXED, __HIP_MEMORY_SCOPE_AGENT);
    } };


typedef short v4i16 __attribute__((ext_vector_type(4)));
constexpr int TP = 528, VT_OFF = 0, PM_OFF = 128 * TP;
DEV f32x4 unpk4(u32x2 r) { return (f32x4){bflo(r.x), bfhi(r.x), bflo(r.y), bfhi(r.y)}; }
DEV void p2_ln(const Ctx& c, int l, int ck, int hh, const bf16_t* pb, LAS unsigned char* lds) {
    int lane_ = c.lane; asm volatile("" : "+v"(lane_));
    const int lane = lane_, w = c.wave, p = lane >> 5, ch = 256 * hh + 8 * (lane & 31); const bool lastck = (ck & 15) == 15;
    const float* st = c.lnst + ((size_t)ck * 128 + 16 * w + (lane & 15)) * 16;
    const f32x4 t0 = *(const f32x4*)st, t1 = *(const f32x4*)(st + 4), t2 = *(const f32x4*)(st + 8), t3 = *(const f32x4*)(st + 12);
    u32x4 gv[8];
#pragma unroll
    for (int k = 0; k < 8; ++k) gv[k] = *(const u32x4*)(pb + (size_t)(16 * w + 2 * k + p) * PC + PGV + ch);
    const f32x4 g0 = *(const f32x4*)(c.lnv_g + l * W + ch), g1 = *(const f32x4*)(c.lnv_g + l * W + ch + 4), b0 = *(const f32x4*)(c.lnv_b + l * W + ch), b1 = *(const f32x4*)(c.lnv_b + l * W + ch + 4);
    const float s = ((t0.x + t0.z) + (t1.x + t1.z)) + ((t2.x + t2.z) + (t3.x + t3.z)), q = ((t0.y + t0.w) + (t1.y + t1.w)) + ((t2.y + t2.w) + (t3.y + t3.w));
    const float mu_l = s * (1.f / W), rstd_l = __builtin_amdgcn_rsqf(fmaxf(q * (1.f / W) - mu_l * mu_l, 0.f) + EPS);
    float* vout = c.out + O_VP + ((size_t)(l * NBP + (ck >> 4)) * 128) * W + ch;
#pragma unroll
    for (int k = 0; k < 8; ++k) { const int t = 16 * w + 2 * k + p;
        const float mu = __shfl(mu_l, 2 * k + p), rstd = __shfl(rstd_l, 2 * k + p);
        f32x4 x0 = (f32x4){bflo(gv[k].x), bfhi(gv[k].x), bflo(gv[k].y), bfhi(gv[k].y)}, x1 = (f32x4){bflo(gv[k].z), bfhi(gv[k].z), bflo(gv[k].w), bfhi(gv[k].w)};
        x0 = (x0 - mu) * rstd * g0 + b0; x1 = (x1 - mu) * rstd * g1 + b1;
        u32x4 o; o.x = pk2(x0.x, x0.y); o.y = pk2(x0.z, x0.w); o.z = pk2(x1.x, x1.y); o.w = pk2(x1.z, x1.w);
        *(LAS u32x4*)(lds + VT_OFF + t * TP + (lane & 31) * 16) = o;
        if (lastck) { *(f32x4*)(vout + (size_t)t * W) = x0; *(f32x4*)(vout + (size_t)t * W + 4) = x1; }
    }
}
template <int HH> DEV void p2_pool(const Ctx& c, int l, int ck, const bf16_t* pb, LAS unsigned char* lds) {
    constexpr int W0 = 2 << (2 * HH), W1 = 2 * W0, H = W1 - 1, NX = H + 16;
    int lane_ = c.lane; asm volatile("" : "+v"(lane_));
    const int lane = lane_, w = c.wave, gi = lane >> 5, cpos = (ck & 15) * 128, ch = 256 * HH + 4 * lane; const bool lastck = (ck & 15) == 15;
    f32x4 x[NX];
#pragma unroll
    for (int k = 0; k < NX; ++k) { const int tt = 16 * w - H + k; const bool valid = cpos + tt >= 0; const int tc = valid ? tt : 0;
        const u32x2 r = *(const u32x2*)(pb + (ptrdiff_t)tc * PC + PCX + ch); const f32x4 v = unpk4(r); x[k] = valid ? v : (f32x4){0.f, 0.f, 0.f, 0.f}; }
    f32x4 slo = x[H];
#pragma unroll
    for (int j = 1; j < W0; ++j) slo += x[H - j];
    f32x4 shi = slo;
#pragma unroll
    for (int j = W0; j < W1; ++j) shi += x[H - j];
    float* pout = c.out + O_POOLP + ((size_t)(l * NBP + (ck >> 4)) * 15) * W + ch;
#pragma unroll
    for (int i = 0; i < 16; ++i) { const int t = 16 * w + i, pos = cpos + t, wd = gi ? W1 : W0;
        const f32x4 s = gi ? shi : slo; const float inv = __builtin_amdgcn_rcpf((float)(wd < pos + 1 ? wd : pos + 1));
        const f32x4 pm = s * inv - x[H + i];
        *(LAS u32x2*)(lds + PM_OFF + t * TP + 8 * lane) = (u32x2){pk2(pm.x, pm.y), pk2(pm.z, pm.w)};
        if (lastck && t >= 113) *(f32x4*)(pout + (size_t)(t - 113) * W) = x[H + i];
        if (i < 15) { slo += x[H + i + 1] - x[H + i + 1 - W0]; shi += x[H + i + 1] - x[H + i + 1 - W1]; }
    }
}
DEV void p2_conv(const Ctx& c, int l, int ck, int hh, const bf16_t* pb) {
    int lane_ = c.lane; asm volatile("" : "+v"(lane_));
    const int lane = lane_, w = c.wave, cpos = (ck & 15) * 128, ch = 256 * hh + 4 * lane, row0 = ck * 128; const bool lastck = (ck & 15) == 15;
    const f32x4 cb = *(const f32x4*)(c.conv_b + l * W + ch), w0 = *(const f32x4*)(c.conv_w + (l * 3 + 0) * W + ch), w1 = *(const f32x4*)(c.conv_w + (l * 3 + 1) * W + ch), w2 = *(const f32x4*)(c.conv_w + (l * 3 + 2) * W + ch);
    f32x4 z[18];
#pragma unroll
    for (int k = 0; k < 18; ++k) { const int tt = 16 * w - 2 + k; const bool valid = cpos + tt >= 0; const int tc = valid ? tt : 0;
        const f32x4 v = unpk4(*(const u32x2*)(pb + (ptrdiff_t)tc * PC + PZ + ch)); z[k] = valid ? v : (f32x4){0.f, 0.f, 0.f, 0.f}; }
    float* cout = c.out + O_CONVP + ((size_t)(l * NBP + (ck >> 4)) * 2) * W + ch;
#pragma unroll
    for (int i = 0; i < 16; ++i) { const int t = 16 * w + i;
        const f32x4 abg = unpk4(*(const u32x2*)(pb + (size_t)t * PC + PABG + ch));
        const f32x4 o = abg * (cb + w0 * z[i] + w1 * z[i + 1] + w2 * z[i + 2]);
        *(u32x2*)(c.y + (size_t)(row0 + t) * 1536 + ch) = (u32x2){pk2(o.x, o.y), pk2(o.z, o.w)};
        if (lastck && t >= 126) *(f32x4*)(cout + (size_t)(t - 126) * W) = z[i + 2];
    }
}
constexpr int TPS = 1040;
DEV void p2_sample_block(const Ctx& c, int l, int sb, LAS unsigned char* ldsw) {
    const int lane = c.lane, fr = lane & 15, fq = lane >> 4, ch = 8 * lane, h = lane >> 3, g = lane >> 4;
    {
        const int i = c.wave, n = 8 * sb + i, row = MPR + n; const bf16_t* pr = c.pbuf + (size_t)row * PC; bf16_t* yr = c.y + (size_t)row * 1536;
        const float* sc = c.state_conv + ((size_t)(l * NSM + n) * 2) * W + ch; const float* sp = c.state_pool + ((size_t)(l * NSM + n) * 15) * W + ch;
        const u32x4 qz = ld_sc16(pr + PZ + ch), qa = ld_sc16(pr + PABG + ch), qg = ld_sc16(pr + PGV + ch), qu = ld_sc16(pr + PUG + ch), qc = ld_sc16(pr + PCX + ch);
        const f32x4 s00 = *(const f32x4*)(sc), s01 = *(const f32x4*)(sc + 4), s10 = *(const f32x4*)(sc + W), s11 = *(const f32x4*)(sc + W + 4);
        f32x4 st0[15], st1[15];
#pragma unroll
        for (int k = 7; k < 15; ++k) { st0[k] = *(const f32x4*)(sp + (size_t)k * W); st1[k] = *(const f32x4*)(sp + (size_t)k * W + 4); }
        const f32x4 cb0 = *(const f32x4*)(c.conv_b + l * W + ch), cb1 = *(const f32x4*)(c.conv_b + l * W + ch + 4);
        const f32x4 w0a = *(const f32x4*)(c.conv_w + (l * 3 + 0) * W + ch), w0b = *(const f32x4*)(c.conv_w + (l * 3 + 0) * W + ch + 4);
        const f32x4 w1a = *(const f32x4*)(c.conv_w + (l * 3 + 1) * W + ch), w1b = *(const f32x4*)(c.conv_w + (l * 3 + 1) * W + ch + 4);
        const f32x4 w2a = *(const f32x4*)(c.conv_w + (l * 3 + 2) * W + ch), w2b = *(const f32x4*)(c.conv_w + (l * 3 + 2) * W + ch + 4);
        const f32x4 lg0 = *(const f32x4*)(c.lnv_g + l * W + ch), lg1 = *(const f32x4*)(c.lnv_g + l * W + ch + 4), lb0 = *(const f32x4*)(c.lnv_b + l * W + ch), lb1 = *(const f32x4*)(c.lnv_b + l * W + ch + 4);
        const float w00 = c.sgu_w[(size_t)(l * 8 + h) * 128 * 128], b00 = c.sgu_b[(l * 8 + h) * 128], invw = 1.f / (float)(2 << g);
        asm volatile("" ::: "memory");
        {
            f32x4 z0, z1, a0, a1; unpk8(qz, z0, z1); unpk8(qa, a0, a1);
            const f32x4 ya = a0 * (cb0 + w0a * s00 + w1a * s10 + w2a * z0), yb = a1 * (cb1 + w0b * s01 + w1b * s11 + w2b * z1);
#pragma unroll
            for (int k = 0; k < 7; ++k) { st0[k] = *(const f32x4*)(sp + (size_t)k * W); st1[k] = *(const f32x4*)(sp + (size_t)k * W + 4); }
            store8(yr + ch, ya, yb);
            float* o = c.out + O_CONVS + ((size_t)(l * NSM + n) * 2) * W + ch;
            *(f32x4*)(o) = s10; *(f32x4*)(o + 4) = s11; *(f32x4*)(o + W) = z0; *(f32x4*)(o + W + 4) = z1;
        }
        {
            f32x4 x0, x1, u0, u1; unpk8(qg, x0, x1); unpk8(qu, u0, u1);
            float s = ((x0.x + x0.y) + (x0.z + x0.w)) + ((x1.x + x1.y) + (x1.z + x1.w));
            float q = ((x0.x * x0.x + x0.y * x0.y) + (x0.z * x0.z + x0.w * x0.w)) + ((x1.x * x1.x + x1.y * x1.y) + (x1.z * x1.z + x1.w * x1.w));
#pragma unroll
            for (int o = 1; o < 64; o <<= 1) { s += __shfl_xor(s, o); q += __shfl_xor(q, o); }
            const float mu = s * (1.f / W), var = fmaxf(q * (1.f / W) - mu * mu, 0.f), rstd = __builtin_amdgcn_rsqf(var + EPS);
            x0 = (x0 - mu) * rstd * lg0 + lb0; x1 = (x1 - mu) * rstd * lg1 + lb1;
            float* vo = c.out + O_VS + (size_t)(l * NSM + n) * W + ch; *(f32x4*)(vo) = x0; *(f32x4*)(vo + 4) = x1;
            store8(yr + 512 + ch, u0 * (x0 * w00 + b00), u1 * (x1 * w00 + b00));
        }
        {
            f32x4 c0, c1; unpk8(qc, c0, c1);
            float* po = c.out + O_POOLS + ((size_t)(l * NSM + n) * 15) * W + ch;
            f32x4 r0 = c0, r1 = c1, s2a, s2b, s4a, s4b, s8a, s8b;
#pragma unroll
            for (int k = 14; k >= 0; --k) {
                if (k >= 1) { *(f32x4*)(po + (size_t)(k - 1) * W) = st0[k]; *(f32x4*)(po + (size_t)(k - 1) * W + 4) = st1[k]; }
                r0 += st0[k]; r1 += st1[k];
                if (k == 14) { s2a = r0; s2b = r1; } if (k == 12) { s4a = r0; s4b = r1; } if (k == 8) { s8a = r0; s8b = r1; } }
            *(f32x4*)(po + (size_t)14 * W) = c0; *(f32x4*)(po + (size_t)14 * W + 4) = c1;
            const f32x4 sa = g == 0 ? s2a : g == 1 ? s4a : g == 2 ? s8a : r0, sb2 = g == 0 ? s2b : g == 1 ? s4b : g == 2 ? s8b : r1;
            const f32x4 p0 = sa * invw - c0, p1 = sb2 * invw - c1;
            u32x4 o; o.x = pk2(p0.x, p0.y); o.y = pk2(p0.z, p0.w); o.z = pk2(p1.x, p1.y); o.w = pk2(p1.z, p1.w);
            *(LAS u32x4*)(ldsw + i * TPS + 16 * lane) = o;
        }
    }
    __syncthreads();
    const int row = MPR + 8 * sb + (fr & 7); const bf16_t* pr = c.pbuf + (size_t)row * PC; bf16_t* yr = c.y + (size_t)row * 1536;
    bf16x8 bw[2][4][2]; u32x4 sgv[2]; f32x4 pbv[2][2], psv[2][2];
#pragma unroll
    for (int gi2 = 0; gi2 < 2; ++gi2) { const int gq = 2 * c.wave + gi2, g2 = gq >> 2, nq = gq & 3, cc = 128 * g2 + 32 * nq + 8 * fq;
        const bf16_t* pw = c.PoolWT + ((size_t)(l * 4 + g2) * 128 + 32 * nq + fr) * 128 + 8 * fq;
#pragma unroll
        for (int ks = 0; ks < 4; ++ks) { bw[gi2][ks][0] = *(const bf16x8*)(pw + 32 * ks); bw[gi2][ks][1] = *(const bf16x8*)(pw + 16 * 128 + 32 * ks); }
        sgv[gi2] = ld_sc16(pr + PSG + cc);
        pbv[gi2][0] = *(const f32x4*)(c.pool_b + l * W + cc); pbv[gi2][1] = *(const f32x4*)(c.pool_b + l * W + cc + 4); psv[gi2][0] = *(const f32x4*)(c.pool_scale + l * W + cc); psv[gi2][1] = *(const f32x4*)(c.pool_scale + l * W + cc + 4); }
#pragma unroll
    for (int gi2 = 0; gi2 < 2; ++gi2) { const int gq = 2 * c.wave + gi2, g2 = gq >> 2, nq = gq & 3, cc = 128 * g2 + 32 * nq + 8 * fq;
        f32x4 a0 = (f32x4){0.f, 0.f, 0.f, 0.f}, a1 = (f32x4){0.f, 0.f, 0.f, 0.f};
#pragma unroll
        for (int ks = 0; ks < 4; ++ks) { const bf16x8 af = *(const LAS bf16x8*)(ldsw + fr * TPS + 2 * (128 * g2 + 32 * ks + 8 * fq));
            a0 = __builtin_amdgcn_mfma_f32_16x16x32_bf16(bw[gi2][ks][0], af, a0, 0, 0, 0); a1 = __builtin_amdgcn_mfma_f32_16x16x32_bf16(bw[gi2][ks][1], af, a1, 0, 0, 0); }
        f32x4 g0v, g1v; unpk8(sgv[gi2], g0v, g1v);
        if (fr < 8) store8(yr + 1024 + cc, (a0 + pbv[gi2][0]) * psv[gi2][0] * g0v, (a1 + pbv[gi2][1]) * psv[gi2][1] * g1v);
    }
}

DEV void p2_mm(const Ctx& c, const int l, const int ck, const int hh, const bf16_t* pb, LAS unsigned char* lds) {
    int lane_ = c.lane; asm volatile("" : "+v"(lane_));
    const int lane = lane_, w = c.wave, fr = lane & 15, fq = lane >> 4, row0 = ck * 128;
    const int hq = w >> 1, a = w & 1, h = 4 * hh + hq;
    bf16x8 wf[4][4]; u32x4 ug[4][2]; float bias[4];
    { const bf16_t* wm = c.SguW + ((size_t)(l * 8 + h) * 128) * 128;
#pragma unroll
      for (int i = 0; i < 4; ++i) { const int tb = a ? (i == 0 ? 1 : i == 1 ? 2 : i == 2 ? 5 : 6) : (i == 0 ? 0 : i == 1 ? 3 : i == 2 ? 4 : 7), t = 16 * tb + fr;
#pragma unroll
          for (int ks = 0; ks < 4; ++ks) wf[i][ks] = *(const bf16x8*)(wm + (size_t)t * 128 + 32 * ks + 8 * fq);
      } }
    __syncthreads();
#pragma unroll
    for (int i = 0; i < 4; ++i) { const int tb = a ? (i == 0 ? 1 : i == 1 ? 2 : i == 2 ? 5 : 6) : (i == 0 ? 0 : i == 1 ? 3 : i == 2 ? 4 : 7), t = 16 * tb + fr;
        bias[i] = c.sgu_b[(l * 8 + h) * 128 + t];
#pragma unroll
        for (int c2 = 0; c2 < 2; ++c2) ug[i][c2] = *(const u32x4*)(pb + (size_t)t * PC + PUG + 256 * hh + 64 * hq + 32 * c2 + 8 * fq); }
    f32x4 acc[4][4];
#pragma unroll
    for (int i = 0; i < 4; ++i)
#pragma unroll
        for (int cc = 0; cc < 4; ++cc) acc[i][cc] = (f32x4){0.f, 0.f, 0.f, 0.f};
    { const int q = fr >> 2, p = fr & 3;
#pragma unroll
      for (int ks = 0; ks < 4; ++ks) {
        bf16x8 vb[4];
#pragma unroll
        for (int cc = 0; cc < 4; ++cc) { const int col = 64 * hq + 32 * (cc >> 1) + 8 * p + 4 * (cc & 1);
            const v4i16 lo = __builtin_amdgcn_ds_read_tr16_b64_v4i16((LAS v4i16*)(lds + VT_OFF + (32 * ks + 8 * fq + q) * TP + 2 * col));
            const v4i16 hi = __builtin_amdgcn_ds_read_tr16_b64_v4i16((LAS v4i16*)(lds + VT_OFF + (32 * ks + 8 * fq + 4 + q) * TP + 2 * col));
            vb[cc] = (bf16x8){lo[0], lo[1], lo[2], lo[3], hi[0], hi[1], hi[2], hi[3]}; }
#pragma unroll
        for (int i = 0; i < 4; ++i) { const int tb = a ? (i == 0 ? 1 : i == 1 ? 2 : i == 2 ? 5 : 6) : (i == 0 ? 0 : i == 1 ? 3 : i == 2 ? 4 : 7);
            if (ks <= (tb >> 1)) {
#pragma unroll
                for (int cc = 0; cc < 4; ++cc) acc[i][cc] = __builtin_amdgcn_mfma_f32_16x16x32_bf16(vb[cc], wf[i][ks], acc[i][cc], 0, 0, 0); } }
      } }
    asm volatile("" ::: "memory");
    const int gi2 = w >> 2, nq = w & 3, chc = 256 * hh + 128 * gi2 + 32 * nq + 8 * fq;
    bf16x8 pw0[4], pw1[4]; u32x4 sgv[8];
    { const bf16_t* pw = c.PoolWT + ((size_t)(l * 4 + 2 * hh + gi2) * 128 + 32 * nq + fr) * 128 + 8 * fq;
#pragma unroll
      for (int ks = 0; ks < 4; ++ks) { pw0[ks] = *(const bf16x8*)(pw + 32 * ks); pw1[ks] = *(const bf16x8*)(pw + 16 * 128 + 32 * ks); }
#pragma unroll
      for (int m = 0; m < 8; ++m) sgv[m] = *(const u32x4*)(pb + (size_t)(16 * m + fr) * PC + PSG + chc); }
    const f32x4 pb0 = *(const f32x4*)(c.pool_b + l * W + chc), pb1 = *(const f32x4*)(c.pool_b + l * W + chc + 4), ps0 = *(const f32x4*)(c.pool_scale + l * W + chc), ps1 = *(const f32x4*)(c.pool_scale + l * W + chc + 4);
#pragma unroll
    for (int i = 0; i < 4; ++i) { const int tb = a ? (i == 0 ? 1 : i == 1 ? 2 : i == 2 ? 5 : 6) : (i == 0 ? 0 : i == 1 ? 3 : i == 2 ? 4 : 7), t = 16 * tb + fr;
#pragma unroll
        for (int c2 = 0; c2 < 2; ++c2) { f32x4 u0, u1; unpk8(ug[i][c2], u0, u1);
            store8(c.y + (size_t)(row0 + t) * 1536 + 512 + 256 * hh + 64 * hq + 32 * c2 + 8 * fq, (acc[i][2 * c2] + bias[i]) * u0, (acc[i][2 * c2 + 1] + bias[i]) * u1); } }
    f32x4 ac2[8][2];
#pragma unroll
    for (int m = 0; m < 8; ++m) { ac2[m][0] = (f32x4){0.f, 0.f, 0.f, 0.f}; ac2[m][1] = (f32x4){0.f, 0.f, 0.f, 0.f}; }
#pragma unroll
    for (int ks = 0; ks < 4; ++ks)
#pragma unroll
        for (int m = 0; m < 8; ++m) { const bf16x8 af = *(const LAS bf16x8*)(lds + PM_OFF + (16 * m + fr) * TP + 2 * (128 * gi2 + 32 * ks + 8 * fq));
            ac2[m][0] = __builtin_amdgcn_mfma_f32_16x16x32_bf16(pw0[ks], af, ac2[m][0], 0, 0, 0); ac2[m][1] = __builtin_amdgcn_mfma_f32_16x16x32_bf16(pw1[ks], af, ac2[m][1], 0, 0, 0); }
#pragma unroll
    for (int m = 0; m < 8; ++m) { f32x4 s0, s1; unpk8(sgv[m], s0, s1);
        store8(c.y + (size_t)(row0 + 16 * m + fr) * 1536 + 1024 + chc, (ac2[m][0] + pb0) * ps0 * s0, (ac2[m][1] + pb1) * ps1 * s1); }
    __syncthreads();
}
template <int HH> DEV void p2_item_front(const Ctx& c, const int l, const int ck, const bf16_t* pb, LAS unsigned char* lds) {
    constexpr int W0 = 2 << (2 * HH), W1 = 2 * W0, H = W1 - 1, NX = H + 16;
    int lane_ = c.lane; asm volatile("" : "+v"(lane_));
    const int lane = lane_, w = c.wave, p = lane >> 5, gi = lane >> 5, cpos = (ck & 15) * 128, row0 = ck * 128; const bool lastck = (ck & 15) == 15;
    const int ch8 = 256 * HH + 8 * (lane & 31), ch4 = 256 * HH + 4 * lane;
    const float* st = c.lnst + ((size_t)ck * 128 + 16 * w + (lane & 15)) * 16;
    const f32x4 t0 = *(const f32x4*)st, t1 = *(const f32x4*)(st + 4), t2 = *(const f32x4*)(st + 8), t3 = *(const f32x4*)(st + 12);
    u32x4 gv[8];
#pragma unroll
    for (int k = 0; k < 8; ++k) gv[k] = *(const u32x4*)(pb + (size_t)(16 * w + 2 * k + p) * PC + PGV + ch8);
    const f32x4 g0 = *(const f32x4*)(c.lnv_g + l * W + ch8), g1 = *(const f32x4*)(c.lnv_g + l * W + ch8 + 4), b0 = *(const f32x4*)(c.lnv_b + l * W + ch8), b1 = *(const f32x4*)(c.lnv_b + l * W + ch8 + 4);
    u32x2 xr[NX];
#pragma unroll
    for (int k = 0; k < NX; ++k) { const int tt = 16 * w - H + k; const bool valid = cpos + tt >= 0; const int tc = valid ? tt : 0;
        const u32x2 r = *(const u32x2*)(pb + (ptrdiff_t)tc * PC + PCX + ch4); xr[k] = valid ? r : (u32x2){0u, 0u}; }
    {
        const float s = ((t0.x + t0.z) + (t1.x + t1.z)) + ((t2.x + t2.z) + (t3.x + t3.z)), q = ((t0.y + t0.w) + (t1.y + t1.w)) + ((t2.y + t2.w) + (t3.y + t3.w));
        const float mu_l = s * (1.f / W), rstd_l = __builtin_amdgcn_rsqf(fmaxf(q * (1.f / W) - mu_l * mu_l, 0.f) + EPS);
        float* vout = c.out + O_VP + ((size_t)(l * NBP + (ck >> 4)) * 128) * W + ch8;
#pragma unroll
        for (int k = 0; k < 8; ++k) { const int t = 16 * w + 2 * k + p;
            const float mu = __shfl(mu_l, 2 * k + p), rstd = __shfl(rstd_l, 2 * k + p);
            f32x4 x0 = (f32x4){bflo(gv[k].x), bfhi(gv[k].x), bflo(gv[k].y), bfhi(gv[k].y)}, x1 = (f32x4){bflo(gv[k].z), bfhi(gv[k].z), bflo(gv[k].w), bfhi(gv[k].w)};
            x0 = (x0 - mu) * rstd * g0 + b0; x1 = (x1 - mu) * rstd * g1 + b1;
            u32x4 o; o.x = pk2(x0.x, x0.y); o.y = pk2(x0.z, x0.w); o.z = pk2(x1.x, x1.y); o.w = pk2(x1.z, x1.w);
            *(LAS u32x4*)(lds + VT_OFF + t * TP + (lane & 31) * 16) = o;
            if (lastck) { *(f32x4*)(vout + (size_t)t * W) = x0; *(f32x4*)(vout + (size_t)t * W + 4) = x1; }
        }
    }
    const f32x4 cb = *(const f32x4*)(c.conv_b + l * W + ch4), w0 = *(const f32x4*)(c.conv_w + (l * 3 + 0) * W + ch4), w1 = *(const f32x4*)(c.conv_w + (l * 3 + 1) * W + ch4), w2 = *(const f32x4*)(c.conv_w + (l * 3 + 2) * W + ch4);
    u32x2 zr[18], ar[16];
#pragma unroll
    for (int k = 0; k < 18; ++k) { const int tt = 16 * w - 2 + k; const bool valid = cpos + tt >= 0; const int tc = valid ? tt : 0;
        const u32x2 r = *(const u32x2*)(pb + (ptrdiff_t)tc * PC + PZ + ch4); zr[k] = valid ? r : (u32x2){0u, 0u}; }
#pragma unroll
    for (int i = 0; i < 16; ++i) ar[i] = *(const u32x2*)(pb + (size_t)(16 * w + i) * PC + PABG + ch4);
    {
        f32x4 slo = unpk4(xr[H]);
#pragma unroll
        for (int j = 1; j < W0; ++j) slo += unpk4(xr[H - j]);
        f32x4 shi = slo;
#pragma unroll
        for (int j = W0; j < W1; ++j) shi += unpk4(xr[H - j]);
        float* pout = c.out + O_POOLP + ((size_t)(l * NBP + (ck >> 4)) * 15) * W + ch4;
#pragma unroll
        for (int i = 0; i < 16; ++i) { const int t = 16 * w + i, pos = cpos + t, wd = gi ? W1 : W0;
            const f32x4 sm = gi ? shi : slo, xc = unpk4(xr[H + i]); const float inv = __builtin_amdgcn_rcpf((float)(wd < pos + 1 ? wd : pos + 1));
            const f32x4 pm = sm * inv - xc;
            *(LAS u32x2*)(lds + PM_OFF + t * TP + 8 * lane) = (u32x2){pk2(pm.x, pm.y), pk2(pm.z, pm.w)};
            if (lastck && t >= 113) *(f32x4*)(pout + (size_t)(t - 113) * W) = xc;
            if (i < 15) { const f32x4 xn = unpk4(xr[H + i + 1]); slo += xn - unpk4(xr[H + i + 1 - W0]); shi += xn - unpk4(xr[H + i + 1 - W1]); }
        }
    }
    {
        float* cout = c.out + O_CONVP + ((size_t)(l * NBP + (ck >> 4)) * 2) * W + ch4;
#pragma unroll
        for (int i = 0; i < 16; ++i) { const int t = 16 * w + i;
            const f32x4 abg = unpk4(ar[i]), z2 = unpk4(zr[i + 2]);
            const f32x4 o = abg * (cb + w0 * unpk4(zr[i]) + w1 * unpk4(zr[i + 1]) + w2 * z2);
            *(u32x2*)(c.y + (size_t)(row0 + t) * 1536 + ch4) = (u32x2){pk2(o.x, o.y), pk2(o.z, o.w)};
            if (lastck && t >= 126) *(f32x4*)(cout + (size_t)(t - 126) * W) = z2;
        }
    }
}
DEV void ph_p2_prompt(const Args& a, int l, LAS unsigned char* lds) {
    LAUNDER_CTX(a);
    VB_LOAD(lds);
    {
        const int ck = 16 * vx_ + (vr_ >> 1), hh = vr_ & 1; const bf16_t* pb = c.pbuf + (size_t)ck * 128 * PC;
        { if (hh) p2_item_front<1>(c, l, ck, pb, lds); else p2_item_front<0>(c, l, ck, pb, lds); }
        p2_mm(c, l, ck, hh, pb, lds);
    }
    if (vr_ >= 30) {
        unsigned* ctl = (unsigned*)(a.ws + WS_CTL + z_);
        if (threadIdx.x == 0) { XB_SPIN(xb_ld(&ctl[XB_CNT_P1S]) < 960u * (unsigned)(l + 1), ctl); __builtin_amdgcn_fence(__ATOMIC_ACQUIRE, "agent"); asm volatile("s_waitcnt vmcnt(0)" ::: "memory"); }
        __syncthreads();
        p2_sample_block(c, l, 2 * vx_ + (vr_ - 30), lds); __syncthreads(); }
}
DEV void ph_final(const Args& a, LAS unsigned char* lds) {
    LAUNDER_CTX(a); VB_LOAD(lds);
    const int lane = c.lane;
#pragma unroll 2
    for (int i = 8 * vr_ + c.wave; i < 2048 + 16; i += 256) { const int row = i < 2048 ? 2048 * vx_ + i : MPR + 16 * vx_ + (i - 2048);
        const float r = row_rstd(c.ssq, row);
#pragma unroll
        for (int j = 0; j < 2; ++j) { f32x4 x0, x1; unpk8(*((const u32x4*)(c.xb + (size_t)row * D) + lane + 64 * j), x0, x1);
            const f32x4* gp = (const f32x4*)c.final_g + 2 * lane + 128 * j; f32x4* o = (f32x4*)(c.out + (size_t)row * D) + 2 * lane + 128 * j;
            o[0] = x0 * r * gp[0]; o[1] = x1 * r * gp[1]; }
    }
}

__global__ __launch_bounds__(NTHREADS, 2) void mega_fwd(Args a) {
    extern __shared__ __attribute__((aligned(16))) unsigned char lds[];
    LAS unsigned char* ldsp = (LAS unsigned char*)lds;
    if (threadIdx.x < 16) ((LAS unsigned*)(ldsp + LDSCTL_OFF))[threadIdx.x] = 0u;
    __syncthreads();
    const XcdBarrier bar = xcd_barrier_post((unsigned*)(a.ws + WS_CTL), (volatile LAS unsigned*)(ldsp + LDSCTL_OFF));
    ph_convert(a, lds, 0, 0);
    xcd_barrier(bar);
    { LAUNDER_CTX(a); int bx_ = blockIdx.x, gx_ = gridDim.x; asm volatile("" : "+s"(bx_), "+s"(gx_)); SchedMod S{gx_, bx_, (const char*)c.scb, (const char*)c.WadaT}; EpiRows<EpiMod> E{EpiMod{c.mod, c.atab, c.shb, c.b_ada, c.norm_g}}; gemm_phase(ldsp, D * 2, D * 2, D / BK, S, E); }
    ph_convert(a, lds, 1, (int)gridDim.x > 96 ? 48 : 0);
    xcd_barrier(bar);
    { LAUNDER_CTX(a); int bx_ = blockIdx.x, gx_ = gridDim.x; asm volatile("" : "+s"(bx_), "+s"(gx_)); SchedSW S{gx_, bx_, (const char*)c.shb, (const char*)c.WinT}; EpiRows<EpiSWx> E{EpiSWx{c.SW}}; gemm_phase(ldsp, D * 2, D * 2, D / BK, S, E); }
    ph_xa0(a);
    xcd_barrier(bar);
#pragma unroll 1
    for (int l = 0; l < DEPTH; ++l) {
        { LAUNDER_CTX(a); VB_LOAD(ldsp); SchedP1 S; S.T.init(8, NIN / 256, 32, vr_, 8 * vx_); S.A = (const char*)((l & 1) ? c.xa2 : c.xa); S.B = (const char*)(c.WinT + (size_t)l * NIN * D);
          p1_rtab(S, c.ssq, c.SW + (size_t)l * NBT * NIN, (LAS float*)(ldsp + RTAB_OFF), (LAS float*)(ldsp + SWT_OFF));
          EpiP1T E{c.pbuf, c.SW + (size_t)l * NBT * NIN, (const LAS float*)(ldsp + RTAB_OFF), (const LAS float*)(ldsp + SWT_OFF), c.lnst};
          gemm_phase(ldsp, D * 2, D * 2, D / BK, S, E);
          if (vr_ >= 16) {
              const EpiP1S es{c.pbuf, c.SW + (size_t)l * NBT * NIN, c.ssq};
              const int spn = vx_ + 8 * ((vr_ - 16) >> 2), sl = 4 * spn + (vr_ & 3);
              if (spn < 30) { unsigned* ctl = (unsigned*)(a.ws + WS_CTL + z_);
                  XB_SPIN(xb_ld(&ctl[XB_CNT_P4S]) < 128u * (unsigned)l, ctl);
                  __builtin_amdgcn_fence(__ATOMIC_ACQUIRE, "agent"); asm volatile("s_waitcnt vmcnt(0)" ::: "memory");
                  p1_sample_slice(c.tid, sl, (l & 1) ? c.xa2 : c.xa, c.WinT + (size_t)l * NIN * D, es, ldsp);
                  asm volatile("s_waitcnt vmcnt(0)" ::: "memory");
                  if (c.lane == 0) xb_add(&ctl[XB_CNT_P1S], 1u); } } }
        layer_barrier(bar);
        ph_p2_prompt(a, l, ldsp);
        layer_barrier(bar);
        { LAUNDER_CTX(a); VB_LOAD(ldsp); const EpiP3 e3{c.pbuf, c.mg};
          if (vr_ < 16) { mini_gemm<3, 2>(a, ldsp, vx_ | (vr_ << 3), c.y, 1536, W, c.WbT + (size_t)l * 3 * D * W, W, (size_t)D * W, e3);
              if (threadIdx.x == 0) { asm volatile("s_waitcnt vmcnt(0)" ::: "memory"); xb_add((unsigned*)(a.ws + WS_CTL + z_) + XB_CNT_P3S(vx_), 1u); } }
          SchedP3R S; S.T.init(8, 8, 32, vr_, 8 * vx_); S.A = (const char*)c.y; S.B = (const char*)(c.WbT + (size_t)l * 3 * D * W);
          f32x4 tot[2][4][2];
#pragma unroll
          for (int i0 = 0; i0 < 2; ++i0)
#pragma unroll
              for (int i1 = 0; i1 < 4; ++i1) { tot[i0][i1][0] = (f32x4){0.f, 0.f, 0.f, 0.f}; tot[i0][i1][1] = (f32x4){0.f, 0.f, 0.f, 0.f}; }
          u32x2 gpre[8]; EpiP3R E{tot, gpre, c.pbuf, c.mg};
          { UnitD u0; int t_ = threadIdx.x; asm volatile("" : "+v"(t_)); const int wv = __builtin_amdgcn_readfirstlane(t_ >> 6); if (S.next(0, u0)) E.prefetch(u0, wv >> 2, wv & 3, t_ & 15, (t_ & 63) >> 4); }
          gemm_phase<EpiP3R, SchedP3R, 1>(ldsp, 1536 * 2, W * 2, W / BK, S, E);
          if (vr_ >= 16) {
              unsigned* ctl = (unsigned*)(a.ws + WS_CTL + z_);
              if (threadIdx.x == 0) { XB_SPIN(xb_ld(&ctl[XB_CNT_P3S(vx_)]) < 16u * (unsigned)(l + 1), ctl); __builtin_amdgcn_fence(__ATOMIC_ACQUIRE, "agent"); asm volatile("s_waitcnt vmcnt(0)" ::: "memory"); }
              __syncthreads();
              const float* gate = c.mod + (size_t)l * NBT * 3072 + 2048; const float* atc = c.atab + (size_t)l * NBT * D; const float* atn = l + 1 < DEPTH ? c.atab + (size_t)(l + 1) * NBT * D : nullptr;
              const EpiP4 e4{gate, atc, atn, (l & 1) ? c.xa2 : c.xa, (l & 1) ? c.xa : c.xa2, c.ssq, c.x_sample - (size_t)MPR * D, c.xb, l > 0};
              mini_gemm<1, 4>(a, ldsp, vx_ | ((vr_ - 16) << 3), c.mg, D, 0, c.WoT + (size_t)l * D * D, D, (size_t)0, e4);
              if (threadIdx.x == 0) { asm volatile("s_waitcnt vmcnt(0)" ::: "memory"); xb_add(&ctl[XB_CNT_P4S], 1u); } } }
        layer_barrier(bar);
        { LAUNDER_CTX(a); VB_LOAD(ldsp); const float* gate = c.mod + (size_t)l * NBT * 3072 + 2048;
          const float* atc = c.atab + (size_t)l * NBT * D; const float* atn = l + 1 < DEPTH ? c.atab + (size_t)(l + 1) * NBT * D : nullptr;
          const bf16_t* xai = (l & 1) ? c.xa2 : c.xa; bf16_t* xao = (l & 1) ? c.xa : c.xa2;
          const EpiP4 e4{gate, atc, atn, xai, xao, c.ssq, c.x_sample - (size_t)MPR * D, c.xb, l > 0};
          SchedP4 S; S.T.init(8, 4, 32, vr_, 8 * vx_); S.A = (const char*)c.mg; S.B = (const char*)(c.WoT + (size_t)l * D * D);
          if (l == 0) { EpiP4T<false, false> E{gate, atc, atn, xai, xao, c.ssq, c.x_prompt, c.xb}; gemm_phase(ldsp, D * 2, D * 2, D / BK, S, E); }
          else if (l + 1 < DEPTH) { EpiP4T<true, false> E{gate, atc, atn, xai, xao, c.ssq, c.x_prompt, c.xb}; gemm_phase(ldsp, D * 2, D * 2, D / BK, S, E); }
          else { EpiP4T<true, true> E{gate, atc, atn, xai, xao, c.ssq, c.x_prompt, c.xb}; gemm_phase(ldsp, D * 2, D * 2, D / BK, S, E); } }
        layer_barrier(bar);
    }
    ph_final(a, ldsp);
}

extern "C" void kernel_launch(void* const* d_in, const int* in_sizes, int n_in, void* d_out, int out_size, void* d_ws, size_t ws_size, hipStream_t stream) {
    static int grid_blocks = 0;
    if (grid_blocks == 0) {
        if (n_in != 22 || ws_size < WS_END) { fprintf(stderr, "kernel_launch: unexpected n_in %d or ws_size %zu < %zu\n", n_in, ws_size, (size_t)WS_END); grid_blocks = -1; return; }
        int dev = 0, cus = 0, per_cu = 0;
        (void)hipGetDevice(&dev); (void)hipDeviceGetAttribute(&cus, hipDeviceAttributeMultiprocessorCount, dev);
        if (hipFuncSetAttribute((const void*)mega_fwd, hipFuncAttributeMaxDynamicSharedMemorySize, LDS_BYTES) != hipSuccess) { fprintf(stderr, "kernel_launch: hipFuncSetAttribute failed\n"); grid_blocks = -1; return; }
        if (hipOccupancyMaxActiveBlocksPerMultiprocessor(&per_cu, (const void*)mega_fwd, NTHREADS, LDS_BYTES) != hipSuccess || per_cu < 1) { fprintf(stderr, "kernel_launch: occupancy query gave %d\n", per_cu); grid_blocks = -1; return; }
        if (cus < 256) { fprintf(stderr, "kernel_launch: this kernel is laid out for >= 256 CUs (found %d)\n", cus); grid_blocks = -1; return; }
        grid_blocks = 256;
        fprintf(stderr, "kernel_launch: cus %d per_cu %d grid %d\n", cus, per_cu, grid_blocks);
    }
    if (grid_blocks < 0) return;
    Args a{};
    for (int i = 0; i < 22; ++i) a.in[i] = (const float*)d_in[i];
    a.out = (float*)d_out; a.ws = (unsigned char*)d_ws;
    if (hipMemsetAsync((char*)d_ws + WS_CTL, 0, CTL_BYTES, stream) != hipSuccess) { fprintf(stderr, "kernel_launch: memset failed\n"); return; }
    void* args[] = {&a};
    hipError_t e = hipLaunchCooperativeKernel((const void*)mega_fwd, dim3(grid_blocks), dim3(NTHREADS), args, LDS_BYTES, stream);
    if (e != hipSuccess) fprintf(stderr, "kernel_launch: cooperative launch failed: %s (grid %d)\n", hipGetErrorString(e), grid_blocks);
}
```

```cpp
#include <hip/hip_runtime.h>
#include <cstdio>
#include <cstdint>

#define DEV __device__ __forceinline__
typedef unsigned short bf16_t;
typedef short bf16x8 __attribute__((ext_vector_type(8)));
typedef float f32x4 __attribute__((ext_vector_type(4)));
typedef unsigned u32x4 __attribute__((ext_vector_type(4)));
typedef unsigned u32x2 __attribute__((ext_vector_type(2)));

constexpr int D = 1024, TSEQ = 2048, NBP = 8, MPR = NBP * TSEQ  , NSM = 128, MV = MPR + NSM  , MP = 16640  , NBT = NBP + NSM  ;
constexpr int W = 512, NIN = 7680, PC = 4608  , DEPTH = 4;
constexpr int PZ = 0, PABG = 512, PUG = 1024, PGV = 1536, PCX = 2048, PSG = 2560, PGATE = 3072;
constexpr float EPS = 1e-6f;
constexpr size_t O_Y = 0, O_YS = 16777216, O_CONVP = 16908288, O_CONVS = 16941056, O_POOLP = 17465344, O_POOLS = 17711104, O_VP = 21643264, O_VS = 23740416;

constexpr size_t al256(size_t x) { return (x + 255) & ~(size_t)255; }
constexpr size_t WS_WIN = 0;
constexpr size_t WS_WB = al256(WS_WIN + (size_t)DEPTH * NIN * D * 2);
constexpr size_t WS_WO = al256(WS_WB + (size_t)DEPTH * 3 * D * W * 2);
constexpr size_t WS_MOD = al256(WS_WO + (size_t)DEPTH * D * D * 2);
constexpr size_t WS_ATAB = al256(WS_MOD + (size_t)DEPTH * NBT * 3 * D * 4);
constexpr size_t WS_SHB = al256(WS_ATAB + (size_t)DEPTH * NBT * D * 4);
constexpr size_t WS_SW = al256(WS_SHB + (size_t)DEPTH * 256 * D * 2);
constexpr size_t WS_XA = al256(WS_SW + (size_t)DEPTH * NBT * NIN * 4);
constexpr size_t WS_SSQ = al256(WS_XA + (size_t)MP * D * 2);
constexpr size_t WS_PBUF = al256(WS_SSQ + (size_t)MP * 16 * 4);
constexpr size_t WS_Y = al256(WS_PBUF + (size_t)MP * PC * 2);
constexpr size_t WS_MG = al256(WS_Y + (size_t)MP * 1536 * 2);
constexpr size_t WS_SGUW = al256(WS_MG + (size_t)MP * D * 2);
constexpr size_t WS_POOLW = al256(WS_SGUW + (size_t)DEPTH * 8 * 128 * 128 * 2);
constexpr size_t WS_WADA = al256(WS_POOLW + (size_t)DEPTH * 4 * 128 * 128 * 2);
constexpr size_t WS_SCB = al256(WS_WADA + (size_t)DEPTH * 3072 * D * 2);
constexpr size_t WS_XB = al256(WS_SCB + (size_t)256 * D * 2);
constexpr size_t WS_XA2 = al256(WS_XB + (size_t)MV * D * 2);
constexpr size_t WS_LNST = al256(WS_XA2 + (size_t)MP * D * 2);
constexpr size_t WS_CTL = al256(WS_LNST + (size_t)MP * 16 * 4);
constexpr size_t CTL_BYTES = 32768;
constexpr size_t WS_END = al256(WS_CTL + CTL_BYTES);

constexpr int NTHREADS = 512, NWAVES = 8;
constexpr int LDS_BYTES = 155648;
constexpr int LDSCTL_OFF = LDS_BYTES - 256;

typedef __bf16 bf16x2_t __attribute__((ext_vector_type(2)));
typedef float f32x2_t __attribute__((ext_vector_type(2)));
DEV unsigned pk2(float lo, float hi) { const f32x2_t v = {lo, hi}; const bf16x2_t b = __builtin_convertvector(v, bf16x2_t); return __builtin_bit_cast(unsigned, b); }
typedef unsigned long long u64_t;
DEV u32x2 ld_sc8(const void* p) { const u64_t v = __hip_atomic_load((const u64_t*)p, __ATOMIC_RELAXED, __HIP_MEMORY_SCOPE_AGENT); return (u32x2){(unsigned)v, (unsigned)(v >> 32)}; }
DEV u32x4 ld_sc16(const void* p) { const u32x2 a = ld_sc8(p), b = ld_sc8((const char*)p + 8); return (u32x4){a.x, a.y, b.x, b.y}; }
DEV void st_sc8(void* p, u32x2 v) { __hip_atomic_store((u64_t*)p, (u64_t)v.x | ((u64_t)v.y << 32), __ATOMIC_RELAXED, __HIP_MEMORY_SCOPE_AGENT); }
DEV void st_sc16(void* p, u32x4 v) { st_sc8(p, (u32x2){v.x, v.y}); st_sc8((char*)p + 8, (u32x2){v.z, v.w}); }
DEV void store8_sc(bf16_t* p, f32x4 a, f32x4 b) { u32x4 w; w.x = pk2(a.x, a.y); w.y = pk2(a.z, a.w); w.z = pk2(b.x, b.y); w.w = pk2(b.z, b.w); st_sc16(p, w); }
DEV float row_rstd_sc(const float* ssq, int row) {
    float s = 0.f;
#pragma unroll
    for (int i = 0; i < 8; ++i) { const u32x2 v = ld_sc8(ssq + (size_t)row * 16 + 2 * i); const unsigned lo = v.x, hi = v.y; s += __builtin_bit_cast(float, lo) + __builtin_bit_cast(float, hi); }
    return __builtin_amdgcn_rsqf(s * (1.f / D) + EPS);
}
DEV float bflo(unsigned u) { return __builtin_bit_cast(float, u << 16); }
DEV float bfhi(unsigned u) { return __builtin_bit_cast(float, u & 0xffff0000u); }
DEV void unpk8(const u32x4 u, f32x4& a, f32x4& b) { a = (f32x4){bflo(u.x), bfhi(u.x), bflo(u.y), bfhi(u.y)}; b = (f32x4){bflo(u.z), bfhi(u.z), bflo(u.w), bfhi(u.w)}; }
DEV f32x4 gate4(unsigned u) { return (f32x4){(float)(u & 0xffu), (float)((u >> 8) & 0xffu), (float)((u >> 16) & 0xffu), (float)(u >> 24)} * (1.f / 255.f); }
DEV unsigned pku8(f32x4 s) { const unsigned a = (unsigned)(s.x * 255.f + 0.5f), b = (unsigned)(s.y * 255.f + 0.5f), c = (unsigned)(s.z * 255.f + 0.5f), d = (unsigned)(s.w * 255.f + 0.5f); return a | (b << 8) | (c << 16) | (d << 24); }
DEV f32x4 exp2_4(f32x4 t) { return (f32x4){__builtin_amdgcn_exp2f(t.x), __builtin_amdgcn_exp2f(t.y), __builtin_amdgcn_exp2f(t.z), __builtin_amdgcn_exp2f(t.w)}; }
DEV unsigned pku8_t(f32x4 t);
DEV f32x4 rcp4(f32x4 d) { return (f32x4){__builtin_amdgcn_rcpf(d.x), __builtin_amdgcn_rcpf(d.y), __builtin_amdgcn_rcpf(d.z), __builtin_amdgcn_rcpf(d.w)}; }
DEV unsigned pku8_t(f32x4 t) {
    const f32x4 g = rcp4(exp2_4(t) * (1.f / 255.f) + (1.f / 255.f)) + 8388608.f;
    const u32x4 gu = __builtin_bit_cast(u32x4, g);
    const unsigned p01 = __builtin_amdgcn_perm(gu.y, gu.x, 0x0c0c0400u), p23 = __builtin_amdgcn_perm(gu.w, gu.z, 0x0c0c0400u);
    return __builtin_amdgcn_perm(p23, p01, 0x05040100u);
}
DEV f32x4 sigmoid4(f32x4 x) { return rcp4(exp2_4(x * -1.44269504f) + 1.f); }
DEV f32x4 silu4(f32x4 x) { return x * sigmoid4(x); }
DEV f32x4 gelu4(f32x4 x) { const f32x4 t = x * (x * x * (-2.f * 0.7978845608f * 0.044715f * 1.44269504f) + (-2.f * 0.7978845608f * 1.44269504f)); return x * rcp4(exp2_4(t) + 1.f); }
DEV int perm32(int rho) { const int n = rho >> 4, i = rho & 15; return 8 * (i >> 2) + 4 * n + (i & 3); }
DEV int nidx_of(int row) { return row < MPR ? (row >> 11) : (row < MV ? NBP + (row - MPR) : NBT - 1); }
DEV int src_win(int j) {
    const int pn = j >> 8, c = j & 255, bj = c >> 7, cc = c & 127;
    if (pn < 4) return (bj ? 1024 : 512) + 128 * pn + cc;
    if (pn < 8) return (bj ? 1536 : 0) + 128 * (pn - 4) + cc;
    if (pn < 12) return (bj ? 3072 : 2048) + 128 * (pn - 8) + cc;
    if (pn < 14) return 2560 + 256 * (pn - 12) + c;
    if (pn < 16) return 3584 + 256 * (pn - 14) + c;
    if (pn < 18) return 4096 + 256 * (pn - 16) + c;
    return 4608 + 256 * (pn - 18) + c;
}

struct Args { const float* in[22]; float* out; unsigned char* ws; };
struct Ctx {
    const float *x_prompt, *x_sample, *c_prompt, *c_sample, *state_conv, *state_pool, *w_ada, *b_ada, *norm_g, *w_in, *conv_w, *conv_b, *lnv_g, *lnv_b, *sgu_w, *sgu_b, *pool_w, *pool_b, *pool_scale, *w_branch, *w_out, *final_g;
    float* out; bf16_t *WinT, *WbT, *WoT; float *mod, *atab; bf16_t* shb; float* SW; bf16_t* xa; float* ssq; bf16_t *pbuf, *y, *mg; bf16_t *SguW, *PoolWT, *WadaT, *scb, *xb, *xa2; float* lnst;
    unsigned char* lds;
    int tid, lane, wave, gw, NGW, gtid, NGT;
};

DEV Ctx make_ctx(const Args& a, size_t z) {
    Ctx c;
    c.x_prompt = a.in[0] + z; c.x_sample = a.in[1] + z; c.c_prompt = a.in[2] + z; c.c_sample = a.in[3] + z; c.state_conv = a.in[4] + z; c.state_pool = a.in[5] + z; c.w_ada = a.in[6] + z; c.b_ada = a.in[7] + z;
    c.norm_g = a.in[8] + z; c.w_in = a.in[9] + z; c.conv_w = a.in[10] + z; c.conv_b = a.in[11] + z; c.lnv_g = a.in[12] + z; c.lnv_b = a.in[13] + z; c.sgu_w = a.in[14] + z; c.sgu_b = a.in[15] + z;
    c.pool_w = a.in[16] + z; c.pool_b = a.in[17] + z; c.pool_scale = a.in[18] + z; c.w_branch = a.in[19] + z; c.w_out = a.in[20] + z; c.final_g = a.in[21] + z;
    c.out = a.out + z; unsigned char* ws = a.ws + z;
    c.WinT = (bf16_t*)(ws + WS_WIN); c.WbT = (bf16_t*)(ws + WS_WB); c.WoT = (bf16_t*)(ws + WS_WO);
    c.mod = (float*)(ws + WS_MOD); c.atab = (float*)(ws + WS_ATAB); c.shb = (bf16_t*)(ws + WS_SHB); c.SW = (float*)(ws + WS_SW);
    c.xa = (bf16_t*)(ws + WS_XA); c.ssq = (float*)(ws + WS_SSQ); c.pbuf = (bf16_t*)(ws + WS_PBUF); c.y = (bf16_t*)(ws + WS_Y); c.mg = (bf16_t*)(ws + WS_MG);
    c.WadaT = (bf16_t*)(ws + WS_WADA); c.scb = (bf16_t*)(ws + WS_SCB); c.xb = (bf16_t*)(ws + WS_XB); c.xa2 = (bf16_t*)(ws + WS_XA2); c.lnst = (float*)(ws + WS_LNST); c.SguW = (bf16_t*)(ws + WS_SGUW); c.PoolWT = (bf16_t*)(ws + WS_POOLW);
    c.lds = nullptr; c.tid = 0; c.lane = 0; c.wave = 0; c.gw = 0; c.NGW = 0; c.gtid = 0; c.NGT = 0;
    return c;
}
#define LAUNDER_CTX(a) size_t z_ = 0; asm volatile("" : "+s"(z_)); Ctx c = make_ctx(a, z_); { int t_ = threadIdx.x; asm volatile("" : "+v"(t_)); c.tid = t_; c.lane = t_ & 63; c.wave = __builtin_amdgcn_readfirstlane(t_ >> 6); \
    c.gw = blockIdx.x * NWAVES + c.wave; c.NGW = gridDim.x * NWAVES; c.gtid = blockIdx.x * NTHREADS + t_; c.NGT = gridDim.x * NTHREADS; }
#define VB_LOAD(ldsp) const int vb_ = __builtin_amdgcn_readfirstlane((int)((volatile LAS unsigned*)((ldsp) + LDSCTL_OFF))[2]); const int vx_ = vb_ >> 5, vr_ = vb_ & 31;
struct MapWin { DEV int operator()(int g) const { return src_win((g & ~31) + perm32(g & 31)); } };
struct MapPerm { DEV int operator()(int g) const { return (g & ~31) + perm32(g & 31); } };
template <class Map>
DEV void transpose_item(const float* Wsrc, int ldw, int K, bf16_t* WT, int nblk, int item, float* scr, int lane, Map map) {
    const int kb = item / nblk, nb = item % nblk, k0 = 64 * kb, g0 = 32 * nb;
    const int scol = map(g0 + (lane & 31));
#pragma unroll 8
    for (int i = 0; i < 32; ++i) { const int kk = 2 * i + (lane >> 5); scr[kk * 33 + (lane & 31)] = Wsrc[(size_t)(k0 + kk) * ldw + scol]; }
    asm volatile("s_waitcnt lgkmcnt(0)" ::: "memory");
    const int c = lane & 7;
#pragma unroll
    for (int j = 0; j < 4; ++j) { const int n = (lane >> 3) + 8 * j; const float* s = scr + (8 * c) * 33 + n;
        u32x4 o; o.x = pk2(s[0 * 33], s[1 * 33]); o.y = pk2(s[2 * 33], s[3 * 33]); o.z = pk2(s[4 * 33], s[5 * 33]); o.w = pk2(s[6 * 33], s[7 * 33]);
        *(u32x4*)(WT + (size_t)(g0 + n) * K + k0 + 8 * c) = o; }
    asm volatile("s_waitcnt lgkmcnt(0)" ::: "memory");
}
constexpr int IT_WIN = (D / 64) * (NIN / 32), IT_WB = (W / 64) * (D / 32), IT_WO = (D / 64) * (D / 32);
constexpr int IT_PW = (128 / 64) * (128 / 32);
constexpr int IT_WADA = (D / 64) * (3072 / 32);
constexpr int IT_TOTAL = DEPTH * IT_WIN + DEPTH * 3 * IT_WB + DEPTH * IT_WO + DEPTH * 4 * IT_PW + DEPTH * IT_WADA;
DEV void ph_convert(const Args& a, unsigned char* lds, const int stage, const int b0) {
    LAUNDER_CTX(a);
    float* scr = (float*)(lds + c.wave * 16384);
    const int nb = (int)gridDim.x - b0, bw = ((int)blockIdx.x - b0) * NWAVES + c.wave, nw = nb * NWAVES, bt = ((int)blockIdx.x - b0) * NTHREADS + c.tid, nthr = nb * NTHREADS;
    if ((int)blockIdx.x < b0) return;
    if (stage == 0) {
        for (int r = bw; r < DEPTH * IT_WADA; r += nw) { const int l = r / IT_WADA; transpose_item(c.w_ada + (size_t)l * D * 3072, 3072, D, c.WadaT + (size_t)l * 3072 * D, 3072 / 32, r - l * IT_WADA, scr, c.lane, MapPerm()); }
        for (int idx = bt; idx < 256 * D / 4; idx += nthr) { const int n = idx >> 8, k4 = (idx & 255) * 4; f32x4 v = (f32x4){0.f, 0.f, 0.f, 0.f};
            if (n < NBT) { v = *(const f32x4*)((n < NBP ? c.c_prompt + (size_t)n * D : c.c_sample + (size_t)(n - NBP) * D) + k4); v = silu4(v); }
            *((u32x2*)c.scb + idx) = (u32x2){pk2(v.x, v.y), pk2(v.z, v.w)}; }
        return;
    }
    for (int it = bw; it < IT_TOTAL - DEPTH * IT_WADA; it += nw) {
        int r = it;
        if (r < DEPTH * IT_WIN) { const int l = r / IT_WIN; r -= l * IT_WIN; transpose_item(c.w_in + (size_t)l * D * NIN, NIN, D, c.WinT + (size_t)l * NIN * D, NIN / 32, r, scr, c.lane, MapWin()); continue; }
        r -= DEPTH * IT_WIN;
        if (r < DEPTH * 3 * IT_WB) { const int li = r / IT_WB; r -= li * IT_WB; transpose_item(c.w_branch + (size_t)li * W * D, D, W, c.WbT + (size_t)li * D * W, D / 32, r, scr, c.lane, MapPerm()); continue; }
        r -= DEPTH * 3 * IT_WB;
        if (r < DEPTH * IT_WO) { const int l = r / IT_WO; r -= l * IT_WO; transpose_item(c.w_out + (size_t)l * D * D, D, D, c.WoT + (size_t)l * D * D, D / 32, r, scr, c.lane, MapPerm()); continue; }
        r -= DEPTH * IT_WO;
        { const int lg = r / IT_PW; r -= lg * IT_PW; transpose_item(c.pool_w + (size_t)lg * 128 * 128, 128, 128, c.PoolWT + (size_t)lg * 128 * 128, 4, r, scr, c.lane, MapPerm()); }
    }
    for (int idx = bt; idx < DEPTH * 8 * 128 * 128 / 4; idx += nthr) { const int s4 = (idx & 31) * 4, t = (idx >> 5) & 127; const f32x4 v = *((const f32x4*)c.sgu_w + idx);
        *((u32x2*)c.SguW + idx) = (u32x2){pk2(s4 <= t ? v.x : 0.f, s4 + 1 <= t ? v.y : 0.f), pk2(s4 + 2 <= t ? v.z : 0.f, s4 + 3 <= t ? v.w : 0.f)}; }
}
DEV void ph_xa0(const Args& a) {
    LAUNDER_CTX(a);
    const int lane = c.lane, NSW = DEPTH * 30;
    if ((int)gridDim.x <= NSW || (int)blockIdx.x < NSW) { if ((int)gridDim.x > NSW) return; }
    const int w0 = ((int)gridDim.x > NSW) ? ((int)blockIdx.x - NSW) * NWAVES + c.wave : c.gw, nw = ((int)gridDim.x > NSW) ? ((int)gridDim.x - NSW) * NWAVES : c.NGW;
    for (int row = MV + w0; row < MP; row += nw) { u32x2* xo = (u32x2*)(c.xa + (size_t)row * D) + lane;
#pragma unroll
        for (int j = 0; j < 4; ++j) { xo[64 * j] = (u32x2){0u, 0u}; ((u32x2*)(c.xa2 + (size_t)row * D) + lane)[64 * j] = (u32x2){0u, 0u}; }
        if (lane < 16) c.ssq[row * 16 + lane] = 0.f; }
#pragma unroll 2
    for (int row = w0; row < MV; row += nw) {
        u32x2* xo = (u32x2*)(c.xa + (size_t)row * D) + lane;
        const float* xr = row < MPR ? c.x_prompt + (size_t)row * D : c.x_sample + (size_t)(row - MPR) * D;
        const float* ar = c.atab + (size_t)nidx_of(row) * D;
#pragma unroll
        for (int j = 0; j < 4; ++j) {
            const f32x4 v = *((const f32x4*)xr + lane + 64 * j), at = *((const f32x4*)ar + lane + 64 * j);
            const u32x2 pv = (u32x2){pk2(v.x * at.x, v.y * at.y), pk2(v.z * at.z, v.w * at.w)};
            if (row >= MPR) st_sc8(&xo[64 * j], pv); else xo[64 * j] = pv;
            float s = (v.x * v.x + v.y * v.y) + (v.z * v.z + v.w * v.w);
            s += __shfl_xor(s, 1); s += __shfl_xor(s, 2); s += __shfl_xor(s, 4); s += __shfl_xor(s, 32);
            if ((lane & 39) == 0) { if (row >= MPR) __hip_atomic_store(c.ssq + row * 16 + 4 * j + (lane >> 3), s, __ATOMIC_RELAXED, __HIP_MEMORY_SCOPE_AGENT); else c.ssq[row * 16 + 4 * j + (lane >> 3)] = s; }
        }
    }
}
DEV float row_rstd(const float* ssq, int row) {
    const f32x4* p = (const f32x4*)(ssq + (size_t)row * 16); const f32x4 a = p[0], b = p[1], c = p[2], d = p[3];
    const float s = ((a.x + a.y) + (a.z + a.w)) + ((b.x + b.y) + (b.z + b.w)) + ((c.x + c.y) + (c.z + c.w)) + ((d.x + d.y) + (d.z + d.w));
    return __builtin_amdgcn_rsqf(s * (1.f / D) + EPS);
}

DEV void store8(bf16_t* p, f32x4 a, f32x4 b) { u32x4 w; w.x = pk2(a.x, a.y); w.y = pk2(a.z, a.w); w.z = pk2(b.x, b.y); w.w = pk2(b.z, b.w); *(u32x4*)p = w; }

#define LAS __attribute__((address_space(3)))
constexpr int BK = 64, HALF = 128, HTB = HALF * BK * 2, STAGE_BYTES = 8 * HTB;
DEV int lds_byte(int r, int c) { const int st = (r >> 4) * 2 + (c >> 5), rr = r & 15, cc = c & 31, ob = rr * 64 + cc * 2; return st * 1024 + (ob ^ (((ob >> 9) & 1) << 5)); }
DEV void stage_rc(int b, int& R, int& C) { const int st = b / 1024, sb = b % 1024, swz = sb ^ (((sb >> 9) & 1) << 5); R = (st >> 1) * 16 + swz / 64; C = (st & 1) * 32 + (swz % 64) / 2; }
struct UnitD { const char* A; const char* B; int pm, pn, aux; };
constexpr int NXCD = 8;
constexpr int WGM_P1 = 4, WGM_P3 = 4, WGM_P4 = 8;
struct TileOrder {
    int nM, nN, nwg, G, c, pm0;
    DEV void init(int nM_, int nN_, int G_, int c_, int pm0_) { nM = nM_; nN = nN_; nwg = nM * nN; G = G_; c = c_; pm0 = pm0_; }
    template <int WGM> DEV bool tile(int i, int& pm, int& pn) const {
        const int wgid = i * G + c; if (wgid >= nwg) return false;
        const int nig = WGM * nN, gid = wgid / nig, fm = gid * WGM, gsz = (nM - fm) < WGM ? (nM - fm) : WGM;
        pm = pm0 + fm + ((wgid % nig) % gsz); pn = (wgid % nig) / gsz; return true;
    }
};
template <class Epi, class Sched, int NBH = 2>
DEV void gemm_phase(LAS unsigned char* lds, const int lda  , const int ldb  , const int nt  , const Sched& S, const Epi& E) {
    int tid = threadIdx.x; asm volatile("" : "+v"(tid));
    const int wid = __builtin_amdgcn_readfirstlane(tid >> 6), lane = tid & 63, wr = wid >> 2, wc = wid & 3, fr = lane & 15, fq = lane >> 4;
    unsigned voffA[2], voffB[2];
#pragma unroll
    for (int i = 0; i < 2; ++i) { int R, C; stage_rc(tid * 16 + i * 8192, R, C); voffA[i] = (unsigned)(R * lda + C * 2); voffB[i] = (unsigned)(R * ldb + C * 2); }
    const size_t kstep = (size_t)(BK * 2);
    const size_t hstepA = (size_t)HALF * lda, hstepB = (size_t)HALF * ldb;
    const unsigned ldsw = (unsigned)wid * 1024u;
    const int aoff = lds_byte(wr * 64 + fr, fq * 8), boff = lds_byte(wc * 32 + fr, fq * 8);
#define PG8_SA(b, h) (((b) * 2 + (h)) * HTB)
#define PG8_SB(b, h) ((4 + (b) * 2 + (h)) * HTB)
#define PG8_STAGE(bufoff, gbase, voff) do { _Pragma("unroll") for (int _i = 0; _i < 2; ++_i) \
        __builtin_amdgcn_global_load_lds((const unsigned*)((const char*)(gbase) + (voff)[_i]), (LAS unsigned*)(lds + (bufoff) + ldsw + _i * 8192), 16, 0, 0); } while (0)
#define PG8_LDA(dst, b, h) do { _Pragma("unroll") for (int m = 0; m < 4; ++m) _Pragma("unroll") for (int k = 0; k < 2; ++k) dst[m][k] = *(const LAS bf16x8*)(lds + PG8_SA(b, h) + aoff + m * 2048 + k * 1024); } while (0)
#define PG8_LDB(dst, b, h) do { _Pragma("unroll") for (int n = 0; n < 2; ++n) _Pragma("unroll") for (int k = 0; k < 2; ++k) dst[n][k] = *(const LAS bf16x8*)(lds + PG8_SB(b, h) + boff + n * 2048 + k * 1024); } while (0)
#define PG8_MMA(ai, bj, At, Bt) do { __builtin_amdgcn_s_setprio(1); _Pragma("unroll") for (int m = 0; m < 4; ++m) _Pragma("unroll") for (int n = 0; n < 2; ++n) _Pragma("unroll") for (int k = 0; k < 2; ++k) \
        acc[ai][bj][m][n] = __builtin_amdgcn_mfma_f32_16x16x32_bf16(Bt[n][k], At[m][k], acc[ai][bj][m][n], 0, 0, 0); __builtin_amdgcn_s_setprio(0); } while (0)
#define PG8_WAIT_V(n) asm volatile("s_waitcnt vmcnt(" #n ")" ::: "memory")
#define PG8_WAIT_VN() do { if constexpr (NBH == 2) PG8_WAIT_V(8); else PG8_WAIT_V(6); } while (0)
#define PG8_WAIT_L(n) asm volatile("s_waitcnt lgkmcnt(" #n ")" ::: "memory")
#define PG8_BAR __builtin_amdgcn_s_barrier()
#define PG8_SCHED __builtin_amdgcn_sched_barrier(0)
    UnitD cur, nxt; int ui = 0;
    if (!S.next(0, cur)) return;
    f32x4 acc[2][NBH][4][2];
#pragma unroll
    for (int a = 0; a < 2; ++a)
#pragma unroll
        for (int b = 0; b < NBH; ++b)
#pragma unroll
            for (int m = 0; m < 4; ++m)
#pragma unroll
                for (int n = 0; n < 2; ++n) acc[a][b][m][n] = (f32x4){0.f, 0.f, 0.f, 0.f};
    bf16x8 At[4][2], B0[2][2], B1[2][2];
    const char* cA = cur.A; const char* cB = cur.B;
    PG8_STAGE(PG8_SB(0, 0), cB, voffB); if constexpr (NBH == 2) PG8_STAGE(PG8_SB(0, 1), cB + hstepB, voffB); PG8_STAGE(PG8_SA(0, 0), cA, voffA); PG8_STAGE(PG8_SA(0, 1), cA + hstepA, voffA);
    if (wr == 1) PG8_BAR;
    PG8_WAIT_V(2); PG8_BAR;
    PG8_STAGE(PG8_SB(1, 0), cB + kstep, voffB); PG8_STAGE(PG8_SA(1, 0), cA + kstep, voffA); if constexpr (NBH == 2) PG8_STAGE(PG8_SB(1, 1), cB + hstepB + kstep, voffB);
    if constexpr (NBH == 2) PG8_WAIT_V(6); else PG8_WAIT_V(4);
    PG8_BAR;
    for (;;) {
        const bool has_next = S.next(ui + 1, nxt);
        const char* nA = has_next ? nxt.A : cA; const char* nB = has_next ? nxt.B : cB;
        for (int t = 0; t < nt; t += 2) {
            const bool last = (t == nt - 2);
            const char* a1 = cA + (size_t)(t + 1) * kstep;
            const char* a2 = last ? nA : cA + (size_t)(t + 2) * kstep; const char* b2 = last ? nB : cB + (size_t)(t + 2) * kstep;
            const char* a3 = a2 + kstep; const char* b3 = b2 + kstep;
            PG8_LDB(B0, 0, 0); if constexpr (NBH == 2) PG8_LDB(B1, 0, 1); PG8_SCHED; PG8_LDA(At, 0, 0); PG8_STAGE(PG8_SA(1, 1), a1 + hstepA, voffA);
            PG8_WAIT_VN(); PG8_WAIT_L(0); PG8_BAR; PG8_MMA(0, 0, At, B0); if constexpr (NBH == 2) PG8_MMA(0, 1, At, B1); PG8_BAR; PG8_SCHED;
            PG8_LDA(At, 0, 1); PG8_STAGE(PG8_SB(0, 0), b2, voffB); if constexpr (NBH == 2) PG8_STAGE(PG8_SB(0, 1), b2 + hstepB, voffB); PG8_STAGE(PG8_SA(0, 0), a2, voffA);
            PG8_WAIT_VN(); PG8_WAIT_L(0); PG8_BAR; PG8_MMA(1, 0, At, B0); if constexpr (NBH == 2) PG8_MMA(1, 1, At, B1); PG8_BAR; PG8_SCHED;
            PG8_LDB(B0, 1, 0); if constexpr (NBH == 2) PG8_LDB(B1, 1, 1); PG8_SCHED; PG8_LDA(At, 1, 0); PG8_STAGE(PG8_SA(0, 1), a2 + hstepA, voffA);
            PG8_WAIT_VN(); PG8_WAIT_L(0); PG8_BAR; PG8_MMA(0, 0, At, B0); if constexpr (NBH == 2) PG8_MMA(0, 1, At, B1); PG8_BAR; PG8_SCHED;
            PG8_LDA(At, 1, 1); PG8_STAGE(PG8_SB(1, 0), b3, voffB); if constexpr (NBH == 2) PG8_STAGE(PG8_SB(1, 1), b3 + hstepB, voffB); PG8_STAGE(PG8_SA(1, 0), a3, voffA);
            PG8_WAIT_VN(); PG8_WAIT_L(0); PG8_BAR; PG8_MMA(1, 0, At, B0); if constexpr (NBH == 2) PG8_MMA(1, 1, At, B1); PG8_BAR; PG8_SCHED;
        }
        if (wr == 0) PG8_BAR;
        E(acc, cur, nxt, has_next, wr, wc, fr, fq);
        if (!has_next) break;
#pragma unroll
        for (int a = 0; a < 2; ++a)
#pragma unroll
            for (int b = 0; b < NBH; ++b)
#pragma unroll
                for (int m = 0; m < 4; ++m)
#pragma unroll
                    for (int n = 0; n < 2; ++n) acc[a][b][m][n] = (f32x4){0.f, 0.f, 0.f, 0.f};
        cur = nxt; cA = nA; cB = nB; ++ui;
        if (wr == 1) PG8_BAR;
    }
    PG8_WAIT_V(0);
    PG8_BAR;
#undef PG8_SA
#undef PG8_SB
#undef PG8_STAGE
#undef PG8_LDA
#undef PG8_LDB
#undef PG8_MMA
#undef PG8_WAIT_V
#undef PG8_WAIT_L
#undef PG8_WAIT_VN
#undef PG8_BAR
#undef PG8_SCHED
}


struct SchedMod { int G, c; const char* A; const char* B;
    DEV bool next(int i, UnitD& u) const { const int idx = i * G + c; if (idx >= 48) return false; u.pm = 0; u.pn = idx; u.aux = 0; u.A = A; u.B = B + (size_t)idx * 256 * (D * 2); return true; } };
struct EpiMod { float* mod; float* atab; bf16_t* shb; const float* b_ada; const float* norm_g;
    DEV void operator()(int pn, int row, int wc, int fq, f32x4 (&v)[2][2]) const {
#pragma unroll
        for (int bj = 0; bj < 2; ++bj) { const int gc = 256 * pn + 128 * bj + 32 * wc + 8 * fq, l = gc / 3072, j3 = gc - l * 3072;
            const f32x4 v0 = v[bj][0] + *(const f32x4*)(b_ada + gc), v1 = v[bj][1] + *(const f32x4*)(b_ada + gc + 4);
            if (row < NBT) { float* o = mod + ((size_t)l * NBT + row) * 3072 + j3; *(f32x4*)o = v0; *(f32x4*)(o + 4) = v1; }
            if (j3 < D) { const f32x4 z = (f32x4){0.f, 0.f, 0.f, 0.f}; store8(shb + ((size_t)l * 256 + row) * D + j3, row < NBT ? v0 : z, row < NBT ? v1 : z); }
            else if (j3 < 2 * D && row < NBT) { const float* ng = norm_g + l * D + (j3 - D); float* o = atab + ((size_t)l * NBT + row) * D + (j3 - D);
                f32x4 a0 = *(const f32x4*)ng * (v0 + 1.f), a1 = *(const f32x4*)(ng + 4) * (v1 + 1.f);
#pragma unroll
                for (int j = 0; j < 4; ++j) { a0[j] = __builtin_fabsf(a0[j]) < 1e-20f ? 1e-20f : a0[j]; a1[j] = __builtin_fabsf(a1[j]) < 1e-20f ? 1e-20f : a1[j]; }
                *(f32x4*)o = a0; *(f32x4*)(o + 4) = a1; }
        }
    } };
template <int NSEG, int KS  , class RowEpi>
DEV void mini_gemm(const Args& a, LAS unsigned char* lds, int u, const bf16_t* A, int lda, int a_seg, const bf16_t* Bt, int ldb, size_t b_seg, const RowEpi& e) {
    LAUNDER_CTX(a);
    const int lane = c.lane, w = c.wave, fr = lane & 15, fq = lane >> 4, rb = u & 7, pn = u >> 5, wc = (u >> 3) & 3, row = MPR + 16 * rb + fr, kw = 32 * KS;
    bf16x8 af[NSEG][KS], bf[NSEG][KS][4];
#pragma unroll
    for (int s = 0; s < NSEG; ++s) { const bf16_t* ap = A + (size_t)row * lda + s * a_seg + w * kw + 8 * fq; const bf16_t* bp = Bt + s * b_seg + (size_t)(256 * pn + 32 * wc + fr) * ldb + w * kw + 8 * fq;
#pragma unroll
        for (int k = 0; k < KS; ++k) { af[s][k] = *(const bf16x8*)(ap + 32 * k);
#pragma unroll
            for (int q = 0; q < 4; ++q) bf[s][k][q] = *(const bf16x8*)(bp + (size_t)(128 * (q >> 1) + 16 * (q & 1)) * ldb + 32 * k); } }
    f32x4 acc[NSEG][4];
#pragma unroll
    for (int s = 0; s < NSEG; ++s) {
#pragma unroll
        for (int q = 0; q < 4; ++q) acc[s][q] = (f32x4){0.f, 0.f, 0.f, 0.f};
#pragma unroll
        for (int k = 0; k < KS; ++k)
#pragma unroll
            for (int q = 0; q < 4; ++q) acc[s][q] = __builtin_amdgcn_mfma_f32_16x16x32_bf16(bf[s][k][q], af[s][k], acc[s][q], 0, 0, 0);
    }
#pragma unroll
    for (int s = 0; s < NSEG; ++s)
#pragma unroll
        for (int q = 0; q < 4; ++q) *(LAS f32x4*)(lds + (((w * NSEG + s) * 4 + q) * 64 + lane) * 16) = acc[s][q];
    __syncthreads();
    if (w == 0) {
        f32x4 v[NSEG][2][2];
#pragma unroll
        for (int s = 0; s < NSEG; ++s)
#pragma unroll
            for (int q = 0; q < 4; ++q) { f32x4 t = *(const LAS f32x4*)(lds + (((0 * NSEG + s) * 4 + q) * 64 + lane) * 16);
#pragma unroll
                for (int ww = 1; ww < 8; ++ww) t += *(const LAS f32x4*)(lds + (((ww * NSEG + s) * 4 + q) * 64 + lane) * 16);
                v[s][q >> 1][q & 1] = t; }
        e(pn, row, wc, fq, v);
    }
    __syncthreads();
}

constexpr int RTAB_OFF = STAGE_BYTES;
constexpr int SWT_OFF = RTAB_OFF + 8192;
template <int TY, bool SMP> DEV void p1_rows(const f32x4 (&acc)[2][2][4][2], bf16_t* pb  , const LAS float* rt, const float* swb, const int row0, f32x4 s00, f32x4 s01, f32x4 s10, f32x4 s11, float* st = nullptr  ) {
    if (TY == 6 && !SMP) { s00 *= -1.44269504f; s01 *= -1.44269504f; s10 *= -1.44269504f; s11 *= -1.44269504f; }
    f32x4 n00 = s00, n01 = s01, n10 = s10, n11 = s11;
    if (SMP) { const float* sw = swb + (size_t)nidx_of(row0) * NIN; n00 = *(const f32x4*)(sw); n01 = *(const f32x4*)(sw + 4); n10 = *(const f32x4*)(sw + 128); n11 = *(const f32x4*)(sw + 132); }
#pragma unroll
    for (int ai = 0; ai < 2; ++ai) {
#pragma unroll
        for (int m = 0; m < 4; ++m) { const int rl = ai * HALF + m * 16; const float r = (TY == 6 && !SMP) ? rt[rl] * -1.44269504f : rt[rl];
            if (SMP) { s00 = n00; s01 = n01; s10 = n10; s11 = n11;
                if (ai * 4 + m < 7) { const int rn = ((ai * 4 + m + 1) >> 2) * HALF + ((ai * 4 + m + 1) & 3) * 16; const float* sw = swb + (size_t)nidx_of(row0 + rn) * NIN; n00 = *(const f32x4*)(sw); n01 = *(const f32x4*)(sw + 4); n10 = *(const f32x4*)(sw + 128); n11 = *(const f32x4*)(sw + 132); } }
            f32x4 a0 = acc[ai][0][m][0] * r + s00, a1 = acc[ai][0][m][1] * r + s01, b0 = acc[ai][1][m][0] * r + s10, b1 = acc[ai][1][m][1] * r + s11;
            bf16_t* pr = pb + (size_t)rl * PC;
            if (TY == 0) { store8(pr, a0 * b0, a1 * b1); }
            else if (TY == 1) { store8(pr, a0 * silu4(b0), a1 * silu4(b1)); }
            else if (TY == 2) { store8(pr, gelu4(a0) * silu4(b0), gelu4(a1) * silu4(b1)); }
            else {
                if (TY == 3) { a0 = gelu4(a0); a1 = gelu4(a1); b0 = gelu4(b0); b1 = gelu4(b1); }
                if (TY == 3) {
                    const f32x4 sv = (a0 + a1) + (b0 + b1), qv = (a0 * a0 + a1 * a1) + (b0 * b0 + b1 * b1);
                    float s = (sv.x + sv.y) + (sv.z + sv.w), q = (qv.x + qv.y) + (qv.z + qv.w);
                    s += __shfl_xor(s, 16); q += __shfl_xor(q, 16); s += __shfl_xor(s, 32); q += __shfl_xor(q, 32);
                    if (st) *(f32x2_t*)(st + (size_t)rl * 16) = (f32x2_t){s, q}; }
                if (TY == 5) { a0 = silu4(a0); a1 = silu4(a1); b0 = silu4(b0); b1 = silu4(b1); }
                if (TY == 6 && SMP) { a0 = sigmoid4(a0); a1 = sigmoid4(a1); b0 = sigmoid4(b0); b1 = sigmoid4(b1); }
                if (TY == 6) { unsigned char* gq = (unsigned char*)pr; if (SMP) { *(u32x2*)gq = (u32x2){pku8(a0), pku8(a1)}; *(u32x2*)(gq + 128) = (u32x2){pku8(b0), pku8(b1)}; } else { *(u32x2*)gq = (u32x2){pku8_t(a0), pku8_t(a1)}; *(u32x2*)(gq + 128) = (u32x2){pku8_t(b0), pku8_t(b1)}; } }
                else { store8(pr, a0, a1); store8(pr + 128, b0, b1); } }
        }
        if (!SMP) asm volatile("" ::: "memory");
    }
}
struct EpiP1T { bf16_t* pbuf; const float* SWl; const LAS float* rtab; const LAS float* swt; float* lnst;
    DEV void operator()(f32x4 (&acc)[2][2][4][2], const UnitD& u, const UnitD& un, const bool has_next, int wr, int wc, int fr, int fq) const {
        const int pn = u.pn, cb = 32 * wc + 8 * fq, row0 = u.pm * 256 + wr * 64 + fr; const bool smp = u.pm >= MPR / 256;
        const float* swb = SWl + 256 * pn + cb; const LAS float* sw = swt + u.aux * 256 + cb;
        const f32x4 s00 = *(const LAS f32x4*)(sw), s01 = *(const LAS f32x4*)(sw + 4), s10 = *(const LAS f32x4*)(sw + 128), s11 = *(const LAS f32x4*)(sw + 132);
        const LAS float* rt = rtab + u.aux * 256 + wr * 64 + fr;
        bf16_t* pb = pbuf + (size_t)row0 * PC + cb;
#define P1_DISPATCH(SM) \
        if (pn < 4) p1_rows<0, SM>(acc, pb + PZ + 128 * pn, rt, swb, row0, s00, s01, s10, s11); \
        else if (pn < 8) p1_rows<1, SM>(acc, pb + PABG + 128 * (pn - 4), rt, swb, row0, s00, s01, s10, s11); \
        else if (pn < 12) p1_rows<2, SM>(acc, pb + PUG + 128 * (pn - 8), rt, swb, row0, s00, s01, s10, s11); \
        else if (pn < 14) p1_rows<3, SM>(acc, pb + PGV + 256 * (pn - 12), rt, swb, row0, s00, s01, s10, s11, fq == 0 ? lnst + (size_t)row0 * 16 + 2 * (4 * (pn - 12) + wc) : nullptr); \
        else if (pn < 16) p1_rows<4, SM>(acc, pb + PCX + 256 * (pn - 14), rt, swb, row0, s00, s01, s10, s11); \
        else if (pn < 18) p1_rows<5, SM>(acc, pb + PSG + 256 * (pn - 16), rt, swb, row0, s00, s01, s10, s11); \
        else p1_rows<6, SM>(acc, (bf16_t*)((unsigned char*)(pb - cb + PGATE) + 256 * (pn - 18) + cb), rt, swb, row0, s00, s01, s10, s11);
        P1_DISPATCH(false)
#undef P1_DISPATCH
    } };
struct EpiP1S { bf16_t* pbuf; const float* SWl; const float* ssq;
    DEV void operator()(int pn, int row, int wc, int fq, f32x4 (&v)[1][2][2]) const {
        const int cb = 32 * wc + 8 * fq; const float r = row_rstd_sc(ssq, row);
        const float* sw = SWl + (size_t)nidx_of(row) * NIN + 256 * pn + cb;
        const f32x4 a0 = v[0][0][0] * r + *(const f32x4*)(sw), a1 = v[0][0][1] * r + *(const f32x4*)(sw + 4), b0 = v[0][1][0] * r + *(const f32x4*)(sw + 128), b1 = v[0][1][1] * r + *(const f32x4*)(sw + 132);
        bf16_t* pr = pbuf + (size_t)row * PC + cb;
        if (pn < 4) store8_sc(pr + PZ + 128 * pn, a0 * b0, a1 * b1);
        else if (pn < 8) store8_sc(pr + PABG + 128 * (pn - 4), a0 * silu4(b0), a1 * silu4(b1));
        else if (pn < 12) store8_sc(pr + PUG + 128 * (pn - 8), gelu4(a0) * silu4(b0), gelu4(a1) * silu4(b1));
        else if (pn < 14) { bf16_t* o = pr + PGV + 256 * (pn - 12); store8_sc(o, gelu4(a0), gelu4(a1)); store8_sc(o + 128, gelu4(b0), gelu4(b1)); }
        else if (pn < 16) { bf16_t* o = pr + PCX + 256 * (pn - 14); store8_sc(o, a0, a1); store8_sc(o + 128, b0, b1); }
        else if (pn < 18) { bf16_t* o = pr + PSG + 256 * (pn - 16); store8_sc(o, silu4(a0), silu4(a1)); store8_sc(o + 128, silu4(b0), silu4(b1)); }
        else { unsigned char* gq = (unsigned char*)(pbuf + (size_t)row * PC + PGATE) + 256 * (pn - 18) + cb;
            st_sc8(gq, (u32x2){pku8(sigmoid4(a0)), pku8(sigmoid4(a1))}); st_sc8(gq + 128, (u32x2){pku8(sigmoid4(b0)), pku8(sigmoid4(b1))}); }
    } };
DEV void p1_sample_slice(const int tid, const int slice  , const bf16_t* xa, const bf16_t* Wl, const EpiP1S& e, LAS unsigned char* lds) {
    const int lane = tid & 63, w = __builtin_amdgcn_readfirstlane(tid >> 6), fr = lane & 15, fq = lane >> 4, pn = slice >> 2, wc = slice & 3, row = MPR + 16 * w + fr;
    const bf16_t* ap = xa + (size_t)row * D + 8 * fq; const bf16_t* bp = Wl + (size_t)(256 * pn + 32 * wc + fr) * D + 8 * fq;
    __syncthreads();
#pragma unroll
    for (int j = 0; j < 16; ++j) { const int b = w * 16 + j, q = b >> 5, ks = b & 31;
        __builtin_amdgcn_global_load_lds((const unsigned*)(bp + (size_t)(128 * (q >> 1) + 16 * (q & 1)) * D + 32 * ks), (LAS unsigned*)(lds + b * 1024), 16, 0, 0); }
    bf16x8 af[32];
#pragma unroll
    for (int ks = 0; ks < 32; ++ks) af[ks] = __builtin_bit_cast(bf16x8, ld_sc16(ap + 32 * ks));
    f32x4 v[1][2][2];
#pragma unroll
    for (int q = 0; q < 4; ++q) v[0][q >> 1][q & 1] = (f32x4){0.f, 0.f, 0.f, 0.f};
    asm volatile("s_waitcnt vmcnt(0)" ::: "memory");
    __syncthreads();
#pragma unroll
    for (int ks = 0; ks < 32; ++ks)
#pragma unroll
        for (int q = 0; q < 4; ++q) { const bf16x8 bfr = *(const LAS bf16x8*)(lds + (q * 32 + ks) * 1024 + lane * 16);
            v[0][q >> 1][q & 1] = __builtin_amdgcn_mfma_f32_16x16x32_bf16(bfr, af[ks], v[0][q >> 1][q & 1], 0, 0, 0); }
    e(pn, row, wc, fq, v);
}
template <class Sched> DEV void p1_rtab(const Sched& S, const float* ssq, const float* SWl, LAS float* rtab, LAS float* swt) {
    int t = threadIdx.x; asm volatile("" : "+v"(t));
#pragma unroll
    for (int k = 0; k < 4; ++k) { const int q = t + 512 * k, i = q >> 8, rl = q & 255; UnitD u;
        if (S.next(i, u)) { rtab[q] = row_rstd(ssq, u.pm * 256 + rl); swt[q] = SWl[(size_t)(u.pm < MPR / 256 ? (u.pm >> 3) : NBP) * NIN + 256 * u.pn + rl]; } }
    __syncthreads();
}
template <bool IN16, bool LAST> struct EpiP4T { const float* gate; const float* atab_cur; const float* atab_next; const bf16_t* xa; bf16_t* xao; float* ssq; const float* xin; bf16_t* xb;
    DEV void operator()(f32x4 (&acc)[2][2][4][2], const UnitD& u, const UnitD& un, const bool has_next, int wr, int wc, int fr, int fq) const {
        const int pn = u.pn, nb = u.pm >> 3, col = 256 * pn + 32 * wc + 8 * fq, row0 = u.pm * 256 + wr * 64 + fr;
        const float* gp = gate + (size_t)nb * 3072 + col;
        f32x4 g[2][2], at[2][2], iv[2][2];
#pragma unroll
        for (int bj = 0; bj < 2; ++bj)
#pragma unroll
            for (int n = 0; n < 2; ++n) { g[bj][n] = *(const f32x4*)(gp + 128 * bj + 4 * n);
                at[bj][n] = LAST ? (f32x4){0.f, 0.f, 0.f, 0.f} : *(const f32x4*)(atab_next + (size_t)nb * D + col + 128 * bj + 4 * n);
                iv[bj][n] = IN16 ? rcp4(*(const f32x4*)(atab_cur + (size_t)nb * D + col + 128 * bj + 4 * n)) : (f32x4){0.f, 0.f, 0.f, 0.f}; }
        const size_t off0 = (size_t)row0 * D + col;
        f32x4 x[2][2], xn[2][2]; u32x4 xh[2], xhn[2];
#pragma unroll
        for (int bj = 0; bj < 2; ++bj) { if (IN16) xh[bj] = *(const u32x4*)(xa + off0 + 128 * bj); else { x[bj][0] = *(const f32x4*)(xin + off0 + 128 * bj); x[bj][1] = *(const f32x4*)(xin + off0 + 128 * bj + 4); } }
#pragma unroll
        for (int r = 0; r < 8; ++r) { const int ai = r >> 2, m = r & 3, rl = ai * HALF + m * 16, row = row0 + rl; float s = 0.f;
            if (r < 7) { const size_t offn = off0 + (size_t)(((r + 1) >> 2) * HALF + ((r + 1) & 3) * 16) * D;
#pragma unroll
                for (int bj = 0; bj < 2; ++bj) { if (IN16) xhn[bj] = *(const u32x4*)(xa + offn + 128 * bj); else { xn[bj][0] = *(const f32x4*)(xin + offn + 128 * bj); xn[bj][1] = *(const f32x4*)(xin + offn + 128 * bj + 4); } } }
            const size_t off = off0 + (size_t)rl * D;
#pragma unroll
            for (int bj = 0; bj < 2; ++bj) {
                if (IN16) { unpk8(xh[bj], x[bj][0], x[bj][1]); x[bj][0] *= iv[bj][0]; x[bj][1] *= iv[bj][1]; }
#pragma unroll
                for (int n = 0; n < 2; ++n) { const f32x4 t = x[bj][n] + g[bj][n] * acc[ai][bj][m][n]; x[bj][n] = t; s += (t.x * t.x + t.y * t.y) + (t.z * t.z + t.w * t.w); }
                if (LAST) store8(xb + off + 128 * bj, x[bj][0], x[bj][1]);
                else store8(xao + off + 128 * bj, x[bj][0] * at[bj][0], x[bj][1] * at[bj][1]); }
            s += __shfl_xor(s, 16); s += __shfl_xor(s, 32);
            if (fq == 0) ssq[row * 16 + 4 * pn + wc] = s;
#pragma unroll
            for (int bj = 0; bj < 2; ++bj) { xh[bj] = xhn[bj]; x[bj][0] = xn[bj][0]; x[bj][1] = xn[bj][1]; }
        }
    } };

struct SchedP3R { TileOrder T; const char* A; const char* B;
    DEV bool next(int i, UnitD& u) const { int pm, pc; const int seg = i % 3; if (!T.tile<WGM_P3>(i / 3, pm, pc)) return false; u.pm = pm; u.pn = pc; u.aux = seg;
        u.A = A + (size_t)pm * 256 * (1536 * 2) + (size_t)seg * (W * 2); u.B = B + (size_t)seg * D * (W * 2) + (size_t)pc * 128 * (W * 2); return true; } };
struct EpiP3R { f32x4 (&tot)[2][4][2]; u32x2 (&gpre)[8]; const bf16_t* pbuf; bf16_t* mg;
    DEV void prefetch(const UnitD& u, int wr, int wc, int fr, int fq) const {
        const unsigned char* gp = (const unsigned char*)(pbuf + (size_t)(u.pm * 256 + wr * 64 + fr) * PC + PGATE) + 1024 * u.aux + 128 * u.pn + 32 * wc + 8 * fq;
#pragma unroll
        for (int r = 0; r < 8; ++r) gpre[r] = *(const u32x2*)(gp + (size_t)((r >> 2) * HALF + (r & 3) * 16) * (PC * 2));
    }
    DEV void operator()(f32x4 (&acc)[2][1][4][2], const UnitD& u, const UnitD& un, const bool has_next, int wr, int wc, int fr, int fq) const {
        const int seg = u.aux, cb = 128 * u.pn + 32 * wc + 8 * fq, row0 = u.pm * 256 + wr * 64 + fr;
        bf16_t* o = mg + (size_t)row0 * D + cb;
        u32x2 g[8];
#pragma unroll
        for (int r = 0; r < 8; ++r) g[r] = gpre[r];
        if (has_next) prefetch(un, wr, wc, fr, fq);
        const float keep = seg ? 1.f : 0.f;
#pragma unroll
        for (int r = 0; r < 8; ++r) { const int ai = r >> 2, m = r & 3; const f32x4 g0 = gate4(g[r].x), g1 = gate4(g[r].y);
            const f32x4 t0 = acc[ai][0][m][0] * g0 + tot[ai][m][0] * keep, t1 = acc[ai][0][m][1] * g1 + tot[ai][m][1] * keep;
            tot[ai][m][0] = t0; tot[ai][m][1] = t1;
            if (seg == 2) store8(o + (size_t)(ai * HALF + m * 16) * D, t0, t1); }
    } };
#define XB_TMO      128
#define XB_XCNT(j)  (256  + 64 * (j))
#define XB_XSUB(j)  (1280 + 64 * (j))
#define XB_XGEN(j)  (2304 + 64 * (j))
#define XB_TOP      3328
#define XB_TOPGEN   3392
#define XCD_BAR_WORDS 3456
#define XB_LSUB(j)  (3456 + 64 * (j))
#define XB_LGEN(j)  (3968 + 64 * (j))
#define XB_CNT_P4S  4480
#define XB_CNT_P3S(j) (4608 + 64 * (j))
#define XB_CNT_P1S  4544
#define XB_SPIN_CAP (1u << 18)
DEV unsigned xb_ld(unsigned* p)              { return __hip_atomic_load(p, __ATOMIC_RELAXED, __HIP_MEMORY_SCOPE_AGENT); }
DEV unsigned xb_add(unsigned* p, unsigned v) { return __hip_atomic_fetch_add(p, v, __ATOMIC_RELAXED, __HIP_MEMORY_SCOPE_AGENT); }
DEV unsigned xb_xcc_id() { return (unsigned)__builtin_amdgcn_s_getreg((3 << 11) | 20) & 0xFu; }
#define XB_SPIN(cond, bar) do { unsigned _sp = 0; while (cond) { __builtin_amdgcn_s_sleep(1); \
    if ((++_sp & 255u) == 0u) { if (xb_ld(&(bar)[XB_TMO])) break; if (_sp > XB_SPIN_CAP) { atomicAdd(&(bar)[XB_TMO], 1u); break; } } } } while (0)
struct XcdBarrier { unsigned* bar; unsigned x; volatile LAS unsigned* st; };
DEV XcdBarrier xcd_barrier_post(unsigned* bar, volatile LAS unsigned* st) {
    XcdBarrier b; b.bar = bar; b.x = xb_xcc_id(); b.st = st;
    if (threadIdx.x == 0) st[4] = xb_add(&bar[XB_XCNT(b.x)], 1u);
    return b;
}
DEV void xcd_barrier_complete(unsigned* bar, unsigned x, unsigned& nloc, unsigned& nx, unsigned& even) {
    const unsigned G = gridDim.x * gridDim.y * gridDim.z;
    unsigned sum, cnt, mine, n32, sp = 0u;
    for (;;) {
        sum = 0u; cnt = 0u; mine = 0u; n32 = 0u;
#pragma unroll
        for (unsigned j = 0; j < 16; ++j) { const unsigned c = xb_ld(&bar[XB_XCNT(j)]); sum += c; cnt += (c > 0u) ? 1u : 0u; n32 += (j < 8u && c == 32u) ? 1u : 0u; mine = (j == x) ? c : mine; }
        if (sum == G) break;
        __builtin_amdgcn_s_sleep(1);
        if ((++sp & 255u) == 0u) { if (xb_ld(&bar[XB_TMO])) break; if (sp > XB_SPIN_CAP) { atomicAdd(&bar[XB_TMO], 1u); break; } }
    }
    nloc = mine > 0u ? mine : 1u; nx = cnt > 0u ? cnt : 1u;
    even = (sum == G && G == 256u && n32 == 8u) ? 1u : 0u;
}
DEV void xcd_barrier(const XcdBarrier& b) {
    asm volatile("s_waitcnt vmcnt(0)" ::: "memory");
    __syncthreads();
    if (threadIdx.x == 0) {
        unsigned* bar = b.bar; unsigned bx = b.x; asm volatile("" : "+s"(bar), "+s"(bx));
        __builtin_amdgcn_s_waitcnt(0);
        unsigned nloc = b.st[0], nx = b.st[1];
        if (nloc == 0u) { unsigned even; xcd_barrier_complete(bar, bx, nloc, nx, even); b.st[0] = nloc; b.st[1] = nx;
            b.st[2] = even ? bx * 32u + b.st[4] : (unsigned)blockIdx.x;
            b.st[3] = even; }
        const unsigned old = xb_add(&bar[XB_XSUB(bx)], 1u);
        const unsigned gen = old / nloc;
        if (old + 1u == (gen + 1u) * nloc) {
            __builtin_amdgcn_fence(__ATOMIC_RELEASE, "agent");
            asm volatile("s_waitcnt vmcnt(0)" ::: "memory");
            const unsigned og = xb_add(&bar[XB_TOP], 1u);
            const unsigned tg = og / nx;
            if (og + 1u == (tg + 1u) * nx) xb_add(&bar[XB_TOPGEN], 1u);
            else XB_SPIN(xb_ld(&bar[XB_TOPGEN]) == tg, bar);
            __builtin_amdgcn_fence(__ATOMIC_ACQUIRE, "agent");
            xb_add(&bar[XB_XGEN(bx)], 1u);
            asm volatile("s_waitcnt vmcnt(0)" ::: "memory");
        } else {
            XB_SPIN(xb_ld(&bar[XB_XGEN(bx)]) == gen, bar);
            __builtin_amdgcn_fence(__ATOMIC_ACQUIRE, "agent");
            asm volatile("s_waitcnt vmcnt(0)" ::: "memory");
        }
    }
    __syncthreads();
}
DEV void xcd_local_barrier(const XcdBarrier& b) {
    asm volatile("s_waitcnt vmcnt(0)" ::: "memory");
    __syncthreads();
    if (threadIdx.x == 0) {
        unsigned* bar = b.bar; unsigned bx = b.x; asm volatile("" : "+s"(bar), "+s"(bx));
        __builtin_amdgcn_s_waitcnt(0);
        const unsigned old = xb_add(&bar[XB_LSUB(bx)], 1u);
        const unsigned gen = old >> 5;
        if ((old & 31u) == 31u) xb_add(&bar[XB_LGEN(bx)], 1u);
        else XB_SPIN(xb_ld(&bar[XB_LGEN(bx)]) == gen, bar);
        __builtin_amdgcn_fence(__ATOMIC_ACQUIRE, "agent");
        asm volatile("s_waitcnt vmcnt(0)" ::: "memory");
    }
    __syncthreads();
}
constexpr bool LOCAL_BAR = true;
DEV void layer_barrier(const XcdBarrier& b) { if (LOCAL_BAR && b.st[3]) xcd_local_barrier(b); else xcd_barrier(b); }
template <class RowEpi> struct EpiRows { RowEpi e;
    DEV void operator()(f32x4 (&acc)[2][2][4][2], const UnitD& u, const UnitD& un, const bool has_next, int wr, int wc, int fr, int fq) const {
#pragma unroll
        for (int ai = 0; ai < 2; ++ai)
#pragma unroll
            for (int m = 0; m < 4; ++m) { f32x4 v[2][2] = {{acc[ai][0][m][0], acc[ai][0][m][1]}, {acc[ai][1][m][0], acc[ai][1][m][1]}};
                e(u.pn, u.pm * 256 + ai * HALF + wr * 64 + m * 16 + fr, wc, fq, v); asm volatile("" ::: "memory"); }
    } };
struct SchedP1 { TileOrder T; const char* A; const char* B;
    DEV bool next(int i, UnitD& u) const { int pm, pn; if (!T.tile<WGM_P1>(i, pm, pn)) return false; pn += (T.pm0 >> 3) * 4; pn -= pn >= 30 ? 30 : 0;   u.pm = pm; u.pn = pn; u.aux = i; u.A = A + (size_t)pm * 256 * (D * 2); u.B = B + (size_t)pn * 256 * (D * 2); return true; } };

struct SchedP4 { TileOrder T; const char* A; const char* B;
    DEV bool next(int i, UnitD& u) const { int pm, pn; if (!T.tile<WGM_P4>(i, pm, pn)) return false; u.pm = pm; u.pn = pn; u.aux = 0; u.A = A + (size_t)pm * 256 * (D * 2); u.B = B + (size_t)pn * 256 * (D * 2); return true; } };
struct EpiP3 { const bf16_t* pbuf; bf16_t* mg;
    DEV void operator()(int pn, int row, int wc, int fq, f32x4 (&v)[3][2][2]) const {
        const int cb = 256 * pn + 32 * wc + 8 * fq;
        const unsigned char* gp = (const unsigned char*)(pbuf + (size_t)row * PC + PGATE) + cb; bf16_t* o = mg + (size_t)row * D + cb;
        u32x2 g[3][2];
#pragma unroll
        for (int s = 0; s < 3; ++s) { g[s][0] = ld_sc8(gp + 1024 * s); g[s][1] = ld_sc8(gp + 1024 * s + 128); }
#pragma unroll
        for (int bj = 0; bj < 2; ++bj) { f32x4 t0 = v[0][bj][0] * gate4(g[0][bj].x), t1 = v[0][bj][1] * gate4(g[0][bj].y);
#pragma unroll
            for (int s = 1; s < 3; ++s) { t0 += v[s][bj][0] * gate4(g[s][bj].x); t1 += v[s][bj][1] * gate4(g[s][bj].y); }
            store8(o + 128 * bj, t0, t1); }
    } };
struct SchedSW { int G, c; const char* A; const char* B;
    DEV bool next(int i, UnitD& u) const { const int idx = i * G + c; if (idx >= DEPTH * 30) return false; const int l = idx / 30, pn = idx % 30; u.pm = 0; u.pn = pn + 32 * l; u.aux = l;
        u.A = A + (size_t)l * 256 * (D * 2); u.B = B + (size_t)l * NIN * (D * 2) + (size_t)pn * 256 * (D * 2); return true; } };
struct EpiSWx { float* SW;
    DEV void operator()(int pnx, int row, int wc, int fq, f32x4 (&v)[2][2]) const {
        if (row >= NBT) return;
        const int l = pnx >> 5, pn = pnx & 31;
        float* o = SW + (size_t)l * NBT * NIN + (size_t)row * NIN + 256 * pn + 32 * wc + 8 * fq;
        *(f32x4*)(o) = v[0][0]; *(f32x4*)(o + 4) = v[0][1]; *(f32x4*)(o + 128) = v[1][0]; *(f32x4*)(o + 132) = v[1][1];
    } };
struct EpiP4 { const float* gate  ; const float* atab_cur; const float* atab_next  ; const bf16_t* xa; bf16_t* xao; float* ssq; const float* xin  ; bf16_t* xb; int in16;
    DEV void operator()(int pn, int row, int wc, int fq, f32x4 (&vv)[1][2][2]) const {
        f32x4 (&v)[2][2] = vv[0];
        const int nb = nidx_of(row), col = 256 * pn + 32 * wc + 8 * fq;
        const float* gp = gate + (size_t)nb * 3072 + col;
        float s = 0.f;
#pragma unroll
        for (int bj = 0; bj < 2; ++bj) {
            f32x4 x0, x1;
            if (in16) { unpk8(*(const u32x4*)(xa + (size_t)row * D + col + 128 * bj), x0, x1); const float* ac = atab_cur + (size_t)nb * D + col + 128 * bj; x0 *= rcp4(*(const f32x4*)ac); x1 *= rcp4(*(const f32x4*)(ac + 4)); }
            else { x0 = *(const f32x4*)(xin + (size_t)row * D + col + 128 * bj); x1 = *(const f32x4*)(xin + (size_t)row * D + col + 128 * bj + 4); }
            const f32x4 t0 = x0 + *(const f32x4*)(gp + 128 * bj) * v[bj][0], t1 = x1 + *(const f32x4*)(gp + 128 * bj + 4) * v[bj][1];
            s += ((t0.x * t0.x + t0.y * t0.y) + (t0.z * t0.z + t0.w * t0.w)) + ((t1.x * t1.x + t1.y * t1.y) + (t1.z * t1.z + t1.w * t1.w));
            if (atab_next) { const float* ap = atab_next + (size_t)nb * D + col + 128 * bj; store8_sc(xao + (size_t)row * D + col + 128 * bj, t0 * *(const f32x4*)ap, t1 * *(const f32x4*)(ap + 4)); }
            else store8(xb + (size_t)row * D + col + 128 * bj, t0, t1);
        }
        s += __shfl_xor(s, 16); s += __shfl_xor(s, 32);
        if (fq == 0) __hip_atomic_store(ssq + row * 16 + 4 * pn + wc, s, __ATOMIC_RELAXED, __HIP_MEMORY_SCOPE_AGENT);
    } };


typedef short v4i16 __attribute__((ext_vector_type(4)));
constexpr int TP = 528, VT_OFF = 0, PM_OFF = 128 * TP;
DEV f32x4 unpk4(u32x2 r) { return (f32x4){bflo(r.x), bfhi(r.x), bflo(r.y), bfhi(r.y)}; }
DEV void p2_ln(const Ctx& c, int l, int ck, int hh, const bf16_t* pb, LAS unsigned char* lds) {
    int lane_ = c.lane; asm volatile("" : "+v"(lane_));
    const int lane = lane_, w = c.wave, p = lane >> 5, ch = 256 * hh + 8 * (lane & 31); const bool lastck = (ck & 15) == 15;
    const float* st = c.lnst + ((size_t)ck * 128 + 16 * w + (lane & 15)) * 16;
    const f32x4 t0 = *(const f32x4*)st, t1 = *(const f32x4*)(st + 4), t2 = *(const f32x4*)(st + 8), t3 = *(const f32x4*)(st + 12);
    u32x4 gv[8];
#pragma unroll
    for (int k = 0; k < 8; ++k) gv[k] = *(const u32x4*)(pb + (size_t)(16 * w + 2 * k + p) * PC + PGV + ch);
    const f32x4 g0 = *(const f32x4*)(c.lnv_g + l * W + ch), g1 = *(const f32x4*)(c.lnv_g + l * W + ch + 4), b0 = *(const f32x4*)(c.lnv_b + l * W + ch), b1 = *(const f32x4*)(c.lnv_b + l * W + ch + 4);
    const float s = ((t0.x + t0.z) + (t1.x + t1.z)) + ((t2.x + t2.z) + (t3.x + t3.z)), q = ((t0.y + t0.w) + (t1.y + t1.w)) + ((t2.y + t2.w) + (t3.y + t3.w));
    const float mu_l = s * (1.f / W), rstd_l = __builtin_amdgcn_rsqf(fmaxf(q * (1.f / W) - mu_l * mu_l, 0.f) + EPS);
    float* vout = c.out + O_VP + ((size_t)(l * NBP + (ck >> 4)) * 128) * W + ch;
#pragma unroll
    for (int k = 0; k < 8; ++k) { const int t = 16 * w + 2 * k + p;
        const float mu = __shfl(mu_l, 2 * k + p), rstd = __shfl(rstd_l, 2 * k + p);
        f32x4 x0 = (f32x4){bflo(gv[k].x), bfhi(gv[k].x), bflo(gv[k].y), bfhi(gv[k].y)}, x1 = (f32x4){bflo(gv[k].z), bfhi(gv[k].z), bflo(gv[k].w), bfhi(gv[k].w)};
        x0 = (x0 - mu) * rstd * g0 + b0; x1 = (x1 - mu) * rstd * g1 + b1;
        u32x4 o; o.x = pk2(x0.x, x0.y); o.y = pk2(x0.z, x0.w); o.z = pk2(x1.x, x1.y); o.w = pk2(x1.z, x1.w);
        *(LAS u32x4*)(lds + VT_OFF + t * TP + (lane & 31) * 16) = o;
        if (lastck) { *(f32x4*)(vout + (size_t)t * W) = x0; *(f32x4*)(vout + (size_t)t * W + 4) = x1; }
    }
}
template <int HH> DEV void p2_pool(const Ctx& c, int l, int ck, const bf16_t* pb, LAS unsigned char* lds) {
    constexpr int W0 = 2 << (2 * HH), W1 = 2 * W0, H = W1 - 1, NX = H + 16;
    int lane_ = c.lane; asm volatile("" : "+v"(lane_));
    const int lane = lane_, w = c.wave, gi = lane >> 5, cpos = (ck & 15) * 128, ch = 256 * HH + 4 * lane; const bool lastck = (ck & 15) == 15;
    f32x4 x[NX];
#pragma unroll
    for (int k = 0; k < NX; ++k) { const int tt = 16 * w - H + k; const bool valid = cpos + tt >= 0; const int tc = valid ? tt : 0;
        const u32x2 r = *(const u32x2*)(pb + (ptrdiff_t)tc * PC + PCX + ch); const f32x4 v = unpk4(r); x[k] = valid ? v : (f32x4){0.f, 0.f, 0.f, 0.f}; }
    f32x4 slo = x[H];
#pragma unroll
    for (int j = 1; j < W0; ++j) slo += x[H - j];
    f32x4 shi = slo;
#pragma unroll
    for (int j = W0; j < W1; ++j) shi += x[H - j];
    float* pout = c.out + O_POOLP + ((size_t)(l * NBP + (ck >> 4)) * 15) * W + ch;
#pragma unroll
    for (int i = 0; i < 16; ++i) { const int t = 16 * w + i, pos = cpos + t, wd = gi ? W1 : W0;
        const f32x4 s = gi ? shi : slo; const float inv = __builtin_amdgcn_rcpf((float)(wd < pos + 1 ? wd : pos + 1));
        const f32x4 pm = s * inv - x[H + i];
        *(LAS u32x2*)(lds + PM_OFF + t * TP + 8 * lane) = (u32x2){pk2(pm.x, pm.y), pk2(pm.z, pm.w)};
        if (lastck && t >= 113) *(f32x4*)(pout + (size_t)(t - 113) * W) = x[H + i];
        if (i < 15) { slo += x[H + i + 1] - x[H + i + 1 - W0]; shi += x[H + i + 1] - x[H + i + 1 - W1]; }
    }
}
DEV void p2_conv(const Ctx& c, int l, int ck, int hh, const bf16_t* pb) {
    int lane_ = c.lane; asm volatile("" : "+v"(lane_));
    const int lane = lane_, w = c.wave, cpos = (ck & 15) * 128, ch = 256 * hh + 4 * lane, row0 = ck * 128; const bool lastck = (ck & 15) == 15;
    const f32x4 cb = *(const f32x4*)(c.conv_b + l * W + ch), w0 = *(const f32x4*)(c.conv_w + (l * 3 + 0) * W + ch), w1 = *(const f32x4*)(c.conv_w + (l * 3 + 1) * W + ch), w2 = *(const f32x4*)(c.conv_w + (l * 3 + 2) * W + ch);
    f32x4 z[18];
#pragma unroll
    for (int k = 0; k < 18; ++k) { const int tt = 16 * w - 2 + k; const bool valid = cpos + tt >= 0; const int tc = valid ? tt : 0;
        const f32x4 v = unpk4(*(const u32x2*)(pb + (ptrdiff_t)tc * PC + PZ + ch)); z[k] = valid ? v : (f32x4){0.f, 0.f, 0.f, 0.f}; }
    float* cout = c.out + O_CONVP + ((size_t)(l * NBP + (ck >> 4)) * 2) * W + ch;
#pragma unroll
    for (int i = 0; i < 16; ++i) { const int t = 16 * w + i;
        const f32x4 abg = unpk4(*(const u32x2*)(pb + (size_t)t * PC + PABG + ch));
        const f32x4 o = abg * (cb + w0 * z[i] + w1 * z[i + 1] + w2 * z[i + 2]);
        *(u32x2*)(c.y + (size_t)(row0 + t) * 1536 + ch) = (u32x2){pk2(o.x, o.y), pk2(o.z, o.w)};
        if (lastck && t >= 126) *(f32x4*)(cout + (size_t)(t - 126) * W) = z[i + 2];
    }
}
constexpr int TPS = 1040;
DEV void p2_sample_block(const Ctx& c, int l, int sb, LAS unsigned char* ldsw) {
    const int lane = c.lane, fr = lane & 15, fq = lane >> 4, ch = 8 * lane, h = lane >> 3, g = lane >> 4;
    {
        const int i = c.wave, n = 8 * sb + i, row = MPR + n; const bf16_t* pr = c.pbuf + (size_t)row * PC; bf16_t* yr = c.y + (size_t)row * 1536;
        const float* sc = c.state_conv + ((size_t)(l * NSM + n) * 2) * W + ch; const float* sp = c.state_pool + ((size_t)(l * NSM + n) * 15) * W + ch;
        const u32x4 qz = ld_sc16(pr + PZ + ch), qa = ld_sc16(pr + PABG + ch), qg = ld_sc16(pr + PGV + ch), qu = ld_sc16(pr + PUG + ch), qc = ld_sc16(pr + PCX + ch);
        const f32x4 s00 = *(const f32x4*)(sc), s01 = *(const f32x4*)(sc + 4), s10 = *(const f32x4*)(sc + W), s11 = *(const f32x4*)(sc + W + 4);
        f32x4 st0[15], st1[15];
#pragma unroll
        for (int k = 7; k < 15; ++k) { st0[k] = *(const f32x4*)(sp + (size_t)k * W); st1[k] = *(const f32x4*)(sp + (size_t)k * W + 4); }
        const f32x4 cb0 = *(const f32x4*)(c.conv_b + l * W + ch), cb1 = *(const f32x4*)(c.conv_b + l * W + ch + 4);
        const f32x4 w0a = *(const f32x4*)(c.conv_w + (l * 3 + 0) * W + ch), w0b = *(const f32x4*)(c.conv_w + (l * 3 + 0) * W + ch + 4);
        const f32x4 w1a = *(const f32x4*)(c.conv_w + (l * 3 + 1) * W + ch), w1b = *(const f32x4*)(c.conv_w + (l * 3 + 1) * W + ch + 4);
        const f32x4 w2a = *(const f32x4*)(c.conv_w + (l * 3 + 2) * W + ch), w2b = *(const f32x4*)(c.conv_w + (l * 3 + 2) * W + ch + 4);
        const f32x4 lg0 = *(const f32x4*)(c.lnv_g + l * W + ch), lg1 = *(const f32x4*)(c.lnv_g + l * W + ch + 4), lb0 = *(const f32x4*)(c.lnv_b + l * W + ch), lb1 = *(const f32x4*)(c.lnv_b + l * W + ch + 4);
        const float w00 = c.sgu_w[(size_t)(l * 8 + h) * 128 * 128], b00 = c.sgu_b[(l * 8 + h) * 128], invw = 1.f / (float)(2 << g);
        asm volatile("" ::: "memory");
        {
            f32x4 z0, z1, a0, a1; unpk8(qz, z0, z1); unpk8(qa, a0, a1);
            const f32x4 ya = a0 * (cb0 + w0a * s00 + w1a * s10 + w2a * z0), yb = a1 * (cb1 + w0b * s01 + w1b * s11 + w2b * z1);
#pragma unroll
            for (int k = 0; k < 7; ++k) { st0[k] = *(const f32x4*)(sp + (size_t)k * W); st1[k] = *(const f32x4*)(sp + (size_t)k * W + 4); }
            store8(yr + ch, ya, yb);
            float* o = c.out + O_CONVS + ((size_t)(l * NSM + n) * 2) * W + ch;
            *(f32x4*)(o) = s10; *(f32x4*)(o + 4) = s11; *(f32x4*)(o + W) = z0; *(f32x4*)(o + W + 4) = z1;
        }
        {
            f32x4 x0, x1, u0, u1; unpk8(qg, x0, x1); unpk8(qu, u0, u1);
            float s = ((x0.x + x0.y) + (x0.z + x0.w)) + ((x1.x + x1.y) + (x1.z + x1.w));
            float q = ((x0.x * x0.x + x0.y * x0.y) + (x0.z * x0.z + x0.w * x0.w)) + ((x1.x * x1.x + x1.y * x1.y) + (x1.z * x1.z + x1.w * x1.w));
#pragma unroll
            for (int o = 1; o < 64; o <<= 1) { s += __shfl_xor(s, o); q += __shfl_xor(q, o); }
            const float mu = s * (1.f / W), var = fmaxf(q * (1.f / W) - mu * mu, 0.f), rstd = __builtin_amdgcn_rsqf(var + EPS);
            x0 = (x0 - mu) * rstd * lg0 + lb0; x1 = (x1 - mu) * rstd * lg1 + lb1;
            float* vo = c.out + O_VS + (size_t)(l * NSM + n) * W + ch; *(f32x4*)(vo) = x0; *(f32x4*)(vo + 4) = x1;
            store8(yr + 512 + ch, u0 * (x0 * w00 + b00), u1 * (x1 * w00 + b00));
        }
        {
            f32x4 c0, c1; unpk8(qc, c0, c1);
            float* po = c.out + O_POOLS + ((size_t)(l * NSM + n) * 15) * W + ch;
            f32x4 r0 = c0, r1 = c1, s2a, s2b, s4a, s4b, s8a, s8b;
#pragma unroll
            for (int k = 14; k >= 0; --k) {
                if (k >= 1) { *(f32x4*)(po + (size_t)(k - 1) * W) = st0[k]; *(f32x4*)(po + (size_t)(k - 1) * W + 4) = st1[k]; }
                r0 += st0[k]; r1 += st1[k];
                if (k == 14) { s2a = r0; s2b = r1; } if (k == 12) { s4a = r0; s4b = r1; } if (k == 8) { s8a = r0; s8b = r1; } }
            *(f32x4*)(po + (size_t)14 * W) = c0; *(f32x4*)(po + (size_t)14 * W + 4) = c1;
            const f32x4 sa = g == 0 ? s2a : g == 1 ? s4a : g == 2 ? s8a : r0, sb2 = g == 0 ? s2b : g == 1 ? s4b : g == 2 ? s8b : r1;
            const f32x4 p0 = sa * invw - c0, p1 = sb2 * invw - c1;
            u32x4 o; o.x = pk2(p0.x, p0.y); o.y = pk2(p0.z, p0.w); o.z = pk2(p1.x, p1.y); o.w = pk2(p1.z, p1.w);
            *(LAS u32x4*)(ldsw + i * TPS + 16 * lane) = o;
        }
    }
    __syncthreads();
    const int row = MPR + 8 * sb + (fr & 7); const bf16_t* pr = c.pbuf + (size_t)row * PC; bf16_t* yr = c.y + (size_t)row * 1536;
    bf16x8 bw[2][4][2]; u32x4 sgv[2]; f32x4 pbv[2][2], psv[2][2];
#pragma unroll
    for (int gi2 = 0; gi2 < 2; ++gi2) { const int gq = 2 * c.wave + gi2, g2 = gq >> 2, nq = gq & 3, cc = 128 * g2 + 32 * nq + 8 * fq;
        const bf16_t* pw = c.PoolWT + ((size_t)(l * 4 + g2) * 128 + 32 * nq + fr) * 128 + 8 * fq;
#pragma unroll
        for (int ks = 0; ks < 4; ++ks) { bw[gi2][ks][0] = *(const bf16x8*)(pw + 32 * ks); bw[gi2][ks][1] = *(const bf16x8*)(pw + 16 * 128 + 32 * ks); }
        sgv[gi2] = ld_sc16(pr + PSG + cc);
        pbv[gi2][0] = *(const f32x4*)(c.pool_b + l * W + cc); pbv[gi2][1] = *(const f32x4*)(c.pool_b + l * W + cc + 4); psv[gi2][0] = *(const f32x4*)(c.pool_scale + l * W + cc); psv[gi2][1] = *(const f32x4*)(c.pool_scale + l * W + cc + 4); }
#pragma unroll
    for (int gi2 = 0; gi2 < 2; ++gi2) { const int gq = 2 * c.wave + gi2, g2 = gq >> 2, nq = gq & 3, cc = 128 * g2 + 32 * nq + 8 * fq;
        f32x4 a0 = (f32x4){0.f, 0.f, 0.f, 0.f}, a1 = (f32x4){0.f, 0.f, 0.f, 0.f};
#pragma unroll
        for (int ks = 0; ks < 4; ++ks) { const bf16x8 af = *(const LAS bf16x8*)(ldsw + fr * TPS + 2 * (128 * g2 + 32 * ks + 8 * fq));
            a0 = __builtin_amdgcn_mfma_f32_16x16x32_bf16(bw[gi2][ks][0], af, a0, 0, 0, 0); a1 = __builtin_amdgcn_mfma_f32_16x16x32_bf16(bw[gi2][ks][1], af, a1, 0, 0, 0); }
        f32x4 g0v, g1v; unpk8(sgv[gi2], g0v, g1v);
        if (fr < 8) store8(yr + 1024 + cc, (a0 + pbv[gi2][0]) * psv[gi2][0] * g0v, (a1 + pbv[gi2][1]) * psv[gi2][1] * g1v);
    }
}

DEV void p2_mm(const Ctx& c, const int l, const int ck, const int hh, const bf16_t* pb, LAS unsigned char* lds) {
    int lane_ = c.lane; asm volatile("" : "+v"(lane_));
    const int lane = lane_, w = c.wave, fr = lane & 15, fq = lane >> 4, row0 = ck * 128;
    const int hq = w >> 1, a = w & 1, h = 4 * hh + hq;
    bf16x8 wf[4][4]; u32x4 ug[4][2]; float bias[4];
    { const bf16_t* wm = c.SguW + ((size_t)(l * 8 + h) * 128) * 128;
#pragma unroll
      for (int i = 0; i < 4; ++i) { const int tb = a ? (i == 0 ? 1 : i == 1 ? 2 : i == 2 ? 5 : 6) : (i == 0 ? 0 : i == 1 ? 3 : i == 2 ? 4 : 7), t = 16 * tb + fr;
#pragma unroll
          for (int ks = 0; ks < 4; ++ks) wf[i][ks] = *(const bf16x8*)(wm + (size_t)t * 128 + 32 * ks + 8 * fq);
      } }
    __syncthreads();
#pragma unroll
    for (int i = 0; i < 4; ++i) { const int tb = a ? (i == 0 ? 1 : i == 1 ? 2 : i == 2 ? 5 : 6) : (i == 0 ? 0 : i == 1 ? 3 : i == 2 ? 4 : 7), t = 16 * tb + fr;
        bias[i] = c.sgu_b[(l * 8 + h) * 128 + t];
#pragma unroll
        for (int c2 = 0; c2 < 2; ++c2) ug[i][c2] = *(const u32x4*)(pb + (size_t)t * PC + PUG + 256 * hh + 64 * hq + 32 * c2 + 8 * fq); }
    f32x4 acc[4][4];
#pragma unroll
    for (int i = 0; i < 4; ++i)
#pragma unroll
        for (int cc = 0; cc < 4; ++cc) acc[i][cc] = (f32x4){0.f, 0.f, 0.f, 0.f};
    { const int q = fr >> 2, p = fr & 3;
#pragma unroll
      for (int ks = 0; ks < 4; ++ks) {
        bf16x8 vb[4];
#pragma unroll
        for (int cc = 0; cc < 4; ++cc) { const int col = 64 * hq + 32 * (cc >> 1) + 8 * p + 4 * (cc & 1);
            const v4i16 lo = __builtin_amdgcn_ds_read_tr16_b64_v4i16((LAS v4i16*)(lds + VT_OFF + (32 * ks + 8 * fq + q) * TP + 2 * col));
            const v4i16 hi = __builtin_amdgcn_ds_read_tr16_b64_v4i16((LAS v4i16*)(lds + VT_OFF + (32 * ks + 8 * fq + 4 + q) * TP + 2 * col));
            vb[cc] = (bf16x8){lo[0], lo[1], lo[2], lo[3], hi[0], hi[1], hi[2], hi[3]}; }
#pragma unroll
        for (int i = 0; i < 4; ++i) { const int tb = a ? (i == 0 ? 1 : i == 1 ? 2 : i == 2 ? 5 : 6) : (i == 0 ? 0 : i == 1 ? 3 : i == 2 ? 4 : 7);
            if (ks <= (tb >> 1)) {
#pragma unroll
                for (int cc = 0; cc < 4; ++cc) acc[i][cc] = __builtin_amdgcn_mfma_f32_16x16x32_bf16(vb[cc], wf[i][ks], acc[i][cc], 0, 0, 0); } }
      } }
    asm volatile("" ::: "memory");
    const int gi2 = w >> 2, nq = w & 3, chc = 256 * hh + 128 * gi2 + 32 * nq + 8 * fq;
    bf16x8 pw0[4], pw1[4]; u32x4 sgv[8];
    { const bf16_t* pw = c.PoolWT + ((size_t)(l * 4 + 2 * hh + gi2) * 128 + 32 * nq + fr) * 128 + 8 * fq;
#pragma unroll
      for (int ks = 0; ks < 4; ++ks) { pw0[ks] = *(const bf16x8*)(pw + 32 * ks); pw1[ks] = *(const bf16x8*)(pw + 16 * 128 + 32 * ks); }
#pragma unroll
      for (int m = 0; m < 8; ++m) sgv[m] = *(const u32x4*)(pb + (size_t)(16 * m + fr) * PC + PSG + chc); }
    const f32x4 pb0 = *(const f32x4*)(c.pool_b + l * W + chc), pb1 = *(const f32x4*)(c.pool_b + l * W + chc + 4), ps0 = *(const f32x4*)(c.pool_scale + l * W + chc), ps1 = *(const f32x4*)(c.pool_scale + l * W + chc + 4);
#pragma unroll
    for (int i = 0; i < 4; ++i) { const int tb = a ? (i == 0 ? 1 : i == 1 ? 2 : i == 2 ? 5 : 6) : (i == 0 ? 0 : i == 1 ? 3 : i == 2 ? 4 : 7), t = 16 * tb + fr;
#pragma unroll
        for (int c2 = 0; c2 < 2; ++c2) { f32x4 u0, u1; unpk8(ug[i][c2], u0, u1);
            store8(c.y + (size_t)(row0 + t) * 1536 + 512 + 256 * hh + 64 * hq + 32 * c2 + 8 * fq, (acc[i][2 * c2] + bias[i]) * u0, (acc[i][2 * c2 + 1] + bias[i]) * u1); } }
    f32x4 ac2[8][2];
#pragma unroll
    for (int m = 0; m < 8; ++m) { ac2[m][0] = (f32x4){0.f, 0.f, 0.f, 0.f}; ac2[m][1] = (f32x4){0.f, 0.f, 0.f, 0.f}; }
#pragma unroll
    for (int ks = 0; ks < 4; ++ks)
#pragma unroll
        for (int m = 0; m < 8; ++m) { const bf16x8 af = *(const LAS bf16x8*)(lds + PM_OFF + (16 * m + fr) * TP + 2 * (128 * gi2 + 32 * ks + 8 * fq));
            ac2[m][0] = __builtin_amdgcn_mfma_f32_16x16x32_bf16(pw0[ks], af, ac2[m][0], 0, 0, 0); ac2[m][1] = __builtin_amdgcn_mfma_f32_16x16x32_bf16(pw1[ks], af, ac2[m][1], 0, 0, 0); }
#pragma unroll
    for (int m = 0; m < 8; ++m) { f32x4 s0, s1; unpk8(sgv[m], s0, s1);
        store8(c.y + (size_t)(row0 + 16 * m + fr) * 1536 + 1024 + chc, (ac2[m][0] + pb0) * ps0 * s0, (ac2[m][1] + pb1) * ps1 * s1); }
    __syncthreads();
}
template <int HH> DEV void p2_item_front(const Ctx& c, const int l, const int ck, const bf16_t* pb, LAS unsigned char* lds) {
    constexpr int W0 = 2 << (2 * HH), W1 = 2 * W0, H = W1 - 1, NX = H + 16;
    int lane_ = c.lane; asm volatile("" : "+v"(lane_));
    const int lane = lane_, w = c.wave, p = lane >> 5, gi = lane >> 5, cpos = (ck & 15) * 128, row0 = ck * 128; const bool lastck = (ck & 15) == 15;
    const int ch8 = 256 * HH + 8 * (lane & 31), ch4 = 256 * HH + 4 * lane;
    const float* st = c.lnst + ((size_t)ck * 128 + 16 * w + (lane & 15)) * 16;
    const f32x4 t0 = *(const f32x4*)st, t1 = *(const f32x4*)(st + 4), t2 = *(const f32x4*)(st + 8), t3 = *(const f32x4*)(st + 12);
    u32x4 gv[8];
#pragma unroll
    for (int k = 0; k < 8; ++k) gv[k] = *(const u32x4*)(pb + (size_t)(16 * w + 2 * k + p) * PC + PGV + ch8);
    const f32x4 g0 = *(const f32x4*)(c.lnv_g + l * W + ch8), g1 = *(const f32x4*)(c.lnv_g + l * W + ch8 + 4), b0 = *(const f32x4*)(c.lnv_b + l * W + ch8), b1 = *(const f32x4*)(c.lnv_b + l * W + ch8 + 4);
    u32x2 xr[NX];
#pragma unroll
    for (int k = 0; k < NX; ++k) { const int tt = 16 * w - H + k; const bool valid = cpos + tt >= 0; const int tc = valid ? tt : 0;
        const u32x2 r = *(const u32x2*)(pb + (ptrdiff_t)tc * PC + PCX + ch4); xr[k] = valid ? r : (u32x2){0u, 0u}; }
    {
        const float s = ((t0.x + t0.z) + (t1.x + t1.z)) + ((t2.x + t2.z) + (t3.x + t3.z)), q = ((t0.y + t0.w) + (t1.y + t1.w)) + ((t2.y + t2.w) + (t3.y + t3.w));
        const float mu_l = s * (1.f / W), rstd_l = __builtin_amdgcn_rsqf(fmaxf(q * (1.f / W) - mu_l * mu_l, 0.f) + EPS);
        float* vout = c.out + O_VP + ((size_t)(l * NBP + (ck >> 4)) * 128) * W + ch8;
#pragma unroll
        for (int k = 0; k < 8; ++k) { const int t = 16 * w + 2 * k + p;
            const float mu = __shfl(mu_l, 2 * k + p), rstd = __shfl(rstd_l, 2 * k + p);
            f32x4 x0 = (f32x4){bflo(gv[k].x), bfhi(gv[k].x), bflo(gv[k].y), bfhi(gv[k].y)}, x1 = (f32x4){bflo(gv[k].z), bfhi(gv[k].z), bflo(gv[k].w), bfhi(gv[k].w)};
            x0 = (x0 - mu) * rstd * g0 + b0; x1 = (x1 - mu) * rstd * g1 + b1;
            u32x4 o; o.x = pk2(x0.x, x0.y); o.y = pk2(x0.z, x0.w); o.z = pk2(x1.x, x1.y); o.w = pk2(x1.z, x1.w);
            *(LAS u32x4*)(lds + VT_OFF + t * TP + (lane & 31) * 16) = o;
            if (lastck) { *(f32x4*)(vout + (size_t)t * W) = x0; *(f32x4*)(vout + (size_t)t * W + 4) = x1; }
        }
    }
    const f32x4 cb = *(const f32x4*)(c.conv_b + l * W + ch4), w0 = *(const f32x4*)(c.conv_w + (l * 3 + 0) * W + ch4), w1 = *(const f32x4*)(c.conv_w + (l * 3 + 1) * W + ch4), w2 = *(const f32x4*)(c.conv_w + (l * 3 + 2) * W + ch4);
    u32x2 zr[18], ar[16];
#pragma unroll
    for (int k = 0; k < 18; ++k) { const int tt = 16 * w - 2 + k; const bool valid = cpos + tt >= 0; const int tc = valid ? tt : 0;
        const u32x2 r = *(const u32x2*)(pb + (ptrdiff_t)tc * PC + PZ + ch4); zr[k] = valid ? r : (u32x2){0u, 0u}; }
#pragma unroll
    for (int i = 0; i < 16; ++i) ar[i] = *(const u32x2*)(pb + (size_t)(16 * w + i) * PC + PABG + ch4);
    {
        f32x4 slo = unpk4(xr[H]);
#pragma unroll
        for (int j = 1; j < W0; ++j) slo += unpk4(xr[H - j]);
        f32x4 shi = slo;
#pragma unroll
        for (int j = W0; j < W1; ++j) shi += unpk4(xr[H - j]);
        float* pout = c.out + O_POOLP + ((size_t)(l * NBP + (ck >> 4)) * 15) * W + ch4;
#pragma unroll
        for (int i = 0; i < 16; ++i) { const int t = 16 * w + i, pos = cpos + t, wd = gi ? W1 : W0;
            const f32x4 sm = gi ? shi : slo, xc = unpk4(xr[H + i]); const float inv = __builtin_amdgcn_rcpf((float)(wd < pos + 1 ? wd : pos + 1));
            const f32x4 pm = sm * inv - xc;
            *(LAS u32x2*)(lds + PM_OFF + t * TP + 8 * lane) = (u32x2){pk2(pm.x, pm.y), pk2(pm.z, pm.w)};
            if (lastck && t >= 113) *(f32x4*)(pout + (size_t)(t - 113) * W) = xc;
            if (i < 15) { const f32x4 xn = unpk4(xr[H + i + 1]); slo += xn - unpk4(xr[H + i + 1 - W0]); shi += xn - unpk4(xr[H + i + 1 - W1]); }
        }
    }
    {
        float* cout = c.out + O_CONVP + ((size_t)(l * NBP + (ck >> 4)) * 2) * W + ch4;
#pragma unroll
        for (int i = 0; i < 16; ++i) { const int t = 16 * w + i;
            const f32x4 abg = unpk4(ar[i]), z2 = unpk4(zr[i + 2]);
            const f32x4 o = abg * (cb + w0 * unpk4(zr[i]) + w1 * unpk4(zr[i + 1]) + w2 * z2);
            *(u32x2*)(c.y + (size_t)(row0 + t) * 1536 + ch4) = (u32x2){pk2(o.x, o.y), pk2(o.z, o.w)};
            if (lastck && t >= 126) *(f32x4*)(cout + (size_t)(t - 126) * W) = z2;
        }
    }
}
DEV void ph_p2_prompt(const Args& a, int l, LAS unsigned char* lds) {
    LAUNDER_CTX(a);
    VB_LOAD(lds);
    {
        const int ck = 16 * vx_ + (vr_ >> 1), hh = vr_ & 1; const bf16_t* pb = c.pbuf + (size_t)ck * 128 * PC;
        { if (hh) p2_item_front<1>(c, l, ck, pb, lds); else p2_item_front<0>(c, l, ck, pb, lds); }
        p2_mm(c, l, ck, hh, pb, lds);
    }
    if (vr_ >= 30) {
        unsigned* ctl = (unsigned*)(a.ws + WS_CTL + z_);
        if (threadIdx.x == 0) { XB_SPIN(xb_ld(&ctl[XB_CNT_P1S]) < 960u * (unsigned)(l + 1), ctl); __builtin_amdgcn_fence(__ATOMIC_ACQUIRE, "agent"); asm volatile("s_waitcnt vmcnt(0)" ::: "memory"); }
        __syncthreads();
        p2_sample_block(c, l, 2 * vx_ + (vr_ - 30), lds); __syncthreads(); }
}
DEV void ph_final(const Args& a, LAS unsigned char* lds) {
    LAUNDER_CTX(a); VB_LOAD(lds);
    const int lane = c.lane;
#pragma unroll 2
    for (int i = 8 * vr_ + c.wave; i < 2048 + 16; i += 256) { const int row = i < 2048 ? 2048 * vx_ + i : MPR + 16 * vx_ + (i - 2048);
        const float r = row_rstd(c.ssq, row);
#pragma unroll
        for (int j = 0; j < 2; ++j) { f32x4 x0, x1; unpk8(*((const u32x4*)(c.xb + (size_t)row * D) + lane + 64 * j), x0, x1);
            const f32x4* gp = (const f32x4*)c.final_g + 2 * lane + 128 * j; f32x4* o = (f32x4*)(c.out + (size_t)row * D) + 2 * lane + 128 * j;
            o[0] = x0 * r * gp[0]; o[1] = x1 * r * gp[1]; }
    }
}

__global__ __launch_bounds__(NTHREADS, 2) void mega_fwd(Args a) {
    extern __shared__ __attribute__((aligned(16))) unsigned char lds[];
    LAS unsigned char* ldsp = (LAS unsigned char*)lds;
    if (threadIdx.x < 16) ((LAS unsigned*)(ldsp + LDSCTL_OFF))[threadIdx.x] = 0u;
    __syncthreads();
    const XcdBarrier bar = xcd_barrier_post((unsigned*)(a.ws + WS_CTL), (volatile LAS unsigned*)(ldsp + LDSCTL_OFF));
    ph_convert(a, lds, 0, 0);
    xcd_barrier(bar);
    { LAUNDER_CTX(a); int bx_ = blockIdx.x, gx_ = gridDim.x; asm volatile("" : "+s"(bx_), "+s"(gx_)); SchedMod S{gx_, bx_, (const char*)c.scb, (const char*)c.WadaT}; EpiRows<EpiMod> E{EpiMod{c.mod, c.atab, c.shb, c.b_ada, c.norm_g}}; gemm_phase(ldsp, D * 2, D * 2, D / BK, S, E); }
    ph_convert(a, lds, 1, (int)gridDim.x > 96 ? 48 : 0);
    xcd_barrier(bar);
    { LAUNDER_CTX(a); int bx_ = blockIdx.x, gx_ = gridDim.x; asm volatile("" : "+s"(bx_), "+s"(gx_)); SchedSW S{gx_, bx_, (const char*)c.shb, (const char*)c.WinT}; EpiRows<EpiSWx> E{EpiSWx{c.SW}}; gemm_phase(ldsp, D * 2, D * 2, D / BK, S, E); }
    ph_xa0(a);
    xcd_barrier(bar);
#pragma unroll 1
    for (int l = 0; l < DEPTH; ++l) {
        { LAUNDER_CTX(a); VB_LOAD(ldsp); SchedP1 S; S.T.init(8, NIN / 256, 32, vr_, 8 * vx_); S.A = (const char*)((l & 1) ? c.xa2 : c.xa); S.B = (const char*)(c.WinT + (size_t)l * NIN * D);
          p1_rtab(S, c.ssq, c.SW + (size_t)l * NBT * NIN, (LAS float*)(ldsp + RTAB_OFF), (LAS float*)(ldsp + SWT_OFF));
          EpiP1T E{c.pbuf, c.SW + (size_t)l * NBT * NIN, (const LAS float*)(ldsp + RTAB_OFF), (const LAS float*)(ldsp + SWT_OFF), c.lnst};
          gemm_phase(ldsp, D * 2, D * 2, D / BK, S, E);
          if (vr_ >= 16) {
              const EpiP1S es{c.pbuf, c.SW + (size_t)l * NBT * NIN, c.ssq};
              const int spn = vx_ + 8 * ((vr_ - 16) >> 2), sl = 4 * spn + (vr_ & 3);
              if (spn < 30) { unsigned* ctl = (unsigned*)(a.ws + WS_CTL + z_);
                  if (threadIdx.x == 0) { XB_SPIN(xb_ld(&ctl[XB_CNT_P4S]) < 128u * (unsigned)l, ctl);
                      __builtin_amdgcn_fence(__ATOMIC_ACQUIRE, "agent"); asm volatile("s_waitcnt vmcnt(0)" ::: "memory"); }
                  p1_sample_slice(c.tid, sl, (l & 1) ? c.xa2 : c.xa, c.WinT + (size_t)l * NIN * D, es, ldsp);
                  asm volatile("s_waitcnt vmcnt(0)" ::: "memory");
                  if (c.lane == 0) xb_add(&ctl[XB_CNT_P1S], 1u); } } }
        layer_barrier(bar);
        ph_p2_prompt(a, l, ldsp);
        layer_barrier(bar);
        { LAUNDER_CTX(a); VB_LOAD(ldsp); const EpiP3 e3{c.pbuf, c.mg};
          if (vr_ < 16) { mini_gemm<3, 2>(a, ldsp, vx_ | (vr_ << 3), c.y, 1536, W, c.WbT + (size_t)l * 3 * D * W, W, (size_t)D * W, e3);
              if (threadIdx.x == 0) { asm volatile("s_waitcnt vmcnt(0)" ::: "memory"); xb_add((unsigned*)(a.ws + WS_CTL + z_) + XB_CNT_P3S(vx_), 1u); } }
          SchedP3R S; S.T.init(8, 8, 32, vr_, 8 * vx_); S.A = (const char*)c.y; S.B = (const char*)(c.WbT + (size_t)l * 3 * D * W);
          f32x4 tot[2][4][2];
#pragma unroll
          for (int i0 = 0; i0 < 2; ++i0)
#pragma unroll
              for (int i1 = 0; i1 < 4; ++i1) { tot[i0][i1][0] = (f32x4){0.f, 0.f, 0.f, 0.f}; tot[i0][i1][1] = (f32x4){0.f, 0.f, 0.f, 0.f}; }
          u32x2 gpre[8]; EpiP3R E{tot, gpre, c.pbuf, c.mg};
          { UnitD u0; int t_ = threadIdx.x; asm volatile("" : "+v"(t_)); const int wv = __builtin_amdgcn_readfirstlane(t_ >> 6); if (S.next(0, u0)) E.prefetch(u0, wv >> 2, wv & 3, t_ & 15, (t_ & 63) >> 4); }
          gemm_phase<EpiP3R, SchedP3R, 1>(ldsp, 1536 * 2, W * 2, W / BK, S, E);
          if (vr_ >= 16) {
              unsigned* ctl = (unsigned*)(a.ws + WS_CTL + z_);
              if (threadIdx.x == 0) { XB_SPIN(xb_ld(&ctl[XB_CNT_P3S(vx_)]) < 16u * (unsigned)(l + 1), ctl); __builtin_amdgcn_fence(__ATOMIC_ACQUIRE, "agent"); asm volatile("s_waitcnt vmcnt(0)" ::: "memory"); }
              __syncthreads();
              const float* gate = c.mod + (size_t)l * NBT * 3072 + 2048; const float* atc = c.atab + (size_t)l * NBT * D; const float* atn = l + 1 < DEPTH ? c.atab + (size_t)(l + 1) * NBT * D : nullptr;
              const EpiP4 e4{gate, atc, atn, (l & 1) ? c.xa2 : c.xa, (l & 1) ? c.xa : c.xa2, c.ssq, c.x_sample - (size_t)MPR * D, c.xb, l > 0};
              mini_gemm<1, 4>(a, ldsp, vx_ | ((vr_ - 16) << 3), c.mg, D, 0, c.WoT + (size_t)l * D * D, D, (size_t)0, e4);
              if (threadIdx.x == 0) { asm volatile("s_waitcnt vmcnt(0)" ::: "memory"); xb_add(&ctl[XB_CNT_P4S], 1u); } } }
        layer_barrier(bar);
        { LAUNDER_CTX(a); VB_LOAD(ldsp); const float* gate = c.mod + (size_t)l * NBT * 3072 + 2048;
          const float* atc = c.atab + (size_t)l * NBT * D; const float* atn = l + 1 < DEPTH ? c.atab + (size_t)(l + 1) * NBT * D : nullptr;
          const bf16_t* xai = (l & 1) ? c.xa2 : c.xa; bf16_t* xao = (l & 1) ? c.xa : c.xa2;
          const EpiP4 e4{gate, atc, atn, xai, xao, c.ssq, c.x_sample - (size_t)MPR * D, c.xb, l > 0};
          SchedP4 S; S.T.init(8, 4, 32, vr_, 8 * vx_); S.A = (const char*)c.mg; S.B = (const char*)(c.WoT + (size_t)l * D * D);
          if (l == 0) { EpiP4T<false, false> E{gate, atc, atn, xai, xao, c.ssq, c.x_prompt, c.xb}; gemm_phase(ldsp, D * 2, D * 2, D / BK, S, E); }
          else if (l + 1 < DEPTH) { EpiP4T<true, false> E{gate, atc, atn, xai, xao, c.ssq, c.x_prompt, c.xb}; gemm_phase(ldsp, D * 2, D * 2, D / BK, S, E); }
          else { EpiP4T<true, true> E{gate, atc, atn, xai, xao, c.ssq, c.x_prompt, c.xb}; gemm_phase(ldsp, D * 2, D * 2, D / BK, S, E); } }
        layer_barrier(bar);
    }
    ph_final(a, ldsp);
}

extern "C" void kernel_launch(void* const* d_in, const int* in_sizes, int n_in, void* d_out, int out_size, void* d_ws, size_t ws_size, hipStream_t stream) {
    static int grid_blocks = 0;
    if (grid_blocks == 0) {
        if (n_in != 22 || ws_size < WS_END) { fprintf(stderr, "kernel_launch: unexpected n_in %d or ws_size %zu < %zu\n", n_in, ws_size, (size_t)WS_END); grid_blocks = -1; return; }
        int dev = 0, cus = 0, per_cu = 0;
        (void)hipGetDevice(&dev); (void)hipDeviceGetAttribute(&cus, hipDeviceAttributeMultiprocessorCount, dev);
        if (hipFuncSetAttribute((const void*)mega_fwd, hipFuncAttributeMaxDynamicSharedMemorySize, LDS_BYTES) != hipSuccess) { fprintf(stderr, "kernel_launch: hipFuncSetAttribute failed\n"); grid_blocks = -1; return; }
        if (hipOccupancyMaxActiveBlocksPerMultiprocessor(&per_cu, (const void*)mega_fwd, NTHREADS, LDS_BYTES) != hipSuccess || per_cu < 1) { fprintf(stderr, "kernel_launch: occupancy query gave %d\n", per_cu); grid_blocks = -1; return; }
        if (cus < 256) { fprintf(stderr, "kernel_launch: this kernel is laid out for >= 256 CUs (found %d)\n", cus); grid_blocks = -1; return; }
        grid_blocks = 256;
        fprintf(stderr, "kernel_launch: cus %d per_cu %d grid %d\n", cus, per_cu, grid_blocks);
    }
    if (grid_blocks < 0) return;
    Args a{};
    for (int i = 0; i < 22; ++i) a.in[i] = (const float*)d_in[i];
    a.out = (float*)d_out; a.ws = (unsigned char*)d_ws;
    if (hipMemsetAsync((char*)d_ws + WS_CTL, 0, CTL_BYTES, stream) != hipSuccess) { fprintf(stderr, "kernel_launch: memset failed\n"); return; }
    void* args[] = {&a};
    hipError_t e = hipLaunchCooperativeKernel((const void*)mega_fwd, dim3(grid_blocks), dim3(NTHREADS), args, LDS_BYTES, stream);
    if (e != hipSuccess) fprintf(stderr, "kernel_launch: cooperative launch failed: %s (grid %d)\n", hipGetErrorString(e), grid_blocks);
}
```

```cpp
#include <hip/hip_runtime.h>
#include <cstdio>
#include <cstdint>

#define DEV __device__ __forceinline__
typedef unsigned short bf16_t;
typedef short bf16x8 __attribute__((ext_vector_type(8)));
typedef float f32x4 __attribute__((ext_vector_type(4)));
typedef unsigned u32x4 __attribute__((ext_vector_type(4)));
typedef unsigned u32x2 __attribute__((ext_vector_type(2)));

constexpr int D = 1024, TSEQ = 2048, NBP = 8, MPR = NBP * TSEQ  , NSM = 128, MV = MPR + NSM  , MP = 16640  , NBT = NBP + NSM  ;
constexpr int W = 512, NIN = 7680, PC = 4608  , DEPTH = 4;
constexpr int PZ = 0, PABG = 512, PUG = 1024, PGV = 1536, PCX = 2048, PSG = 2560, PGATE = 3072;
constexpr float EPS = 1e-6f;
constexpr size_t O_Y = 0, O_YS = 16777216, O_CONVP = 16908288, O_CONVS = 16941056, O_POOLP = 17465344, O_POOLS = 17711104, O_VP = 21643264, O_VS = 23740416;

constexpr size_t al256(size_t x) { return (x + 255) & ~(size_t)255; }
constexpr size_t WS_WIN = 0;
constexpr size_t WS_WB = al256(WS_WIN + (size_t)DEPTH * NIN * D * 2);
constexpr size_t WS_WO = al256(WS_WB + (size_t)DEPTH * 3 * D * W * 2);
constexpr size_t WS_MOD = al256(WS_WO + (size_t)DEPTH * D * D * 2);
constexpr size_t WS_ATAB = al256(WS_MOD + (size_t)DEPTH * NBT * 3 * D * 4);
constexpr size_t WS_SHB = al256(WS_ATAB + (size_t)DEPTH * NBT * D * 4);
constexpr size_t WS_SW = al256(WS_SHB + (size_t)DEPTH * 256 * D * 2);
constexpr size_t WS_XA = al256(WS_SW + (size_t)DEPTH * NBT * NIN * 4);
constexpr size_t WS_SSQ = al256(WS_XA + (size_t)MP * D * 2);
constexpr size_t WS_PBUF = al256(WS_SSQ + (size_t)MP * 16 * 4);
constexpr size_t WS_Y = al256(WS_PBUF + (size_t)MP * PC * 2);
constexpr size_t WS_MG = al256(WS_Y + (size_t)MP * 1536 * 2);
constexpr size_t WS_SGUW = al256(WS_MG + (size_t)MP * D * 2);
constexpr size_t WS_POOLW = al256(WS_SGUW + (size_t)DEPTH * 8 * 128 * 128 * 2);
constexpr size_t WS_WADA = al256(WS_POOLW + (size_t)DEPTH * 4 * 128 * 128 * 2);
constexpr size_t WS_SCB = al256(WS_WADA + (size_t)DEPTH * 3072 * D * 2);
constexpr size_t WS_XB = al256(WS_SCB + (size_t)256 * D * 2);
constexpr size_t WS_XA2 = al256(WS_XB + (size_t)MV * D * 2);
constexpr size_t WS_LNST = al256(WS_XA2 + (size_t)MP * D * 2);
constexpr size_t WS_CTL = al256(WS_LNST + (size_t)MP * 16 * 4);
constexpr size_t CTL_BYTES = 32768;
constexpr size_t WS_END = al256(WS_CTL + CTL_BYTES);

constexpr int NTHREADS = 512, NWAVES = 8;
constexpr int LDS_BYTES = 155648;
constexpr int LDSCTL_OFF = LDS_BYTES - 256;

typedef __bf16 bf16x2_t __attribute__((ext_vector_type(2)));
typedef float f32x2_t __attribute__((ext_vector_type(2)));
DEV unsigned pk2(float lo, float hi) { const f32x2_t v = {lo, hi}; const bf16x2_t b = __builtin_convertvector(v, bf16x2_t); return __builtin_bit_cast(unsigned, b); }
typedef unsigned long long u64_t;
DEV u32x2 ld_sc8(const void* p) { const u64_t v = __hip_atomic_load((const u64_t*)p, __ATOMIC_RELAXED, __HIP_MEMORY_SCOPE_AGENT); return (u32x2){(unsigned)v, (unsigned)(v >> 32)}; }
DEV u32x4 ld_sc16(const void* p) { const u32x2 a = ld_sc8(p), b = ld_sc8((const char*)p + 8); return (u32x4){a.x, a.y, b.x, b.y}; }
DEV void st_sc8(void* p, u32x2 v) { __hip_atomic_store((u64_t*)p, (u64_t)v.x | ((u64_t)v.y << 32), __ATOMIC_RELAXED, __HIP_MEMORY_SCOPE_AGENT); }
DEV void st_sc16(void* p, u32x4 v) { st_sc8(p, (u32x2){v.x, v.y}); st_sc8((char*)p + 8, (u32x2){v.z, v.w}); }
DEV void store8_sc(bf16_t* p, f32x4 a, f32x4 b) { u32x4 w; w.x = pk2(a.x, a.y); w.y = pk2(a.z, a.w); w.z = pk2(b.x, b.y); w.w = pk2(b.z, b.w); st_sc16(p, w); }
DEV float row_rstd_sc(const float* ssq, int row) {
    float s = 0.f;
#pragma unroll
    for (int i = 0; i < 8; ++i) { const u32x2 v = ld_sc8(ssq + (size_t)row * 16 + 2 * i); const unsigned lo = v.x, hi = v.y; s += __builtin_bit_cast(float, lo) + __builtin_bit_cast(float, hi); }
    return __builtin_amdgcn_rsqf(s * (1.f / D) + EPS);
}
DEV float bflo(unsigned u) { return __builtin_bit_cast(float, u << 16); }
DEV float bfhi(unsigned u) { return __builtin_bit_cast(float, u & 0xffff0000u); }
DEV void unpk8(const u32x4 u, f32x4& a, f32x4& b) { a = (f32x4){bflo(u.x), bfhi(u.x), bflo(u.y), bfhi(u.y)}; b = (f32x4){bflo(u.z), bfhi(u.z), bflo(u.w), bfhi(u.w)}; }
DEV f32x4 gate4(unsigned u) { return (f32x4){(float)(u & 0xffu), (float)((u >> 8) & 0xffu), (float)((u >> 16) & 0xffu), (float)(u >> 24)} * (1.f / 255.f); }
DEV unsigned pku8(f32x4 s) { const unsigned a = (unsigned)(s.x * 255.f + 0.5f), b = (unsigned)(s.y * 255.f + 0.5f), c = (unsigned)(s.z * 255.f + 0.5f), d = (unsigned)(s.w * 255.f + 0.5f); return a | (b << 8) | (c << 16) | (d << 24); }
DEV f32x4 exp2_4(f32x4 t) { return (f32x4){__builtin_amdgcn_exp2f(t.x), __builtin_amdgcn_exp2f(t.y), __builtin_amdgcn_exp2f(t.z), __builtin_amdgcn_exp2f(t.w)}; }
DEV unsigned pku8_t(f32x4 t);
DEV f32x4 rcp4(f32x4 d) { return (f32x4){__builtin_amdgcn_rcpf(d.x), __builtin_amdgcn_rcpf(d.y), __builtin_amdgcn_rcpf(d.z), __builtin_amdgcn_rcpf(d.w)}; }
DEV unsigned pku8_t(f32x4 t) {
    const f32x4 g = rcp4(exp2_4(t) * (1.f / 255.f) + (1.f / 255.f)) + 8388608.f;
    const u32x4 gu = __builtin_bit_cast(u32x4, g);
    const unsigned p01 = __builtin_amdgcn_perm(gu.y, gu.x, 0x0c0c0400u), p23 = __builtin_amdgcn_perm(gu.w, gu.z, 0x0c0c0400u);
    return __builtin_amdgcn_perm(p23, p01, 0x05040100u);
}
DEV f32x4 sigmoid4(f32x4 x) { return rcp4(exp2_4(x * -1.44269504f) + 1.f); }
DEV f32x4 silu4(f32x4 x) { return x * sigmoid4(x); }
DEV f32x4 gelu4(f32x4 x) { const f32x4 t = x * (x * x * (-2.f * 0.7978845608f * 0.044715f * 1.44269504f) + (-2.f * 0.7978845608f * 1.44269504f)); return x * rcp4(exp2_4(t) + 1.f); }
DEV int perm32(int rho) { const int n = rho >> 4, i = rho & 15; return 8 * (i >> 2) + 4 * n + (i & 3); }
DEV int nidx_of(int row) { return row < MPR ? (row >> 11) : (row < MV ? NBP + (row - MPR) : NBT - 1); }
DEV int src_win(int j) {
    const int pn = j >> 8, c = j & 255, bj = c >> 7, cc = c & 127;
    if (pn < 4) return (bj ? 1024 : 512) + 128 * pn + cc;
    if (pn < 8) return (bj ? 1536 : 0) + 128 * (pn - 4) + cc;
    if (pn < 12) return (bj ? 3072 : 2048) + 128 * (pn - 8) + cc;
    if (pn < 14) return 2560 + 256 * (pn - 12) + c;
    if (pn < 16) return 3584 + 256 * (pn - 14) + c;
    if (pn < 18) return 4096 + 256 * (pn - 16) + c;
    return 4608 + 256 * (pn - 18) + c;
}

struct Args { const float* in[22]; float* out; unsigned char* ws; };
struct Ctx {
    const float *x_prompt, *x_sample, *c_prompt, *c_sample, *state_conv, *state_pool, *w_ada, *b_ada, *norm_g, *w_in, *conv_w, *conv_b, *lnv_g, *lnv_b, *sgu_w, *sgu_b, *pool_w, *pool_b, *pool_scale, *w_branch, *w_out, *final_g;
    float* out; bf16_t *WinT, *WbT, *WoT; float *mod, *atab; bf16_t* shb; float* SW; bf16_t* xa; float* ssq; bf16_t *pbuf, *y, *mg; bf16_t *SguW, *PoolWT, *WadaT, *scb, *xb, *xa2; float* lnst;
    unsigned char* lds;
    int tid, lane, wave, gw, NGW, gtid, NGT;
};

DEV Ctx make_ctx(const Args& a, size_t z) {
    Ctx c;
    c.x_prompt = a.in[0] + z; c.x_sample = a.in[1] + z; c.c_prompt = a.in[2] + z; c.c_sample = a.in[3] + z; c.state_conv = a.in[4] + z; c.state_pool = a.in[5] + z; c.w_ada = a.in[6] + z; c.b_ada = a.in[7] + z;
    c.norm_g = a.in[8] + z; c.w_in = a.in[9] + z; c.conv_w = a.in[10] + z; c.conv_b = a.in[11] + z; c.lnv_g = a.in[12] + z; c.lnv_b = a.in[13] + z; c.sgu_w = a.in[14] + z; c.sgu_b = a.in[15] + z;
    c.pool_w = a.in[16] + z; c.pool_b = a.in[17] + z; c.pool_scale = a.in[18] + z; c.w_branch = a.in[19] + z; c.w_out = a.in[20] + z; c.final_g = a.in[21] + z;
    c.out = a.out + z; unsigned char* ws = a.ws + z;
    c.WinT = (bf16_t*)(ws + WS_WIN); c.WbT = (bf16_t*)(ws + WS_WB); c.WoT = (bf16_t*)(ws + WS_WO);
    c.mod = (float*)(ws + WS_MOD); c.atab = (float*)(ws + WS_ATAB); c.shb = (bf16_t*)(ws + WS_SHB); c.SW = (float*)(ws + WS_SW);
    c.xa = (bf16_t*)(ws + WS_XA); c.ssq = (float*)(ws + WS_SSQ); c.pbuf = (bf16_t*)(ws + WS_PBUF); c.y = (bf16_t*)(ws + WS_Y); c.mg = (bf16_t*)(ws + WS_MG);
    c.WadaT = (bf16_t*)(ws + WS_WADA); c.scb = (bf16_t*)(ws + WS_SCB); c.xb = (bf16_t*)(ws + WS_XB); c.xa2 = (bf16_t*)(ws + WS_XA2); c.lnst = (float*)(ws + WS_LNST); c.SguW = (bf16_t*)(ws + WS_SGUW); c.PoolWT = (bf16_t*)(ws + WS_POOLW);
    c.lds = nullptr; c.tid = 0; c.lane = 0; c.wave = 0; c.gw = 0; c.NGW = 0; c.gtid = 0; c.NGT = 0;
    return c;
}
#define LAUNDER_CTX(a) size_t z_ = 0; asm volatile("" : "+s"(z_)); Ctx c = make_ctx(a, z_); { int t_ = threadIdx.x; asm volatile("" : "+v"(t_)); c.tid = t_; c.lane = t_ & 63; c.wave = __builtin_amdgcn_readfirstlane(t_ >> 6); \
    c.gw = blockIdx.x * NWAVES + c.wave; c.NGW = gridDim.x * NWAVES; c.gtid = blockIdx.x * NTHREADS + t_; c.NGT = gridDim.x * NTHREADS; }
#define VB_LOAD(ldsp) const int vb_ = __builtin_amdgcn_readfirstlane((int)((volatile LAS unsigned*)((ldsp) + LDSCTL_OFF))[2]); const int vx_ = vb_ >> 5, vr_ = vb_ & 31;
struct MapWin { DEV int operator()(int g) const { return src_win((g & ~31) + perm32(g & 31)); } };
struct MapPerm { DEV int operator()(int g) const { return (g & ~31) + perm32(g & 31); } };
template <class Map>
DEV void transpose_item(const float* Wsrc, int ldw, int K, bf16_t* WT, int nblk, int item, float* scr, int lane, Map map) {
    const int kb = item / nblk, nb = item % nblk, k0 = 64 * kb, g0 = 32 * nb;
    const int scol = map(g0 + (lane & 31));
#pragma unroll 8
    for (int i = 0; i < 32; ++i) { const int kk = 2 * i + (lane >> 5); scr[kk * 33 + (lane & 31)] = Wsrc[(size_t)(k0 + kk) * ldw + scol]; }
    asm volatile("s_waitcnt lgkmcnt(0)" ::: "memory");
    const int c = lane & 7;
#pragma unroll
    for (int j = 0; j < 4; ++j) { const int n = (lane >> 3) + 8 * j; const float* s = scr + (8 * c) * 33 + n;
        u32x4 o; o.x = pk2(s[0 * 33], s[1 * 33]); o.y = pk2(s[2 * 33], s[3 * 33]); o.z = pk2(s[4 * 33], s[5 * 33]); o.w = pk2(s[6 * 33], s[7 * 33]);
        *(u32x4*)(WT + (size_t)(g0 + n) * K + k0 + 8 * c) = o; }
    asm volatile("s_waitcnt lgkmcnt(0)" ::: "memory");
}
constexpr int IT_WIN = (D / 64) * (NIN / 32), IT_WB = (W / 64) * (D / 32), IT_WO = (D / 64) * (D / 32);
constexpr int IT_PW = (128 / 64) * (128 / 32);
constexpr int IT_WADA = (D / 64) * (3072 / 32);
constexpr int IT_TOTAL = DEPTH * IT_WIN + DEPTH * 3 * IT_WB + DEPTH * IT_WO + DEPTH * 4 * IT_PW + DEPTH * IT_WADA;
DEV void ph_convert(const Args& a, unsigned char* lds, const int stage, const int b0) {
    LAUNDER_CTX(a);
    float* scr = (float*)(lds + c.wave * 16384);
    const int nb = (int)gridDim.x - b0, bw = ((int)blockIdx.x - b0) * NWAVES + c.wave, nw = nb * NWAVES, bt = ((int)blockIdx.x - b0) * NTHREADS + c.tid, nthr = nb * NTHREADS;
    if ((int)blockIdx.x < b0) return;
    if (stage == 0) {
        for (int r = bw; r < DEPTH * IT_WADA; r += nw) { const int l = r / IT_WADA; transpose_item(c.w_ada + (size_t)l * D * 3072, 3072, D, c.WadaT + (size_t)l * 3072 * D, 3072 / 32, r - l * IT_WADA, scr, c.lane, MapPerm()); }
        for (int idx = bt; idx < 256 * D / 4; idx += nthr) { const int n = idx >> 8, k4 = (idx & 255) * 4; f32x4 v = (f32x4){0.f, 0.f, 0.f, 0.f};
            if (n < NBT) { v = *(const f32x4*)((n < NBP ? c.c_prompt + (size_t)n * D : c.c_sample + (size_t)(n - NBP) * D) + k4); v = silu4(v); }
            *((u32x2*)c.scb + idx) = (u32x2){pk2(v.x, v.y), pk2(v.z, v.w)}; }
        return;
    }
    for (int it = bw; it < IT_TOTAL - DEPTH * IT_WADA; it += nw) {
        int r = it;
        if (r < DEPTH * IT_WIN) { const int l = r / IT_WIN; r -= l * IT_WIN; transpose_item(c.w_in + (size_t)l * D * NIN, NIN, D, c.WinT + (size_t)l * NIN * D, NIN / 32, r, scr, c.lane, MapWin()); continue; }
        r -= DEPTH * IT_WIN;
        if (r < DEPTH * 3 * IT_WB) { const int li = r / IT_WB; r -= li * IT_WB; transpose_item(c.w_branch + (size_t)li * W * D, D, W, c.WbT + (size_t)li * D * W, D / 32, r, scr, c.lane, MapPerm()); continue; }
        r -= DEPTH * 3 * IT_WB;
        if (r < DEPTH * IT_WO) { const int l = r / IT_WO; r -= l * IT_WO; transpose_item(c.w_out + (size_t)l * D * D, D, D, c.WoT + (size_t)l * D * D, D / 32, r, scr, c.lane, MapPerm()); continue; }
        r -= DEPTH * IT_WO;
        { const int lg = r / IT_PW; r -= lg * IT_PW; transpose_item(c.pool_w + (size_t)lg * 128 * 128, 128, 128, c.PoolWT + (size_t)lg * 128 * 128, 4, r, scr, c.lane, MapPerm()); }
    }
    for (int idx = bt; idx < DEPTH * 8 * 128 * 128 / 4; idx += nthr) { const int s4 = (idx & 31) * 4, t = (idx >> 5) & 127; const f32x4 v = *((const f32x4*)c.sgu_w + idx);
        *((u32x2*)c.SguW + idx) = (u32x2){pk2(s4 <= t ? v.x : 0.f, s4 + 1 <= t ? v.y : 0.f), pk2(s4 + 2 <= t ? v.z : 0.f, s4 + 3 <= t ? v.w : 0.f)}; }
}
DEV void ph_xa0(const Args& a) {
    LAUNDER_CTX(a);
    const int lane = c.lane, NSW = DEPTH * 30;
    if ((int)gridDim.x <= NSW || (int)blockIdx.x < NSW) { if ((int)gridDim.x > NSW) return; }
    const int w0 = ((int)gridDim.x > NSW) ? ((int)blockIdx.x - NSW) * NWAVES + c.wave : c.gw, nw = ((int)gridDim.x > NSW) ? ((int)gridDim.x - NSW) * NWAVES : c.NGW;
    for (int row = MV + w0; row < MP; row += nw) { u32x2* xo = (u32x2*)(c.xa + (size_t)row * D) + lane;
#pragma unroll
        for (int j = 0; j < 4; ++j) { xo[64 * j] = (u32x2){0u, 0u}; ((u32x2*)(c.xa2 + (size_t)row * D) + lane)[64 * j] = (u32x2){0u, 0u}; }
        if (lane < 16) c.ssq[row * 16 + lane] = 0.f; }
#pragma unroll 2
    for (int row = w0; row < MV; row += nw) {
        u32x2* xo = (u32x2*)(c.xa + (size_t)row * D) + lane;
        const float* xr = row < MPR ? c.x_prompt + (size_t)row * D : c.x_sample + (size_t)(row - MPR) * D;
        const float* ar = c.atab + (size_t)nidx_of(row) * D;
#pragma unroll
        for (int j = 0; j < 4; ++j) {
            const f32x4 v = *((const f32x4*)xr + lane + 64 * j), at = *((const f32x4*)ar + lane + 64 * j);
            const u32x2 pv = (u32x2){pk2(v.x * at.x, v.y * at.y), pk2(v.z * at.z, v.w * at.w)};
            if (row >= MPR) st_sc8(&xo[64 * j], pv); else xo[64 * j] = pv;
            float s = (v.x * v.x + v.y * v.y) + (v.z * v.z + v.w * v.w);
            s += __shfl_xor(s, 1); s += __shfl_xor(s, 2); s += __shfl_xor(s, 4); s += __shfl_xor(s, 32);
            if ((lane & 39) == 0) { if (row >= MPR) __hip_atomic_store(c.ssq + row * 16 + 4 * j + (lane >> 3), s, __ATOMIC_RELAXED, __HIP_MEMORY_SCOPE_AGENT); else c.ssq[row * 16 + 4 * j + (lane >> 3)] = s; }
        }
    }
}
DEV float row_rstd(const float* ssq, int row) {
    const f32x4* p = (const f32x4*)(ssq + (size_t)row * 16); const f32x4 a = p[0], b = p[1], c = p[2], d = p[3];
    const float s = ((a.x + a.y) + (a.z + a.w)) + ((b.x + b.y) + (b.z + b.w)) + ((c.x + c.y) + (c.z + c.w)) + ((d.x + d.y) + (d.z + d.w));
    return __builtin_amdgcn_rsqf(s * (1.f / D) + EPS);
}

DEV void store8(bf16_t* p, f32x4 a, f32x4 b) { u32x4 w; w.x = pk2(a.x, a.y); w.y = pk2(a.z, a.w); w.z = pk2(b.x, b.y); w.w = pk2(b.z, b.w); *(u32x4*)p = w; }

#define LAS __attribute__((address_space(3)))
constexpr int BK = 64, HALF = 128, HTB = HALF * BK * 2, STAGE_BYTES = 8 * HTB;
DEV int lds_byte(int r, int c) { const int st = (r >> 4) * 2 + (c >> 5), rr = r & 15, cc = c & 31, ob = rr * 64 + cc * 2; return st * 1024 + (ob ^ (((ob >> 9) & 1) << 5)); }
DEV void stage_rc(int b, int& R, int& C) { const int st = b / 1024, sb = b % 1024, swz = sb ^ (((sb >> 9) & 1) << 5); R = (st >> 1) * 16 + swz / 64; C = (st & 1) * 32 + (swz % 64) / 2; }
struct UnitD { const char* A; const char* B; int pm, pn, aux; };
constexpr int NXCD = 8;
constexpr int WGM_P1 = 4, WGM_P3 = 4, WGM_P4 = 8;
struct TileOrder {
    int nM, nN, nwg, G, c, pm0;
    DEV void init(int nM_, int nN_, int G_, int c_, int pm0_) { nM = nM_; nN = nN_; nwg = nM * nN; G = G_; c = c_; pm0 = pm0_; }
    template <int WGM> DEV bool tile(int i, int& pm, int& pn) const {
        const int wgid = i * G + c; if (wgid >= nwg) return false;
        const int nig = WGM * nN, gid = wgid / nig, fm = gid * WGM, gsz = (nM - fm) < WGM ? (nM - fm) : WGM;
        pm = pm0 + fm + ((wgid % nig) % gsz); pn = (wgid % nig) / gsz; return true;
    }
};
template <class Epi, class Sched, int NBH = 2>
DEV void gemm_phase(LAS unsigned char* lds, const int lda  , const int ldb  , const int nt  , const Sched& S, const Epi& E) {
    int tid = threadIdx.x; asm volatile("" : "+v"(tid));
    const int wid = __builtin_amdgcn_readfirstlane(tid >> 6), lane = tid & 63, wr = wid >> 2, wc = wid & 3, fr = lane & 15, fq = lane >> 4;
    unsigned voffA[2], voffB[2];
#pragma unroll
    for (int i = 0; i < 2; ++i) { int R, C; stage_rc(tid * 16 + i * 8192, R, C); voffA[i] = (unsigned)(R * lda + C * 2); voffB[i] = (unsigned)(R * ldb + C * 2); }
    const size_t kstep = (size_t)(BK * 2);
    const size_t hstepA = (size_t)HALF * lda, hstepB = (size_t)HALF * ldb;
    const unsigned ldsw = (unsigned)wid * 1024u;
    const int aoff = lds_byte(wr * 64 + fr, fq * 8), boff = lds_byte(wc * 32 + fr, fq * 8);
#define PG8_SA(b, h) (((b) * 2 + (h)) * HTB)
#define PG8_SB(b, h) ((4 + (b) * 2 + (h)) * HTB)
#define PG8_STAGE(bufoff, gbase, voff) do { _Pragma("unroll") for (int _i = 0; _i < 2; ++_i) \
        __builtin_amdgcn_global_load_lds((const unsigned*)((const char*)(gbase) + (voff)[_i]), (LAS unsigned*)(lds + (bufoff) + ldsw + _i * 8192), 16, 0, 0); } while (0)
#define PG8_LDA(dst, b, h) do { _Pragma("unroll") for (int m = 0; m < 4; ++m) _Pragma("unroll") for (int k = 0; k < 2; ++k) dst[m][k] = *(const LAS bf16x8*)(lds + PG8_SA(b, h) + aoff + m * 2048 + k * 1024); } while (0)
#define PG8_LDB(dst, b, h) do { _Pragma("unroll") for (int n = 0; n < 2; ++n) _Pragma("unroll") for (int k = 0; k < 2; ++k) dst[n][k] = *(const LAS bf16x8*)(lds + PG8_SB(b, h) + boff + n * 2048 + k * 1024); } while (0)
#define PG8_MMA(ai, bj, At, Bt) do { __builtin_amdgcn_s_setprio(1); _Pragma("unroll") for (int m = 0; m < 4; ++m) _Pragma("unroll") for (int n = 0; n < 2; ++n) _Pragma("unroll") for (int k = 0; k < 2; ++k) \
        acc[ai][bj][m][n] = __builtin_amdgcn_mfma_f32_16x16x32_bf16(Bt[n][k], At[m][k], acc[ai][bj][m][n], 0, 0, 0); __builtin_amdgcn_s_setprio(0); } while (0)
#define PG8_WAIT_V(n) asm volatile("s_waitcnt vmcnt(" #n ")" ::: "memory")
#define PG8_WAIT_VN() do { if constexpr (NBH == 2) PG8_WAIT_V(8); else PG8_WAIT_V(6); } while (0)
#define PG8_WAIT_L(n) asm volatile("s_waitcnt lgkmcnt(" #n ")" ::: "memory")
#define PG8_BAR __builtin_amdgcn_s_barrier()
#define PG8_SCHED __builtin_amdgcn_sched_barrier(0)
    UnitD cur, nxt; int ui = 0;
    if (!S.next(0, cur)) return;
    f32x4 acc[2][NBH][4][2];
#pragma unroll
    for (int a = 0; a < 2; ++a)
#pragma unroll
        for (int b = 0; b < NBH; ++b)
#pragma unroll
            for (int m = 0; m < 4; ++m)
#pragma unroll
                for (int n = 0; n < 2; ++n) acc[a][b][m][n] = (f32x4){0.f, 0.f, 0.f, 0.f};
    bf16x8 At[4][2], B0[2][2], B1[2][2];
    const char* cA = cur.A; const char* cB = cur.B;
    PG8_STAGE(PG8_SB(0, 0), cB, voffB); if constexpr (NBH == 2) PG8_STAGE(PG8_SB(0, 1), cB + hstepB, voffB); PG8_STAGE(PG8_SA(0, 0), cA, voffA); PG8_STAGE(PG8_SA(0, 1), cA + hstepA, voffA);
    if (wr == 1) PG8_BAR;
    PG8_WAIT_V(2); PG8_BAR;
    PG8_STAGE(PG8_SB(1, 0), cB + kstep, voffB); PG8_STAGE(PG8_SA(1, 0), cA + kstep, voffA); if constexpr (NBH == 2) PG8_STAGE(PG8_SB(1, 1), cB + hstepB + kstep, voffB);
    if constexpr (NBH == 2) PG8_WAIT_V(6); else PG8_WAIT_V(4);
    PG8_BAR;
    for (;;) {
        const bool has_next = S.next(ui + 1, nxt);
        const char* nA = has_next ? nxt.A : cA; const char* nB = has_next ? nxt.B : cB;
        for (int t = 0; t < nt; t += 2) {
            const bool last = (t == nt - 2);
            const char* a1 = cA + (size_t)(t + 1) * kstep;
            const char* a2 = last ? nA : cA + (size_t)(t + 2) * kstep; const char* b2 = last ? nB : cB + (size_t)(t + 2) * kstep;
            const char* a3 = a2 + kstep; const char* b3 = b2 + kstep;
            PG8_LDB(B0, 0, 0); if constexpr (NBH == 2) PG8_LDB(B1, 0, 1); PG8_SCHED; PG8_LDA(At, 0, 0); PG8_STAGE(PG8_SA(1, 1), a1 + hstepA, voffA);
            PG8_WAIT_VN(); PG8_WAIT_L(0); PG8_BAR; PG8_MMA(0, 0, At, B0); if constexpr (NBH == 2) PG8_MMA(0, 1, At, B1); PG8_BAR; PG8_SCHED;
            PG8_LDA(At, 0, 1); PG8_STAGE(PG8_SB(0, 0), b2, voffB); if constexpr (NBH == 2) PG8_STAGE(PG8_SB(0, 1), b2 + hstepB, voffB); PG8_STAGE(PG8_SA(0, 0), a2, voffA);
            PG8_WAIT_VN(); PG8_WAIT_L(0); PG8_BAR; PG8_MMA(1, 0, At, B0); if constexpr (NBH == 2) PG8_MMA(1, 1, At, B1); PG8_BAR; PG8_SCHED;
            PG8_LDB(B0, 1, 0); if constexpr (NBH == 2) PG8_LDB(B1, 1, 1); PG8_SCHED; PG8_LDA(At, 1, 0); PG8_STAGE(PG8_SA(0, 1), a2 + hstepA, voffA);
            PG8_WAIT_VN(); PG8_WAIT_L(0); PG8_BAR; PG8_MMA(0, 0, At, B0); if constexpr (NBH == 2) PG8_MMA(0, 1, At, B1); PG8_BAR; PG8_SCHED;
            PG8_LDA(At, 1, 1); PG8_STAGE(PG8_SB(1, 0), b3, voffB); if constexpr (NBH == 2) PG8_STAGE(PG8_SB(1, 1), b3 + hstepB, voffB); PG8_STAGE(PG8_SA(1, 0), a3, voffA);
            PG8_WAIT_VN(); PG8_WAIT_L(0); PG8_BAR; PG8_MMA(1, 0, At, B0); if constexpr (NBH == 2) PG8_MMA(1, 1, At, B1); PG8_BAR; PG8_SCHED;
        }
        if (wr == 0) PG8_BAR;
        E(acc, cur, nxt, has_next, wr, wc, fr, fq);
        if (!has_next) break;
#pragma unroll
        for (int a = 0; a < 2; ++a)
#pragma unroll
            for (int b = 0; b < NBH; ++b)
#pragma unroll
                for (int m = 0; m < 4; ++m)
#pragma unroll
                    for (int n = 0; n < 2; ++n) acc[a][b][m][n] = (f32x4){0.f, 0.f, 0.f, 0.f};
        cur = nxt; cA = nA; cB = nB; ++ui;
        if (wr == 1) PG8_BAR;
    }
    PG8_WAIT_V(0);
    PG8_BAR;
#undef PG8_SA
#undef PG8_SB
#undef PG8_STAGE
#undef PG8_LDA
#undef PG8_LDB
#undef PG8_MMA
#undef PG8_WAIT_V
#undef PG8_WAIT_L
#undef PG8_WAIT_VN
#undef PG8_BAR
#undef PG8_SCHED
}


struct SchedMod { int G, c; const char* A; const char* B;
    DEV bool next(int i, UnitD& u) const { const int idx = i * G + c; if (idx >= 48) return false; u.pm = 0; u.pn = idx; u.aux = 0; u.A = A; u.B = B + (size_t)idx * 256 * (D * 2); return true; } };
struct EpiMod { float* mod; float* atab; bf16_t* shb; const float* b_ada; const float* norm_g;
    DEV void operator()(int pn, int row, int wc, int fq, f32x4 (&v)[2][2]) const {
#pragma unroll
        for (int bj = 0; bj < 2; ++bj) { const int gc = 256 * pn + 128 * bj + 32 * wc + 8 * fq, l = gc / 3072, j3 = gc - l * 3072;
            const f32x4 v0 = v[bj][0] + *(const f32x4*)(b_ada + gc), v1 = v[bj][1] + *(const f32x4*)(b_ada + gc + 4);
            if (row < NBT) { float* o = mod + ((size_t)l * NBT + row) * 3072 + j3; *(f32x4*)o = v0; *(f32x4*)(o + 4) = v1; }
            if (j3 < D) { const f32x4 z = (f32x4){0.f, 0.f, 0.f, 0.f}; store8(shb + ((size_t)l * 256 + row) * D + j3, row < NBT ? v0 : z, row < NBT ? v1 : z); }
            else if (j3 < 2 * D && row < NBT) { const float* ng = norm_g + l * D + (j3 - D); float* o = atab + ((size_t)l * NBT + row) * D + (j3 - D);
                f32x4 a0 = *(const f32x4*)ng * (v0 + 1.f), a1 = *(const f32x4*)(ng + 4) * (v1 + 1.f);
#pragma unroll
                for (int j = 0; j < 4; ++j) { a0[j] = __builtin_fabsf(a0[j]) < 1e-20f ? 1e-20f : a0[j]; a1[j] = __builtin_fabsf(a1[j]) < 1e-20f ? 1e-20f : a1[j]; }
                *(f32x4*)o = a0; *(f32x4*)(o + 4) = a1; }
        }
    } };
template <int NSEG, int KS  , class RowEpi>
DEV void mini_gemm(const Args& a, LAS unsigned char* lds, int u, const bf16_t* A, int lda, int a_seg, const bf16_t* Bt, int ldb, size_t b_seg, const RowEpi& e) {
    LAUNDER_CTX(a);
    const int lane = c.lane, w = c.wave, fr = lane & 15, fq = lane >> 4, rb = u & 7, pn = u >> 5, wc = (u >> 3) & 3, row = MPR + 16 * rb + fr, kw = 32 * KS;
    bf16x8 af[NSEG][KS], bf[NSEG][KS][4];
#pragma unroll
    for (int s = 0; s < NSEG; ++s) { const bf16_t* ap = A + (size_t)row * lda + s * a_seg + w * kw + 8 * fq; const bf16_t* bp = Bt + s * b_seg + (size_t)(256 * pn + 32 * wc + fr) * ldb + w * kw + 8 * fq;
#pragma unroll
        for (int k = 0; k < KS; ++k) { af[s][k] = *(const bf16x8*)(ap + 32 * k);
#pragma unroll
            for (int q = 0; q < 4; ++q) bf[s][k][q] = *(const bf16x8*)(bp + (size_t)(128 * (q >> 1) + 16 * (q & 1)) * ldb + 32 * k); } }
    f32x4 acc[NSEG][4];
#pragma unroll
    for (int s = 0; s < NSEG; ++s) {
#pragma unroll
        for (int q = 0; q < 4; ++q) acc[s][q] = (f32x4){0.f, 0.f, 0.f, 0.f};
#pragma unroll
        for (int k = 0; k < KS; ++k)
#pragma unroll
            for (int q = 0; q < 4; ++q) acc[s][q] = __builtin_amdgcn_mfma_f32_16x16x32_bf16(bf[s][k][q], af[s][k], acc[s][q], 0, 0, 0);
    }
#pragma unroll
    for (int s = 0; s < NSEG; ++s)
#pragma unroll
        for (int q = 0; q < 4; ++q) *(LAS f32x4*)(lds + (((w * NSEG + s) * 4 + q) * 64 + lane) * 16) = acc[s][q];
    __syncthreads();
    if (w == 0) {
        f32x4 v[NSEG][2][2];
#pragma unroll
        for (int s = 0; s < NSEG; ++s)
#pragma unroll
            for (int q = 0; q < 4; ++q) { f32x4 t = *(const LAS f32x4*)(lds + (((0 * NSEG + s) * 4 + q) * 64 + lane) * 16);
#pragma unroll
                for (int ww = 1; ww < 8; ++ww) t += *(const LAS f32x4*)(lds + (((ww * NSEG + s) * 4 + q) * 64 + lane) * 16);
                v[s][q >> 1][q & 1] = t; }
        e(pn, row, wc, fq, v);
    }
    __syncthreads();
}

constexpr int RTAB_OFF = STAGE_BYTES;
constexpr int SWT_OFF = RTAB_OFF + 8192;
template <int TY, bool SMP> DEV void p1_rows(const f32x4 (&acc)[2][2][4][2], bf16_t* pb  , const LAS float* rt, const float* swb, const int row0, f32x4 s00, f32x4 s01, f32x4 s10, f32x4 s11, float* st = nullptr  ) {
    if (TY == 6 && !SMP) { s00 *= -1.44269504f; s01 *= -1.44269504f; s10 *= -1.44269504f; s11 *= -1.44269504f; }
    f32x4 n00 = s00, n01 = s01, n10 = s10, n11 = s11;
    if (SMP) { const float* sw = swb + (size_t)nidx_of(row0) * NIN; n00 = *(const f32x4*)(sw); n01 = *(const f32x4*)(sw + 4); n10 = *(const f32x4*)(sw + 128); n11 = *(const f32x4*)(sw + 132); }
#pragma unroll
    for (int ai = 0; ai < 2; ++ai) {
#pragma unroll
        for (int m = 0; m < 4; ++m) { const int rl = ai * HALF + m * 16; const float r = (TY == 6 && !SMP) ? rt[rl] * -1.44269504f : rt[rl];
            if (SMP) { s00 = n00; s01 = n01; s10 = n10; s11 = n11;
                if (ai * 4 + m < 7) { const int rn = ((ai * 4 + m + 1) >> 2) * HALF + ((ai * 4 + m + 1) & 3) * 16; const float* sw = swb + (size_t)nidx_of(row0 + rn) * NIN; n00 = *(const f32x4*)(sw); n01 = *(const f32x4*)(sw + 4); n10 = *(const f32x4*)(sw + 128); n11 = *(const f32x4*)(sw + 132); } }
            f32x4 a0 = acc[ai][0][m][0] * r + s00, a1 = acc[ai][0][m][1] * r + s01, b0 = acc[ai][1][m][0] * r + s10, b1 = acc[ai][1][m][1] * r + s11;
            bf16_t* pr = pb + (size_t)rl * PC;
            if (TY == 0) { store8(pr, a0 * b0, a1 * b1); }
            else if (TY == 1) { store8(pr, a0 * silu4(b0), a1 * silu4(b1)); }
            else if (TY == 2) { store8(pr, gelu4(a0) * silu4(b0), gelu4(a1) * silu4(b1)); }
            else {
                if (TY == 3) { a0 = gelu4(a0); a1 = gelu4(a1); b0 = gelu4(b0); b1 = gelu4(b1); }
                if (TY == 3) {
                    const f32x4 sv = (a0 + a1) + (b0 + b1), qv = (a0 * a0 + a1 * a1) + (b0 * b0 + b1 * b1);
                    float s = (sv.x + sv.y) + (sv.z + sv.w), q = (qv.x + qv.y) + (qv.z + qv.w);
                    s += __shfl_xor(s, 16); q += __shfl_xor(q, 16); s += __shfl_xor(s, 32); q += __shfl_xor(q, 32);
                    if (st) *(f32x2_t*)(st + (size_t)rl * 16) = (f32x2_t){s, q}; }
                if (TY == 5) { a0 = silu4(a0); a1 = silu4(a1); b0 = silu4(b0); b1 = silu4(b1); }
                if (TY == 6 && SMP) { a0 = sigmoid4(a0); a1 = sigmoid4(a1); b0 = sigmoid4(b0); b1 = sigmoid4(b1); }
                if (TY == 6) { unsigned char* gq = (unsigned char*)pr; if (SMP) { *(u32x2*)gq = (u32x2){pku8(a0), pku8(a1)}; *(u32x2*)(gq + 128) = (u32x2){pku8(b0), pku8(b1)}; } else { *(u32x2*)gq = (u32x2){pku8_t(a0), pku8_t(a1)}; *(u32x2*)(gq + 128) = (u32x2){pku8_t(b0), pku8_t(b1)}; } }
                else { store8(pr, a0, a1); store8(pr + 128, b0, b1); } }
        }
        if (!SMP) asm volatile("" ::: "memory");
    }
}
struct EpiP1T { bf16_t* pbuf; const float* SWl; const LAS float* rtab; const LAS float* swt; float* lnst;
    DEV void operator()(f32x4 (&acc)[2][2][4][2], const UnitD& u, const UnitD& un, const bool has_next, int wr, int wc, int fr, int fq) const {
        const int pn = u.pn, cb = 32 * wc + 8 * fq, row0 = u.pm * 256 + wr * 64 + fr; const bool smp = u.pm >= MPR / 256;
        const float* swb = SWl + 256 * pn + cb; const LAS float* sw = swt + u.aux * 256 + cb;
        const f32x4 s00 = *(const LAS f32x4*)(sw), s01 = *(const LAS f32x4*)(sw + 4), s10 = *(const LAS f32x4*)(sw + 128), s11 = *(const LAS f32x4*)(sw + 132);
        const LAS float* rt = rtab + u.aux * 256 + wr * 64 + fr;
        bf16_t* pb = pbuf + (size_t)row0 * PC + cb;
#define P1_DISPATCH(SM) \
        if (pn < 4) p1_rows<0, SM>(acc, pb + PZ + 128 * pn, rt, swb, row0, s00, s01, s10, s11); \
        else if (pn < 8) p1_rows<1, SM>(acc, pb + PABG + 128 * (pn - 4), rt, swb, row0, s00, s01, s10, s11); \
        else if (pn < 12) p1_rows<2, SM>(acc, pb + PUG + 128 * (pn - 8), rt, swb, row0, s00, s01, s10, s11); \
        else if (pn < 14) p1_rows<3, SM>(acc, pb + PGV + 256 * (pn - 12), rt, swb, row0, s00, s01, s10, s11, fq == 0 ? lnst + (size_t)row0 * 16 + 2 * (4 * (pn - 12) + wc) : nullptr); \
        else if (pn < 16) p1_rows<4, SM>(acc, pb + PCX + 256 * (pn - 14), rt, swb, row0, s00, s01, s10, s11); \
        else if (pn < 18) p1_rows<5, SM>(acc, pb + PSG + 256 * (pn - 16), rt, swb, row0, s00, s01, s10, s11); \
        else p1_rows<6, SM>(acc, (bf16_t*)((unsigned char*)(pb - cb + PGATE) + 256 * (pn - 18) + cb), rt, swb, row0, s00, s01, s10, s11);
        P1_DISPATCH(false)
#undef P1_DISPATCH
    } };
struct EpiP1S { bf16_t* pbuf; const float* SWl; const float* ssq;
    DEV void operator()(int pn, int row, int wc, int fq, f32x4 (&v)[1][2][2]) const {
        const int cb = 32 * wc + 8 * fq; const float r = row_rstd(ssq, row);
        const float* sw = SWl + (size_t)nidx_of(row) * NIN + 256 * pn + cb;
        const f32x4 a0 = v[0][0][0] * r + *(const f32x4*)(sw), a1 = v[0][0][1] * r + *(const f32x4*)(sw + 4), b0 = v[0][1][0] * r + *(const f32x4*)(sw + 128), b1 = v[0][1][1] * r + *(const f32x4*)(sw + 132);
        bf16_t* pr = pbuf + (size_t)row * PC + cb;
        if (pn < 4) store8_sc(pr + PZ + 128 * pn, a0 * b0, a1 * b1);
        else if (pn < 8) store8_sc(pr + PABG + 128 * (pn - 4), a0 * silu4(b0), a1 * silu4(b1));
        else if (pn < 12) store8_sc(pr + PUG + 128 * (pn - 8), gelu4(a0) * silu4(b0), gelu4(a1) * silu4(b1));
        else if (pn < 14) { bf16_t* o = pr + PGV + 256 * (pn - 12); store8_sc(o, gelu4(a0), gelu4(a1)); store8_sc(o + 128, gelu4(b0), gelu4(b1)); }
        else if (pn < 16) { bf16_t* o = pr + PCX + 256 * (pn - 14); store8_sc(o, a0, a1); store8_sc(o + 128, b0, b1); }
        else if (pn < 18) { bf16_t* o = pr + PSG + 256 * (pn - 16); store8_sc(o, silu4(a0), silu4(a1)); store8_sc(o + 128, silu4(b0), silu4(b1)); }
        else { unsigned char* gq = (unsigned char*)(pbuf + (size_t)row * PC + PGATE) + 256 * (pn - 18) + cb;
            st_sc8(gq, (u32x2){pku8(sigmoid4(a0)), pku8(sigmoid4(a1))}); st_sc8(gq + 128, (u32x2){pku8(sigmoid4(b0)), pku8(sigmoid4(b1))}); }
    } };
DEV void p1_sample_slice(const int tid, const int slice  , const bf16_t* xa, const bf16_t* Wl, const EpiP1S& e, LAS unsigned char* lds) {
    const int lane = tid & 63, w = __builtin_amdgcn_readfirstlane(tid >> 6), fr = lane & 15, fq = lane >> 4, pn = slice >> 2, wc = slice & 3, row = MPR + 16 * w + fr;
    const bf16_t* ap = xa + (size_t)row * D + 8 * fq; const bf16_t* bp = Wl + (size_t)(256 * pn + 32 * wc + fr) * D + 8 * fq;
    __syncthreads();
#pragma unroll
    for (int j = 0; j < 16; ++j) { const int b = w * 16 + j, q = b >> 5, ks = b & 31;
        __builtin_amdgcn_global_load_lds((const unsigned*)(bp + (size_t)(128 * (q >> 1) + 16 * (q & 1)) * D + 32 * ks), (LAS unsigned*)(lds + b * 1024), 16, 0, 0); }
    bf16x8 af[32];
#pragma unroll
    for (int ks = 0; ks < 32; ++ks) af[ks] = *(const bf16x8*)(ap + 32 * ks);
    f32x4 v[1][2][2];
#pragma unroll
    for (int q = 0; q < 4; ++q) v[0][q >> 1][q & 1] = (f32x4){0.f, 0.f, 0.f, 0.f};
    asm volatile("s_waitcnt vmcnt(0)" ::: "memory");
    __syncthreads();
#pragma unroll
    for (int ks = 0; ks < 32; ++ks)
#pragma unroll
        for (int q = 0; q < 4; ++q) { const bf16x8 bfr = *(const LAS bf16x8*)(lds + (q * 32 + ks) * 1024 + lane * 16);
            v[0][q >> 1][q & 1] = __builtin_amdgcn_mfma_f32_16x16x32_bf16(bfr, af[ks], v[0][q >> 1][q & 1], 0, 0, 0); }
    e(pn, row, wc, fq, v);
}
template <class Sched> DEV void p1_rtab(const Sched& S, const float* ssq, const float* SWl, LAS float* rtab, LAS float* swt) {
    int t = threadIdx.x; asm volatile("" : "+v"(t));
#pragma unroll
    for (int k = 0; k < 4; ++k) { const int q = t + 512 * k, i = q >> 8, rl = q & 255; UnitD u;
        if (S.next(i, u)) { rtab[q] = row_rstd(ssq, u.pm * 256 + rl); swt[q] = SWl[(size_t)(u.pm < MPR / 256 ? (u.pm >> 3) : NBP) * NIN + 256 * u.pn + rl]; } }
    __syncthreads();
}
template <bool IN16, bool LAST> struct EpiP4T { const float* gate; const float* atab_cur; const float* atab_next; const bf16_t* xa; bf16_t* xao; float* ssq; const float* xin; bf16_t* xb;
    DEV void operator()(f32x4 (&acc)[2][2][4][2], const UnitD& u, const UnitD& un, const bool has_next, int wr, int wc, int fr, int fq) const {
        const int pn = u.pn, nb = u.pm >> 3, col = 256 * pn + 32 * wc + 8 * fq, row0 = u.pm * 256 + wr * 64 + fr;
        const float* gp = gate + (size_t)nb * 3072 + col;
        f32x4 g[2][2], at[2][2], iv[2][2];
#pragma unroll
        for (int bj = 0; bj < 2; ++bj)
#pragma unroll
            for (int n = 0; n < 2; ++n) { g[bj][n] = *(const f32x4*)(gp + 128 * bj + 4 * n);
                at[bj][n] = LAST ? (f32x4){0.f, 0.f, 0.f, 0.f} : *(const f32x4*)(atab_next + (size_t)nb * D + col + 128 * bj + 4 * n);
                iv[bj][n] = IN16 ? rcp4(*(const f32x4*)(atab_cur + (size_t)nb * D + col + 128 * bj + 4 * n)) : (f32x4){0.f, 0.f, 0.f, 0.f}; }
        const size_t off0 = (size_t)row0 * D + col;
        f32x4 x[2][2], xn[2][2]; u32x4 xh[2], xhn[2];
#pragma unroll
        for (int bj = 0; bj < 2; ++bj) { if (IN16) xh[bj] = *(const u32x4*)(xa + off0 + 128 * bj); else { x[bj][0] = *(const f32x4*)(xin + off0 + 128 * bj); x[bj][1] = *(const f32x4*)(xin + off0 + 128 * bj + 4); } }
#pragma unroll
        for (int r = 0; r < 8; ++r) { const int ai = r >> 2, m = r & 3, rl = ai * HALF + m * 16, row = row0 + rl; float s = 0.f;
            if (r < 7) { const size_t offn = off0 + (size_t)(((r + 1) >> 2) * HALF + ((r + 1) & 3) * 16) * D;
#pragma unroll
                for (int bj = 0; bj < 2; ++bj) { if (IN16) xhn[bj] = *(const u32x4*)(xa + offn + 128 * bj); else { xn[bj][0] = *(const f32x4*)(xin + offn + 128 * bj); xn[bj][1] = *(const f32x4*)(xin + offn + 128 * bj + 4); } } }
            const size_t off = off0 + (size_t)rl * D;
#pragma unroll
            for (int bj = 0; bj < 2; ++bj) {
                if (IN16) { unpk8(xh[bj], x[bj][0], x[bj][1]); x[bj][0] *= iv[bj][0]; x[bj][1] *= iv[bj][1]; }
#pragma unroll
                for (int n = 0; n < 2; ++n) { const f32x4 t = x[bj][n] + g[bj][n] * acc[ai][bj][m][n]; x[bj][n] = t; s += (t.x * t.x + t.y * t.y) + (t.z * t.z + t.w * t.w); }
                if (LAST) store8(xb + off + 128 * bj, x[bj][0], x[bj][1]);
                else store8(xao + off + 128 * bj, x[bj][0] * at[bj][0], x[bj][1] * at[bj][1]); }
            s += __shfl_xor(s, 16); s += __shfl_xor(s, 32);
            if (fq == 0) ssq[row * 16 + 4 * pn + wc] = s;
#pragma unroll
            for (int bj = 0; bj < 2; ++bj) { xh[bj] = xhn[bj]; x[bj][0] = xn[bj][0]; x[bj][1] = xn[bj][1]; }
        }
    } };

struct SchedP3R { TileOrder T; const char* A; const char* B;
    DEV bool next(int i, UnitD& u) const { int pm, pc; const int seg = i % 3; if (!T.tile<WGM_P3>(i / 3, pm, pc)) return false; u.pm = pm; u.pn = pc; u.aux = seg;
        u.A = A + (size_t)pm * 256 * (1536 * 2) + (size_t)seg * (W * 2); u.B = B + (size_t)seg * D * (W * 2) + (size_t)pc * 128 * (W * 2); return true; } };
struct EpiP3R { f32x4 (&tot)[2][4][2]; u32x2 (&gpre)[8]; const bf16_t* pbuf; bf16_t* mg;
    DEV void prefetch(const UnitD& u, int wr, int wc, int fr, int fq) const {
        const unsigned char* gp = (const unsigned char*)(pbuf + (size_t)(u.pm * 256 + wr * 64 + fr) * PC + PGATE) + 1024 * u.aux + 128 * u.pn + 32 * wc + 8 * fq;
#pragma unroll
        for (int r = 0; r < 8; ++r) gpre[r] = *(const u32x2*)(gp + (size_t)((r >> 2) * HALF + (r & 3) * 16) * (PC * 2));
    }
    DEV void operator()(f32x4 (&acc)[2][1][4][2], const UnitD& u, const UnitD& un, const bool has_next, int wr, int wc, int fr, int fq) const {
        const int seg = u.aux, cb = 128 * u.pn + 32 * wc + 8 * fq, row0 = u.pm * 256 + wr * 64 + fr;
        bf16_t* o = mg + (size_t)row0 * D + cb;
        u32x2 g[8];
#pragma unroll
        for (int r = 0; r < 8; ++r) g[r] = gpre[r];
        if (has_next) prefetch(un, wr, wc, fr, fq);
        const float keep = seg ? 1.f : 0.f;
#pragma unroll
        for (int r = 0; r < 8; ++r) { const int ai = r >> 2, m = r & 3; const f32x4 g0 = gate4(g[r].x), g1 = gate4(g[r].y);
            const f32x4 t0 = acc[ai][0][m][0] * g0 + tot[ai][m][0] * keep, t1 = acc[ai][0][m][1] * g1 + tot[ai][m][1] * keep;
            tot[ai][m][0] = t0; tot[ai][m][1] = t1;
            if (seg == 2) store8(o + (size_t)(ai * HALF + m * 16) * D, t0, t1); }
    } };
#define XB_TMO      128
#define XB_XCNT(j)  (256  + 64 * (j))
#define XB_XSUB(j)  (1280 + 64 * (j))
#define XB_XGEN(j)  (2304 + 64 * (j))
#define XB_TOP      3328
#define XB_TOPGEN   3392
#define XCD_BAR_WORDS 3456
#define XB_LSUB(j)  (3456 + 64 * (j))
#define XB_LGEN(j)  (3968 + 64 * (j))
#define XB_CNT_P4S  4480
#define XB_CNT_P3S(j) (4608 + 64 * (j))
#define XB_CNT_P1S  4544
#define XB_SPIN_CAP (1u << 18)
DEV unsigned xb_ld(unsigned* p)              { return __hip_atomic_load(p, __ATOMIC_RELAXED, __HIP_MEMORY_SCOPE_AGENT); }
DEV unsigned xb_add(unsigned* p, unsigned v) { return __hip_atomic_fetch_add(p, v, __ATOMIC_RELAXED, __HIP_MEMORY_SCOPE_AGENT); }
DEV unsigned xb_xcc_id() { return (unsigned)__builtin_amdgcn_s_getreg((3 << 11) | 20) & 0xFu; }
#define XB_SPIN(cond, bar) do { unsigned _sp = 0; while (cond) { __builtin_amdgcn_s_sleep(1); \
    if ((++_sp & 255u) == 0u) { if (xb_ld(&(bar)[XB_TMO])) break; if (_sp > XB_SPIN_CAP) { atomicAdd(&(bar)[XB_TMO], 1u); break; } } } } while (0)
struct XcdBarrier { unsigned* bar; unsigned x; volatile LAS unsigned* st; };
DEV XcdBarrier xcd_barrier_post(unsigned* bar, volatile LAS unsigned* st) {
    XcdBarrier b; b.bar = bar; b.x = xb_xcc_id(); b.st = st;
    if (threadIdx.x == 0) st[4] = xb_add(&bar[XB_XCNT(b.x)], 1u);
    return b;
}
DEV void xcd_barrier_complete(unsigned* bar, unsigned x, unsigned& nloc, unsigned& nx, unsigned& even) {
    const unsigned G = gridDim.x * gridDim.y * gridDim.z;
    unsigned sum, cnt, mine, n32, sp = 0u;
    for (;;) {
        sum = 0u; cnt = 0u; mine = 0u; n32 = 0u;
#pragma unroll
        for (unsigned j = 0; j < 16; ++j) { const unsigned c = xb_ld(&bar[XB_XCNT(j)]); sum += c; cnt += (c > 0u) ? 1u : 0u; n32 += (j < 8u && c == 32u) ? 1u : 0u; mine = (j == x) ? c : mine; }
        if (sum == G) break;
        __builtin_amdgcn_s_sleep(1);
        if ((++sp & 255u) == 0u) { if (xb_ld(&bar[XB_TMO])) break; if (sp > XB_SPIN_CAP) { atomicAdd(&bar[XB_TMO], 1u); break; } }
    }
    nloc = mine > 0u ? mine : 1u; nx = cnt > 0u ? cnt : 1u;
    even = (sum == G && G == 256u && n32 == 8u) ? 1u : 0u;
}
DEV void xcd_barrier(const XcdBarrier& b) {
    asm volatile("s_waitcnt vmcnt(0)" ::: "memory");
    __syncthreads();
    if (threadIdx.x == 0) {
        unsigned* bar = b.bar; unsigned bx = b.x; asm volatile("" : "+s"(bar), "+s"(bx));
        __builtin_amdgcn_s_waitcnt(0);
        unsigned nloc = b.st[0], nx = b.st[1];
        if (nloc == 0u) { unsigned even; xcd_barrier_complete(bar, bx, nloc, nx, even); b.st[0] = nloc; b.st[1] = nx;
            b.st[2] = even ? bx * 32u + b.st[4] : (unsigned)blockIdx.x;
            b.st[3] = even; }
        const unsigned old = xb_add(&bar[XB_XSUB(bx)], 1u);
        const unsigned gen = old / nloc;
        if (old + 1u == (gen + 1u) * nloc) {
            __builtin_amdgcn_fence(__ATOMIC_RELEASE, "agent");
            asm volatile("s_waitcnt vmcnt(0)" ::: "memory");
            const unsigned og = xb_add(&bar[XB_TOP], 1u);
            const unsigned tg = og / nx;
            if (og + 1u == (tg + 1u) * nx) xb_add(&bar[XB_TOPGEN], 1u);
            else XB_SPIN(xb_ld(&bar[XB_TOPGEN]) == tg, bar);
            __builtin_amdgcn_fence(__ATOMIC_ACQUIRE, "agent");
            xb_add(&bar[XB_XGEN(bx)], 1u);
            asm volatile("s_waitcnt vmcnt(0)" ::: "memory");
        } else {
            XB_SPIN(xb_ld(&bar[XB_XGEN(bx)]) == gen, bar);
            __builtin_amdgcn_fence(__ATOMIC_ACQUIRE, "agent");
            asm volatile("s_waitcnt vmcnt(0)" ::: "memory");
        }
    }
    __syncthreads();
}
DEV void xcd_local_barrier(const XcdBarrier& b) {
    asm volatile("s_waitcnt vmcnt(0)" ::: "memory");
    __syncthreads();
    if (threadIdx.x == 0) {
        unsigned* bar = b.bar; unsigned bx = b.x; asm volatile("" : "+s"(bar), "+s"(bx));
        __builtin_amdgcn_s_waitcnt(0);
        const unsigned old = xb_add(&bar[XB_LSUB(bx)], 1u);
        const unsigned gen = old >> 5;
        if ((old & 31u) == 31u) xb_add(&bar[XB_LGEN(bx)], 1u);
        else XB_SPIN(xb_ld(&bar[XB_LGEN(bx)]) == gen, bar);
        __builtin_amdgcn_fence(__ATOMIC_ACQUIRE, "agent");
        asm volatile("s_waitcnt vmcnt(0)" ::: "memory");
    }
    __syncthreads();
}
constexpr bool LOCAL_BAR = true;
DEV void layer_barrier(const XcdBarrier& b) { if (LOCAL_BAR && b.st[3]) xcd_local_barrier(b); else xcd_barrier(b); }
template <class RowEpi> struct EpiRows { RowEpi e;
    DEV void operator()(f32x4 (&acc)[2][2][4][2], const UnitD& u, const UnitD& un, const bool has_next, int wr, int wc, int fr, int fq) const {
#pragma unroll
        for (int ai = 0; ai < 2; ++ai)
#pragma unroll
            for (int m = 0; m < 4; ++m) { f32x4 v[2][2] = {{acc[ai][0][m][0], acc[ai][0][m][1]}, {acc[ai][1][m][0], acc[ai][1][m][1]}};
                e(u.pn, u.pm * 256 + ai * HALF + wr * 64 + m * 16 + fr, wc, fq, v); asm volatile("" ::: "memory"); }
    } };
struct SchedP1 { TileOrder T; const char* A; const char* B;
    DEV bool next(int i, UnitD& u) const { int pm, pn; if (!T.tile<WGM_P1>(i, pm, pn)) return false; pn += (T.pm0 >> 3) * 4; pn -= pn >= 30 ? 30 : 0;   u.pm = pm; u.pn = pn; u.aux = i; u.A = A + (size_t)pm * 256 * (D * 2); u.B = B + (size_t)pn * 256 * (D * 2); return true; } };

struct SchedP4 { TileOrder T; const char* A; const char* B;
    DEV bool next(int i, UnitD& u) const { int pm, pn; if (!T.tile<WGM_P4>(i, pm, pn)) return false; u.pm = pm; u.pn = pn; u.aux = 0; u.A = A + (size_t)pm * 256 * (D * 2); u.B = B + (size_t)pn * 256 * (D * 2); return true; } };
struct EpiP3 { const bf16_t* pbuf; bf16_t* mg;
    DEV void operator()(int pn, int row, int wc, int fq, f32x4 (&v)[3][2][2]) const {
        const int cb = 256 * pn + 32 * wc + 8 * fq;
        const unsigned char* gp = (const unsigned char*)(pbuf + (size_t)row * PC + PGATE) + cb; bf16_t* o = mg + (size_t)row * D + cb;
        u32x2 g[3][2];
#pragma unroll
        for (int s = 0; s < 3; ++s) { g[s][0] = ld_sc8(gp + 1024 * s); g[s][1] = ld_sc8(gp + 1024 * s + 128); }
#pragma unroll
        for (int bj = 0; bj < 2; ++bj) { f32x4 t0 = v[0][bj][0] * gate4(g[0][bj].x), t1 = v[0][bj][1] * gate4(g[0][bj].y);
#pragma unroll
            for (int s = 1; s < 3; ++s) { t0 += v[s][bj][0] * gate4(g[s][bj].x); t1 += v[s][bj][1] * gate4(g[s][bj].y); }
            store8(o + 128 * bj, t0, t1); }
    } };
struct SchedSW { int G, c; const char* A; const char* B;
    DEV bool next(int i, UnitD& u) const { const int idx = i * G + c; if (idx >= DEPTH * 30) return false; const int l = idx / 30, pn = idx % 30; u.pm = 0; u.pn = pn + 32 * l; u.aux = l;
        u.A = A + (size_t)l * 256 * (D * 2); u.B = B + (size_t)l * NIN * (D * 2) + (size_t)pn * 256 * (D * 2); return true; } };
struct EpiSWx { float* SW;
    DEV void operator()(int pnx, int row, int wc, int fq, f32x4 (&v)[2][2]) const {
        if (row >= NBT) return;
        const int l = pnx >> 5, pn = pnx & 31;
        float* o = SW + (size_t)l * NBT * NIN + (size_t)row * NIN + 256 * pn + 32 * wc + 8 * fq;
        *(f32x4*)(o) = v[0][0]; *(f32x4*)(o + 4) = v[0][1]; *(f32x4*)(o + 128) = v[1][0]; *(f32x4*)(o + 132) = v[1][1];
    } };
struct EpiP4 { const float* gate  ; const float* atab_cur; const float* atab_next  ; const bf16_t* xa; bf16_t* xao; float* ssq; const float* xin  ; bf16_t* xb; int in16;
    DEV void operator()(int pn, int row, int wc, int fq, f32x4 (&vv)[1][2][2]) const {
        f32x4 (&v)[2][2] = vv[0];
        const int nb = nidx_of(row), col = 256 * pn + 32 * wc + 8 * fq;
        const float* gp = gate + (size_t)nb * 3072 + col;
        float s = 0.f;
#pragma unroll
        for (int bj = 0; bj < 2; ++bj) {
            f32x4 x0, x1;
            if (in16) { unpk8(*(const u32x4*)(xa + (size_t)row * D + col + 128 * bj), x0, x1); const float* ac = atab_cur + (size_t)nb * D + col + 128 * bj; x0 *= rcp4(*(const f32x4*)ac); x1 *= rcp4(*(const f32x4*)(ac + 4)); }
            else { x0 = *(const f32x4*)(xin + (size_t)row * D + col + 128 * bj); x1 = *(const f32x4*)(xin + (size_t)row * D + col + 128 * bj + 4); }
            const f32x4 t0 = x0 + *(const f32x4*)(gp + 128 * bj) * v[bj][0], t1 = x1 + *(const f32x4*)(gp + 128 * bj + 4) * v[bj][1];
            s += ((t0.x * t0.x + t0.y * t0.y) + (t0.z * t0.z + t0.w * t0.w)) + ((t1.x * t1.x + t1.y * t1.y) + (t1.z * t1.z + t1.w * t1.w));
            if (atab_next) { const float* ap = atab_next + (size_t)nb * D + col + 128 * bj; store8_sc(xao + (size_t)row * D + col + 128 * bj, t0 * *(const f32x4*)ap, t1 * *(const f32x4*)(ap + 4)); }
            else store8(xb + (size_t)row * D + col + 128 * bj, t0, t1);
        }
        s += __shfl_xor(s, 16); s += __shfl_xor(s, 32);
        if (fq == 0) __hip_atomic_store(ssq + row * 16 + 4 * pn + wc, s, __ATOMIC_RELAXED, __HIP_MEMORY_SCOPE_AGENT);
    } };


typedef short v4i16 __attribute__((ext_vector_type(4)));
constexpr int TP = 528, VT_OFF = 0, PM_OFF = 128 * TP;
DEV f32x4 unpk4(u32x2 r) { return (f32x4){bflo(r.x), bfhi(r.x), bflo(r.y), bfhi(r.y)}; }
DEV void p2_ln(const Ctx& c, int l, int ck, int hh, const bf16_t* pb, LAS unsigned char* lds) {
    int lane_ = c.lane; asm volatile("" : "+v"(lane_));
    const int lane = lane_, w = c.wave, p = lane >> 5, ch = 256 * hh + 8 * (lane & 31); const bool lastck = (ck & 15) == 15;
    const float* st = c.lnst + ((size_t)ck * 128 + 16 * w + (lane & 15)) * 16;
    const f32x4 t0 = *(const f32x4*)st, t1 = *(const f32x4*)(st + 4), t2 = *(const f32x4*)(st + 8), t3 = *(const f32x4*)(st + 12);
    u32x4 gv[8];
#pragma unroll
    for (int k = 0; k < 8; ++k) gv[k] = *(const u32x4*)(pb + (size_t)(16 * w + 2 * k + p) * PC + PGV + ch);
    const f32x4 g0 = *(const f32x4*)(c.lnv_g + l * W + ch), g1 = *(const f32x4*)(c.lnv_g + l * W + ch + 4), b0 = *(const f32x4*)(c.lnv_b + l * W + ch), b1 = *(const f32x4*)(c.lnv_b + l * W + ch + 4);
    const float s = ((t0.x + t0.z) + (t1.x + t1.z)) + ((t2.x + t2.z) + (t3.x + t3.z)), q = ((t0.y + t0.w) + (t1.y + t1.w)) + ((t2.y + t2.w) + (t3.y + t3.w));
    const float mu_l = s * (1.f / W), rstd_l = __builtin_amdgcn_rsqf(fmaxf(q * (1.f / W) - mu_l * mu_l, 0.f) + EPS);
    float* vout = c.out + O_VP + ((size_t)(l * NBP + (ck >> 4)) * 128) * W + ch;
#pragma unroll
    for (int k = 0; k < 8; ++k) { const int t = 16 * w + 2 * k + p;
        const float mu = __shfl(mu_l, 2 * k + p), rstd = __shfl(rstd_l, 2 * k + p);
        f32x4 x0 = (f32x4){bflo(gv[k].x), bfhi(gv[k].x), bflo(gv[k].y), bfhi(gv[k].y)}, x1 = (f32x4){bflo(gv[k].z), bfhi(gv[k].z), bflo(gv[k].w), bfhi(gv[k].w)};
        x0 = (x0 - mu) * rstd * g0 + b0; x1 = (x1 - mu) * rstd * g1 + b1;
        u32x4 o; o.x = pk2(x0.x, x0.y); o.y = pk2(x0.z, x0.w); o.z = pk2(x1.x, x1.y); o.w = pk2(x1.z, x1.w);
        *(LAS u32x4*)(lds + VT_OFF + t * TP + (lane & 31) * 16) = o;
        if (lastck) { *(f32x4*)(vout + (size_t)t * W) = x0; *(f32x4*)(vout + (size_t)t * W + 4) = x1; }
    }
}
template <int HH> DEV void p2_pool(const Ctx& c, int l, int ck, const bf16_t* pb, LAS unsigned char* lds) {
    constexpr int W0 = 2 << (2 * HH), W1 = 2 * W0, H = W1 - 1, NX = H + 16;
    int lane_ = c.lane; asm volatile("" : "+v"(lane_));
    const int lane = lane_, w = c.wave, gi = lane >> 5, cpos = (ck & 15) * 128, ch = 256 * HH + 4 * lane; const bool lastck = (ck & 15) == 15;
    f32x4 x[NX];
#pragma unroll
    for (int k = 0; k < NX; ++k) { const int tt = 16 * w - H + k; const bool valid = cpos + tt >= 0; const int tc = valid ? tt : 0;
        const u32x2 r = *(const u32x2*)(pb + (ptrdiff_t)tc * PC + PCX + ch); const f32x4 v = unpk4(r); x[k] = valid ? v : (f32x4){0.f, 0.f, 0.f, 0.f}; }
    f32x4 slo = x[H];
#pragma unroll
    for (int j = 1; j < W0; ++j) slo += x[H - j];
    f32x4 shi = slo;
#pragma unroll
    for (int j = W0; j < W1; ++j) shi += x[H - j];
    float* pout = c.out + O_POOLP + ((size_t)(l * NBP + (ck >> 4)) * 15) * W + ch;
#pragma unroll
    for (int i = 0; i < 16; ++i) { const int t = 16 * w + i, pos = cpos + t, wd = gi ? W1 : W0;
        const f32x4 s = gi ? shi : slo; const float inv = __builtin_amdgcn_rcpf((float)(wd < pos + 1 ? wd : pos + 1));
        const f32x4 pm = s * inv - x[H + i];
        *(LAS u32x2*)(lds + PM_OFF + t * TP + 8 * lane) = (u32x2){pk2(pm.x, pm.y), pk2(pm.z, pm.w)};
        if (lastck && t >= 113) *(f32x4*)(pout + (size_t)(t - 113) * W) = x[H + i];
        if (i < 15) { slo += x[H + i + 1] - x[H + i + 1 - W0]; shi += x[H + i + 1] - x[H + i + 1 - W1]; }
    }
}
DEV void p2_conv(const Ctx& c, int l, int ck, int hh, const bf16_t* pb) {
    int lane_ = c.lane; asm volatile("" : "+v"(lane_));
    const int lane = lane_, w = c.wave, cpos = (ck & 15) * 128, ch = 256 * hh + 4 * lane, row0 = ck * 128; const bool lastck = (ck & 15) == 15;
    const f32x4 cb = *(const f32x4*)(c.conv_b + l * W + ch), w0 = *(const f32x4*)(c.conv_w + (l * 3 + 0) * W + ch), w1 = *(const f32x4*)(c.conv_w + (l * 3 + 1) * W + ch), w2 = *(const f32x4*)(c.conv_w + (l * 3 + 2) * W + ch);
    f32x4 z[18];
#pragma unroll
    for (int k = 0; k < 18; ++k) { const int tt = 16 * w - 2 + k; const bool valid = cpos + tt >= 0; const int tc = valid ? tt : 0;
        const f32x4 v = unpk4(*(const u32x2*)(pb + (ptrdiff_t)tc * PC + PZ + ch)); z[k] = valid ? v : (f32x4){0.f, 0.f, 0.f, 0.f}; }
    float* cout = c.out + O_CONVP + ((size_t)(l * NBP + (ck >> 4)) * 2) * W + ch;
#pragma unroll
    for (int i = 0; i < 16; ++i) { const int t = 16 * w + i;
        const f32x4 abg = unpk4(*(const u32x2*)(pb + (size_t)t * PC + PABG + ch));
        const f32x4 o = abg * (cb + w0 * z[i] + w1 * z[i + 1] + w2 * z[i + 2]);
        *(u32x2*)(c.y + (size_t)(row0 + t) * 1536 + ch) = (u32x2){pk2(o.x, o.y), pk2(o.z, o.w)};
        if (lastck && t >= 126) *(f32x4*)(cout + (size_t)(t - 126) * W) = z[i + 2];
    }
}
constexpr int TPS = 1040;
DEV void p2_sample_block(const Ctx& c, int l, int sb, LAS unsigned char* ldsw) {
    const int lane = c.lane, fr = lane & 15, fq = lane >> 4, ch = 8 * lane, h = lane >> 3, g = lane >> 4;
    {
        const int i = c.wave, n = 8 * sb + i, row = MPR + n; const bf16_t* pr = c.pbuf + (size_t)row * PC; bf16_t* yr = c.y + (size_t)row * 1536;
        const float* sc = c.state_conv + ((size_t)(l * NSM + n) * 2) * W + ch; const float* sp = c.state_pool + ((size_t)(l * NSM + n) * 15) * W + ch;
        const u32x4 qz = ld_sc16(pr + PZ + ch), qa = ld_sc16(pr + PABG + ch), qg = ld_sc16(pr + PGV + ch), qu = ld_sc16(pr + PUG + ch), qc = ld_sc16(pr + PCX + ch);
        const f32x4 s00 = *(const f32x4*)(sc), s01 = *(const f32x4*)(sc + 4), s10 = *(const f32x4*)(sc + W), s11 = *(const f32x4*)(sc + W + 4);
        f32x4 st0[15], st1[15];
#pragma unroll
        for (int k = 7; k < 15; ++k) { st0[k] = *(const f32x4*)(sp + (size_t)k * W); st1[k] = *(const f32x4*)(sp + (size_t)k * W + 4); }
        const f32x4 cb0 = *(const f32x4*)(c.conv_b + l * W + ch), cb1 = *(const f32x4*)(c.conv_b + l * W + ch + 4);
        const f32x4 w0a = *(const f32x4*)(c.conv_w + (l * 3 + 0) * W + ch), w0b = *(const f32x4*)(c.conv_w + (l * 3 + 0) * W + ch + 4);
        const f32x4 w1a = *(const f32x4*)(c.conv_w + (l * 3 + 1) * W + ch), w1b = *(const f32x4*)(c.conv_w + (l * 3 + 1) * W + ch + 4);
        const f32x4 w2a = *(const f32x4*)(c.conv_w + (l * 3 + 2) * W + ch), w2b = *(const f32x4*)(c.conv_w + (l * 3 + 2) * W + ch + 4);
        const f32x4 lg0 = *(const f32x4*)(c.lnv_g + l * W + ch), lg1 = *(const f32x4*)(c.lnv_g + l * W + ch + 4), lb0 = *(const f32x4*)(c.lnv_b + l * W + ch), lb1 = *(const f32x4*)(c.lnv_b + l * W + ch + 4);
        const float w00 = c.sgu_w[(size_t)(l * 8 + h) * 128 * 128], b00 = c.sgu_b[(l * 8 + h) * 128], invw = 1.f / (float)(2 << g);
        asm volatile("" ::: "memory");
        {
            f32x4 z0, z1, a0, a1; unpk8(qz, z0, z1); unpk8(qa, a0, a1);
            const f32x4 ya = a0 * (cb0 + w0a * s00 + w1a * s10 + w2a * z0), yb = a1 * (cb1 + w0b * s01 + w1b * s11 + w2b * z1);
#pragma unroll
            for (int k = 0; k < 7; ++k) { st0[k] = *(const f32x4*)(sp + (size_t)k * W); st1[k] = *(const f32x4*)(sp + (size_t)k * W + 4); }
            store8(yr + ch, ya, yb);
            float* o = c.out + O_CONVS + ((size_t)(l * NSM + n) * 2) * W + ch;
            *(f32x4*)(o) = s10; *(f32x4*)(o + 4) = s11; *(f32x4*)(o + W) = z0; *(f32x4*)(o + W + 4) = z1;
        }
        {
            f32x4 x0, x1, u0, u1; unpk8(qg, x0, x1); unpk8(qu, u0, u1);
            float s = ((x0.x + x0.y) + (x0.z + x0.w)) + ((x1.x + x1.y) + (x1.z + x1.w));
            float q = ((x0.x * x0.x + x0.y * x0.y) + (x0.z * x0.z + x0.w * x0.w)) + ((x1.x * x1.x + x1.y * x1.y) + (x1.z * x1.z + x1.w * x1.w));
#pragma unroll
            for (int o = 1; o < 64; o <<= 1) { s += __shfl_xor(s, o); q += __shfl_xor(q, o); }
            const float mu = s * (1.f / W), var = fmaxf(q * (1.f / W) - mu * mu, 0.f), rstd = __builtin_amdgcn_rsqf(var + EPS);
            x0 = (x0 - mu) * rstd * lg0 + lb0; x1 = (x1 - mu) * rstd * lg1 + lb1;
            float* vo = c.out + O_VS + (size_t)(l * NSM + n) * W + ch; *(f32x4*)(vo) = x0; *(f32x4*)(vo + 4) = x1;
            store8(yr + 512 + ch, u0 * (x0 * w00 + b00), u1 * (x1 * w00 + b00));
        }
        {
            f32x4 c0, c1; unpk8(qc, c0, c1);
            float* po = c.out + O_POOLS + ((size_t)(l * NSM + n) * 15) * W + ch;
            f32x4 r0 = c0, r1 = c1, s2a, s2b, s4a, s4b, s8a, s8b;
#pragma unroll
            for (int k = 14; k >= 0; --k) {
                if (k >= 1) { *(f32x4*)(po + (size_t)(k - 1) * W) = st0[k]; *(f32x4*)(po + (size_t)(k - 1) * W + 4) = st1[k]; }
                r0 += st0[k]; r1 += st1[k];
                if (k == 14) { s2a = r0; s2b = r1; } if (k == 12) { s4a = r0; s4b = r1; } if (k == 8) { s8a = r0; s8b = r1; } }
            *(f32x4*)(po + (size_t)14 * W) = c0; *(f32x4*)(po + (size_t)14 * W + 4) = c1;
            const f32x4 sa = g == 0 ? s2a : g == 1 ? s4a : g == 2 ? s8a : r0, sb2 = g == 0 ? s2b : g == 1 ? s4b : g == 2 ? s8b : r1;
            const f32x4 p0 = sa * invw - c0, p1 = sb2 * invw - c1;
            u32x4 o; o.x = pk2(p0.x, p0.y); o.y = pk2(p0.z, p0.w); o.z = pk2(p1.x, p1.y); o.w = pk2(p1.z, p1.w);
            *(LAS u32x4*)(ldsw + i * TPS + 16 * lane) = o;
        }
    }
    __syncthreads();
    const int row = MPR + 8 * sb + (fr & 7); const bf16_t* pr = c.pbuf + (size_t)row * PC; bf16_t* yr = c.y + (size_t)row * 1536;
    bf16x8 bw[2][4][2]; u32x4 sgv[2]; f32x4 pbv[2][2], psv[2][2];
#pragma unroll
    for (int gi2 = 0; gi2 < 2; ++gi2) { const int gq = 2 * c.wave + gi2, g2 = gq >> 2, nq = gq & 3, cc = 128 * g2 + 32 * nq + 8 * fq;
        const bf16_t* pw = c.PoolWT + ((size_t)(l * 4 + g2) * 128 + 32 * nq + fr) * 128 + 8 * fq;
#pragma unroll
        for (int ks = 0; ks < 4; ++ks) { bw[gi2][ks][0] = *(const bf16x8*)(pw + 32 * ks); bw[gi2][ks][1] = *(const bf16x8*)(pw + 16 * 128 + 32 * ks); }
        sgv[gi2] = ld_sc16(pr + PSG + cc);
        pbv[gi2][0] = *(const f32x4*)(c.pool_b + l * W + cc); pbv[gi2][1] = *(const f32x4*)(c.pool_b + l * W + cc + 4); psv[gi2][0] = *(const f32x4*)(c.pool_scale + l * W + cc); psv[gi2][1] = *(const f32x4*)(c.pool_scale + l * W + cc + 4); }
#pragma unroll
    for (int gi2 = 0; gi2 < 2; ++gi2) { const int gq = 2 * c.wave + gi2, g2 = gq >> 2, nq = gq & 3, cc = 128 * g2 + 32 * nq + 8 * fq;
        f32x4 a0 = (f32x4){0.f, 0.f, 0.f, 0.f}, a1 = (f32x4){0.f, 0.f, 0.f, 0.f};
#pragma unroll
        for (int ks = 0; ks < 4; ++ks) { const bf16x8 af = *(const LAS bf16x8*)(ldsw + fr * TPS + 2 * (128 * g2 + 32 * ks + 8 * fq));
            a0 = __builtin_amdgcn_mfma_f32_16x16x32_bf16(bw[gi2][ks][0], af, a0, 0, 0, 0); a1 = __builtin_amdgcn_mfma_f32_16x16x32_bf16(bw[gi2][ks][1], af, a1, 0, 0, 0); }
        f32x4 g0v, g1v; unpk8(sgv[gi2], g0v, g1v);
        if (fr < 8) store8(yr + 1024 + cc, (a0 + pbv[gi2][0]) * psv[gi2][0] * g0v, (a1 + pbv[gi2][1]) * psv[gi2][1] * g1v);
    }
}

DEV void p2_mm(const Ctx& c, const int l, const int ck, const int hh, const bf16_t* pb, LAS unsigned char* lds) {
    int lane_ = c.lane; asm volatile("" : "+v"(lane_));
    const int lane = lane_, w = c.wave, fr = lane & 15, fq = lane >> 4, row0 = ck * 128;
    const int hq = w >> 1, a = w & 1, h = 4 * hh + hq;
    bf16x8 wf[4][4]; u32x4 ug[4][2]; float bias[4];
    { const bf16_t* wm = c.SguW + ((size_t)(l * 8 + h) * 128) * 128;
#pragma unroll
      for (int i = 0; i < 4; ++i) { const int tb = a ? (i == 0 ? 1 : i == 1 ? 2 : i == 2 ? 5 : 6) : (i == 0 ? 0 : i == 1 ? 3 : i == 2 ? 4 : 7), t = 16 * tb + fr;
#pragma unroll
          for (int ks = 0; ks < 4; ++ks) wf[i][ks] = *(const bf16x8*)(wm + (size_t)t * 128 + 32 * ks + 8 * fq);
      } }
    __syncthreads();
#pragma unroll
    for (int i = 0; i < 4; ++i) { const int tb = a ? (i == 0 ? 1 : i == 1 ? 2 : i == 2 ? 5 : 6) : (i == 0 ? 0 : i == 1 ? 3 : i == 2 ? 4 : 7), t = 16 * tb + fr;
        bias[i] = c.sgu_b[(l * 8 + h) * 128 + t];
#pragma unroll
        for (int c2 = 0; c2 < 2; ++c2) ug[i][c2] = *(const u32x4*)(pb + (size_t)t * PC + PUG + 256 * hh + 64 * hq + 32 * c2 + 8 * fq); }
    f32x4 acc[4][4];
#pragma unroll
    for (int i = 0; i < 4; ++i)
#pragma unroll
        for (int cc = 0; cc < 4; ++cc) acc[i][cc] = (f32x4){0.f, 0.f, 0.f, 0.f};
    { const int q = fr >> 2, p = fr & 3;
#pragma unroll
      for (int ks = 0; ks < 4; ++ks) {
        bf16x8 vb[4];
#pragma unroll
        for (int cc = 0; cc < 4; ++cc) { const int col = 64 * hq + 32 * (cc >> 1) + 8 * p + 4 * (cc & 1);
            const v4i16 lo = __builtin_amdgcn_ds_read_tr16_b64_v4i16((LAS v4i16*)(lds + VT_OFF + (32 * ks + 8 * fq + q) * TP + 2 * col));
            const v4i16 hi = __builtin_amdgcn_ds_read_tr16_b64_v4i16((LAS v4i16*)(lds + VT_OFF + (32 * ks + 8 * fq + 4 + q) * TP + 2 * col));
            vb[cc] = (bf16x8){lo[0], lo[1], lo[2], lo[3], hi[0], hi[1], hi[2], hi[3]}; }
#pragma unroll
        for (int i = 0; i < 4; ++i) { const int tb = a ? (i == 0 ? 1 : i == 1 ? 2 : i == 2 ? 5 : 6) : (i == 0 ? 0 : i == 1 ? 3 : i == 2 ? 4 : 7);
            if (ks <= (tb >> 1)) {
#pragma unroll
                for (int cc = 0; cc < 4; ++cc) acc[i][cc] = __builtin_amdgcn_mfma_f32_16x16x32_bf16(vb[cc], wf[i][ks], acc[i][cc], 0, 0, 0); } }
      } }
    asm volatile("" ::: "memory");
    const int gi2 = w >> 2, nq = w & 3, chc = 256 * hh + 128 * gi2 + 32 * nq + 8 * fq;
    bf16x8 pw0[4], pw1[4]; u32x4 sgv[8];
    { const bf16_t* pw = c.PoolWT + ((size_t)(l * 4 + 2 * hh + gi2) * 128 + 32 * nq + fr) * 128 + 8 * fq;
#pragma unroll
      for (int ks = 0; ks < 4; ++ks) { pw0[ks] = *(const bf16x8*)(pw + 32 * ks); pw1[ks] = *(const bf16x8*)(pw + 16 * 128 + 32 * ks); }
#pragma unroll
      for (int m = 0; m < 8; ++m) sgv[m] = *(const u32x4*)(pb + (size_t)(16 * m + fr) * PC + PSG + chc); }
    const f32x4 pb0 = *(const f32x4*)(c.pool_b + l * W + chc), pb1 = *(const f32x4*)(c.pool_b + l * W + chc + 4), ps0 = *(const f32x4*)(c.pool_scale + l * W + chc), ps1 = *(const f32x4*)(c.pool_scale + l * W + chc + 4);
#pragma unroll
    for (int i = 0; i < 4; ++i) { const int tb = a ? (i == 0 ? 1 : i == 1 ? 2 : i == 2 ? 5 : 6) : (i == 0 ? 0 : i == 1 ? 3 : i == 2 ? 4 : 7), t = 16 * tb + fr;
#pragma unroll
        for (int c2 = 0; c2 < 2; ++c2) { f32x4 u0, u1; unpk8(ug[i][c2], u0, u1);
            store8(c.y + (size_t)(row0 + t) * 1536 + 512 + 256 * hh + 64 * hq + 32 * c2 + 8 * fq, (acc[i][2 * c2] + bias[i]) * u0, (acc[i][2 * c2 + 1] + bias[i]) * u1); } }
    f32x4 ac2[8][2];
#pragma unroll
    for (int m = 0; m < 8; ++m) { ac2[m][0] = (f32x4){0.f, 0.f, 0.f, 0.f}; ac2[m][1] = (f32x4){0.f, 0.f, 0.f, 0.f}; }
#pragma unroll
    for (int ks = 0; ks < 4; ++ks)
#pragma unroll
        for (int m = 0; m < 8; ++m) { const bf16x8 af = *(const LAS bf16x8*)(lds + PM_OFF + (16 * m + fr) * TP + 2 * (128 * gi2 + 32 * ks + 8 * fq));
            ac2[m][0] = __builtin_amdgcn_mfma_f32_16x16x32_bf16(pw0[ks], af, ac2[m][0], 0, 0, 0); ac2[m][1] = __builtin_amdgcn_mfma_f32_16x16x32_bf16(pw1[ks], af, ac2[m][1], 0, 0, 0); }
#pragma unroll
    for (int m = 0; m < 8; ++m) { f32x4 s0, s1; unpk8(sgv[m], s0, s1);
        store8(c.y + (size_t)(row0 + 16 * m + fr) * 1536 + 1024 + chc, (ac2[m][0] + pb0) * ps0 * s0, (ac2[m][1] + pb1) * ps1 * s1); }
    __syncthreads();
}
template <int HH> DEV void p2_item_front(const Ctx& c, const int l, const int ck, const bf16_t* pb, LAS unsigned char* lds) {
    constexpr int W0 = 2 << (2 * HH), W1 = 2 * W0, H = W1 - 1, NX = H + 16;
    int lane_ = c.lane; asm volatile("" : "+v"(lane_));
    const int lane = lane_, w = c.wave, p = lane >> 5, gi = lane >> 5, cpos = (ck & 15) * 128, row0 = ck * 128; const bool lastck = (ck & 15) == 15;
    const int ch8 = 256 * HH + 8 * (lane & 31), ch4 = 256 * HH + 4 * lane;
    const float* st = c.lnst + ((size_t)ck * 128 + 16 * w + (lane & 15)) * 16;
    const f32x4 t0 = *(const f32x4*)st, t1 = *(const f32x4*)(st + 4), t2 = *(const f32x4*)(st + 8), t3 = *(const f32x4*)(st + 12);
    u32x4 gv[8];
#pragma unroll
    for (int k = 0; k < 8; ++k) gv[k] = *(const u32x4*)(pb + (size_t)(16 * w + 2 * k + p) * PC + PGV + ch8);
    const f32x4 g0 = *(const f32x4*)(c.lnv_g + l * W + ch8), g1 = *(const f32x4*)(c.lnv_g + l * W + ch8 + 4), b0 = *(const f32x4*)(c.lnv_b + l * W + ch8), b1 = *(const f32x4*)(c.lnv_b + l * W + ch8 + 4);
    u32x2 xr[NX];
#pragma unroll
    for (int k = 0; k < NX; ++k) { const int tt = 16 * w - H + k; const bool valid = cpos + tt >= 0; const int tc = valid ? tt : 0;
        const u32x2 r = *(const u32x2*)(pb + (ptrdiff_t)tc * PC + PCX + ch4); xr[k] = valid ? r : (u32x2){0u, 0u}; }
    {
        const float s = ((t0.x + t0.z) + (t1.x + t1.z)) + ((t2.x + t2.z) + (t3.x + t3.z)), q = ((t0.y + t0.w) + (t1.y + t1.w)) + ((t2.y + t2.w) + (t3.y + t3.w));
        const float mu_l = s * (1.f / W), rstd_l = __builtin_amdgcn_rsqf(fmaxf(q * (1.f / W) - mu_l * mu_l, 0.f) + EPS);
        float* vout = c.out + O_VP + ((size_t)(l * NBP + (ck >> 4)) * 128) * W + ch8;
#pragma unroll
        for (int k = 0; k < 8; ++k) { const int t = 16 * w + 2 * k + p;
            const float mu = __shfl(mu_l, 2 * k + p), rstd = __shfl(rstd_l, 2 * k + p);
            f32x4 x0 = (f32x4){bflo(gv[k].x), bfhi(gv[k].x), bflo(gv[k].y), bfhi(gv[k].y)}, x1 = (f32x4){bflo(gv[k].z), bfhi(gv[k].z), bflo(gv[k].w), bfhi(gv[k].w)};
            x0 = (x0 - mu) * rstd * g0 + b0; x1 = (x1 - mu) * rstd * g1 + b1;
            u32x4 o; o.x = pk2(x0.x, x0.y); o.y = pk2(x0.z, x0.w); o.z = pk2(x1.x, x1.y); o.w = pk2(x1.z, x1.w);
            *(LAS u32x4*)(lds + VT_OFF + t * TP + (lane & 31) * 16) = o;
            if (lastck) { *(f32x4*)(vout + (size_t)t * W) = x0; *(f32x4*)(vout + (size_t)t * W + 4) = x1; }
        }
    }
    const f32x4 cb = *(const f32x4*)(c.conv_b + l * W + ch4), w0 = *(const f32x4*)(c.conv_w + (l * 3 + 0) * W + ch4), w1 = *(const f32x4*)(c.conv_w + (l * 3 + 1) * W + ch4), w2 = *(const f32x4*)(c.conv_w + (l * 3 + 2) * W + ch4);
    u32x2 zr[18], ar[16];
#pragma unroll
    for (int k = 0; k < 18; ++k) { const int tt = 16 * w - 2 + k; const bool valid = cpos + tt >= 0; const int tc = valid ? tt : 0;
        const u32x2 r = *(const u32x2*)(pb + (ptrdiff_t)tc * PC + PZ + ch4); zr[k] = valid ? r : (u32x2){0u, 0u}; }
#pragma unroll
    for (int i = 0; i < 16; ++i) ar[i] = *(const u32x2*)(pb + (size_t)(16 * w + i) * PC + PABG + ch4);
    {
        f32x4 slo = unpk4(xr[H]);
#pragma unroll
        for (int j = 1; j < W0; ++j) slo += unpk4(xr[H - j]);
        f32x4 shi = slo;
#pragma unroll
        for (int j = W0; j < W1; ++j) shi += unpk4(xr[H - j]);
        float* pout = c.out + O_POOLP + ((size_t)(l * NBP + (ck >> 4)) * 15) * W + ch4;
#pragma unroll
        for (int i = 0; i < 16; ++i) { const int t = 16 * w + i, pos = cpos + t, wd = gi ? W1 : W0;
            const f32x4 sm = gi ? shi : slo, xc = unpk4(xr[H + i]); const float inv = __builtin_amdgcn_rcpf((float)(wd < pos + 1 ? wd : pos + 1));
            const f32x4 pm = sm * inv - xc;
            *(LAS u32x2*)(lds + PM_OFF + t * TP + 8 * lane) = (u32x2){pk2(pm.x, pm.y), pk2(pm.z, pm.w)};
            if (lastck && t >= 113) *(f32x4*)(pout + (size_t)(t - 113) * W) = xc;
            if (i < 15) { const f32x4 xn = unpk4(xr[H + i + 1]); slo += xn - unpk4(xr[H + i + 1 - W0]); shi += xn - unpk4(xr[H + i + 1 - W1]); }
        }
    }
    {
        float* cout = c.out + O_CONVP + ((size_t)(l * NBP + (ck >> 4)) * 2) * W + ch4;
#pragma unroll
        for (int i = 0; i < 16; ++i) { const int t = 16 * w + i;
            const f32x4 abg = unpk4(ar[i]), z2 = unpk4(zr[i + 2]);
            const f32x4 o = abg * (cb + w0 * unpk4(zr[i]) + w1 * unpk4(zr[i + 1]) + w2 * z2);
            *(u32x2*)(c.y + (size_t)(row0 + t) * 1536 + ch4) = (u32x2){pk2(o.x, o.y), pk2(o.z, o.w)};
            if (lastck && t >= 126) *(f32x4*)(cout + (size_t)(t - 126) * W) = z2;
        }
    }
}
DEV void ph_p2_prompt(const Args& a, int l, LAS unsigned char* lds) {
    LAUNDER_CTX(a);
    VB_LOAD(lds);
    {
        const int ck = 16 * vx_ + (vr_ >> 1), hh = vr_ & 1; const bf16_t* pb = c.pbuf + (size_t)ck * 128 * PC;
        { if (hh) p2_item_front<1>(c, l, ck, pb, lds); else p2_item_front<0>(c, l, ck, pb, lds); }
        p2_mm(c, l, ck, hh, pb, lds);
    }
    if (vr_ >= 30) {
        unsigned* ctl = (unsigned*)(a.ws + WS_CTL + z_);
        if (threadIdx.x == 0) { XB_SPIN(xb_ld(&ctl[XB_CNT_P1S]) < 960u * (unsigned)(l + 1), ctl); __builtin_amdgcn_fence(__ATOMIC_ACQUIRE, "agent"); asm volatile("s_waitcnt vmcnt(0)" ::: "memory"); }
        __syncthreads();
        p2_sample_block(c, l, 2 * vx_ + (vr_ - 30), lds); __syncthreads(); }
}
DEV void ph_final(const Args& a, LAS unsigned char* lds) {
    LAUNDER_CTX(a); VB_LOAD(lds);
    const int lane = c.lane;
#pragma unroll 2
    for (int i = 8 * vr_ + c.wave; i < 2048 + 16; i += 256) { const int row = i < 2048 ? 2048 * vx_ + i : MPR + 16 * vx_ + (i - 2048);
        const float r = row_rstd(c.ssq, row);
#pragma unroll
        for (int j = 0; j < 2; ++j) { f32x4 x0, x1; unpk8(*((const u32x4*)(c.xb + (size_t)row * D) + lane + 64 * j), x0, x1);
            const f32x4* gp = (const f32x4*)c.final_g + 2 * lane + 128 * j; f32x4* o = (f32x4*)(c.out + (size_t)row * D) + 2 * lane + 128 * j;
            o[0] = x0 * r * gp[0]; o[1] = x1 * r * gp[1]; }
    }
}

__global__ __launch_bounds__(NTHREADS, 2) void mega_fwd(Args a) {
    extern __shared__ __attribute__((aligned(16))) unsigned char lds[];
    LAS unsigned char* ldsp = (LAS unsigned char*)lds;
    if (threadIdx.x < 16) ((LAS unsigned*)(ldsp + LDSCTL_OFF))[threadIdx.x] = 0u;
    __syncthreads();
    const XcdBarrier bar = xcd_barrier_post((unsigned*)(a.ws + WS_CTL), (volatile LAS unsigned*)(ldsp + LDSCTL_OFF));
    ph_convert(a, lds, 0, 0);
    xcd_barrier(bar);
    { LAUNDER_CTX(a); int bx_ = blockIdx.x, gx_ = gridDim.x; asm volatile("" : "+s"(bx_), "+s"(gx_)); SchedMod S{gx_, bx_, (const char*)c.scb, (const char*)c.WadaT}; EpiRows<EpiMod> E{EpiMod{c.mod, c.atab, c.shb, c.b_ada, c.norm_g}}; gemm_phase(ldsp, D * 2, D * 2, D / BK, S, E); }
    ph_convert(a, lds, 1, (int)gridDim.x > 96 ? 48 : 0);
    xcd_barrier(bar);
    { LAUNDER_CTX(a); int bx_ = blockIdx.x, gx_ = gridDim.x; asm volatile("" : "+s"(bx_), "+s"(gx_)); SchedSW S{gx_, bx_, (const char*)c.shb, (const char*)c.WinT}; EpiRows<EpiSWx> E{EpiSWx{c.SW}}; gemm_phase(ldsp, D * 2, D * 2, D / BK, S, E); }
    ph_xa0(a);
    xcd_barrier(bar);
#pragma unroll 1
    for (int l = 0; l < DEPTH; ++l) {
        { LAUNDER_CTX(a); VB_LOAD(ldsp); SchedP1 S; S.T.init(8, NIN / 256, 32, vr_, 8 * vx_); S.A = (const char*)((l & 1) ? c.xa2 : c.xa); S.B = (const char*)(c.WinT + (size_t)l * NIN * D);
          p1_rtab(S, c.ssq, c.SW + (size_t)l * NBT * NIN, (LAS float*)(ldsp + RTAB_OFF), (LAS float*)(ldsp + SWT_OFF));
          EpiP1T E{c.pbuf, c.SW + (size_t)l * NBT * NIN, (const LAS float*)(ldsp + RTAB_OFF), (const LAS float*)(ldsp + SWT_OFF), c.lnst};
          gemm_phase(ldsp, D * 2, D * 2, D / BK, S, E);
          if (vr_ >= 16) {
              const EpiP1S es{c.pbuf, c.SW + (size_t)l * NBT * NIN, c.ssq};
              const int spn = vx_ + 8 * ((vr_ - 16) >> 2), sl = 4 * spn + (vr_ & 3);
              if (spn < 30) { unsigned* ctl = (unsigned*)(a.ws + WS_CTL + z_);
                  if (threadIdx.x == 0) { XB_SPIN(xb_ld(&ctl[XB_CNT_P4S]) < 128u * (unsigned)l, ctl);
                      __builtin_amdgcn_fence(__ATOMIC_ACQUIRE, "agent"); asm volatile("s_waitcnt vmcnt(0)" ::: "memory"); }
                  p1_sample_slice(c.tid, sl, (l & 1) ? c.xa2 : c.xa, c.WinT + (size_t)l * NIN * D, es, ldsp);
                  asm volatile("s_waitcnt vmcnt(0)" ::: "memory");
                  if (c.lane == 0) xb_add(&ctl[XB_CNT_P1S], 1u); } } }
        layer_barrier(bar);
        ph_p2_prompt(a, l, ldsp);
        layer_barrier(bar);
        { LAUNDER_CTX(a); VB_LOAD(ldsp); const EpiP3 e3{c.pbuf, c.mg};
          if (vr_ < 16) { mini_gemm<3, 2>(a, ldsp, vx_ | (vr_ << 3), c.y, 1536, W, c.WbT + (size_t)l * 3 * D * W, W, (size_t)D * W, e3);
              if (threadIdx.x == 0) { asm volatile("s_waitcnt vmcnt(0)" ::: "memory"); xb_add((unsigned*)(a.ws + WS_CTL + z_) + XB_CNT_P3S(vx_), 1u); } }
          SchedP3R S; S.T.init(8, 8, 32, vr_, 8 * vx_); S.A = (const char*)c.y; S.B = (const char*)(c.WbT + (size_t)l * 3 * D * W);
          f32x4 tot[2][4][2];
#pragma unroll
          for (int i0 = 0; i0 < 2; ++i0)
#pragma unroll
              for (int i1 = 0; i1 < 4; ++i1) { tot[i0][i1][0] = (f32x4){0.f, 0.f, 0.f, 0.f}; tot[i0][i1][1] = (f32x4){0.f, 0.f, 0.f, 0.f}; }
          u32x2 gpre[8]; EpiP3R E{tot, gpre, c.pbuf, c.mg};
          { UnitD u0; int t_ = threadIdx.x; asm volatile("" : "+v"(t_)); const int wv = __builtin_amdgcn_readfirstlane(t_ >> 6); if (S.next(0, u0)) E.prefetch(u0, wv >> 2, wv & 3, t_ & 15, (t_ & 63) >> 4); }
          gemm_phase<EpiP3R, SchedP3R, 1>(ldsp, 1536 * 2, W * 2, W / BK, S, E);
          if (vr_ >= 16) {
              unsigned* ctl = (unsigned*)(a.ws + WS_CTL + z_);
              if (threadIdx.x == 0) { XB_SPIN(xb_ld(&ctl[XB_CNT_P3S(vx_)]) < 16u * (unsigned)(l + 1), ctl); __builtin_amdgcn_fence(__ATOMIC_ACQUIRE, "agent"); asm volatile("s_waitcnt vmcnt(0)" ::: "memory"); }
              __syncthreads();
              const float* gate = c.mod + (size_t)l * NBT * 3072 + 2048; const float* atc = c.atab + (size_t)l * NBT * D; const float* atn = l + 1 < DEPTH ? c.atab + (size_t)(l + 1) * NBT * D : nullptr;
              const EpiP4 e4{gate, atc, atn, (l & 1) ? c.xa2 : c.xa, (l & 1) ? c.xa : c.xa2, c.ssq, c.x_sample - (size_t)MPR * D, c.xb, l > 0};
              mini_gemm<1, 4>(a, ldsp, vx_ | ((vr_ - 16) << 3), c.mg, D, 0, c.WoT + (size_t)l * D * D, D, (size_t)0, e4);
              if (threadIdx.x == 0) { asm volatile("s_waitcnt vmcnt(0)" ::: "memory"); xb_add(&ctl[XB_CNT_P4S], 1u); } } }
        layer_barrier(bar);
        { LAUNDER_CTX(a); VB_LOAD(ldsp); const float* gate = c.mod + (size_t)l * NBT * 3072 + 2048;
          const float* atc = c.atab + (size_t)l * NBT * D; const float* atn = l + 1 < DEPTH ? c.atab + (size_t)(l + 1) * NBT * D : nullptr;
          const bf16_t* xai = (l & 1) ? c.xa2 : c.xa; bf16_t* xao = (l & 1) ? c.xa : c.xa2;
          const EpiP4 e4{gate, atc, atn, xai, xao, c.ssq, c.x_sample - (size_t)MPR * D, c.xb, l > 0};
          SchedP4 S; S.T.init(8, 4, 32, vr_, 8 * vx_); S.A = (const char*)c.mg; S.B = (const char*)(c.WoT + (size_t)l * D * D);
          if (l == 0) { EpiP4T<false, false> E{gate, atc, atn, xai, xao, c.ssq, c.x_prompt, c.xb}; gemm_phase(ldsp, D * 2, D * 2, D / BK, S, E); }
          else if (l + 1 < DEPTH) { EpiP4T<true, false> E{gate, atc, atn, xai, xao, c.ssq, c.x_prompt, c.xb}; gemm_phase(ldsp, D * 2, D * 2, D / BK, S, E); }
          else { EpiP4T<true, true> E{gate, atc, atn, xai, xao, c.ssq, c.x_prompt, c.xb}; gemm_phase(ldsp, D * 2, D * 2, D / BK, S, E); } }
        layer_barrier(bar);
    }
    ph_final(a, ldsp);
}

extern "C" void kernel_launch(void* const* d_in, const int* in_sizes, int n_in, void* d_out, int out_size, void* d_ws, size_t ws_size, hipStream_t stream) {
    static int grid_blocks = 0;
    if (grid_blocks == 0) {
        if (n_in != 22 || ws_size < WS_END) { fprintf(stderr, "kernel_launch: unexpected n_in %d or ws_size %zu < %zu\n", n_in, ws_size, (size_t)WS_END); grid_blocks = -1; return; }
        int dev = 0, cus = 0, per_cu = 0;
        (void)hipGetDevice(&dev); (void)hipDeviceGetAttribute(&cus, hipDeviceAttributeMultiprocessorCount, dev);
        if (hipFuncSetAttribute((const void*)mega_fwd, hipFuncAttributeMaxDynamicSharedMemorySize, LDS_BYTES) != hipSuccess) { fprintf(stderr, "kernel_launch: hipFuncSetAttribute failed\n"); grid_blocks = -1; return; }
        if (hipOccupancyMaxActiveBlocksPerMultiprocessor(&per_cu, (const void*)mega_fwd, NTHREADS, LDS_BYTES) != hipSuccess || per_cu < 1) { fprintf(stderr, "kernel_launch: occupancy query gave %d\n", per_cu); grid_blocks = -1; return; }
        if (cus < 256) { fprintf(stderr, "kernel_launch: this kernel is laid out for >= 256 CUs (found %d)\n", cus); grid_blocks = -1; return; }
        grid_blocks = 256;
        fprintf(stderr, "kernel_launch: cus %d per_cu %d grid %d\n", cus, per_cu, grid_blocks);
    }
    if (grid_blocks < 0) return;
    Args a{};
    for (int i = 0; i < 22; ++i) a.in[i] = (const float*)d_in[i];
    a.out = (float*)d_out; a.ws = (unsigned char*)d_ws;
    if (hipMemsetAsync((char*)d_ws + WS_CTL, 0, CTL_BYTES, stream) != hipSuccess) { fprintf(stderr, "kernel_launch: memset failed\n"); return; }
    void* args[] = {&a};
    hipError_t e = hipLaunchCooperativeKernel((const void*)mega_fwd, dim3(grid_blocks), dim3(NTHREADS), args, LDS_BYTES, stream);
    if (e != hipSuccess) fprintf(stderr, "kernel_launch: cooperative launch failed: %s (grid %d)\n", hipGetErrorString(e), grid_blocks);
}
```
